# Optimizing an MI355X kernel written in HIP

```python
import math
import jax, jax.numpy as jnp
from jax import lax
import numpy as np

D_MODEL = 1024
BATCH = 8
SEQ = 4096
DEPTH = 1

GRID_W = 64
CTX_LEN = 256
RMS_EPS = 1e-6
SHORT_CONV = 3
D_HYENA = 512
HYENA_ORDER = 2
HYENA_EMB_BANDS = 16
HYENA_EMB_DIM = 1 + 2 * HYENA_EMB_BANDS
HYENA_FILTER_HIDDEN = 64
HYENA_DECAY_TARGET = 1e-2
HYENA_MIN_DECAY = math.log(HYENA_DECAY_TARGET) / 1.5
HYENA_MAX_DECAY = math.log(HYENA_DECAY_TARGET) / 0.3
MLSTM_HEADS = 4
MLSTM_HEAD_DIM = 128
D_MLSTM = MLSTM_HEADS * MLSTM_HEAD_DIM
MLSTM_CHUNK = 128
N_BRANCHES = 2
HY_COLS = (HYENA_ORDER + 1) * D_HYENA
ML_COLS = 4 * D_MLSTM
GATE_COLS = 4 * MLSTM_HEADS
MERGE_COLS = N_BRANCHES * D_MODEL
ML_START = HY_COLS
GATE_START = ML_START + ML_COLS
MERGE_START = GATE_START + GATE_COLS
D_IN_PROJ = MERGE_START + MERGE_COLS
N_EXPERTS = 16
EC_CAPACITY_FACTOR = 2
D_FF_EXPERT = 2 * D_MODEL

kernel_name = 'hybrid_hyena_mlstm_ecmoe_dit_layer'


def rmsnorm(x, g):
    x32 = x.astype(jnp.float32)
    y = x32 * lax.rsqrt(jnp.mean(x32 * x32, axis=-1, keepdims=True) + RMS_EPS)
    return y.astype(x.dtype) * g


def modulate(h, shift, scale):
    return h * (1.0 + scale[:, None, :]) + shift[:, None, :]


def short_conv(u, w, rows, row_len):
    B, L, C = u.shape
    K = w.shape[0]
    ur = u.reshape(B, rows, row_len, C)
    up = jnp.pad(ur, ((0, 0), (0, 0), (K // 2, K // 2), (0, 0)))
    y = sum(up[:, :, j:j + row_len] * w[j] for j in range(K))
    return y.reshape(B, L, C)


def hyena_filters(L, w1, b1, w2, b2, w3):
    f32 = lambda a: a.astype(jnp.float32)
    t = jnp.linspace(0.0, 1.0, L, dtype=jnp.float32)[:, None]
    bands = jnp.linspace(1e-4, HYENA_EMB_BANDS - 1, HYENA_EMB_BANDS, dtype=jnp.float32)[None, :]
    ang = (2.0 * math.pi / L) * jnp.arange(L, dtype=jnp.float32)[:, None] * bands
    z = jnp.concatenate([t, jnp.cos(ang), jnp.sin(ang)], axis=-1)
    h = jnp.sin(z @ f32(w1) + f32(b1))
    h = jnp.sin(h @ f32(w2) + f32(b2))
    h = (h @ f32(w3)).reshape(L, HYENA_ORDER, 2, D_HYENA)
    deltas = jnp.abs(jnp.linspace(HYENA_MIN_DECAY, HYENA_MAX_DECAY, D_HYENA, dtype=jnp.float32))
    return h * jnp.exp(-t * deltas)[:, None, None, :]


def bidir_long_conv(u, h, skip):
    B, L, C = u.shape
    k = jnp.concatenate([h[:, 0], jnp.zeros((1, C), h.dtype), h[:0:-1, 1]], axis=0)
    U = jnp.fft.rfft(u.astype(jnp.float32), n=2 * L, axis=1)
    Kf = jnp.fft.rfft(k, n=2 * L, axis=0)
    y = jnp.fft.irfft(U * Kf[None], n=2 * L, axis=1)[:, :L]
    return (y + u.astype(jnp.float32) * skip.astype(jnp.float32)).astype(u.dtype)


def hyena_branch(hy_p, conv_w, f_w1, f_b1, f_w2, f_b2, f_w3, skip, rows, row_len):
    L = hy_p.shape[1]
    parts = jnp.split(short_conv(hy_p, conv_w, rows, row_len), HYENA_ORDER + 1, axis=-1)
    filt = hyena_filters(L, f_w1, f_b1, f_w2, f_b2, f_w3)
    z = parts[0]
    for o in range(HYENA_ORDER):
        z = parts[o + 1] * bidir_long_conv(z, filt[:, o], skip[o])
    return z


def mlstm_chunk_scan(q, k, v, log_i, log_f, state0):
    G, H, L, dh = q.shape
    nc = L // MLSTM_CHUNK

    def chunks(a):
        return jnp.moveaxis(a.reshape(G, H, nc, MLSTM_CHUNK, *a.shape[3:]), 2, 0)

    tril = jnp.tril(jnp.ones((MLSTM_CHUNK, MLSTM_CHUNK), dtype=bool))

    def step(carry, inp):
        C, n, m = carry
        qc, kc, vc, li, lf = inp
        b = jnp.cumsum(lf, axis=-1)
        logw = jnp.where(tril, b[..., :, None] - b[..., None, :] + li[..., None, :], -jnp.inf)
        m_inter = b + m[..., None]
        m_t = jnp.maximum(m_inter, logw.max(-1))
        a_intra = jnp.exp(logw - m_t[..., None]) * jnp.einsum('ghtd,ghsd->ghts', qc, kc)
        a_inter = jnp.exp(m_inter - m_t)
        num = jnp.einsum('ghts,ghse->ghte', a_intra, vc) + a_inter[..., None] * jnp.einsum('ghtd,ghde->ghte', qc, C)
        den = a_intra.sum(-1) + a_inter * jnp.einsum('ghtd,ghd->ght', qc, n)
        h = num / jnp.maximum(jnp.abs(den), jnp.exp(-m_t))[..., None]
        b_end = b[..., -1]
        logw_end = b_end[..., None] - b + li
        m_new = jnp.maximum(b_end + m, logw_end.max(-1))
        w_end = jnp.exp(logw_end - m_new[..., None])
        decay = jnp.exp(b_end + m - m_new)
        C_new = decay[..., None, None] * C + jnp.einsum('ghs,ghsd,ghse->ghde', w_end, kc, vc)
        n_new = decay[..., None] * n + jnp.einsum('ghs,ghsd->ghd', w_end, kc)
        return (C_new, n_new, m_new), h

    state, hs = lax.scan(step, state0, (chunks(q), chunks(k), chunks(v), chunks(log_i), chunks(log_f)))
    return jnp.moveaxis(hs, 0, 2).reshape(G, H, L, dh), state


def mlstm_zero_state(batch):
    g = 2 * batch
    return (jnp.zeros((g, MLSTM_HEADS, MLSTM_HEAD_DIM, MLSTM_HEAD_DIM), jnp.float32),
            jnp.zeros((g, MLSTM_HEADS, MLSTM_HEAD_DIM), jnp.float32),
            jnp.zeros((g, MLSTM_HEADS), jnp.float32))


def mlstm_branch(ml_p, gate_p, conv_w, norm_g, rows, row_len, state0):
    B, L, _ = ml_p.shape
    q_pre, k_pre, v, o = jnp.split(ml_p, 4, axis=-1)
    qk = jax.nn.silu(short_conv(jnp.concatenate([q_pre, k_pre], axis=-1), conv_w, rows, row_len))
    q, k = jnp.split(qk, 2, axis=-1)

    def heads(a):
        return a.reshape(B, L, MLSTM_HEADS, MLSTM_HEAD_DIM).transpose(0, 2, 1, 3).astype(jnp.float32)

    q = heads(q) * (MLSTM_HEAD_DIM ** -0.5)
    k = heads(k)
    v = heads(v)
    g = gate_p.astype(jnp.float32).reshape(B, L, 4, MLSTM_HEADS).transpose(2, 0, 3, 1)
    i_f, f_f, i_b, f_b = g[0], g[1], g[2], g[3]
    flip = lambda a: jnp.flip(a, axis=2)
    q2 = jnp.concatenate([q, flip(q)], axis=0)
    k2 = jnp.concatenate([k, flip(k)], axis=0)
    v2 = jnp.concatenate([v, flip(v)], axis=0)
    log_i = jnp.concatenate([i_f, flip(i_b)], axis=0)
    log_f = jax.nn.log_sigmoid(jnp.concatenate([f_f, flip(f_b)], axis=0))
    h2, state = mlstm_chunk_scan(q2, k2, v2, log_i, log_f, state0)
    h = h2[:B] + flip(h2[B:])
    h = h * lax.rsqrt(jnp.mean(h * h, axis=-1, keepdims=True) + RMS_EPS)
    h = h.transpose(0, 2, 1, 3).reshape(B, L, D_MLSTM).astype(ml_p.dtype) * norm_g
    return h * jax.nn.sigmoid(o), state


def token_mixer(h, w_in, b_in, hy_conv, hy_f_w1, hy_f_b1, hy_f_w2, hy_f_b2, hy_f_w3, hy_skip,
                ml_conv, ml_norm_g, w_branch_hy, w_branch_ml, w_out, rows, row_len, state0):
    p = h @ w_in + b_in
    y_a = hyena_branch(p[..., :ML_START], hy_conv, hy_f_w1, hy_f_b1, hy_f_w2, hy_f_b2, hy_f_w3, hy_skip, rows, row_len)
    y_b, state = mlstm_branch(p[..., ML_START:GATE_START], p[..., GATE_START:MERGE_START], ml_conv, ml_norm_g, rows, row_len, state0)
    g_a, g_b = jnp.split(jax.nn.sigmoid(p[..., MERGE_START:]), N_BRANCHES, axis=-1)
    y = (g_a * (y_a @ w_branch_hy) + g_b * (y_b @ w_branch_ml)) @ w_out
    return y, state


def expert_choice_ffn(h, w_router, w1, w3, w2):
    B, N, D = h.shape
    cap = EC_CAPACITY_FACTOR * N // N_EXPERTS
    aff = jax.nn.softmax((h @ w_router).astype(jnp.float32), axis=-1)
    gate, idx = lax.top_k(jnp.swapaxes(aff, 1, 2), cap)
    bidx = jnp.arange(B)[:, None, None]
    xg = h[bidx, idx]
    a = jnp.einsum('becd,edf->becf', xg, w1)
    b = jnp.einsum('becd,edf->becf', xg, w3)
    ye = jnp.einsum('becf,efd->becd', jax.nn.silu(a) * b, w2) * gate[..., None].astype(h.dtype)
    return jnp.zeros_like(h).at[bidx, idx].add(ye)


def setup_inputs(seed: int = 0) -> dict:
    key = jax.random.key(seed)
    ks = jax.random.split(key, 32)
    D = D_MODEL
    nrm = lambda k, shape, scale: jax.random.normal(k, shape, jnp.float32) * scale
    forget_offset = np.zeros((D_IN_PROJ,), np.float32)
    forget_offset[GATE_START + MLSTM_HEADS:GATE_START + 2 * MLSTM_HEADS] = np.linspace(3.0, 6.0, MLSTM_HEADS)
    forget_offset[GATE_START + 3 * MLSTM_HEADS:GATE_START + 4 * MLSTM_HEADS] = np.linspace(3.0, 6.0, MLSTM_HEADS)
    return {
        'x': nrm(ks[0], (BATCH, SEQ, D), 1.0),
        'c': nrm(ks[1], (BATCH, D), 1.0),
        'ctx': nrm(ks[2], (BATCH, CTX_LEN, D), 1.0),
        'c_ctx': nrm(ks[3], (D,), 1.0),
        'w_ada': nrm(ks[4], (DEPTH, D, 6 * D), 0.5 * D ** -0.5),
        'b_ada': nrm(ks[5], (DEPTH, 6 * D), 0.02),
        'norm_mix_g': 1.0 + nrm(ks[6], (DEPTH, D), 0.02),
        'norm_ffn_g': 1.0 + nrm(ks[7], (DEPTH, D), 0.02),
        'w_in': nrm(ks[8], (DEPTH, D, D_IN_PROJ), D ** -0.5),
        'b_in': nrm(ks[9], (DEPTH, D_IN_PROJ), 0.02) + jnp.asarray(forget_offset),
        'hy_conv': nrm(ks[10], (DEPTH, SHORT_CONV, HY_COLS), 0.5),
        'hy_f_w1': nrm(ks[11], (DEPTH, HYENA_EMB_DIM, HYENA_FILTER_HIDDEN), HYENA_EMB_DIM ** -0.5),
        'hy_f_b1': nrm(ks[12], (DEPTH, HYENA_FILTER_HIDDEN), 0.1),
        'hy_f_w2': nrm(ks[13], (DEPTH, HYENA_FILTER_HIDDEN, HYENA_FILTER_HIDDEN), HYENA_FILTER_HIDDEN ** -0.5),
        'hy_f_b2': nrm(ks[14], (DEPTH, HYENA_FILTER_HIDDEN), 0.1),
        'hy_f_w3': nrm(ks[15], (DEPTH, HYENA_FILTER_HIDDEN, HYENA_ORDER * 2 * D_HYENA), 0.03 * HYENA_FILTER_HIDDEN ** -0.5),
        'hy_skip': nrm(ks[16], (DEPTH, HYENA_ORDER, D_HYENA), 1.0),
        'ml_conv': nrm(ks[17], (DEPTH, SHORT_CONV, 2 * D_MLSTM), 0.5),
        'ml_norm_g': 1.0 + nrm(ks[18], (DEPTH, D_MLSTM), 0.02),
        'w_branch_hy': nrm(ks[19], (DEPTH, D_HYENA, D), D_HYENA ** -0.5),
        'w_branch_ml': nrm(ks[20], (DEPTH, D_MLSTM, D), D_MLSTM ** -0.5),
        'w_out': nrm(ks[21], (DEPTH, D, D), D ** -0.5),
        'w_router': nrm(ks[22], (DEPTH, D, N_EXPERTS), D ** -0.5),
        'w_exp1': nrm(ks[23], (DEPTH, N_EXPERTS, D, D_FF_EXPERT), D ** -0.5),
        'w_exp3': nrm(ks[24], (DEPTH, N_EXPERTS, D, D_FF_EXPERT), D ** -0.5),
        'w_exp2': nrm(ks[25], (DEPTH, N_EXPERTS, D_FF_EXPERT, D), D_FF_EXPERT ** -0.5),
        'final_norm_g': 1.0 + nrm(ks[26], (D,), 0.02),
    }


def reference(x, c, ctx, c_ctx, w_ada, b_ada, norm_mix_g, norm_ffn_g, w_in, b_in,
              hy_conv, hy_f_w1, hy_f_b1, hy_f_w2, hy_f_b2, hy_f_w3, hy_skip,
              ml_conv, ml_norm_g, w_branch_hy, w_branch_ml, w_out,
              w_router, w_exp1, w_exp3, w_exp2, final_norm_g):
    B, L, _ = x.shape
    rows = L // GRID_W
    Lc = ctx.shape[1]
    s_lat = jax.nn.silu(c)
    s_ctx = jax.nn.silu(c_ctx)[None, :]
    for l in range(DEPTH):
        last = l == DEPTH - 1
        ada_x = jnp.split(s_lat @ w_ada[l] + b_ada[l], 6, axis=-1)
        ada_c = jnp.split(s_ctx @ w_ada[l] + b_ada[l], 6, axis=-1)
        mix_params = (w_in[l], b_in[l], hy_conv[l], hy_f_w1[l], hy_f_b1[l], hy_f_w2[l], hy_f_b2[l], hy_f_w3[l],
                      hy_skip[l], ml_conv[l], ml_norm_g[l], w_branch_hy[l], w_branch_ml[l], w_out[l])
        hc = modulate(rmsnorm(ctx, norm_mix_g[l]), ada_c[0], ada_c[1])
        if last:
            pc = hc @ w_in[l][:, ML_START:MERGE_START] + b_in[l][ML_START:MERGE_START]
            _, ctx_state = mlstm_branch(pc[..., :ML_COLS], pc[..., ML_COLS:], ml_conv[l], ml_norm_g[l],
                                        1, Lc, mlstm_zero_state(B))
        else:
            yc, ctx_state = token_mixer(hc, *mix_params, 1, Lc, mlstm_zero_state(B))
            ctx = ctx + ada_c[2][:, None, :] * yc
            hc2 = modulate(rmsnorm(ctx, norm_ffn_g[l]), ada_c[3], ada_c[4])
            ctx = ctx + ada_c[5][:, None, :] * expert_choice_ffn(hc2, w_router[l], w_exp1[l], w_exp3[l], w_exp2[l])
        hx = modulate(rmsnorm(x, norm_mix_g[l]), ada_x[0], ada_x[1])
        yx, _ = token_mixer(hx, *mix_params, rows, GRID_W, ctx_state)
        x = x + ada_x[2][:, None, :] * yx
        hx2 = modulate(rmsnorm(x, norm_ffn_g[l]), ada_x[3], ada_x[4])
        x = x + ada_x[5][:, None, :] * expert_choice_ffn(hx2, w_router[l], w_exp1[l], w_exp3[l], w_exp2[l])
    return rmsnorm(x, final_norm_g)
```

```cpp
#include <hip/hip_runtime.h>
#include <hip/hip_cooperative_groups.h>
#include <cstdio>
#include <cstdint>
#include <cstring>
namespace cg = cooperative_groups;

#ifndef N_LAUNCH_MODE
#define N_LAUNCH_MODE 1
#endif

#define LAS __attribute__((address_space(3)))
typedef unsigned short bf16_t;
typedef short bf16x8 __attribute__((ext_vector_type(8)));
typedef float f32x4 __attribute__((ext_vector_type(4)));
typedef float f32x16 __attribute__((ext_vector_type(16)));
typedef unsigned u32x4 __attribute__((ext_vector_type(4)));
typedef unsigned u32x2 __attribute__((ext_vector_type(2)));

constexpr int NTHR = 512;
constexpr int BATCH = 8, SEQ = 4096, DM = 1024, CTXL = 256;
constexpr int MX = BATCH * SEQ;
constexpr int MC = BATCH * CTXL;
constexpr int DIN = 5648, NPROJ = 5632, GATE0 = 3584, MERGE0 = 3600;
constexpr int NE = 16, CAP = 512, DFF = 2048;
constexpr int NCHK = 34;
constexpr float RMS_EPS = 1e-6f;

constexpr size_t MiB = 1u << 20;
constexpr size_t WS_ADAP = 0;
constexpr size_t WS_ADA = 7 * MiB;
constexpr size_t WS_GATES = 8 * MiB;
constexpr size_t WS_KREV = 11 * MiB;
constexpr size_t WS_BL = 27 * MiB;
constexpr size_t WS_MST = 27 * MiB + 64 * 1024;
constexpr size_t WS_NLOC = 28 * MiB;
constexpr size_t WS_NST = 30 * MiB;
constexpr size_t WS_WIN = 32 * MiB;
constexpr size_t WS_WBH = 43 * MiB;
constexpr size_t WS_WBM = 44 * MiB;
constexpr size_t WS_WOUT = 45 * MiB;
constexpr size_t WS_HX = 48 * MiB;
constexpr size_t WS_PLOC = 48 * MiB;
constexpr size_t WS_PCM = 116 * MiB;
constexpr size_t WS_PML = 212 * MiB;
constexpr size_t WS_PC = 340 * MiB;
constexpr size_t WS_Z1 = 344 * MiB;
constexpr size_t WS_YA = 376 * MiB;
constexpr size_t WS_YB = 408 * MiB;
constexpr size_t WS_CST = 440 * MiB;
constexpr size_t WS_Z = 504 * MiB;
constexpr size_t WS_AFF = 0;
constexpr size_t WS_SLOT = 2 * MiB;
constexpr size_t WS_SIDX = 4 * MiB;
constexpr size_t WS_SGATE = 4 * MiB + 512 * 1024;
constexpr size_t WS_HX2 = 48 * MiB;
constexpr size_t WS_W13 = 112 * MiB;
constexpr size_t WS_W2A = 176 * MiB;
constexpr size_t WS_XG = 208 * MiB;
constexpr size_t WS_ACT = 272 * MiB;
constexpr size_t WS_YE = 400 * MiB;
constexpr size_t WS_W2B = 528 * MiB;
constexpr size_t WS_END = 560 * MiB;

constexpr int LDS_BYTES = 147456;

__device__ __forceinline__ unsigned f2bf(float f) { unsigned u = __builtin_bit_cast(unsigned, f); return (u + 0x7fffu + ((u >> 16) & 1u)) >> 16; }
__device__ __forceinline__ unsigned pk2(float lo, float hi) { return f2bf(lo) | (f2bf(hi) << 16); }
__device__ __forceinline__ float bf2f(unsigned short b) { return __builtin_bit_cast(float, ((unsigned)b) << 16); }
__device__ __forceinline__ float bflo(unsigned w) { return __builtin_bit_cast(float, w << 16); }
__device__ __forceinline__ float bfhi(unsigned w) { return __builtin_bit_cast(float, w & 0xffff0000u); }
__device__ __forceinline__ float sigm(float x) { return 1.f / (1.f + __expf(-x)); }
__device__ __forceinline__ float siluf(float x) { return x / (1.f + __expf(-x)); }
__device__ __forceinline__ float logsig(float x) { return x >= 0.f ? -log1pf(expf(-x)) : x - log1pf(expf(x)); }
__device__ __forceinline__ float wave_sum(float v) {
#pragma unroll
    for (int o = 1; o < 64; o <<= 1) v += __shfl_xor(v, o);
    return v;
}
#define LDS_WAIT() asm volatile("s_waitcnt lgkmcnt(0)" ::: "memory")

struct Params {
    const float* in[27];
    float* out;
    unsigned char* ws;
    int ph_lo, ph_hi;
};

namespace pg8 {
constexpr int BM = 256, BK = 64, HALF = 128, HTB = HALF * BK * 2, STAGE_BYTES = 8 * HTB;
__device__ __forceinline__ int lds_byte(int r, int c) { const int st = (r >> 4) * 2 + (c >> 5), rr = r & 15, cc = c & 31, ob = rr * 64 + cc * 2; return st * 1024 + (ob ^ (((ob >> 9) & 1) << 5)); }
__device__ __forceinline__ void stage_rc(int b, int& R, int& C) { const int st = b / 1024, sb = b % 1024, swz = sb ^ (((sb >> 9) & 1) << 5); R = (st >> 1) * 16 + swz / 64; C = (st & 1) * 32 + (swz % 64) / 2; }
__device__ __forceinline__ int perm32(int rho) { const int n = rho >> 4, i = rho & 15; return 8 * (i >> 2) + 4 * n + (i & 3); }
__device__ __forceinline__ unsigned cvt_pk_bf16(float lo, float hi) { unsigned r; asm volatile("v_cvt_pk_bf16_f32 %0, %1, %2" : "=v"(r) : "v"(lo), "v"(hi)); return r; }

struct Unit { const char* A; const char* B; int pm, pn, aux; };

struct SchedGrid {
    const char* A; const char* B; size_t tstepA, tstepB; int nM, nN, pm0, pn0, G, c;
    int xN, xPm0, xPn0, xCnt;
    __device__ bool next(int i, Unit& u) const {
        const long L = (long)i * G + c; const int nwg = nM * nN;
        if (L >= nwg + xCnt) return false;
        if (L >= nwg) { const int q = (int)L - nwg; u.pm = xPm0 + q / xN; u.pn = xPn0 + q % xN; u.aux = 1; }
        else {
            int wgid = (int)L; { const int q = nwg / 8, r = nwg % 8, xcd = wgid % 8, off = wgid / 8; wgid = (xcd < r ? xcd * (q + 1) : r * (q + 1) + (xcd - r) * q) + off; }
            const int nig = 8 * nN, gid = wgid / nig, fm = gid * 8, gsz = (nM - fm) < 8 ? (nM - fm) : 8;
            u.pm = pm0 + fm + ((wgid % nig) % gsz); u.pn = pn0 + (wgid % nig) / gsz; u.aux = 0;
        }
        u.A = A + (size_t)u.pm * tstepA; u.B = B + (size_t)u.pn * tstepB; return true;
    }
};
struct SchedMoe {
    const char* A; const char* B; size_t tstepA, tstepB, estepA, estepB; int nM, nN, G, c;
    __device__ bool next(int i, Unit& u) const {
        const long L = (long)i * G + c; const int e = (int)(L % 8); const long t = L / 8;
        if (t >= (long)nM * nN) return false;
        u.pm = (int)(t / nN); u.pn = (int)(t % nN); u.aux = e;
        u.A = A + (size_t)e * estepA + (size_t)u.pm * tstepA; u.B = B + (size_t)e * estepB + (size_t)u.pn * tstepB; return true;
    }
};

template <class Epi, class Sched, bool NORMAL>
__device__ __forceinline__ void gemm_phase(LAS unsigned char* lds, const int K, const unsigned lda, const unsigned ldb, const Sched& S, const Epi& E) {
    const int tid = threadIdx.x, wid = __builtin_amdgcn_readfirstlane(tid >> 6), lane = tid & 63, wr = wid >> 2, wc = wid & 3, fr = lane & 15, fq = lane >> 4;
    const int nt = K / BK;
    unsigned voffA[2], voffB[2];
#pragma unroll
    for (int i = 0; i < 2; ++i) { int R, C; stage_rc(tid * 16 + i * 8192, R, C); const int Rb = Epi::PERM ? ((R & ~31) + perm32(R & 31)) : R;
        voffA[i] = (unsigned)R * lda + (unsigned)C * 2u; voffB[i] = (unsigned)Rb * ldb + (unsigned)C * 2u; }
    const size_t kstep = (size_t)(BK * 2);
    const size_t hstepA = (size_t)HALF * lda, hstepB = (size_t)HALF * ldb;
    const unsigned ldsw = (unsigned)wid * 1024u;
    const int aoff = lds_byte(wr * 64 + fr, fq * 8), boff = lds_byte(wc * 32 + fr, fq * 8);
#define PG8_SA(b, h) (((b) * 2 + (h)) * HTB)
#define PG8_SB(b, h) ((4 + (b) * 2 + (h)) * HTB)
#define PG8_STAGE(bufoff, gbase, voff) do { _Pragma("unroll") for (int _i = 0; _i < 2; ++_i) \
        __builtin_amdgcn_global_load_lds((const unsigned*)((const char*)(gbase) + (voff)[_i]), (LAS unsigned*)(lds + (bufoff) + ldsw + _i * 8192), 16, 0, 0); } while (0)
#define PG8_LDA(dst, b, h) do { _Pragma("unroll") for (int m = 0; m < 4; ++m) _Pragma("unroll") for (int k = 0; k < 2; ++k) dst[m][k] = *(const LAS bf16x8*)(lds + PG8_SA(b, h) + aoff + m * 2048 + k * 1024); } while (0)
#define PG8_LDB(dst, b, h) do { _Pragma("unroll") for (int n = 0; n < 2; ++n) _Pragma("unroll") for (int k = 0; k < 2; ++k) dst[n][k] = *(const LAS bf16x8*)(lds + PG8_SB(b, h) + boff + n * 2048 + k * 1024); } while (0)
#define PG8_MMA(ai, bj, At, Bt) do { __builtin_amdgcn_s_setprio(1); _Pragma("unroll") for (int m = 0; m < 4; ++m) _Pragma("unroll") for (int n = 0; n < 2; ++n) _Pragma("unroll") for (int k = 0; k < 2; ++k) \
        acc[ai][bj][m][n] = NORMAL ? __builtin_amdgcn_mfma_f32_16x16x32_bf16(At[m][k], Bt[n][k], acc[ai][bj][m][n], 0, 0, 0) \
                                   : __builtin_amdgcn_mfma_f32_16x16x32_bf16(Bt[n][k], At[m][k], acc[ai][bj][m][n], 0, 0, 0); __builtin_amdgcn_s_setprio(0); } while (0)
#define PG8_WAIT_V(n) asm volatile("s_waitcnt vmcnt(" #n ")" ::: "memory")
#define PG8_WAIT_L(n) asm volatile("s_waitcnt lgkmcnt(" #n ")" ::: "memory")
#define PG8_BAR __builtin_amdgcn_s_barrier()
#define PG8_SCHED __builtin_amdgcn_sched_barrier(0)
    Unit cur, nxt; int ui = 0;
    if (!S.next(0, cur)) return;
    f32x4 acc[2][2][4][2];
#pragma unroll
    for (int a = 0; a < 2; ++a)
#pragma unroll
        for (int b = 0; b < 2; ++b)
#pragma unroll
            for (int m = 0; m < 4; ++m)
#pragma unroll
                for (int n = 0; n < 2; ++n) acc[a][b][m][n] = (f32x4){0.f, 0.f, 0.f, 0.f};
    bf16x8 At[4][2], B0[2][2], B1[2][2];
    const char* cA = cur.A; const char* cB = cur.B;
    PG8_STAGE(PG8_SB(0, 0), cB, voffB); PG8_STAGE(PG8_SB(0, 1), cB + hstepB, voffB); PG8_STAGE(PG8_SA(0, 0), cA, voffA); PG8_STAGE(PG8_SA(0, 1), cA + hstepA, voffA);
    if (wr == 1) PG8_BAR;
    PG8_WAIT_V(2); PG8_BAR;
    PG8_STAGE(PG8_SB(1, 0), cB + kstep, voffB); PG8_STAGE(PG8_SA(1, 0), cA + kstep, voffA); PG8_STAGE(PG8_SB(1, 1), cB + hstepB + kstep, voffB);
    PG8_WAIT_V(6); PG8_BAR;
    for (;;) {
        const bool has_next = S.next(ui + 1, nxt);
        const char* nA = has_next ? nxt.A : cA; const char* nB = has_next ? nxt.B : cB;
        for (int t = 0; t < nt; t += 2) {
            const bool last = (t == nt - 2);
            const char* a1 = cA + (size_t)(t + 1) * kstep;
            const char* a2 = last ? nA : cA + (size_t)(t + 2) * kstep; const char* b2 = last ? nB : cB + (size_t)(t + 2) * kstep;
            const char* a3 = a2 + kstep; const char* b3 = b2 + kstep;
            PG8_LDB(B0, 0, 0); PG8_LDB(B1, 0, 1); PG8_SCHED; PG8_LDA(At, 0, 0); PG8_STAGE(PG8_SA(1, 1), a1 + hstepA, voffA);
            PG8_WAIT_V(8); PG8_WAIT_L(0); PG8_BAR; PG8_MMA(0, 0, At, B0); PG8_MMA(0, 1, At, B1); PG8_BAR; PG8_SCHED;
            PG8_LDA(At, 0, 1); PG8_STAGE(PG8_SB(0, 0), b2, voffB); PG8_STAGE(PG8_SB(0, 1), b2 + hstepB, voffB); PG8_STAGE(PG8_SA(0, 0), a2, voffA);
            PG8_WAIT_V(8); PG8_WAIT_L(0); PG8_BAR; PG8_MMA(1, 0, At, B0); PG8_MMA(1, 1, At, B1); PG8_BAR; PG8_SCHED;
            PG8_LDB(B0, 1, 0); PG8_LDB(B1, 1, 1); PG8_SCHED; PG8_LDA(At, 1, 0); PG8_STAGE(PG8_SA(0, 1), a2 + hstepA, voffA);
            PG8_WAIT_V(8); PG8_WAIT_L(0); PG8_BAR; PG8_MMA(0, 0, At, B0); PG8_MMA(0, 1, At, B1); PG8_BAR; PG8_SCHED;
            PG8_LDA(At, 1, 1); PG8_STAGE(PG8_SB(1, 0), b3, voffB); PG8_STAGE(PG8_SB(1, 1), b3 + hstepB, voffB); PG8_STAGE(PG8_SA(1, 0), a3, voffA);
            PG8_WAIT_V(8); PG8_WAIT_L(0); PG8_BAR; PG8_MMA(1, 0, At, B0); PG8_MMA(1, 1, At, B1); PG8_BAR; PG8_SCHED;
        }
        if (wr == 0) PG8_BAR;
        E(acc, cur, wr, wc, fr, fq);
        if (!has_next) break;
#pragma unroll
        for (int a = 0; a < 2; ++a)
#pragma unroll
            for (int b = 0; b < 2; ++b)
#pragma unroll
                for (int m = 0; m < 4; ++m)
#pragma unroll
                    for (int n = 0; n < 2; ++n) acc[a][b][m][n] = (f32x4){0.f, 0.f, 0.f, 0.f};
        cur = nxt; cA = nA; cB = nB; ++ui;
        if (wr == 1) PG8_BAR;
    }
    PG8_WAIT_V(0);
    PG8_BAR;
#undef PG8_SA
#undef PG8_SB
#undef PG8_STAGE
#undef PG8_LDA
#undef PG8_LDB
#undef PG8_MMA
#undef PG8_WAIT_V
#undef PG8_WAIT_L
#undef PG8_BAR
#undef PG8_SCHED
}


struct EpiHyCM {
    static constexpr bool PERM = false;
    bf16_t* pcm; const float* bias;
    __device__ __forceinline__ void operator()(const f32x4 (&acc)[2][2][4][2], const Unit& u, int wr, int wc, int fr, int fq) const {
#pragma unroll
        for (int bj = 0; bj < 2; ++bj)
#pragma unroll
            for (int n = 0; n < 2; ++n) {
                const int c = u.pn * BM + bj * HALF + wc * 32 + n * 16 + fr; const float bv = bias[c];
#pragma unroll
                for (int ai = 0; ai < 2; ++ai)
#pragma unroll
                    for (int m = 0; m < 4; ++m) {
                        const int r = u.pm * BM + ai * HALF + wr * 64 + m * 16 + 4 * fq; const f32x4 v = acc[ai][bj][m][n] + bv;
                        u32x2 w; w.x = cvt_pk_bf16(v[0], v[1]); w.y = cvt_pk_bf16(v[2], v[3]);
                        *(u32x2*)(pcm + (size_t)c * MX + r) = w; }
                asm volatile("" ::: "memory");
            }
    }
};

struct EpiIn2 {
    static constexpr bool PERM = true;
    bf16_t* pml; bf16_t* pmg; bf16_t* pc; const float* bias;
    __device__ __forceinline__ void operator()(const f32x4 (&acc)[2][2][4][2], const Unit& u, int wr, int wc, int fr, int fq) const {
        const int colt = u.pn * BM; bf16_t* base; int ldc, cbase, bofs = 0, row0 = u.pm * BM; bool sg = false;
        if (u.aux) { base = pc; ldc = 1024; cbase = colt - 2048; row0 -= MX; }
        else if (colt < GATE0) { base = pml; ldc = 2048; cbase = colt - 1536; }
        else { base = pmg; ldc = 2048; cbase = colt - GATE0; bofs = 16; sg = true; }
        const int col0 = cbase + wc * 32 + 8 * fq, bcol0 = colt + bofs + wc * 32 + 8 * fq;
        f32x4 bv[2][2];
#pragma unroll
        for (int bj = 0; bj < 2; ++bj)
#pragma unroll
            for (int n = 0; n < 2; ++n) bv[bj][n] = *(const f32x4*)(bias + bcol0 + bj * HALF + 4 * n);
#pragma unroll
        for (int ai = 0; ai < 2; ++ai)
#pragma unroll
            for (int m = 0; m < 4; ++m) { bf16_t* rowp = base + (size_t)(row0 + wr * 64 + fr + ai * HALF + m * 16) * ldc + col0;
#pragma unroll
                for (int bj = 0; bj < 2; ++bj) { f32x4 v0 = acc[ai][bj][m][0] + bv[bj][0], v1 = acc[ai][bj][m][1] + bv[bj][1];
                    if (sg) {
#pragma unroll
                        for (int j = 0; j < 4; ++j) { v0[j] = sigm(v0[j]); v1[j] = sigm(v1[j]); } }
                    u32x4 w; w.x = cvt_pk_bf16(v0[0], v0[1]); w.y = cvt_pk_bf16(v0[2], v0[3]); w.z = cvt_pk_bf16(v1[0], v1[1]); w.w = cvt_pk_bf16(v1[2], v1[3]);
                    *(u32x4*)(rowp + bj * HALF) = w; }
                asm volatile("" ::: "memory"); }
    }
};

template <int MODE  > struct EpiMerge {
    static constexpr bool PERM = true;
    bf16_t* Z; const bf16_t* pmg;
    __device__ __forceinline__ void operator()(const f32x4 (&acc)[2][2][4][2], const Unit& u, int wr, int wc, int fr, int fq) const {
        const int row0 = u.pm * BM + wr * 64 + fr, col0 = u.pn * BM + wc * 32 + 8 * fq;
#pragma unroll
        for (int ai = 0; ai < 2; ++ai)
#pragma unroll
            for (int m = 0; m < 4; ++m) { const size_t row = (size_t)(row0 + ai * HALF + m * 16);
#pragma unroll
                for (int bj = 0; bj < 2; ++bj) {
                    const u32x4 g = *(const u32x4*)(pmg + row * 2048 + (MODE ? 1024 : 0) + col0 + bj * HALF);
                    f32x4 v0 = acc[ai][bj][m][0], v1 = acc[ai][bj][m][1];
                    v0[0] *= bflo(g.x); v0[1] *= bfhi(g.x); v0[2] *= bflo(g.y); v0[3] *= bfhi(g.y);
                    v1[0] *= bflo(g.z); v1[1] *= bfhi(g.z); v1[2] *= bflo(g.w); v1[3] *= bfhi(g.w);
                    bf16_t* zp = Z + row * 1024 + col0 + bj * HALF;
                    if (MODE) { const u32x4 z = *(const u32x4*)zp;
                        v0[0] += bflo(z.x); v0[1] += bfhi(z.x); v0[2] += bflo(z.y); v0[3] += bfhi(z.y);
                        v1[0] += bflo(z.z); v1[1] += bfhi(z.z); v1[2] += bflo(z.w); v1[3] += bfhi(z.w); }
                    u32x4 w; w.x = cvt_pk_bf16(v0[0], v0[1]); w.y = cvt_pk_bf16(v0[2], v0[3]); w.z = cvt_pk_bf16(v1[0], v1[1]); w.w = cvt_pk_bf16(v1[2], v1[3]);
                    *(u32x4*)zp = w; }
                asm volatile("" ::: "memory"); }
    }
};

struct EpiOut {
    static constexpr bool PERM = false;
    const float* x; float* xmid; const float* ada;
    __device__ __forceinline__ void operator()(const f32x4 (&acc)[2][2][4][2], const Unit& u, int wr, int wc, int fr, int fq) const {
        const int row0 = u.pm * BM + wr * 64 + fr, col0 = u.pn * BM + wc * 32 + 4 * fq;
        const int b = (u.pm * BM) / SEQ;
        f32x4 gv[2][2];
#pragma unroll
        for (int bj = 0; bj < 2; ++bj)
#pragma unroll
            for (int n = 0; n < 2; ++n) gv[bj][n] = *(const f32x4*)(ada + (size_t)b * 6144 + 2048 + col0 + bj * HALF + n * 16);
#pragma unroll
        for (int ai = 0; ai < 2; ++ai)
#pragma unroll
            for (int m = 0; m < 4; ++m) { const size_t off = (size_t)(row0 + ai * HALF + m * 16) * DM + col0;
#pragma unroll
                for (int bj = 0; bj < 2; ++bj)
#pragma unroll
                    for (int n = 0; n < 2; ++n) { const f32x4 xv = *(const f32x4*)(x + off + bj * HALF + n * 16);
                        *(f32x4*)(xmid + off + bj * HALF + n * 16) = xv + gv[bj][n] * acc[ai][bj][m][n]; }
                asm volatile("" ::: "memory"); }
    }
};

struct EpiMoe1 {
    static constexpr bool PERM = true;
    bf16_t* act;
    __device__ __forceinline__ void operator()(const f32x4 (&acc)[2][2][4][2], const Unit& u, int wr, int wc, int fr, int fq) const {
        const int row0 = u.aux * 4096 + u.pm * BM + wr * 64 + fr, col0 = (u.pn * BM + wc * 32) / 2 + 4 * fq;
#pragma unroll
        for (int ai = 0; ai < 2; ++ai)
#pragma unroll
            for (int m = 0; m < 4; ++m) { bf16_t* rowp = act + (size_t)(row0 + ai * HALF + m * 16) * DFF + col0;
#pragma unroll
                for (int bj = 0; bj < 2; ++bj) { const f32x4 v0 = acc[ai][bj][m][0], v1 = acc[ai][bj][m][1];
                    u32x2 w; w.x = cvt_pk_bf16(siluf(v0[0]) * v0[1], siluf(v0[2]) * v0[3]); w.y = cvt_pk_bf16(siluf(v1[0]) * v1[1], siluf(v1[2]) * v1[3]);
                    *(u32x2*)(rowp + bj * (HALF / 2)) = w; }
                asm volatile("" ::: "memory"); }
    }
};

struct EpiMoe2 {
    static constexpr bool PERM = true;
    bf16_t* ye; const float* sgate; int e0;
    __device__ __forceinline__ void operator()(const f32x4 (&acc)[2][2][4][2], const Unit& u, int wr, int wc, int fr, int fq) const {
        const int e = e0 + u.aux, col0 = u.pn * BM + wc * 32 + 8 * fq;
#pragma unroll
        for (int ai = 0; ai < 2; ++ai)
#pragma unroll
            for (int m = 0; m < 4; ++m) { const int rr = u.pm * BM + wr * 64 + fr + ai * HALF + m * 16;
                const float g = sgate[((rr >> 9) * NE + e) * CAP + (rr & 511)];
                bf16_t* rowp = ye + ((size_t)e * 4096 + rr) * DM + col0;
#pragma unroll
                for (int bj = 0; bj < 2; ++bj) { const f32x4 v0 = acc[ai][bj][m][0] * g, v1 = acc[ai][bj][m][1] * g;
                    u32x4 w; w.x = cvt_pk_bf16(v0[0], v0[1]); w.y = cvt_pk_bf16(v0[2], v0[3]); w.z = cvt_pk_bf16(v1[0], v1[1]); w.w = cvt_pk_bf16(v1[2], v1[3]);
                    *(u32x4*)(rowp + bj * HALF) = w; }
                asm volatile("" ::: "memory"); }
    }
};
}

struct Ctx {
    LAS unsigned char* lds;
    int tid, lane, wave, bid, G;
};

__device__ __forceinline__ void transpose_item(const float* W, int ldw, int K, int ncol0, bf16_t* WT, int dst_row0, int rmul, LAS float* scr, int kb, int nb, int lane) {
    const int k0 = 64 * kb, n0 = 32 * nb;
#pragma unroll 8
    for (int i = 0; i < 32; ++i) { const int kk = 2 * i + (lane >> 5); scr[kk * 33 + (lane & 31)] = W[(size_t)(k0 + kk) * ldw + ncol0 + n0 + (lane & 31)]; }
    LDS_WAIT();
    const int c = lane & 7;
#pragma unroll
    for (int j = 0; j < 4; ++j) { const int n = (lane >> 3) + 8 * j; const LAS float* s = scr + (8 * c) * 33 + n;
        u32x4 o; o.x = pk2(s[0 * 33], s[1 * 33]); o.y = pk2(s[2 * 33], s[3 * 33]); o.z = pk2(s[4 * 33], s[5 * 33]); o.w = pk2(s[6 * 33], s[7 * 33]);
        *(u32x4*)(WT + (size_t)(dst_row0 + (n0 + n) * rmul) * K + k0 + 8 * c) = o; }
    LDS_WAIT();
}

__device__ __forceinline__ void convert_expert_group(const Ctx& C, const Params& P, int g, bf16_t* w13, bf16_t* w2) {
    LAS float* scr = (LAS float*)(C.lds + C.wave * 8448);
    const int gw = C.bid * 8 + C.wave, NGW = C.G * 8;
    const int PER_E = 3072;
    for (int it = gw; it < 8 * PER_E; it += NGW) {
        const int el = it / PER_E, r = it % PER_E, e = g * 8 + el;
        if (r < 1024) transpose_item(P.in[23] + (size_t)e * DM * DFF, DFF, DM, 0, w13 + (size_t)el * 4096 * DM, 0, 2, scr, r / 64, r % 64, C.lane);
        else if (r < 2048) transpose_item(P.in[24] + (size_t)e * DM * DFF, DFF, DM, 0, w13 + (size_t)el * 4096 * DM, 1, 2, scr, (r - 1024) / 64, (r - 1024) % 64, C.lane);
        else transpose_item(P.in[25] + (size_t)e * DFF * DM, DM, DFF, 0, w2 + (size_t)el * DM * DFF, 0, 1, scr, (r - 2048) / 32, (r - 2048) % 32, C.lane);
    }
}

__device__ __forceinline__ void phase0(const Ctx& C, const Params& P) {
    unsigned char* ws = P.ws;
    const int gw = C.bid * 8 + C.wave, NGW = C.G * 8;
    {
        LAS float* scr = (LAS float*)(C.lds + C.wave * 8448);
        const int I_IN1 = 16 * 112, I_IN2 = 16 * 64, I_BH = 8 * 32, I_BM = 8 * 32, I_OUT = 16 * 32;
        const int NIT = I_IN1 + I_IN2 + I_BH + I_BM + I_OUT;
        for (int it = gw; it < NIT; it += NGW) {
            int r = it;
            if (r < I_IN1) { transpose_item(P.in[8], DIN, DM, 0, (bf16_t*)(ws + WS_WIN), 0, 1, scr, r / 112, r % 112, C.lane); continue; } r -= I_IN1;
            if (r < I_IN2) { transpose_item(P.in[8], DIN, DM, MERGE0, (bf16_t*)(ws + WS_WIN), GATE0, 1, scr, r / 64, r % 64, C.lane); continue; } r -= I_IN2;
            if (r < I_BH) { transpose_item(P.in[19], DM, 512, 0, (bf16_t*)(ws + WS_WBH), 0, 1, scr, r / 32, r % 32, C.lane); continue; } r -= I_BH;
            if (r < I_BM) { transpose_item(P.in[20], DM, 512, 0, (bf16_t*)(ws + WS_WBM), 0, 1, scr, r / 32, r % 32, C.lane); continue; } r -= I_BM;
            transpose_item(P.in[21], DM, DM, 0, (bf16_t*)(ws + WS_WOUT), 0, 1, scr, r / 32, r % 32, C.lane);
        }
    }
    {
        const float* wada = P.in[4]; const float* bada = P.in[5]; float* part = (float*)(ws + WS_ADAP);
        for (int it = gw; it < 96 * 32; it += NGW) {
            const int cgp = it % 96, ks = it / 96, k0 = ks * 32, n = cgp * 64 + C.lane;
            float sv[9];
            { const int k = k0 + (C.lane & 31);
#pragma unroll
              for (int r = 0; r < 8; ++r) sv[r] = siluf(P.in[1][r * DM + k]);
              sv[8] = siluf(P.in[3][k]); }
            float a[9];
#pragma unroll
            for (int r = 0; r < 9; ++r) a[r] = 0.f;
#pragma unroll 8
            for (int kk = 0; kk < 32; ++kk) { const float w = wada[(size_t)(k0 + kk) * 6144 + n];
#pragma unroll
                for (int r = 0; r < 9; ++r) a[r] += __shfl(sv[r], kk) * w; }
            const float bb = (ks == 0) ? bada[n] : 0.f;
#pragma unroll
            for (int r = 0; r < 9; ++r) part[((size_t)ks * 9 + r) * 6144 + n] = a[r] + bb;
        }
    }
    __syncthreads();
    {
        LAS float* zs = (LAS float*)C.lds;
        LAS float* h1 = zs + 16 * 33;
        LAS float* h2 = h1 + 16 * 64;
        bf16_t* krev = (bf16_t*)(ws + WS_KREV);
        const float* w1 = P.in[11]; const float* b1 = P.in[12]; const float* w2 = P.in[13]; const float* b2 = P.in[14]; const float* w3 = P.in[15];
        for (int it = C.bid; it < 256; it += C.G) {
            const int l0 = it * 16;
            __syncthreads();
            for (int idx = C.tid; idx < 16 * 33; idx += NTHR) { const int pos = idx / 33, m = idx % 33, l = l0 + pos; float v;
                if (m == 0) v = (float)l / 4095.0f;
                else { const int bi = (m - 1) & 15; const float band = 1e-4f + (float)bi * ((15.0f - 1e-4f) / 15.0f);
                    const float ang = ((float)(2.0 * 3.14159265358979323846 / 4096.0) * (float)l) * band; v = (m <= 16) ? cosf(ang) : sinf(ang); }
                zs[idx] = v; }
            __syncthreads();
            for (int idx = C.tid; idx < 16 * 64; idx += NTHR) { const int pos = idx >> 6, j = idx & 63; float s = b1[j];
                for (int m = 0; m < 33; ++m) s += zs[pos * 33 + m] * w1[m * 64 + j];
                h1[idx] = sinf(s); }
            __syncthreads();
            for (int idx = C.tid; idx < 16 * 64; idx += NTHR) { const int pos = idx >> 6, j = idx & 63; float s = b2[j];
                for (int k = 0; k < 64; ++k) s += h1[pos * 64 + k] * w2[k * 64 + j];
                h2[idx] = sinf(s); }
            __syncthreads();
#pragma unroll 1
            for (int q = 0; q < 4; ++q) {
                const int n = C.tid + NTHR * q;
                float a[16];
#pragma unroll
                for (int p = 0; p < 16; ++p) a[p] = 0.f;
                for (int k = 0; k < 64; ++k) { const float w = w3[k * 2048 + n];
#pragma unroll
                    for (int p = 0; p < 16; ++p) a[p] += h2[p * 64 + k] * w; }
                const int o = n >> 10, side = (n >> 9) & 1, c = n & 511;
                const float delta = fabsf(-3.0701134573253944f + (float)c * ((-15.350567286626972f + 3.0701134573253944f) / 511.0f));
                bf16_t* dst = krev + ((size_t)o * 512 + c) * 8192;
#pragma unroll
                for (int p = 0; p < 16; ++p) { const int l = l0 + p; const float t = (float)l / 4095.0f; const float v = a[p] * expf(-t * delta);
                    if (side == 0) dst[4096 - l] = (bf16_t)f2bf(v);
                    else if (l > 0) dst[4096 + l] = (bf16_t)f2bf(v);
                    else dst[0] = 0; }
            }
        }
    }
}

__device__ __forceinline__ void row_dot16(const f32x4 (&y)[4], const LAS float* Wl, int lane, float (&r)[16]) {
#pragma unroll
    for (int e = 0; e < 16; ++e) r[e] = 0.f;
#pragma unroll
    for (int j = 0; j < 4; ++j) {
#pragma unroll
        for (int q = 0; q < 4; ++q) { const int k = 4 * lane + 256 * j + q; const float v = y[j][q];
#pragma unroll
            for (int e4 = 0; e4 < 4; ++e4) { const f32x4 w = *(const LAS f32x4*)(Wl + k * 16 + e4 * 4);
                r[e4 * 4 + 0] += v * w[0]; r[e4 * 4 + 1] += v * w[1]; r[e4 * 4 + 2] += v * w[2]; r[e4 * 4 + 3] += v * w[3]; } }
        asm volatile("" ::: "memory"); }
#pragma unroll
    for (int e = 0; e < 16; ++e) r[e] = wave_sum(r[e]);
}

__device__ __forceinline__ void phase1(const Ctx& C, const Params& P) {
    unsigned char* ws = P.ws;
    const float* part = (const float*)(ws + WS_ADAP); float* ada = (float*)(ws + WS_ADA);
    for (int o = C.bid * NTHR + C.tid; o < 9 * 6144; o += C.G * NTHR) { float s = 0.f;
        for (int ks = 0; ks < 32; ++ks) s += part[(size_t)ks * 9 * 6144 + o];
        ada[o] = s; }
    LAS float* Wg = (LAS float*)C.lds;
    LAS float* mod = Wg + 1024 * 16;
    for (int idx = C.tid; idx < 1024 * 16; idx += NTHR) Wg[idx] = P.in[8][(size_t)(idx >> 4) * DIN + GATE0 + (idx & 15)];
    const float* gmix = P.in[6]; const float* bin = P.in[9];
    bf16_t* hx = (bf16_t*)(ws + WS_HX); float* gates = (float*)(ws + WS_GATES);
    for (int rg = C.bid; rg < 256; rg += C.G) {
        const int b = rg >> 5;
        __syncthreads();
        for (int idx = C.tid; idx < 4096; idx += NTHR) { const int which = idx >> 10, k = idx & 1023; const int r = (which < 2) ? b : 8; const int col = (which & 1) * 1024 + k;
            float s = 0.f;
            for (int ks = 0; ks < 32; ++ks) s += part[((size_t)ks * 9 + r) * 6144 + col];
            mod[idx] = s; }
        __syncthreads();
        for (int rr = C.wave; rr < 136; rr += 8) {
            const bool isx = rr < 128; const int grow = isx ? (rg * 128 + rr) : (MX + rg * 8 + (rr - 128));
            const float* src = isx ? (P.in[0] + (size_t)grow * DM) : (P.in[2] + (size_t)(grow - MX) * DM);
            const LAS float* sh = mod + (isx ? 0 : 2048); const LAS float* sc = sh + 1024;
            f32x4 v[4]; float ss = 0.f;
#pragma unroll
            for (int j = 0; j < 4; ++j) { v[j] = *(const f32x4*)(src + 4 * C.lane + 256 * j); ss += v[j][0] * v[j][0] + v[j][1] * v[j][1] + v[j][2] * v[j][2] + v[j][3] * v[j][3]; }
            const float rstd = rsqrtf(wave_sum(ss) * (1.f / DM) + RMS_EPS);
#pragma unroll
            for (int j = 0; j < 4; ++j) { const int k = 4 * C.lane + 256 * j; const f32x4 g = *(const f32x4*)(gmix + k);
                const f32x4 s4 = *(const LAS f32x4*)(sc + k), h4 = *(const LAS f32x4*)(sh + k);
#pragma unroll
                for (int q = 0; q < 4; ++q) v[j][q] = (v[j][q] * rstd * g[q]) * (1.f + s4[q]) + h4[q];
                u32x2 w; w.x = pk2(v[j][0], v[j][1]); w.y = pk2(v[j][2], v[j][3]);
                *(u32x2*)(hx + (size_t)grow * DM + k) = w; }
            float r16[16]; row_dot16(v, Wg, C.lane, r16);
            if (C.lane < 16) { float o = 0.f;
#pragma unroll
                for (int e = 0; e < 16; ++e) o = (C.lane == e) ? r16[e] : o;
                gates[(size_t)grow * 16 + C.lane] = o + bin[GATE0 + C.lane]; }
        }
    }
}

__device__ __forceinline__ void phase2(const Ctx& C, const Params& P) {
    unsigned char* ws = P.ws;
    {
        pg8::SchedGrid S{(const char*)(ws + WS_HX), (const char*)(ws + WS_WIN), (size_t)256 * 2048, (size_t)256 * 2048, 128, 6, 0, 0, C.G, C.bid, 1, 0, 0, 0};
        pg8::EpiHyCM E{(bf16_t*)(ws + WS_PCM), P.in[9]};
        pg8::gemm_phase<pg8::EpiHyCM, pg8::SchedGrid, true>(C.lds, 1024, 2048, 2048, S, E);
    }
    {
        pg8::SchedGrid S{(const char*)(ws + WS_HX), (const char*)(ws + WS_WIN), (size_t)256 * 2048, (size_t)256 * 2048, 128, 16, 0, 6, C.G, C.bid, 4, 128, 8, 32};
        pg8::EpiIn2 E{(bf16_t*)(ws + WS_PML), (bf16_t*)P.out, (bf16_t*)(ws + WS_PC), P.in[9]};
        pg8::gemm_phase<pg8::EpiIn2, pg8::SchedGrid, false>(C.lds, 1024, 2048, 2048, S, E);
    }
}

__device__ __forceinline__ void hyena_item(const Ctx& C, const Params& P, int o, int c) {
    unsigned char* ws = P.ws;
    LAS bf16_t* krv = (LAS bf16_t*)C.lds;
    LAS bf16_t* up = (LAS bf16_t*)(C.lds + 16384);
    const bf16_t* pcm = (const bf16_t*)(ws + WS_PCM);
    const float* hconv = P.in[10];
    __syncthreads();
    {
        const u32x4* src = (const u32x4*)((const bf16_t*)(ws + WS_KREV) + ((size_t)o * 512 + c) * 8192);
        for (int i = C.tid; i < 1024; i += NTHR) *(LAS u32x4*)(krv + 8 * i) = src[i];
        for (int i = C.tid; i < 8 * 32; i += NTHR) { const int b = i >> 5, q = i & 31; const int off = (q < 16) ? 8 * q : (4224 + 8 * (q - 16));
            *(LAS u32x4*)(up + b * 4352 + off) = (u32x4){0u, 0u, 0u, 0u}; }
        if (o == 0) {
            const bf16_t* src0 = pcm + (size_t)c * MX; const float w0 = hconv[c], w1 = hconv[1536 + c], w2 = hconv[3072 + c];
            for (int i = C.tid; i < 4096; i += NTHR) { const int r0 = 8 * i; const u32x4 v = *(const u32x4*)(src0 + r0);
                float x[10]; x[1] = bflo(v.x); x[2] = bfhi(v.x); x[3] = bflo(v.y); x[4] = bfhi(v.y); x[5] = bflo(v.z); x[6] = bfhi(v.z); x[7] = bflo(v.w); x[8] = bfhi(v.w);
                x[0] = ((r0 & 63) != 0) ? bf2f(src0[r0 - 1]) : 0.f; x[9] = ((r0 & 63) != 56) ? bf2f(src0[r0 + 8]) : 0.f;
                float y[8];
#pragma unroll
                for (int j = 0; j < 8; ++j) y[j] = w0 * x[j] + w1 * x[j + 1] + w2 * x[j + 2];
                u32x4 w; w.x = pk2(y[0], y[1]); w.y = pk2(y[2], y[3]); w.z = pk2(y[4], y[5]); w.w = pk2(y[6], y[7]);
                *(LAS u32x4*)(up + (r0 >> 12) * 4352 + 128 + (r0 & 4095)) = w; }
        } else {
            const u32x4* src1 = (const u32x4*)((const bf16_t*)(ws + WS_Z1) + (size_t)c * MX);
            for (int i = C.tid; i < 4096; i += NTHR) { const int r0 = 8 * i; *(LAS u32x4*)(up + (r0 >> 12) * 4352 + 128 + (r0 & 4095)) = src1[i]; }
        }
    }
    __syncthreads();
    const int lane = C.lane, w = C.wave, i = lane & 31, kq = lane >> 5, nb = lane & 7, np = (lane >> 3) & 3;
    f32x16 acc[4];
#pragma unroll
    for (int a = 0; a < 4; ++a)
#pragma unroll
        for (int r = 0; r < 16; ++r) acc[a][r] = 0.f;
    const LAS bf16_t* ub = up + nb * 4352 + 128 + 32 * np + 8 * kq;
    for (int s0 = -96; s0 < 4096; s0 += 16) {
        const bf16x8 bfr = *(const LAS bf16x8*)(ub + s0);
#pragma unroll
        for (int a = 0; a < 4; ++a) {
            const int T0 = 128 * (4 * w + a);
            const int Y = 4096 - (T0 - s0) - i + 8 * kq;
            bf16x8 af;
#pragma unroll
            for (int j = 0; j < 8; ++j) af[j] = (short)krv[Y + j];
            acc[a] = __builtin_amdgcn_mfma_f32_32x32x16_bf16(af, bfr, acc[a], 0, 0, 0);
        }
    }
    const int gch = (o == 0 ? 512 : 1024) + c;
    const float w0 = hconv[gch], w1 = hconv[1536 + gch], w2 = hconv[3072 + gch], skip = P.in[16][o * 512 + c];
    const bf16_t* gsrc = pcm + (size_t)gch * MX + (size_t)nb * SEQ;
    bf16_t* dst = (bf16_t*)(ws + (o == 0 ? WS_Z1 : WS_Z)) + (size_t)c * MX + (size_t)nb * SEQ;
#pragma unroll
    for (int a = 0; a < 4; ++a)
#pragma unroll
        for (int g = 0; g < 4; ++g) {
            const int t0 = 128 * (4 * w + a) + 32 * np + 8 * g + 4 * kq;
            const u32x2 gv = *(const u32x2*)(gsrc + t0);
            float x[6]; x[1] = bflo(gv.x); x[2] = bfhi(gv.x); x[3] = bflo(gv.y); x[4] = bfhi(gv.y);
            x[0] = ((t0 & 63) != 0) ? bf2f(gsrc[t0 - 1]) : 0.f; x[5] = ((t0 & 63) != 60) ? bf2f(gsrc[t0 + 4]) : 0.f;
            float z[4];
#pragma unroll
            for (int j = 0; j < 4; ++j) { const float gate = w0 * x[j] + w1 * x[j + 1] + w2 * x[j + 2]; const float uu = bf2f(up[nb * 4352 + 128 + t0 + j]);
                z[j] = gate * (acc[a][4 * g + j] + skip * uu); }
            u32x2 wv; wv.x = pk2(z[0], z[1]); wv.y = pk2(z[2], z[3]);
            *(u32x2*)(dst + t0) = wv;
        }
}

constexpr int MLP = 136;
struct ChunkRef { int isctx, b, h, d, oc; };
__device__ __forceinline__ int chunk_row0(const ChunkRef& r) { return r.isctx ? (MX + r.b * CTXL + r.oc * 128) : (r.b * SEQ + r.oc * 128); }

__device__ __forceinline__ void chunk_gates(const Ctx& C, const Params& P, const ChunkRef& r, LAS float* li, LAS float* lf, LAS float* bc) {
    const float* gates = (const float*)(P.ws + WS_GATES);
    if (C.tid < 128) { const float* g = gates + (size_t)(chunk_row0(r) + C.tid) * 16; li[C.tid] = g[(r.d ? 8 : 0) + r.h]; lf[C.tid] = logsig(g[(r.d ? 12 : 4) + r.h]); }
    __syncthreads();
    if (C.tid < 128) { float s = 0.f;
        if (!r.d) { for (int q = 0; q <= C.tid; ++q) s += lf[q]; } else { for (int q = 127; q >= C.tid; --q) s += lf[q]; }
        bc[C.tid] = s; }
    __syncthreads();
}

__device__ __forceinline__ void conv_silu8(const bf16_t* base, int ld, int orig, int rowlen, const float* cw, int col, float scale, float (&y)[8]) {
    const u32x4 vc = *(const u32x4*)(base);
    const bool hl = (orig % rowlen) != 0, hr = (orig % rowlen) != rowlen - 1;
    u32x4 vl = (u32x4){0u, 0u, 0u, 0u}, vr = (u32x4){0u, 0u, 0u, 0u};
    if (hl) vl = *(const u32x4*)(base - ld);
    if (hr) vr = *(const u32x4*)(base + ld);
    const unsigned l4[4] = {vl.x, vl.y, vl.z, vl.w}, c4[4] = {vc.x, vc.y, vc.z, vc.w}, r4[4] = {vr.x, vr.y, vr.z, vr.w};
#pragma unroll
    for (int q = 0; q < 4; ++q) {
        const float a0 = cw[col + 2 * q] * bflo(l4[q]) + cw[1024 + col + 2 * q] * bflo(c4[q]) + cw[2048 + col + 2 * q] * bflo(r4[q]);
        const float a1 = cw[col + 2 * q + 1] * bfhi(l4[q]) + cw[1024 + col + 2 * q + 1] * bfhi(c4[q]) + cw[2048 + col + 2 * q + 1] * bfhi(r4[q]);
        y[2 * q] = siluf(a0) * scale; y[2 * q + 1] = siluf(a1) * scale; }
}

__device__ __forceinline__ void mlstm_a_item(const Ctx& C, const Params& P, int item) {
    unsigned char* ws = P.ws;
    const int j = item % NCHK, seq = item / NCHK, h = seq & 3, b = (seq >> 2) & 7, d = seq >> 5;
    ChunkRef r; r.isctx = j < 2; r.b = b; r.h = h; r.d = d; { const int jj = r.isctx ? j : j - 2, nch = r.isctx ? 2 : 32; r.oc = d ? (nch - 1 - jj) : jj; }
    LAS bf16_t* kT = (LAS bf16_t*)C.lds;
    LAS bf16_t* vT = kT + 128 * MLP;
    LAS float* li = (LAS float*)(C.lds + 2 * 128 * MLP * 2); LAS float* lf = li + 128; LAS float* bc = lf + 128; LAS float* wl = bc + 128;
    __syncthreads();
    chunk_gates(C, P, r, li, lf, bc);
    const float Bj = r.d ? bc[0] : bc[127];
    if (C.tid < 128) wl[C.tid] = Bj - bc[C.tid] + li[C.tid];
    __syncthreads();
    float Lj = -3.0e38f;
    for (int q = 0; q < 128; ++q) Lj = fmaxf(Lj, wl[q]);
    __syncthreads();
    if (C.tid < 128) wl[C.tid] = __expf(wl[C.tid] - Lj);
    __syncthreads();
    const int rowlen = r.isctx ? CTXL : 64, ld = r.isctx ? 1024 : 2048;
    const bf16_t* kbase = r.isctx ? ((const bf16_t*)(ws + WS_PC) + (size_t)(b * CTXL + r.oc * 128) * 1024 + h * 128)
                                  : ((const bf16_t*)(ws + WS_PML) + (size_t)(b * SEQ + r.oc * 128) * 2048 + 512 + h * 128);
    const bf16_t* vbase = r.isctx ? (kbase + 512) : (kbase + 512);
    const float* cw = P.in[17];
    for (int idx = C.tid; idx < 128 * 16; idx += NTHR) { const int tau = idx >> 4, dc = (idx & 15) * 8; const int orig = r.oc * 128 + tau;
        float y[8]; conv_silu8(kbase + (size_t)tau * ld + dc, ld, orig, rowlen, cw, 512 + h * 128 + dc, 1.f, y);
#pragma unroll
        for (int q = 0; q < 8; ++q) kT[(dc + q) * MLP + tau] = (bf16_t)f2bf(y[q]);
        const u32x4 vv = *(const u32x4*)(vbase + (size_t)tau * ld + dc); const float wgt = wl[tau];
        const unsigned v4[4] = {vv.x, vv.y, vv.z, vv.w};
#pragma unroll
        for (int q = 0; q < 4; ++q) { vT[(dc + 2 * q) * MLP + tau] = (bf16_t)f2bf(bflo(v4[q]) * wgt); vT[(dc + 2 * q + 1) * MLP + tau] = (bf16_t)f2bf(bfhi(v4[q]) * wgt); } }
    __syncthreads();
    if (C.tid < 128) { float s = 0.f; for (int q = 0; q < 128; ++q) s += wl[q] * bf2f(kT[C.tid * MLP + q]);
        ((float*)(ws + WS_NLOC))[(size_t)item * 128 + C.tid] = s; }
    if (C.tid == 0) { float* bl = (float*)(ws + WS_BL) + (size_t)item * 2; bl[0] = Bj; bl[1] = Lj; }
    const int lane = C.lane, w = C.wave, fr = lane & 15, fq = lane >> 4;
    bf16x8 af[4];
#pragma unroll
    for (int ks = 0; ks < 4; ++ks) af[ks] = *(const LAS bf16x8*)(vT + (16 * w + fr) * MLP + 32 * ks + 8 * fq);
    bf16_t* dst = (bf16_t*)(ws + WS_PLOC) + (size_t)item * 16384;
#pragma unroll
    for (int nt = 0; nt < 8; ++nt) { f32x4 acc = (f32x4){0.f, 0.f, 0.f, 0.f};
#pragma unroll
        for (int ks = 0; ks < 4; ++ks) { const bf16x8 bfr = *(const LAS bf16x8*)(kT + (16 * nt + fr) * MLP + 32 * ks + 8 * fq);
            acc = __builtin_amdgcn_mfma_f32_16x16x32_bf16(af[ks], bfr, acc, 0, 0, 0); }
#pragma unroll
        for (int q = 0; q < 4; ++q) dst[(16 * w + 4 * fq + q) * 128 + 16 * nt + fr] = (bf16_t)f2bf(acc[q]); }
}

__device__ __forceinline__ void mlstm_scan(const Ctx& C, const Params& P) {
    unsigned char* ws = P.ws;
    const float* BL = (const float*)(ws + WS_BL); const bf16_t* ploc = (const bf16_t*)(ws + WS_PLOC); bf16_t* cst = (bf16_t*)(ws + WS_CST);
    for (int slot = C.bid * NTHR + C.tid; slot < 64 * 2048; slot += C.G * NTHR) {
        const int seq = slot >> 11, off = (slot & 2047) * 8;
        float cs[8];
#pragma unroll
        for (int q = 0; q < 8; ++q) cs[q] = 0.f;
        float m = 0.f;
        u32x4 pl[NCHK - 1];
#pragma unroll
        for (int j = 0; j < NCHK - 1; ++j) pl[j] = *(const u32x4*)(ploc + ((size_t)(seq * NCHK + j)) * 16384 + off);
#pragma unroll
        for (int j = 0; j < NCHK; ++j) {
            if (j >= 2) { u32x4 o; o.x = pk2(cs[0], cs[1]); o.y = pk2(cs[2], cs[3]); o.z = pk2(cs[4], cs[5]); o.w = pk2(cs[6], cs[7]);
                *(u32x4*)(cst + ((size_t)(seq * 32 + j - 2)) * 16384 + off) = o;
                if (off == 0) ((float*)(ws + WS_MST))[seq * 32 + j - 2] = m; }
            if (j < NCHK - 1) {
                const float Bj = BL[(seq * NCHK + j) * 2], Lj = BL[(seq * NCHK + j) * 2 + 1];
                const float mn = fmaxf(Bj + m, Lj), dec = __expf(Bj + m - mn), sc = __expf(Lj - mn);
                const unsigned p4[4] = {pl[j].x, pl[j].y, pl[j].z, pl[j].w};
#pragma unroll
                for (int q = 0; q < 4; ++q) { cs[2 * q] = dec * cs[2 * q] + sc * bflo(p4[q]); cs[2 * q + 1] = dec * cs[2 * q + 1] + sc * bfhi(p4[q]); }
                m = mn; }
        }
    }
    for (int idx = C.bid * NTHR + C.tid; idx < 64 * 128; idx += C.G * NTHR) {
        const int seq = idx >> 7, dd = idx & 127; float n = 0.f, m = 0.f;
        const float* nloc = (const float*)(ws + WS_NLOC); float* nst = (float*)(ws + WS_NST);
        for (int j = 0; j < NCHK; ++j) {
            if (j >= 2) nst[(size_t)(seq * 32 + j - 2) * 128 + dd] = n;
            if (j < NCHK - 1) { const float Bj = BL[(seq * NCHK + j) * 2], Lj = BL[(seq * NCHK + j) * 2 + 1];
                const float mn = fmaxf(Bj + m, Lj); n = __expf(Bj + m - mn) * n + __expf(Lj - mn) * nloc[(size_t)(seq * NCHK + j) * 128 + dd]; m = mn; }
        }
    }
}

__device__ __forceinline__ void mlstm_c_item(const Ctx& C, const Params& P, int item) {
    unsigned char* ws = P.ws;
    const int oc = item & 31, h = (item >> 5) & 3, b = item >> 7;
    LAS bf16_t* Qs = (LAS bf16_t*)C.lds; LAS bf16_t* Ks = Qs + 128 * MLP; LAS bf16_t* VT = Ks + 128 * MLP; LAS bf16_t* CT = VT + 128 * MLP;
    LAS float* li = (LAS float*)(C.lds + 4 * 128 * MLP * 2); LAS float* lf = li + 128; LAS float* bc = lf + 128; LAS float* rowf = bc + 128; LAS float* colf = rowf + 128;
    LAS float* ainter = colf + 128; LAS float* emneg = ainter + 128; LAS float* nsl = emneg + 128;
    const int lane = C.lane, w = C.wave, fr = lane & 15, fq = lane >> 4;
    const bf16_t* pml = (const bf16_t*)(ws + WS_PML) + (size_t)(b * SEQ + oc * 128) * 2048;
    const float* cw = P.in[17];
    f32x4 hacc[8];
#pragma unroll
    for (int nt = 0; nt < 8; ++nt) hacc[nt] = (f32x4){0.f, 0.f, 0.f, 0.f};
#pragma unroll 1
    for (int d = 0; d < 2; ++d) {
        ChunkRef r; r.isctx = 0; r.b = b; r.h = h; r.d = d; r.oc = oc;
        const int sidx = ((d * 8 + b) * 4 + h) * 32 + (d ? 31 - oc : oc);
        __syncthreads();
        chunk_gates(C, P, r, li, lf, bc);
        const float m0 = ((const float*)(ws + WS_MST))[sidx];
        if (C.tid < 128) { const int t = C.tid; float g = -3.0e38f;
            if (!d) { for (int q = 0; q <= t; ++q) g = fmaxf(g, li[q] - bc[q]); } else { for (int q = 127; q >= t; --q) g = fmaxf(g, li[q] - bc[q]); }
            const float mx = fmaxf(m0, g);
            rowf[t] = -mx; colf[t] = li[t] - bc[t]; ainter[t] = __expf(m0 - mx); emneg[t] = __expf(-(bc[t] + mx));
            nsl[t] = ((const float*)(ws + WS_NST))[(size_t)sidx * 128 + t]; }
        for (int idx = C.tid; idx < 128 * 16; idx += NTHR) { const int tau = idx >> 4, dc = (idx & 15) * 8; const int orig = oc * 128 + tau;
            float y[8]; conv_silu8(pml + (size_t)tau * 2048 + h * 128 + dc, 2048, orig, 64, cw, h * 128 + dc, 0.08838834764831845f, y);
            u32x4 o; o.x = pk2(y[0], y[1]); o.y = pk2(y[2], y[3]); o.z = pk2(y[4], y[5]); o.w = pk2(y[6], y[7]);
            *(LAS u32x4*)(Qs + tau * MLP + dc) = o;
            conv_silu8(pml + (size_t)tau * 2048 + 512 + h * 128 + dc, 2048, orig, 64, cw, 512 + h * 128 + dc, 1.f, y);
            o.x = pk2(y[0], y[1]); o.y = pk2(y[2], y[3]); o.z = pk2(y[4], y[5]); o.w = pk2(y[6], y[7]);
            *(LAS u32x4*)(Ks + tau * MLP + dc) = o;
            const u32x4 vv = *(const u32x4*)(pml + (size_t)tau * 2048 + 1024 + h * 128 + dc); const unsigned v4[4] = {vv.x, vv.y, vv.z, vv.w};
#pragma unroll
            for (int q = 0; q < 4; ++q) { VT[(dc + 2 * q) * MLP + tau] = (bf16_t)(v4[q] & 0xffffu); VT[(dc + 2 * q + 1) * MLP + tau] = (bf16_t)(v4[q] >> 16); }
            *(LAS u32x4*)(CT + tau * MLP + dc) = *(const u32x4*)((const bf16_t*)(ws + WS_CST) + (size_t)sidx * 16384 + tau * 128 + dc); }
        __syncthreads();
        bf16x8 qf[4];
#pragma unroll
        for (int ks = 0; ks < 4; ++ks) qf[ks] = *(const LAS bf16x8*)(Qs + (16 * w + fr) * MLP + 32 * ks + 8 * fq);
        f32x4 sacc[8];
#pragma unroll
        for (int nt = 0; nt < 8; ++nt) { f32x4 a = (f32x4){0.f, 0.f, 0.f, 0.f};
#pragma unroll
            for (int ks = 0; ks < 4; ++ks) { const bf16x8 kf = *(const LAS bf16x8*)(Ks + (16 * nt + fr) * MLP + 32 * ks + 8 * fq);
                a = __builtin_amdgcn_mfma_f32_16x16x32_bf16(qf[ks], kf, a, 0, 0, 0); }
            sacc[nt] = a; }
        float qn; { float s = 0.f; for (int q = 0; q < 32; ++q) s += bf2f(Qs[(16 * w + fr) * MLP + 32 * fq + q]) * nsl[32 * fq + q];
            s += __shfl_xor(s, 16); s += __shfl_xor(s, 32); qn = s; }
        __syncthreads();
        float rs[4] = {0.f, 0.f, 0.f, 0.f};
#pragma unroll
        for (int nt = 0; nt < 8; ++nt) { const int s = 16 * nt + fr; const float cf = colf[s];
#pragma unroll
            for (int q = 0; q < 4; ++q) { const int t = 16 * w + 4 * fq + q; const bool ok = d ? (s >= t) : (s <= t);
                const float pv = ok ? __expf(rowf[t] + cf) * sacc[nt][q] : 0.f; rs[q] += pv;
                Ks[t * MLP + s] = (bf16_t)f2bf(pv); } }
#pragma unroll
        for (int q = 0; q < 4; ++q) { rs[q] += __shfl_xor(rs[q], 1); rs[q] += __shfl_xor(rs[q], 2); rs[q] += __shfl_xor(rs[q], 4); rs[q] += __shfl_xor(rs[q], 8); }
        LDS_WAIT();
        bf16x8 pf[4];
#pragma unroll
        for (int ks = 0; ks < 4; ++ks) pf[ks] = *(const LAS bf16x8*)(Ks + (16 * w + fr) * MLP + 32 * ks + 8 * fq);
        float den[4], ai4[4], em4[4];
#pragma unroll
        for (int q = 0; q < 4; ++q) { const int t = 16 * w + 4 * fq + q; const float qnr = __shfl(qn, 4 * fq + q);
            ai4[q] = ainter[t]; em4[q] = emneg[t]; den[q] = rs[q] + ai4[q] * qnr; den[q] = 1.f / fmaxf(fabsf(den[q]), em4[q]); }
#pragma unroll
        for (int nt = 0; nt < 8; ++nt) { f32x4 a = (f32x4){0.f, 0.f, 0.f, 0.f}, c = (f32x4){0.f, 0.f, 0.f, 0.f};
#pragma unroll
            for (int ks = 0; ks < 4; ++ks) { const bf16x8 vf = *(const LAS bf16x8*)(VT + (16 * nt + fr) * MLP + 32 * ks + 8 * fq);
                a = __builtin_amdgcn_mfma_f32_16x16x32_bf16(pf[ks], vf, a, 0, 0, 0);
                const bf16x8 cf = *(const LAS bf16x8*)(CT + (16 * nt + fr) * MLP + 32 * ks + 8 * fq);
                c = __builtin_amdgcn_mfma_f32_16x16x32_bf16(qf[ks], cf, c, 0, 0, 0); }
#pragma unroll
            for (int q = 0; q < 4; ++q) hacc[nt][q] += (a[q] + ai4[q] * c[q]) * den[q]; }
    }
    float ss[4] = {0.f, 0.f, 0.f, 0.f};
#pragma unroll
    for (int nt = 0; nt < 8; ++nt)
#pragma unroll
        for (int q = 0; q < 4; ++q) ss[q] += hacc[nt][q] * hacc[nt][q];
#pragma unroll
    for (int q = 0; q < 4; ++q) { ss[q] += __shfl_xor(ss[q], 1); ss[q] += __shfl_xor(ss[q], 2); ss[q] += __shfl_xor(ss[q], 4); ss[q] += __shfl_xor(ss[q], 8);
        ss[q] = rsqrtf(ss[q] * (1.f / 128.f) + RMS_EPS); }
    const float* ng = P.in[18]; bf16_t* yb = (bf16_t*)(ws + WS_YB);
#pragma unroll
    for (int nt = 0; nt < 8; ++nt) { const int e = h * 128 + 16 * nt + fr; const float gn = ng[e];
#pragma unroll
        for (int q = 0; q < 4; ++q) { const int t = 16 * w + 4 * fq + q; const float og = bf2f(pml[(size_t)t * 2048 + 1536 + e]);
            yb[(size_t)(b * SEQ + oc * 128 + t) * 512 + e] = (bf16_t)f2bf(hacc[nt][q] * ss[q] * gn * sigm(og)); } }
}

__device__ __forceinline__ void transpose_z2(const Ctx& C, const Params& P) {
    unsigned char* ws = P.ws;
    const bf16_t* src = (const bf16_t*)(ws + WS_Z); bf16_t* dst = (bf16_t*)(ws + WS_YA);
    LAS bf16_t* tl = (LAS bf16_t*)(C.lds + 143360 - 20480);
    for (int it = C.bid; it < 8 * 256; it += C.G) {
        const int c0 = (it & 7) * 64, r0 = (it >> 3) * 128;
        __syncthreads();
        for (int idx = C.tid; idx < 64 * 16; idx += NTHR) { const int cc = idx >> 4, rc = (idx & 15) * 8;
            const u32x4 v = *(const u32x4*)(src + (size_t)(c0 + cc) * MX + r0 + rc); const unsigned v4[4] = {v.x, v.y, v.z, v.w};
#pragma unroll
            for (int q = 0; q < 4; ++q) { tl[(rc + 2 * q) * 72 + cc] = (bf16_t)(v4[q] & 0xffffu); tl[(rc + 2 * q + 1) * 72 + cc] = (bf16_t)(v4[q] >> 16); } }
        __syncthreads();
        for (int idx = C.tid; idx < 128 * 8; idx += NTHR) { const int rr = idx >> 3, c8 = (idx & 7) * 8;
            *(u32x4*)(dst + (size_t)(r0 + rr) * 512 + c0 + c8) = *(const LAS u32x4*)(tl + rr * 72 + c8); }
    }
}

__device__ __forceinline__ void phase6(const Ctx& C, const Params& P) {
    unsigned char* ws = P.ws;
    LAS float* Wr = (LAS float*)C.lds;
    for (int idx = C.tid; idx < 1024 * 16; idx += NTHR) Wr[idx] = P.in[22][idx];
    __syncthreads();
    const float* ada = (const float*)(ws + WS_ADA); const float* gffn = P.in[7];
    bf16_t* hx2 = (bf16_t*)(ws + WS_HX2); float* aff = (float*)(ws + WS_AFF); int* slot = (int*)(ws + WS_SLOT);
    for (int row = C.bid * 8 + C.wave; row < MX; row += C.G * 8) {
        const int b = row >> 12, n = row & 4095;
        const float* src = P.out + (size_t)row * DM;
        f32x4 v[4]; float ss = 0.f;
#pragma unroll
        for (int j = 0; j < 4; ++j) { v[j] = *(const f32x4*)(src + 4 * C.lane + 256 * j); ss += v[j][0] * v[j][0] + v[j][1] * v[j][1] + v[j][2] * v[j][2] + v[j][3] * v[j][3]; }
        const float rstd = rsqrtf(wave_sum(ss) * (1.f / DM) + RMS_EPS);
#pragma unroll
        for (int j = 0; j < 4; ++j) { const int k = 4 * C.lane + 256 * j; const f32x4 g = *(const f32x4*)(gffn + k);
            const f32x4 h4 = *(const f32x4*)(ada + (size_t)b * 6144 + 3072 + k), s4 = *(const f32x4*)(ada + (size_t)b * 6144 + 4096 + k);
#pragma unroll
            for (int q = 0; q < 4; ++q) v[j][q] = (v[j][q] * rstd * g[q]) * (1.f + s4[q]) + h4[q];
            u32x2 w; w.x = pk2(v[j][0], v[j][1]); w.y = pk2(v[j][2], v[j][3]);
            *(u32x2*)(hx2 + (size_t)row * DM + k) = w; }
        float lg[16]; row_dot16(v, Wr, C.lane, lg);
        float mx = lg[0];
#pragma unroll
        for (int e = 1; e < 16; ++e) mx = fmaxf(mx, lg[e]);
        float sum = 0.f;
#pragma unroll
        for (int e = 0; e < 16; ++e) { lg[e] = expf(lg[e] - mx); sum += lg[e]; }
        const float inv = 1.f / sum;
        if (C.lane < 16) { float o = 0.f;
#pragma unroll
            for (int e = 0; e < 16; ++e) o = (C.lane == e) ? lg[e] : o;
            aff[((size_t)b * NE + C.lane) * SEQ + n] = o * inv; slot[(size_t)row * 16 + C.lane] = -1; }
    }
}

__device__ __forceinline__ void topk_item(const Ctx& C, const Params& P, int item) {
    unsigned char* ws = P.ws;
    const int b = item >> 4, e = item & 15;
    const float* aff = (const float*)(ws + WS_AFF) + (size_t)item * SEQ;
    LAS unsigned* red = (LAS unsigned*)C.lds;
    unsigned v[8];
    { const u32x4 a = *(const u32x4*)(aff + 8 * C.tid), c = *(const u32x4*)(aff + 8 * C.tid + 4);
      v[0] = a.x; v[1] = a.y; v[2] = a.z; v[3] = a.w; v[4] = c.x; v[5] = c.y; v[6] = c.z; v[7] = c.w; }
    unsigned prefix = 0u;
    for (int bit = 30; bit >= 0; --bit) {
        const unsigned cand = prefix | (1u << bit); int cnt = 0;
#pragma unroll
        for (int q = 0; q < 8; ++q) cnt += (v[q] >= cand) ? 1 : 0;
        cnt = (int)wave_sum((float)cnt);
        __syncthreads();
        if (C.lane == 0) red[C.wave] = (unsigned)cnt;
        __syncthreads();
        int tot = 0;
#pragma unroll
        for (int q = 0; q < 8; ++q) tot += (int)red[q];
        if (tot >= CAP) prefix = cand;
    }
    int cg_ = 0, ce_ = 0;
#pragma unroll
    for (int q = 0; q < 8; ++q) { cg_ += (v[q] > prefix) ? 1 : 0; ce_ += (v[q] == prefix) ? 1 : 0; }
    int ig = cg_, ie = ce_;
#pragma unroll
    for (int o = 1; o < 64; o <<= 1) { const int tg = __shfl_up(ig, o), te = __shfl_up(ie, o); if (C.lane >= o) { ig += tg; ie += te; } }
    __syncthreads();
    if (C.lane == 63) { red[C.wave] = (unsigned)ig; red[8 + C.wave] = (unsigned)ie; }
    __syncthreads();
    int bg = 0, be = 0, totg = 0;
#pragma unroll
    for (int q = 0; q < 8; ++q) { const int xg = (int)red[q], xe = (int)red[8 + q]; if (q < C.wave) { bg += xg; be += xe; } totg += xg; }
    int pg = bg + ig - cg_, pe = be + ie - ce_;
    const int need = CAP - totg;
    int* sidx = (int*)(ws + WS_SIDX) + (size_t)item * CAP; float* sg = (float*)(ws + WS_SGATE) + (size_t)item * CAP; int* slot = (int*)(ws + WS_SLOT);
#pragma unroll
    for (int q = 0; q < 8; ++q) { const int n = 8 * C.tid + q; int s = -1;
        if (v[q] > prefix) s = pg++;
        else if (v[q] == prefix) { if (pe < need) s = totg + pe; ++pe; }
        if (s >= 0) { sidx[s] = n; sg[s] = __builtin_bit_cast(float, v[q]); slot[((size_t)b * SEQ + n) * 16 + e] = s; } }
}

__device__ __forceinline__ void gather_group(const Ctx& C, const Params& P, int g) {
    unsigned char* ws = P.ws;
    const int* sidx = (const int*)(ws + WS_SIDX); const bf16_t* hx2 = (const bf16_t*)(ws + WS_HX2); bf16_t* xg = (bf16_t*)(ws + WS_XG);
    for (int r = C.bid * 8 + C.wave; r < 8 * 4096; r += C.G * 8) {
        const int el = r >> 12, rr = r & 4095, b = rr >> 9, s = rr & 511, e = g * 8 + el;
        const int n = sidx[((size_t)b * NE + e) * CAP + s];
        const u32x4* src = (const u32x4*)(hx2 + ((size_t)b * SEQ + n) * DM); u32x4* dst = (u32x4*)(xg + (size_t)r * DM);
        dst[C.lane] = src[C.lane]; dst[C.lane + 64] = src[C.lane + 64];
    }
}

__device__ __forceinline__ void moe_gemm1(const Ctx& C, const Params& P) {
    unsigned char* ws = P.ws;
    pg8::SchedMoe S{(const char*)(ws + WS_XG), (const char*)(ws + WS_W13), (size_t)256 * 2048, (size_t)256 * 2048, (size_t)4096 * 2048, (size_t)4096 * 2048, 16, 16, C.G, C.bid};
    pg8::EpiMoe1 E{(bf16_t*)(ws + WS_ACT)};
    pg8::gemm_phase<pg8::EpiMoe1, pg8::SchedMoe, false>(C.lds, 1024, 2048, 2048, S, E);
}
__device__ __forceinline__ void moe_gemm2(const Ctx& C, const Params& P, int g) {
    unsigned char* ws = P.ws;
    pg8::SchedMoe S{(const char*)(ws + WS_ACT), (const char*)(ws + (g ? WS_W2B : WS_W2A)), (size_t)256 * 4096, (size_t)256 * 4096, (size_t)4096 * 4096, (size_t)1024 * 4096, 16, 4, C.G, C.bid};
    pg8::EpiMoe2 E{(bf16_t*)(ws + WS_YE), (const float*)(ws + WS_SGATE), g * 8};
    pg8::gemm_phase<pg8::EpiMoe2, pg8::SchedMoe, false>(C.lds, 2048, 4096, 4096, S, E);
}

__device__ __forceinline__ void phase_final(const Ctx& C, const Params& P) {
    unsigned char* ws = P.ws;
    const float* ada = (const float*)(ws + WS_ADA); const float* gfin = P.in[26];
    const int* slot = (const int*)(ws + WS_SLOT); const bf16_t* ye = (const bf16_t*)(ws + WS_YE);
    for (int row = C.bid * 8 + C.wave; row < MX; row += C.G * 8) {
        const int b = row >> 12;
        float* xr = P.out + (size_t)row * DM;
        f32x4 m[4];
#pragma unroll
        for (int j = 0; j < 4; ++j) m[j] = (f32x4){0.f, 0.f, 0.f, 0.f};
        for (int e = 0; e < NE; ++e) { const int s = slot[(size_t)row * 16 + e];
            if (s >= 0) { const bf16_t* yr = ye + ((size_t)e * 4096 + b * CAP + s) * DM;
#pragma unroll
                for (int j = 0; j < 4; ++j) { const u32x2 w = *(const u32x2*)(yr + 4 * C.lane + 256 * j);
                    m[j][0] += bflo(w.x); m[j][1] += bfhi(w.x); m[j][2] += bflo(w.y); m[j][3] += bfhi(w.y); } } }
        f32x4 v[4]; float ss = 0.f;
#pragma unroll
        for (int j = 0; j < 4; ++j) { const int k = 4 * C.lane + 256 * j; const f32x4 g5 = *(const f32x4*)(ada + (size_t)b * 6144 + 5120 + k);
            v[j] = *(const f32x4*)(xr + k) + g5 * m[j]; ss += v[j][0] * v[j][0] + v[j][1] * v[j][1] + v[j][2] * v[j][2] + v[j][3] * v[j][3]; }
        const float rstd = rsqrtf(wave_sum(ss) * (1.f / DM) + RMS_EPS);
#pragma unroll
        for (int j = 0; j < 4; ++j) { const int k = 4 * C.lane + 256 * j; const f32x4 g = *(const f32x4*)(gfin + k);
            *(f32x4*)(xr + k) = v[j] * rstd * g; }
    }
}

constexpr int N_PHASES = 16;
__global__ void __launch_bounds__(NTHR, 2) mega(Params P) {
    extern __shared__ __attribute__((aligned(16))) unsigned char lds_raw[];
    cg::grid_group grid = cg::this_grid();
    Ctx C; C.lds = (LAS unsigned char*)lds_raw; C.tid = threadIdx.x; C.lane = C.tid & 63; C.wave = __builtin_amdgcn_readfirstlane(C.tid >> 6); C.bid = blockIdx.x; C.G = gridDim.x;
    unsigned char* ws = P.ws;
    const int lo = P.ph_lo, hi = P.ph_hi;
#define IN(k) (lo <= (k) && (k) < hi)
#define SEAM(k) do { if (IN(k) && IN((k) + 1)) { __threadfence(); grid.sync(); } } while (0)
    if (IN(0)) phase0(C, P);
    SEAM(0);
    if (IN(1)) phase1(C, P);
    SEAM(1);
    if (IN(2)) phase2(C, P);
    SEAM(2);
    if (IN(3)) {
        for (int it = C.bid; it < 512; it += C.G) hyena_item(C, P, 0, it);
        for (int it = C.bid; it < 64 * NCHK; it += C.G) mlstm_a_item(C, P, it);
    }
    SEAM(3);
    if (IN(4)) {
        for (int it = C.bid; it < 512; it += C.G) hyena_item(C, P, 1, it);
        mlstm_scan(C, P);
    }
    SEAM(4);
    if (IN(5)) {
        for (int it = C.bid; it < 1024; it += C.G) mlstm_c_item(C, P, it);
        transpose_z2(C, P);
    }
    SEAM(5);
    if (IN(6)) {
        pg8::SchedGrid S{(const char*)(ws + WS_YA), (const char*)(ws + WS_WBH), (size_t)256 * 1024, (size_t)256 * 1024, 128, 4, 0, 0, C.G, C.bid, 1, 0, 0, 0};
        pg8::EpiMerge<0> E0{(bf16_t*)(ws + WS_Z), (const bf16_t*)P.out};
        pg8::gemm_phase<pg8::EpiMerge<0>, pg8::SchedGrid, false>(C.lds, 512, 1024, 1024, S, E0);
        S.A = (const char*)(ws + WS_YB); S.B = (const char*)(ws + WS_WBM);
        pg8::EpiMerge<1> E1{(bf16_t*)(ws + WS_Z), (const bf16_t*)P.out};
        pg8::gemm_phase<pg8::EpiMerge<1>, pg8::SchedGrid, false>(C.lds, 512, 1024, 1024, S, E1);
    }
    SEAM(6);
    if (IN(7)) {
        pg8::SchedGrid S{(const char*)(ws + WS_Z), (const char*)(ws + WS_WOUT), (size_t)256 * 2048, (size_t)256 * 2048, 128, 4, 0, 0, C.G, C.bid, 1, 0, 0, 0};
        pg8::EpiOut E{P.in[0], P.out, (const float*)(ws + WS_ADA)};
        pg8::gemm_phase<pg8::EpiOut, pg8::SchedGrid, false>(C.lds, 1024, 2048, 2048, S, E);
    }
    SEAM(7);
    if (IN(8)) phase6(C, P);
    SEAM(8);
    if (IN(9)) {
        for (int it = C.bid; it < BATCH * NE; it += C.G) topk_item(C, P, it);
        __syncthreads();
        convert_expert_group(C, P, 0, (bf16_t*)(ws + WS_W13), (bf16_t*)(ws + WS_W2A));
    }
    SEAM(9);
    if (IN(10)) gather_group(C, P, 0);
    SEAM(10);
    if (IN(11)) moe_gemm1(C, P);
    SEAM(11);
    if (IN(12)) {
        moe_gemm2(C, P, 0);
        __syncthreads();
        convert_expert_group(C, P, 1, (bf16_t*)(ws + WS_W13), (bf16_t*)(ws + WS_W2B));
        gather_group(C, P, 1);
    }
    SEAM(12);
    if (IN(13)) moe_gemm1(C, P);
    SEAM(13);
    if (IN(14)) moe_gemm2(C, P, 1);
    SEAM(14);
    if (IN(15)) phase_final(C, P);
#undef IN
#undef SEAM
}

extern "C" void kernel_launch(void* const* d_in, const int* in_sizes, int n_in, void* d_out, int out_size, void* d_ws, size_t ws_size, hipStream_t stream) {
    static int grid = 0;
    if (grid == 0) {
        if (n_in != 27 || out_size != MX * DM || ws_size < WS_END) { fprintf(stderr, "kernel_launch: unexpected shapes (n_in %d, out %d, ws %zu < %zu)\n", n_in, out_size, ws_size, (size_t)WS_END); grid = -1; return; }
        int dev = 0, cus = 0, per_cu = 0;
        hipGetDevice(&dev);
        hipDeviceGetAttribute(&cus, hipDeviceAttributeMultiprocessorCount, dev);
        if (hipFuncSetAttribute((const void*)mega, hipFuncAttributeMaxDynamicSharedMemorySize, LDS_BYTES) != hipSuccess) { fprintf(stderr, "kernel_launch: hipFuncSetAttribute failed\n"); grid = -1; return; }
        if (hipOccupancyMaxActiveBlocksPerMultiprocessor(&per_cu, (const void*)mega, NTHR, LDS_BYTES) != hipSuccess || per_cu < 1) { fprintf(stderr, "kernel_launch: occupancy query says %d\n", per_cu); per_cu = 1; }
        (void)hipGetLastError();
        grid = cus * 1;
        if (grid <= 0) grid = 256;
    }
    if (grid < 0) return;
    Params p; memset(&p, 0, sizeof(p));
    for (int i = 0; i < 27; ++i) p.in[i] = (const float*)d_in[i];
    p.out = (float*)d_out; p.ws = (unsigned char*)d_ws;
#if N_LAUNCH_MODE == 1
    p.ph_lo = 0; p.ph_hi = N_PHASES;
    void* args[] = {&p};
    hipError_t e = hipLaunchCooperativeKernel((const void*)mega, dim3(grid), dim3(NTHR), args, LDS_BYTES, stream);
    if (e != hipSuccess) fprintf(stderr, "kernel_launch: cooperative launch failed: %s (grid %d)\n", hipGetErrorString(e), grid);
#else
    for (int ph = 0; ph < N_PHASES; ++ph) {
        p.ph_lo = ph; p.ph_hi = ph + 1;
        void* args[] = {&p};
        hipError_t e = hipLaunchCooperativeKernel((const void*)mega, dim3(grid), dim3(NTHR), args, LDS_BYTES, stream);
        if (e != hipSuccess) { fprintf(stderr, "kernel_launch: launch %d failed: %s (grid %d)\n", ph, hipGetErrorString(e), grid); break; }
    }
#endif
}
```

```cpp
#include <hip/hip_runtime.h>
#include <hip/hip_cooperative_groups.h>
#include <cstdio>
#include <cstdint>
#include <cstring>
namespace cg = cooperative_groups;

#ifndef N_LAUNCH_MODE
#define N_LAUNCH_MODE 1
#endif

#define LAS __attribute__((address_space(3)))
typedef unsigned short bf16_t;
typedef short bf16x8 __attribute__((ext_vector_type(8)));
typedef float f32x4 __attribute__((ext_vector_type(4)));
typedef float f32x16 __attribute__((ext_vector_type(16)));
typedef unsigned u32x4 __attribute__((ext_vector_type(4)));
typedef unsigned u32x2 __attribute__((ext_vector_type(2)));

constexpr int NTHR = 512;
constexpr int BATCH = 8, SEQ = 4096, DM = 1024, CTXL = 256;
constexpr int MX = BATCH * SEQ;
constexpr int MC = BATCH * CTXL;
constexpr int DIN = 5648, NPROJ = 5632, GATE0 = 3584, MERGE0 = 3600;
constexpr int NE = 16, CAP = 512, DFF = 2048;
constexpr int NCHK = 34;
constexpr float RMS_EPS = 1e-6f;

constexpr size_t MiB = 1u << 20;
constexpr size_t WS_ADAP = 0;
constexpr size_t WS_ADA = 7 * MiB;
constexpr size_t WS_CTL = 7 * MiB + 512 * 1024;
constexpr size_t WS_GATES = 8 * MiB;
constexpr size_t WS_KREV = 11 * MiB;
constexpr size_t WS_BL = 27 * MiB;
constexpr size_t WS_MST = 27 * MiB + 64 * 1024;
constexpr size_t WS_NLOC = 28 * MiB;
constexpr size_t WS_NST = 30 * MiB;
constexpr size_t WS_WIN = 32 * MiB;
constexpr size_t WS_WBH = 43 * MiB;
constexpr size_t WS_WBM = 44 * MiB;
constexpr size_t WS_WOUT = 45 * MiB;
constexpr size_t WS_HX = 48 * MiB;
constexpr size_t WS_PLOC = 48 * MiB;
constexpr size_t WS_PCM = 116 * MiB;
constexpr size_t WS_PML = 212 * MiB;
constexpr size_t WS_PC = 340 * MiB;
constexpr size_t WS_Z1 = 344 * MiB;
constexpr size_t WS_YA = 376 * MiB;
constexpr size_t WS_YB = 408 * MiB;
constexpr size_t WS_CST = 440 * MiB;
constexpr size_t WS_Z = 504 * MiB;
constexpr size_t WS_AFF = 0;
constexpr size_t WS_SLOT = 2 * MiB;
constexpr size_t WS_SIDX = 4 * MiB;
constexpr size_t WS_SGATE = 4 * MiB + 512 * 1024;
constexpr size_t WS_HX2 = 48 * MiB;
constexpr size_t WS_W13 = 112 * MiB;
constexpr size_t WS_W2A = 176 * MiB;
constexpr size_t WS_XG = 208 * MiB;
constexpr size_t WS_ACT = 272 * MiB;
constexpr size_t WS_YE = 400 * MiB;
constexpr size_t WS_W2B = 528 * MiB;
constexpr size_t WS_END = 560 * MiB;

constexpr int LDS_BYTES = 147456;
constexpr int LDS_MISC = LDS_BYTES - 128;
constexpr unsigned REPEAT = 0u;

__device__ __forceinline__ unsigned f2bf(float f) { unsigned u = __builtin_bit_cast(unsigned, f); return (u + 0x7fffu + ((u >> 16) & 1u)) >> 16; }
__device__ __forceinline__ unsigned pk2(float lo, float hi) { return f2bf(lo) | (f2bf(hi) << 16); }
__device__ __forceinline__ float bf2f(unsigned short b) { return __builtin_bit_cast(float, ((unsigned)b) << 16); }
__device__ __forceinline__ float bflo(unsigned w) { return __builtin_bit_cast(float, w << 16); }
__device__ __forceinline__ float bfhi(unsigned w) { return __builtin_bit_cast(float, w & 0xffff0000u); }
__device__ __forceinline__ float sigm(float x) { return 1.f / (1.f + __expf(-x)); }
__device__ __forceinline__ float siluf(float x) { return x / (1.f + __expf(-x)); }
__device__ __forceinline__ float logsig(float x) { return x >= 0.f ? -log1pf(expf(-x)) : x - log1pf(expf(x)); }
__device__ __forceinline__ float wave_sum(float v) {
#pragma unroll
    for (int o = 1; o < 64; o <<= 1) v += __shfl_xor(v, o);
    return v;
}
#define LDS_WAIT() asm volatile("s_waitcnt lgkmcnt(0)" ::: "memory")

struct Params {
    const float* in[27];
    float* out;
    unsigned char* ws;
    int ph_lo, ph_hi;
};


#define XB_TMO      128
#define XB_XCNT(j)  (256  + 64 * (j))
#define XB_XSUB(j)  (1280 + 64 * (j))
#define XB_XGEN(j)  (2304 + 64 * (j))
#define XB_TOP      3328
#define XB_TOPGEN   3392
#define XCD_BAR_WORDS 3456
#define XB_SPIN_CAP (1u << 18)
__device__ __forceinline__ unsigned xb_ld(unsigned* p)              { return __hip_atomic_load(p, __ATOMIC_RELAXED, __HIP_MEMORY_SCOPE_AGENT); }
__device__ __forceinline__ unsigned xb_add(unsigned* p, unsigned v) { return __hip_atomic_fetch_add(p, v, __ATOMIC_RELAXED, __HIP_MEMORY_SCOPE_AGENT); }
__device__ __forceinline__ unsigned xb_xcc_id() { return (unsigned)__builtin_amdgcn_s_getreg((3 << 11) | 20) & 0xFu; }
#define XB_SPIN(cond, bar) do { unsigned _sp = 0; while (cond) { __builtin_amdgcn_s_sleep(1); \
    if ((++_sp & 255u) == 0u) { if (xb_ld(&(bar)[XB_TMO])) break; if (_sp > XB_SPIN_CAP) { atomicAdd(&(bar)[XB_TMO], 1u); break; } } } } while (0)
struct XcdBarrier { unsigned* bar; unsigned x; volatile LAS unsigned* st; };
__device__ __forceinline__ XcdBarrier xcd_barrier_post(unsigned* bar, volatile LAS unsigned* st) {
    XcdBarrier b; b.bar = bar; b.x = xb_xcc_id(); b.st = st;
    if (threadIdx.x == 0) (void)xb_add(&bar[XB_XCNT(b.x)], 1u);
    return b;
}
__device__ __forceinline__ void xcd_barrier_complete(unsigned* bar, unsigned x, unsigned& nloc, unsigned& nx) {
    const unsigned G = gridDim.x * gridDim.y * gridDim.z;
    unsigned sum, cnt, mine, sp = 0u;
    for (;;) {
        sum = 0u; cnt = 0u; mine = 0u;
#pragma unroll
        for (unsigned j = 0; j < 16; ++j) { const unsigned c = xb_ld(&bar[XB_XCNT(j)]); sum += c; cnt += (c > 0u) ? 1u : 0u; mine = (j == x) ? c : mine; }
        if (sum == G) break;
        __builtin_amdgcn_s_sleep(1);
        if ((++sp & 255u) == 0u) { if (xb_ld(&bar[XB_TMO])) break; if (sp > XB_SPIN_CAP) { atomicAdd(&bar[XB_TMO], 1u); break; } }
    }
    nloc = mine > 0u ? mine : 1u; nx = cnt > 0u ? cnt : 1u;
}
__device__ __forceinline__ void xcd_barrier(const XcdBarrier& b) {
    asm volatile("s_waitcnt vmcnt(0)" ::: "memory");
    __syncthreads();
    if (threadIdx.x == 0) {
        unsigned* bar = b.bar;
        __builtin_amdgcn_s_waitcnt(0);
        unsigned nloc = b.st[0], nx = b.st[1];
        if (nloc == 0u) { xcd_barrier_complete(bar, b.x, nloc, nx); b.st[0] = nloc; b.st[1] = nx; }
        const unsigned old = xb_add(&bar[XB_XSUB(b.x)], 1u);
        const unsigned gen = old / nloc;
        if (old + 1u == (gen + 1u) * nloc) {
            __builtin_amdgcn_fence(__ATOMIC_RELEASE, "agent");
            asm volatile("s_waitcnt vmcnt(0)" ::: "memory");
            const unsigned og = xb_add(&bar[XB_TOP], 1u);
            const unsigned tg = og / nx;
            if (og + 1u == (tg + 1u) * nx) xb_add(&bar[XB_TOPGEN], 1u);
            else XB_SPIN(xb_ld(&bar[XB_TOPGEN]) == tg, bar);
            __builtin_amdgcn_fence(__ATOMIC_ACQUIRE, "agent");
            xb_add(&bar[XB_XGEN(b.x)], 1u);
            asm volatile("s_waitcnt vmcnt(0)" ::: "memory");
        } else {
            XB_SPIN(xb_ld(&bar[XB_XGEN(b.x)]) == gen, bar);
            __builtin_amdgcn_fence(__ATOMIC_ACQUIRE, "agent");
            asm volatile("s_waitcnt vmcnt(0)" ::: "memory");
        }
    }
    __syncthreads();
}

namespace pg8 {
constexpr int BM = 256, BK = 64, HALF = 128, HTB = HALF * BK * 2, STAGE_BYTES = 8 * HTB;
__device__ __forceinline__ int lds_byte(int r, int c) { const int st = (r >> 4) * 2 + (c >> 5), rr = r & 15, cc = c & 31, ob = rr * 64 + cc * 2; return st * 1024 + (ob ^ (((ob >> 9) & 1) << 5)); }
__device__ __forceinline__ void stage_rc(int b, int& R, int& C) { const int st = b / 1024, sb = b % 1024, swz = sb ^ (((sb >> 9) & 1) << 5); R = (st >> 1) * 16 + swz / 64; C = (st & 1) * 32 + (swz % 64) / 2; }
__device__ __forceinline__ int perm32(int rho) { const int n = rho >> 4, i = rho & 15; return 8 * (i >> 2) + 4 * n + (i & 3); }
__device__ __forceinline__ unsigned cvt_pk_bf16(float lo, float hi) { unsigned r; asm volatile("v_cvt_pk_bf16_f32 %0, %1, %2" : "=v"(r) : "v"(lo), "v"(hi)); return r; }

struct Unit { const char* A; const char* B; int pm, pn, aux; };

struct SchedGrid {
    const char* A; const char* B; size_t tstepA, tstepB; int nM, nN, pm0, pn0, G, c;
    int xN, xPm0, xPn0, xCnt;
    __device__ bool next(int i, Unit& u) const {
        const long L = (long)i * G + c; const int nwg = nM * nN;
        if (L >= nwg + xCnt) return false;
        if (L >= nwg) { const int q = (int)L - nwg; u.pm = xPm0 + q / xN; u.pn = xPn0 + q % xN; u.aux = 1; }
        else {
            int wgid = (int)L; { const int q = nwg / 8, r = nwg % 8, xcd = wgid % 8, off = wgid / 8; wgid = (xcd < r ? xcd * (q + 1) : r * (q + 1) + (xcd - r) * q) + off; }
            const int nig = 8 * nN, gid = wgid / nig, fm = gid * 8, gsz = (nM - fm) < 8 ? (nM - fm) : 8;
            u.pm = pm0 + fm + ((wgid % nig) % gsz); u.pn = pn0 + (wgid % nig) / gsz; u.aux = 0;
        }
        u.A = A + (size_t)u.pm * tstepA; u.B = B + (size_t)u.pn * tstepB; return true;
    }
};
struct SchedMoe {
    const char* A; const char* B; size_t tstepA, tstepB, estepA, estepB; int nM, nN, G, c;
    __device__ bool next(int i, Unit& u) const {
        const long L = (long)i * G + c; const int e = (int)(L % 8); const long t = L / 8;
        if (t >= (long)nM * nN) return false;
        u.pm = (int)(t / nN); u.pn = (int)(t % nN); u.aux = e;
        u.A = A + (size_t)e * estepA + (size_t)u.pm * tstepA; u.B = B + (size_t)e * estepB + (size_t)u.pn * tstepB; return true;
    }
};

template <class Epi, class Sched, bool NORMAL>
__device__ __forceinline__ void gemm_phase(LAS unsigned char* lds, const int K, const unsigned lda, const unsigned ldb, const Sched& S, const Epi& E) {
    const int tid = threadIdx.x, wid = __builtin_amdgcn_readfirstlane(tid >> 6), lane = tid & 63, wr = wid >> 2, wc = wid & 3, fr = lane & 15, fq = lane >> 4;
    const int nt = K / BK;
    unsigned voffA[2], voffB[2];
#pragma unroll
    for (int i = 0; i < 2; ++i) { int R, C; stage_rc(tid * 16 + i * 8192, R, C); const int Rb = Epi::PERM ? ((R & ~31) + perm32(R & 31)) : R;
        voffA[i] = (unsigned)R * lda + (unsigned)C * 2u; voffB[i] = (unsigned)Rb * ldb + (unsigned)C * 2u; }
    const size_t kstep = (size_t)(BK * 2);
    const size_t hstepA = (size_t)HALF * lda, hstepB = (size_t)HALF * ldb;
    const unsigned ldsw = (unsigned)wid * 1024u;
    const int aoff = lds_byte(wr * 64 + fr, fq * 8), boff = lds_byte(wc * 32 + fr, fq * 8);
#define PG8_SA(b, h) (((b) * 2 + (h)) * HTB)
#define PG8_SB(b, h) ((4 + (b) * 2 + (h)) * HTB)
#define PG8_STAGE(bufoff, gbase, voff) do { _Pragma("unroll") for (int _i = 0; _i < 2; ++_i) \
        __builtin_amdgcn_global_load_lds((const unsigned*)((const char*)(gbase) + (voff)[_i]), (LAS unsigned*)(lds + (bufoff) + ldsw + _i * 8192), 16, 0, 0); } while (0)
#define PG8_LDA(dst, b, h) do { _Pragma("unroll") for (int m = 0; m < 4; ++m) _Pragma("unroll") for (int k = 0; k < 2; ++k) dst[m][k] = *(const LAS bf16x8*)(lds + PG8_SA(b, h) + aoff + m * 2048 + k * 1024); } while (0)
#define PG8_LDB(dst, b, h) do { _Pragma("unroll") for (int n = 0; n < 2; ++n) _Pragma("unroll") for (int k = 0; k < 2; ++k) dst[n][k] = *(const LAS bf16x8*)(lds + PG8_SB(b, h) + boff + n * 2048 + k * 1024); } while (0)
#define PG8_MMA(ai, bj, At, Bt) do { __builtin_amdgcn_s_setprio(1); _Pragma("unroll") for (int m = 0; m < 4; ++m) _Pragma("unroll") for (int n = 0; n < 2; ++n) _Pragma("unroll") for (int k = 0; k < 2; ++k) \
        acc[ai][bj][m][n] = NORMAL ? __builtin_amdgcn_mfma_f32_16x16x32_bf16(At[m][k], Bt[n][k], acc[ai][bj][m][n], 0, 0, 0) \
                                   : __builtin_amdgcn_mfma_f32_16x16x32_bf16(Bt[n][k], At[m][k], acc[ai][bj][m][n], 0, 0, 0); __builtin_amdgcn_s_setprio(0); } while (0)
#define PG8_WAIT_V(n) asm volatile("s_waitcnt vmcnt(" #n ")" ::: "memory")
#define PG8_WAIT_L(n) asm volatile("s_waitcnt lgkmcnt(" #n ")" ::: "memory")
#define PG8_BAR __builtin_amdgcn_s_barrier()
#define PG8_SCHED __builtin_amdgcn_sched_barrier(0)
    Unit cur, nxt; int ui = 0;
    if (!S.next(0, cur)) return;
    f32x4 acc[2][2][4][2];
#pragma unroll
    for (int a = 0; a < 2; ++a)
#pragma unroll
        for (int b = 0; b < 2; ++b)
#pragma unroll
            for (int m = 0; m < 4; ++m)
#pragma unroll
                for (int n = 0; n < 2; ++n) acc[a][b][m][n] = (f32x4){0.f, 0.f, 0.f, 0.f};
    bf16x8 At[4][2], B0[2][2], B1[2][2];
    const char* cA = cur.A; const char* cB = cur.B;
    PG8_STAGE(PG8_SB(0, 0), cB, voffB); PG8_STAGE(PG8_SB(0, 1), cB + hstepB, voffB); PG8_STAGE(PG8_SA(0, 0), cA, voffA); PG8_STAGE(PG8_SA(0, 1), cA + hstepA, voffA);
    if (wr == 1) PG8_BAR;
    PG8_WAIT_V(2); PG8_BAR;
    PG8_STAGE(PG8_SB(1, 0), cB + kstep, voffB); PG8_STAGE(PG8_SA(1, 0), cA + kstep, voffA); PG8_STAGE(PG8_SB(1, 1), cB + hstepB + kstep, voffB);
    PG8_WAIT_V(6); PG8_BAR;
    for (;;) {
        const bool has_next = S.next(ui + 1, nxt);
        const char* nA = has_next ? nxt.A : cA; const char* nB = has_next ? nxt.B : cB;
        for (int t = 0; t < nt; t += 2) {
            const bool last = (t == nt - 2);
            const char* a1 = cA + (size_t)(t + 1) * kstep;
            const char* a2 = last ? nA : cA + (size_t)(t + 2) * kstep; const char* b2 = last ? nB : cB + (size_t)(t + 2) * kstep;
            const char* a3 = a2 + kstep; const char* b3 = b2 + kstep;
            PG8_LDB(B0, 0, 0); PG8_LDB(B1, 0, 1); PG8_SCHED; PG8_LDA(At, 0, 0); PG8_STAGE(PG8_SA(1, 1), a1 + hstepA, voffA);
            PG8_WAIT_V(8); PG8_WAIT_L(0); PG8_BAR; PG8_MMA(0, 0, At, B0); PG8_MMA(0, 1, At, B1); PG8_BAR; PG8_SCHED;
            PG8_LDA(At, 0, 1); PG8_STAGE(PG8_SB(0, 0), b2, voffB); PG8_STAGE(PG8_SB(0, 1), b2 + hstepB, voffB); PG8_STAGE(PG8_SA(0, 0), a2, voffA);
            PG8_WAIT_V(8); PG8_WAIT_L(0); PG8_BAR; PG8_MMA(1, 0, At, B0); PG8_MMA(1, 1, At, B1); PG8_BAR; PG8_SCHED;
            PG8_LDB(B0, 1, 0); PG8_LDB(B1, 1, 1); PG8_SCHED; PG8_LDA(At, 1, 0); PG8_STAGE(PG8_SA(0, 1), a2 + hstepA, voffA);
            PG8_WAIT_V(8); PG8_WAIT_L(0); PG8_BAR; PG8_MMA(0, 0, At, B0); PG8_MMA(0, 1, At, B1); PG8_BAR; PG8_SCHED;
            PG8_LDA(At, 1, 1); PG8_STAGE(PG8_SB(1, 0), b3, voffB); PG8_STAGE(PG8_SB(1, 1), b3 + hstepB, voffB); PG8_STAGE(PG8_SA(1, 0), a3, voffA);
            PG8_WAIT_V(8); PG8_WAIT_L(0); PG8_BAR; PG8_MMA(1, 0, At, B0); PG8_MMA(1, 1, At, B1); PG8_BAR; PG8_SCHED;
        }
        if (wr == 0) PG8_BAR;
        E(acc, cur, wr, wc, fr, fq);
        if (!has_next) break;
#pragma unroll
        for (int a = 0; a < 2; ++a)
#pragma unroll
            for (int b = 0; b < 2; ++b)
#pragma unroll
                for (int m = 0; m < 4; ++m)
#pragma unroll
                    for (int n = 0; n < 2; ++n) acc[a][b][m][n] = (f32x4){0.f, 0.f, 0.f, 0.f};
        cur = nxt; cA = nA; cB = nB; ++ui;
        if (wr == 1) PG8_BAR;
    }
    PG8_WAIT_V(0);
    PG8_BAR;
#undef PG8_SA
#undef PG8_SB
#undef PG8_STAGE
#undef PG8_LDA
#undef PG8_LDB
#undef PG8_MMA
#undef PG8_WAIT_V
#undef PG8_WAIT_L
#undef PG8_BAR
#undef PG8_SCHED
}


struct EpiHyCM {
    static constexpr bool PERM = false;
    bf16_t* pcm; const float* bias;
    __device__ __forceinline__ void operator()(const f32x4 (&acc)[2][2][4][2], const Unit& u, int wr, int wc, int fr, int fq) const {
#pragma unroll
        for (int bj = 0; bj < 2; ++bj)
#pragma unroll
            for (int n = 0; n < 2; ++n) {
                const int c = u.pn * BM + bj * HALF + wc * 32 + n * 16 + fr; const float bv = bias[c];
#pragma unroll
                for (int ai = 0; ai < 2; ++ai)
#pragma unroll
                    for (int m = 0; m < 4; ++m) {
                        const int r = u.pm * BM + ai * HALF + wr * 64 + m * 16 + 4 * fq; const f32x4 v = acc[ai][bj][m][n] + bv;
                        u32x2 w; w.x = cvt_pk_bf16(v[0], v[1]); w.y = cvt_pk_bf16(v[2], v[3]);
                        *(u32x2*)(pcm + (size_t)c * MX + r) = w; }
                asm volatile("" ::: "memory");
            }
    }
};

struct EpiIn2 {
    static constexpr bool PERM = true;
    bf16_t* pml; bf16_t* pmg; bf16_t* pc; const float* bias;
    __device__ __forceinline__ void operator()(const f32x4 (&acc)[2][2][4][2], const Unit& u, int wr, int wc, int fr, int fq) const {
        const int colt = u.pn * BM; bf16_t* base; int ldc, cbase, bofs = 0, row0 = u.pm * BM; bool sg = false;
        if (u.aux) { base = pc; ldc = 1024; cbase = colt - 2048; row0 -= MX; }
        else if (colt < GATE0) { base = pml; ldc = 2048; cbase = colt - 1536; }
        else { base = pmg; ldc = 2048; cbase = colt - GATE0; bofs = 16; sg = true; }
        const int col0 = cbase + wc * 32 + 8 * fq, bcol0 = colt + bofs + wc * 32 + 8 * fq;
        f32x4 bv[2][2];
#pragma unroll
        for (int bj = 0; bj < 2; ++bj)
#pragma unroll
            for (int n = 0; n < 2; ++n) bv[bj][n] = *(const f32x4*)(bias + bcol0 + bj * HALF + 4 * n);
#pragma unroll
        for (int ai = 0; ai < 2; ++ai)
#pragma unroll
            for (int m = 0; m < 4; ++m) { bf16_t* rowp = base + (size_t)(row0 + wr * 64 + fr + ai * HALF + m * 16) * ldc + col0;
#pragma unroll
                for (int bj = 0; bj < 2; ++bj) { f32x4 v0 = acc[ai][bj][m][0] + bv[bj][0], v1 = acc[ai][bj][m][1] + bv[bj][1];
                    if (sg) {
#pragma unroll
                        for (int j = 0; j < 4; ++j) { v0[j] = sigm(v0[j]); v1[j] = sigm(v1[j]); } }
                    u32x4 w; w.x = cvt_pk_bf16(v0[0], v0[1]); w.y = cvt_pk_bf16(v0[2], v0[3]); w.z = cvt_pk_bf16(v1[0], v1[1]); w.w = cvt_pk_bf16(v1[2], v1[3]);
                    *(u32x4*)(rowp + bj * HALF) = w; }
                asm volatile("" ::: "memory"); }
    }
};

template <int MODE  > struct EpiMerge {
    static constexpr bool PERM = true;
    bf16_t* Z; const bf16_t* pmg;
    __device__ __forceinline__ void operator()(const f32x4 (&acc)[2][2][4][2], const Unit& u, int wr, int wc, int fr, int fq) const {
        const int row0 = u.pm * BM + wr * 64 + fr, col0 = u.pn * BM + wc * 32 + 8 * fq;
#pragma unroll
        for (int ai = 0; ai < 2; ++ai)
#pragma unroll
            for (int m = 0; m < 4; ++m) { const size_t row = (size_t)(row0 + ai * HALF + m * 16);
#pragma unroll
                for (int bj = 0; bj < 2; ++bj) {
                    const u32x4 g = *(const u32x4*)(pmg + row * 2048 + (MODE ? 1024 : 0) + col0 + bj * HALF);
                    f32x4 v0 = acc[ai][bj][m][0], v1 = acc[ai][bj][m][1];
                    v0[0] *= bflo(g.x); v0[1] *= bfhi(g.x); v0[2] *= bflo(g.y); v0[3] *= bfhi(g.y);
                    v1[0] *= bflo(g.z); v1[1] *= bfhi(g.z); v1[2] *= bflo(g.w); v1[3] *= bfhi(g.w);
                    bf16_t* zp = Z + row * 1024 + col0 + bj * HALF;
                    if (MODE) { const u32x4 z = *(const u32x4*)zp;
                        v0[0] += bflo(z.x); v0[1] += bfhi(z.x); v0[2] += bflo(z.y); v0[3] += bfhi(z.y);
                        v1[0] += bflo(z.z); v1[1] += bfhi(z.z); v1[2] += bflo(z.w); v1[3] += bfhi(z.w); }
                    u32x4 w; w.x = cvt_pk_bf16(v0[0], v0[1]); w.y = cvt_pk_bf16(v0[2], v0[3]); w.z = cvt_pk_bf16(v1[0], v1[1]); w.w = cvt_pk_bf16(v1[2], v1[3]);
                    *(u32x4*)zp = w; }
                asm volatile("" ::: "memory"); }
    }
};

struct EpiOut {
    static constexpr bool PERM = false;
    const float* x; float* xmid; const float* ada;
    __device__ __forceinline__ void operator()(const f32x4 (&acc)[2][2][4][2], const Unit& u, int wr, int wc, int fr, int fq) const {
        const int row0 = u.pm * BM + wr * 64 + fr, col0 = u.pn * BM + wc * 32 + 4 * fq;
        const int b = (u.pm * BM) / SEQ;
        f32x4 gv[2][2];
#pragma unroll
        for (int bj = 0; bj < 2; ++bj)
#pragma unroll
            for (int n = 0; n < 2; ++n) gv[bj][n] = *(const f32x4*)(ada + (size_t)b * 6144 + 2048 + col0 + bj * HALF + n * 16);
#pragma unroll
        for (int ai = 0; ai < 2; ++ai)
#pragma unroll
            for (int m = 0; m < 4; ++m) { const size_t off = (size_t)(row0 + ai * HALF + m * 16) * DM + col0;
#pragma unroll
                for (int bj = 0; bj < 2; ++bj)
#pragma unroll
                    for (int n = 0; n < 2; ++n) { const f32x4 xv = *(const f32x4*)(x + off + bj * HALF + n * 16);
                        *(f32x4*)(xmid + off + bj * HALF + n * 16) = xv + gv[bj][n] * acc[ai][bj][m][n]; }
                asm volatile("" ::: "memory"); }
    }
};

struct EpiMoe1 {
    static constexpr bool PERM = true;
    bf16_t* act;
    __device__ __forceinline__ void operator()(const f32x4 (&acc)[2][2][4][2], const Unit& u, int wr, int wc, int fr, int fq) const {
        const int row0 = u.aux * 4096 + u.pm * BM + wr * 64 + fr, col0 = (u.pn * BM + wc * 32) / 2 + 4 * fq;
#pragma unroll
        for (int ai = 0; ai < 2; ++ai)
#pragma unroll
            for (int m = 0; m < 4; ++m) { bf16_t* rowp = act + (size_t)(row0 + ai * HALF + m * 16) * DFF + col0;
#pragma unroll
                for (int bj = 0; bj < 2; ++bj) { const f32x4 v0 = acc[ai][bj][m][0], v1 = acc[ai][bj][m][1];
                    u32x2 w; w.x = cvt_pk_bf16(siluf(v0[0]) * v0[1], siluf(v0[2]) * v0[3]); w.y = cvt_pk_bf16(siluf(v1[0]) * v1[1], siluf(v1[2]) * v1[3]);
                    *(u32x2*)(rowp + bj * (HALF / 2)) = w; }
                asm volatile("" ::: "memory"); }
    }
};

struct EpiMoe2 {
    static constexpr bool PERM = true;
    bf16_t* ye; const float* sgate; int e0;
    __device__ __forceinline__ void operator()(const f32x4 (&acc)[2][2][4][2], const Unit& u, int wr, int wc, int fr, int fq) const {
        const int e = e0 + u.aux, col0 = u.pn * BM + wc * 32 + 8 * fq;
#pragma unroll
        for (int ai = 0; ai < 2; ++ai)
#pragma unroll
            for (int m = 0; m < 4; ++m) { const int rr = u.pm * BM + wr * 64 + fr + ai * HALF + m * 16;
                const float g = sgate[((rr >> 9) * NE + e) * CAP + (rr & 511)];
                bf16_t* rowp = ye + ((size_t)e * 4096 + rr) * DM + col0;
#pragma unroll
                for (int bj = 0; bj < 2; ++bj) { const f32x4 v0 = acc[ai][bj][m][0] * g, v1 = acc[ai][bj][m][1] * g;
                    u32x4 w; w.x = cvt_pk_bf16(v0[0], v0[1]); w.y = cvt_pk_bf16(v0[2], v0[3]); w.z = cvt_pk_bf16(v1[0], v1[1]); w.w = cvt_pk_bf16(v1[2], v1[3]);
                    *(u32x4*)(rowp + bj * HALF) = w; }
                asm volatile("" ::: "memory"); }
    }
};
}

struct Ctx {
    LAS unsigned char* lds;
    int tid, lane, wave, bid, G;
};

__device__ __forceinline__ void transpose_item(const float* W, int ldw, int K, int ncol0, bf16_t* WT, int dst_row0, int rmul, LAS float* scr, int kb, int nb, int lane) {
    const int k0 = 64 * kb, n0 = 32 * nb;
#pragma unroll 8
    for (int i = 0; i < 32; ++i) { const int kk = 2 * i + (lane >> 5); scr[kk * 33 + (lane & 31)] = W[(size_t)(k0 + kk) * ldw + ncol0 + n0 + (lane & 31)]; }
    LDS_WAIT();
    const int c = lane & 7;
#pragma unroll
    for (int j = 0; j < 4; ++j) { const int n = (lane >> 3) + 8 * j; const LAS float* s = scr + (8 * c) * 33 + n;
        u32x4 o; o.x = pk2(s[0 * 33], s[1 * 33]); o.y = pk2(s[2 * 33], s[3 * 33]); o.z = pk2(s[4 * 33], s[5 * 33]); o.w = pk2(s[6 * 33], s[7 * 33]);
        *(u32x4*)(WT + (size_t)(dst_row0 + (n0 + n) * rmul) * K + k0 + 8 * c) = o; }
    LDS_WAIT();
}

__device__ __forceinline__ void convert_expert_group(const Ctx& C, const Params& P, int g, bf16_t* w13, bf16_t* w2) {
    LAS float* scr = (LAS float*)(C.lds + C.wave * 8448);
    const int gw = C.bid * 8 + C.wave, NGW = C.G * 8;
    const int PER_E = 3072;
    for (int it = gw; it < 8 * PER_E; it += NGW) {
        const int el = it / PER_E, r = it % PER_E, e = g * 8 + el;
        if (r < 1024) transpose_item(P.in[23] + (size_t)e * DM * DFF, DFF, DM, 0, w13 + (size_t)el * 4096 * DM, 0, 2, scr, r / 64, r % 64, C.lane);
        else if (r < 2048) transpose_item(P.in[24] + (size_t)e * DM * DFF, DFF, DM, 0, w13 + (size_t)el * 4096 * DM, 1, 2, scr, (r - 1024) / 64, (r - 1024) % 64, C.lane);
        else transpose_item(P.in[25] + (size_t)e * DFF * DM, DM, DFF, 0, w2 + (size_t)el * DM * DFF, 0, 1, scr, (r - 2048) / 32, (r - 2048) % 32, C.lane);
    }
}

__device__ __forceinline__ void phase0(const Ctx& C, const Params& P) {
    unsigned char* ws = P.ws;
    const int gw = C.bid * 8 + C.wave, NGW = C.G * 8;
    {
        LAS float* scr = (LAS float*)(C.lds + C.wave * 8448);
        const int I_IN1 = 16 * 112, I_IN2 = 16 * 64, I_BH = 8 * 32, I_BM = 8 * 32, I_OUT = 16 * 32;
        const int NIT = I_IN1 + I_IN2 + I_BH + I_BM + I_OUT;
        for (int it = gw; it < NIT; it += NGW) {
            int r = it;
            if (r < I_IN1) { transpose_item(P.in[8], DIN, DM, 0, (bf16_t*)(ws + WS_WIN), 0, 1, scr, r / 112, r % 112, C.lane); continue; } r -= I_IN1;
            if (r < I_IN2) { transpose_item(P.in[8], DIN, DM, MERGE0, (bf16_t*)(ws + WS_WIN), GATE0, 1, scr, r / 64, r % 64, C.lane); continue; } r -= I_IN2;
            if (r < I_BH) { transpose_item(P.in[19], DM, 512, 0, (bf16_t*)(ws + WS_WBH), 0, 1, scr, r / 32, r % 32, C.lane); continue; } r -= I_BH;
            if (r < I_BM) { transpose_item(P.in[20], DM, 512, 0, (bf16_t*)(ws + WS_WBM), 0, 1, scr, r / 32, r % 32, C.lane); continue; } r -= I_BM;
            transpose_item(P.in[21], DM, DM, 0, (bf16_t*)(ws + WS_WOUT), 0, 1, scr, r / 32, r % 32, C.lane);
        }
    }
    {
        const float* wada = P.in[4]; const float* bada = P.in[5]; float* part = (float*)(ws + WS_ADAP);
        for (int it = gw; it < 96 * 32; it += NGW) {
            const int cgp = it % 96, ks = it / 96, k0 = ks * 32, n = cgp * 64 + C.lane;
            float sv[9];
            { const int k = k0 + (C.lane & 31);
#pragma unroll
              for (int r = 0; r < 8; ++r) sv[r] = siluf(P.in[1][r * DM + k]);
              sv[8] = siluf(P.in[3][k]); }
            float a[9];
#pragma unroll
            for (int r = 0; r < 9; ++r) a[r] = 0.f;
#pragma unroll 8
            for (int kk = 0; kk < 32; ++kk) { const float w = wada[(size_t)(k0 + kk) * 6144 + n];
#pragma unroll
                for (int r = 0; r < 9; ++r) a[r] += __shfl(sv[r], kk) * w; }
            const float bb = (ks == 0) ? bada[n] : 0.f;
#pragma unroll
            for (int r = 0; r < 9; ++r) part[((size_t)ks * 9 + r) * 6144 + n] = a[r] + bb;
        }
    }
    __syncthreads();
    {
        LAS float* zs = (LAS float*)C.lds;
        LAS float* h1 = zs + 16 * 33;
        LAS float* h2 = h1 + 16 * 64;
        bf16_t* krev = (bf16_t*)(ws + WS_KREV);
        const float* w1 = P.in[11]; const float* b1 = P.in[12]; const float* w2 = P.in[13]; const float* b2 = P.in[14]; const float* w3 = P.in[15];
        for (int it = C.bid; it < 256; it += C.G) {
            const int l0 = it * 16;
            __syncthreads();
            for (int idx = C.tid; idx < 16 * 33; idx += NTHR) { const int pos = idx / 33, m = idx % 33, l = l0 + pos; float v;
                if (m == 0) v = (float)l / 4095.0f;
                else { const int bi = (m - 1) & 15; const float band = 1e-4f + (float)bi * ((15.0f - 1e-4f) / 15.0f);
                    const float ang = ((float)(2.0 * 3.14159265358979323846 / 4096.0) * (float)l) * band; v = (m <= 16) ? cosf(ang) : sinf(ang); }
                zs[idx] = v; }
            __syncthreads();
            for (int idx = C.tid; idx < 16 * 64; idx += NTHR) { const int pos = idx >> 6, j = idx & 63; float s = b1[j];
                for (int m = 0; m < 33; ++m) s += zs[pos * 33 + m] * w1[m * 64 + j];
                h1[idx] = sinf(s); }
            __syncthreads();
            for (int idx = C.tid; idx < 16 * 64; idx += NTHR) { const int pos = idx >> 6, j = idx & 63; float s = b2[j];
                for (int k = 0; k < 64; ++k) s += h1[pos * 64 + k] * w2[k * 64 + j];
                h2[idx] = sinf(s); }
            __syncthreads();
#pragma unroll 1
            for (int q = 0; q < 4; ++q) {
                const int n = C.tid + NTHR * q;
                float a[16];
#pragma unroll
                for (int p = 0; p < 16; ++p) a[p] = 0.f;
                for (int k = 0; k < 64; ++k) { const float w = w3[k * 2048 + n];
#pragma unroll
                    for (int p = 0; p < 16; ++p) a[p] += h2[p * 64 + k] * w; }
                const int o = n >> 10, side = (n >> 9) & 1, c = n & 511;
                const float delta = fabsf(-3.0701134573253944f + (float)c * ((-15.350567286626972f + 3.0701134573253944f) / 511.0f));
                bf16_t* dst = krev + ((size_t)o * 512 + c) * 8192;
#pragma unroll
                for (int p = 0; p < 16; ++p) { const int l = l0 + p; const float t = (float)l / 4095.0f; const float v = a[p] * expf(-t * delta);
                    if (side == 0) dst[4096 - l] = (bf16_t)f2bf(v);
                    else if (l > 0) dst[4096 + l] = (bf16_t)f2bf(v);
                    else dst[0] = 0; }
            }
        }
    }
}

__device__ __forceinline__ void row_dot16(const f32x4 (&y)[4], const LAS float* Wl, int lane, float (&r)[16]) {
#pragma unroll
    for (int e = 0; e < 16; ++e) r[e] = 0.f;
#pragma unroll
    for (int j = 0; j < 4; ++j) {
#pragma unroll
        for (int q = 0; q < 4; ++q) { const int k = 4 * lane + 256 * j + q; const float v = y[j][q];
#pragma unroll
            for (int e4 = 0; e4 < 4; ++e4) { const f32x4 w = *(const LAS f32x4*)(Wl + k * 16 + e4 * 4);
                r[e4 * 4 + 0] += v * w[0]; r[e4 * 4 + 1] += v * w[1]; r[e4 * 4 + 2] += v * w[2]; r[e4 * 4 + 3] += v * w[3]; } }
        asm volatile("" ::: "memory"); }
#pragma unroll
    for (int e = 0; e < 16; ++e) r[e] = wave_sum(r[e]);
}

__device__ __forceinline__ void phase1(const Ctx& C, const Params& P) {
    unsigned char* ws = P.ws;
    const float* part = (const float*)(ws + WS_ADAP); float* ada = (float*)(ws + WS_ADA);
    for (int o = C.bid * NTHR + C.tid; o < 9 * 6144; o += C.G * NTHR) { float s = 0.f;
        for (int ks = 0; ks < 32; ++ks) s += part[(size_t)ks * 9 * 6144 + o];
        ada[o] = s; }
    LAS float* Wg = (LAS float*)C.lds;
    LAS float* mod = Wg + 1024 * 16;
    for (int idx = C.tid; idx < 1024 * 16; idx += NTHR) Wg[idx] = P.in[8][(size_t)(idx >> 4) * DIN + GATE0 + (idx & 15)];
    const float* gmix = P.in[6]; const float* bin = P.in[9];
    bf16_t* hx = (bf16_t*)(ws + WS_HX); float* gates = (float*)(ws + WS_GATES);
    for (int rg = C.bid; rg < 256; rg += C.G) {
        const int b = rg >> 5;
        __syncthreads();
        for (int idx = C.tid; idx < 4096; idx += NTHR) { const int which = idx >> 10, k = idx & 1023; const int r = (which < 2) ? b : 8; const int col = (which & 1) * 1024 + k;
            float s = 0.f;
            for (int ks = 0; ks < 32; ++ks) s += part[((size_t)ks * 9 + r) * 6144 + col];
            mod[idx] = s; }
        __syncthreads();
        for (int rr = C.wave; rr < 136; rr += 8) {
            const bool isx = rr < 128; const int grow = isx ? (rg * 128 + rr) : (MX + rg * 8 + (rr - 128));
            const float* src = isx ? (P.in[0] + (size_t)grow * DM) : (P.in[2] + (size_t)(grow - MX) * DM);
            const LAS float* sh = mod + (isx ? 0 : 2048); const LAS float* sc = sh + 1024;
            f32x4 v[4]; float ss = 0.f;
#pragma unroll
            for (int j = 0; j < 4; ++j) { v[j] = *(const f32x4*)(src + 4 * C.lane + 256 * j); ss += v[j][0] * v[j][0] + v[j][1] * v[j][1] + v[j][2] * v[j][2] + v[j][3] * v[j][3]; }
            const float rstd = rsqrtf(wave_sum(ss) * (1.f / DM) + RMS_EPS);
#pragma unroll
            for (int j = 0; j < 4; ++j) { const int k = 4 * C.lane + 256 * j; const f32x4 g = *(const f32x4*)(gmix + k);
                const f32x4 s4 = *(const LAS f32x4*)(sc + k), h4 = *(const LAS f32x4*)(sh + k);
#pragma unroll
                for (int q = 0; q < 4; ++q) v[j][q] = (v[j][q] * rstd * g[q]) * (1.f + s4[q]) + h4[q];
                u32x2 w; w.x = pk2(v[j][0], v[j][1]); w.y = pk2(v[j][2], v[j][3]);
                *(u32x2*)(hx + (size_t)grow * DM + k) = w; }
            float r16[16]; row_dot16(v, Wg, C.lane, r16);
            if (C.lane < 16) { float o = 0.f;
#pragma unroll
                for (int e = 0; e < 16; ++e) o = (C.lane == e) ? r16[e] : o;
                gates[(size_t)grow * 16 + C.lane] = o + bin[GATE0 + C.lane]; }
        }
    }
}

__device__ __forceinline__ void phase2a(const Ctx& C, const Params& P) {
    unsigned char* ws = P.ws;
    pg8::SchedGrid S{(const char*)(ws + WS_HX), (const char*)(ws + WS_WIN), (size_t)256 * 2048, (size_t)256 * 2048, 128, 6, 0, 0, C.G, C.bid, 1, 0, 0, 0};
    pg8::EpiHyCM E{(bf16_t*)(ws + WS_PCM), P.in[9]};
    pg8::gemm_phase<pg8::EpiHyCM, pg8::SchedGrid, true>(C.lds, 1024, 2048, 2048, S, E);
}
__device__ __forceinline__ void phase2b(const Ctx& C, const Params& P) {
    unsigned char* ws = P.ws;
    pg8::SchedGrid S{(const char*)(ws + WS_HX), (const char*)(ws + WS_WIN), (size_t)256 * 2048, (size_t)256 * 2048, 128, 16, 0, 6, C.G, C.bid, 4, 128, 8, 32};
    pg8::EpiIn2 E{(bf16_t*)(ws + WS_PML), (bf16_t*)P.out, (bf16_t*)(ws + WS_PC), P.in[9]};
    pg8::gemm_phase<pg8::EpiIn2, pg8::SchedGrid, false>(C.lds, 1024, 2048, 2048, S, E);
}
__device__ __forceinline__ void phase_merge(const Ctx& C, const Params& P) {
    unsigned char* ws = P.ws;
    pg8::SchedGrid S{(const char*)(ws + WS_YA), (const char*)(ws + WS_WBH), (size_t)256 * 1024, (size_t)256 * 1024, 128, 4, 0, 0, C.G, C.bid, 1, 0, 0, 0};
    pg8::EpiMerge<0> E0{(bf16_t*)(ws + WS_Z), (const bf16_t*)P.out};
    pg8::gemm_phase<pg8::EpiMerge<0>, pg8::SchedGrid, false>(C.lds, 512, 1024, 1024, S, E0);
    S.A = (const char*)(ws + WS_YB); S.B = (const char*)(ws + WS_WBM);
    pg8::EpiMerge<1> E1{(bf16_t*)(ws + WS_Z), (const bf16_t*)P.out};
    pg8::gemm_phase<pg8::EpiMerge<1>, pg8::SchedGrid, false>(C.lds, 512, 1024, 1024, S, E1);
}
__device__ __forceinline__ void phase_outproj(const Ctx& C, const Params& P) {
    unsigned char* ws = P.ws;
    pg8::SchedGrid S{(const char*)(ws + WS_Z), (const char*)(ws + WS_WOUT), (size_t)256 * 2048, (size_t)256 * 2048, 128, 4, 0, 0, C.G, C.bid, 1, 0, 0, 0};
    pg8::EpiOut E{P.in[0], P.out, (const float*)(ws + WS_ADA)};
    pg8::gemm_phase<pg8::EpiOut, pg8::SchedGrid, false>(C.lds, 1024, 2048, 2048, S, E);
}

constexpr int HY_KSTR = 16448;
constexpr int HY_UOFF = 4 * HY_KSTR;
constexpr int HY_USTR = 4360;
__device__ __forceinline__ void hyena_item(const Ctx& C, const Params& P, int o, int c) {
    unsigned char* ws = P.ws;
    LAS bf16_t* krv = (LAS bf16_t*)C.lds;
    LAS bf16_t* up = (LAS bf16_t*)(C.lds + HY_UOFF);
    const bf16_t* pcm = (const bf16_t*)(ws + WS_PCM);
    const float* hconv = P.in[10];
    __syncthreads();
    {
        const u32x4* src = (const u32x4*)((const bf16_t*)(ws + WS_KREV) + ((size_t)o * 512 + c) * 8192);
        for (int i = C.tid; i < 1024; i += NTHR) *(LAS u32x4*)(krv + 8 * i) = src[i];
        for (int i = C.tid; i < 8 * 32; i += NTHR) { const int b = i >> 5, q = i & 31; const int off = (q < 16) ? 8 * q : (4224 + 8 * (q - 16));
            *(LAS u32x4*)(up + b * HY_USTR + off) = (u32x4){0u, 0u, 0u, 0u}; }
        if (o == 0) {
            const bf16_t* src0 = pcm + (size_t)c * MX; const float w0 = hconv[c], w1 = hconv[1536 + c], w2 = hconv[3072 + c];
            for (int i = C.tid; i < 4096; i += NTHR) { const int r0 = 8 * i; const u32x4 v = *(const u32x4*)(src0 + r0);
                float x[10]; x[1] = bflo(v.x); x[2] = bfhi(v.x); x[3] = bflo(v.y); x[4] = bfhi(v.y); x[5] = bflo(v.z); x[6] = bfhi(v.z); x[7] = bflo(v.w); x[8] = bfhi(v.w);
                x[0] = ((r0 & 63) != 0) ? bf2f(src0[r0 - 1]) : 0.f; x[9] = ((r0 & 63) != 56) ? bf2f(src0[r0 + 8]) : 0.f;
                float y[8];
#pragma unroll
                for (int j = 0; j < 8; ++j) y[j] = w0 * x[j] + w1 * x[j + 1] + w2 * x[j + 2];
                u32x4 w; w.x = pk2(y[0], y[1]); w.y = pk2(y[2], y[3]); w.z = pk2(y[4], y[5]); w.w = pk2(y[6], y[7]);
                *(LAS u32x4*)(up + (r0 >> 12) * HY_USTR + 128 + (r0 & 4095)) = w; }
        } else {
            const u32x4* src1 = (const u32x4*)((const bf16_t*)(ws + WS_Z1) + (size_t)c * MX);
            for (int i = C.tid; i < 4096; i += NTHR) { const int r0 = 8 * i; *(LAS u32x4*)(up + (r0 >> 12) * HY_USTR + 128 + (r0 & 4095)) = src1[i]; }
        }
    }
    __syncthreads();
    for (int idx = C.tid; idx < 3 * 1025; idx += NTHR) { const int rho = 1 + idx / 1025, ch = idx % 1025; unsigned short e[8];
#pragma unroll
        for (int j = 0; j < 8; ++j) { const int z = 8 * ch + j - rho; e[j] = (z >= 0 && z < 8192) ? krv[z] : (unsigned short)0; }
        u32x4 w; w.x = e[0] | ((unsigned)e[1] << 16); w.y = e[2] | ((unsigned)e[3] << 16); w.z = e[4] | ((unsigned)e[5] << 16); w.w = e[6] | ((unsigned)e[7] << 16);
        *(LAS u32x4*)(C.lds + rho * HY_KSTR + 16 * ch) = w; }
    if (C.tid == 0) *(LAS u32x4*)(C.lds + 16 * 1024) = (u32x4){0u, 0u, 0u, 0u};
    __syncthreads();
    const int lane = C.lane, w = C.wave, i = lane & 31, kq = lane >> 5, nb = (lane >> 2) & 7, np = lane & 3, rho = i & 3;
    f32x16 acc[4];
#pragma unroll
    for (int a = 0; a < 4; ++a)
#pragma unroll
        for (int r = 0; r < 16; ++r) acc[a][r] = 0.f;
    const int abase = rho * HY_KSTR + 2 * (4096 - i + 8 * kq + rho) - 1024 * w - 768;
    const int bbase = HY_UOFF + 2 * (nb * HY_USTR + 128 + 32 * np + 8 * kq);
    typedef const volatile LAS u32x2* vp2;
#define HY_LOAD(AF, BF, s0) do { const int _a = abase + 2 * (s0); BF = *(const LAS bf16x8*)(C.lds + bbase + 2 * (s0)); \
        _Pragma("unroll") for (int a = 0; a < 4; ++a) { const u32x2 lo = *(vp2)(C.lds + _a + 256 * (3 - a)), hi = *(vp2)(C.lds + _a + 256 * (3 - a) + 8); \
            AF[a] = __builtin_bit_cast(bf16x8, (u32x4){lo.x, lo.y, hi.x, hi.y}); } } while (0)
    bf16x8 a0[4], a1[4], b0, b1;
    HY_LOAD(a0, b0, -96);
    for (int s0 = -96; s0 < 4096; s0 += 32) {
        HY_LOAD(a1, b1, s0 + 16);
#pragma unroll
        for (int a = 0; a < 4; ++a) acc[a] = __builtin_amdgcn_mfma_f32_32x32x16_bf16(a0[a], b0, acc[a], 0, 0, 0);
        if (s0 + 32 < 4096) HY_LOAD(a0, b0, s0 + 32);
#pragma unroll
        for (int a = 0; a < 4; ++a) acc[a] = __builtin_amdgcn_mfma_f32_32x32x16_bf16(a1[a], b1, acc[a], 0, 0, 0);
    }
#undef HY_LOAD
    const int gch = (o == 0 ? 512 : 1024) + c;
    const float w0 = hconv[gch], w1 = hconv[1536 + gch], w2 = hconv[3072 + gch], skip = P.in[16][o * 512 + c];
    const bf16_t* gsrc = pcm + (size_t)gch * MX + (size_t)nb * SEQ;
    bf16_t* dst = (bf16_t*)(ws + (o == 0 ? WS_Z1 : WS_Z)) + (size_t)c * MX + (size_t)nb * SEQ;
#pragma unroll
    for (int a = 0; a < 4; ++a)
#pragma unroll
        for (int g = 0; g < 4; ++g) {
            const int t0 = 128 * (4 * w + a) + 32 * np + 8 * g + 4 * kq;
            const u32x2 gv = *(const u32x2*)(gsrc + t0);
            float x[6]; x[1] = bflo(gv.x); x[2] = bfhi(gv.x); x[3] = bflo(gv.y); x[4] = bfhi(gv.y);
            x[0] = ((t0 & 63) != 0) ? bf2f(gsrc[t0 - 1]) : 0.f; x[5] = ((t0 & 63) != 60) ? bf2f(gsrc[t0 + 4]) : 0.f;
            const u32x2 uv = *(const LAS u32x2*)(up + nb * HY_USTR + 128 + t0);
            const float uu[4] = {bflo(uv.x), bfhi(uv.x), bflo(uv.y), bfhi(uv.y)};
            float z[4];
#pragma unroll
            for (int j = 0; j < 4; ++j) { const float gate = w0 * x[j] + w1 * x[j + 1] + w2 * x[j + 2]; z[j] = gate * (acc[a][4 * g + j] + skip * uu[j]); }
            u32x2 wv; wv.x = pk2(z[0], z[1]); wv.y = pk2(z[2], z[3]);
            *(u32x2*)(dst + t0) = wv;
        }
}

constexpr int MLP = 136;
struct ChunkRef { int isctx, b, h, d, oc; };
__device__ __forceinline__ int chunk_row0(const ChunkRef& r) { return r.isctx ? (MX + r.b * CTXL + r.oc * 128) : (r.b * SEQ + r.oc * 128); }

__device__ __forceinline__ void chunk_gates(const Ctx& C, const Params& P, const ChunkRef& r, LAS float* li, LAS float* lf, LAS float* bc) {
    const float* gates = (const float*)(P.ws + WS_GATES);
    if (C.tid < 128) { const float* g = gates + (size_t)(chunk_row0(r) + C.tid) * 16; li[C.tid] = g[(r.d ? 8 : 0) + r.h]; lf[C.tid] = logsig(g[(r.d ? 12 : 4) + r.h]); }
    __syncthreads();
    if (C.tid < 128) { float s = 0.f;
        if (!r.d) { for (int q = 0; q <= C.tid; ++q) s += lf[q]; } else { for (int q = 127; q >= C.tid; --q) s += lf[q]; }
        bc[C.tid] = s; }
    __syncthreads();
}

__device__ __forceinline__ void conv_silu8(const bf16_t* base, int ld, int orig, int rowlen, const float* cw, int col, float scale, float (&y)[8]) {
    const u32x4 vc = *(const u32x4*)(base);
    const bool hl = (orig % rowlen) != 0, hr = (orig % rowlen) != rowlen - 1;
    u32x4 vl = (u32x4){0u, 0u, 0u, 0u}, vr = (u32x4){0u, 0u, 0u, 0u};
    if (hl) vl = *(const u32x4*)(base - ld);
    if (hr) vr = *(const u32x4*)(base + ld);
    const unsigned l4[4] = {vl.x, vl.y, vl.z, vl.w}, c4[4] = {vc.x, vc.y, vc.z, vc.w}, r4[4] = {vr.x, vr.y, vr.z, vr.w};
#pragma unroll
    for (int q = 0; q < 4; ++q) {
        const float a0 = cw[col + 2 * q] * bflo(l4[q]) + cw[1024 + col + 2 * q] * bflo(c4[q]) + cw[2048 + col + 2 * q] * bflo(r4[q]);
        const float a1 = cw[col + 2 * q + 1] * bfhi(l4[q]) + cw[1024 + col + 2 * q + 1] * bfhi(c4[q]) + cw[2048 + col + 2 * q + 1] * bfhi(r4[q]);
        y[2 * q] = siluf(a0) * scale; y[2 * q + 1] = siluf(a1) * scale; }
}

__device__ __forceinline__ void mlstm_a_item(const Ctx& C, const Params& P, int item) {
    unsigned char* ws = P.ws;
    const int j = item % NCHK, seq = item / NCHK, h = seq & 3, b = (seq >> 2) & 7, d = seq >> 5;
    ChunkRef r; r.isctx = j < 2; r.b = b; r.h = h; r.d = d; { const int jj = r.isctx ? j : j - 2, nch = r.isctx ? 2 : 32; r.oc = d ? (nch - 1 - jj) : jj; }
    LAS bf16_t* kT = (LAS bf16_t*)C.lds;
    LAS bf16_t* vT = kT + 128 * MLP;
    LAS float* li = (LAS float*)(C.lds + 2 * 128 * MLP * 2); LAS float* lf = li + 128; LAS float* bc = lf + 128; LAS float* wl = bc + 128;
    __syncthreads();
    chunk_gates(C, P, r, li, lf, bc);
    const float Bj = r.d ? bc[0] : bc[127];
    if (C.tid < 128) wl[C.tid] = Bj - bc[C.tid] + li[C.tid];
    __syncthreads();
    float Lj = -3.0e38f;
    for (int q = 0; q < 128; ++q) Lj = fmaxf(Lj, wl[q]);
    __syncthreads();
    if (C.tid < 128) wl[C.tid] = __expf(wl[C.tid] - Lj);
    __syncthreads();
    const int rowlen = r.isctx ? CTXL : 64, ld = r.isctx ? 1024 : 2048;
    const bf16_t* kbase = r.isctx ? ((const bf16_t*)(ws + WS_PC) + (size_t)(b * CTXL + r.oc * 128) * 1024 + h * 128)
                                  : ((const bf16_t*)(ws + WS_PML) + (size_t)(b * SEQ + r.oc * 128) * 2048 + 512 + h * 128);
    const bf16_t* vbase = r.isctx ? (kbase + 512) : (kbase + 512);
    const float* cw = P.in[17];
    for (int idx = C.tid; idx < 128 * 16; idx += NTHR) { const int tau = idx >> 4, dc = (idx & 15) * 8; const int orig = r.oc * 128 + tau;
        float y[8]; conv_silu8(kbase + (size_t)tau * ld + dc, ld, orig, rowlen, cw, 512 + h * 128 + dc, 1.f, y);
#pragma unroll
        for (int q = 0; q < 8; ++q) kT[(dc + q) * MLP + tau] = (bf16_t)f2bf(y[q]);
        const u32x4 vv = *(const u32x4*)(vbase + (size_t)tau * ld + dc); const float wgt = wl[tau];
        const unsigned v4[4] = {vv.x, vv.y, vv.z, vv.w};
#pragma unroll
        for (int q = 0; q < 4; ++q) { vT[(dc + 2 * q) * MLP + tau] = (bf16_t)f2bf(bflo(v4[q]) * wgt); vT[(dc + 2 * q + 1) * MLP + tau] = (bf16_t)f2bf(bfhi(v4[q]) * wgt); } }
    __syncthreads();
    if (C.tid < 128) { float s = 0.f; for (int q = 0; q < 128; ++q) s += wl[q] * bf2f(kT[C.tid * MLP + q]);
        ((float*)(ws + WS_NLOC))[(size_t)item * 128 + C.tid] = s; }
    if (C.tid == 0) { float* bl = (float*)(ws + WS_BL) + (size_t)item * 2; bl[0] = Bj; bl[1] = Lj; }
    const int lane = C.lane, w = C.wave, fr = lane & 15, fq = lane >> 4;
    bf16x8 af[4];
#pragma unroll
    for (int ks = 0; ks < 4; ++ks) af[ks] = *(const LAS bf16x8*)(vT + (16 * w + fr) * MLP + 32 * ks + 8 * fq);
    bf16_t* dst = (bf16_t*)(ws + WS_PLOC) + (size_t)item * 16384;
#pragma unroll
    for (int nt = 0; nt < 8; ++nt) { f32x4 acc = (f32x4){0.f, 0.f, 0.f, 0.f};
#pragma unroll
        for (int ks = 0; ks < 4; ++ks) { const bf16x8 bfr = *(const LAS bf16x8*)(kT + (16 * nt + fr) * MLP + 32 * ks + 8 * fq);
            acc = __builtin_amdgcn_mfma_f32_16x16x32_bf16(af[ks], bfr, acc, 0, 0, 0); }
#pragma unroll
        for (int q = 0; q < 4; ++q) dst[(16 * w + 4 * fq + q) * 128 + 16 * nt + fr] = (bf16_t)f2bf(acc[q]); }
}

__device__ __forceinline__ void mlstm_scan(const Ctx& C, const Params& P) {
    unsigned char* ws = P.ws;
    const float* BL = (const float*)(ws + WS_BL); const bf16_t* ploc = (const bf16_t*)(ws + WS_PLOC); bf16_t* cst = (bf16_t*)(ws + WS_CST);
    for (int slot = C.bid * NTHR + C.tid; slot < 64 * 2048; slot += C.G * NTHR) {
        const int seq = slot >> 11, off = (slot & 2047) * 8;
        float cs[8];
#pragma unroll
        for (int q = 0; q < 8; ++q) cs[q] = 0.f;
        float m = 0.f;
        u32x4 pl[NCHK - 1];
#pragma unroll
        for (int j = 0; j < NCHK - 1; ++j) pl[j] = *(const u32x4*)(ploc + ((size_t)(seq * NCHK + j)) * 16384 + off);
#pragma unroll
        for (int j = 0; j < NCHK; ++j) {
            if (j >= 2) { u32x4 o; o.x = pk2(cs[0], cs[1]); o.y = pk2(cs[2], cs[3]); o.z = pk2(cs[4], cs[5]); o.w = pk2(cs[6], cs[7]);
                *(u32x4*)(cst + ((size_t)(seq * 32 + j - 2)) * 16384 + off) = o;
                if (off == 0) ((float*)(ws + WS_MST))[seq * 32 + j - 2] = m; }
            if (j < NCHK - 1) {
                const float Bj = BL[(seq * NCHK + j) * 2], Lj = BL[(seq * NCHK + j) * 2 + 1];
                const float mn = fmaxf(Bj + m, Lj), dec = __expf(Bj + m - mn), sc = __expf(Lj - mn);
                const unsigned p4[4] = {pl[j].x, pl[j].y, pl[j].z, pl[j].w};
#pragma unroll
                for (int q = 0; q < 4; ++q) { cs[2 * q] = dec * cs[2 * q] + sc * bflo(p4[q]); cs[2 * q + 1] = dec * cs[2 * q + 1] + sc * bfhi(p4[q]); }
                m = mn; }
        }
    }
    for (int idx = C.bid * NTHR + C.tid; idx < 64 * 128; idx += C.G * NTHR) {
        const int seq = idx >> 7, dd = idx & 127; float n = 0.f, m = 0.f;
        const float* nloc = (const float*)(ws + WS_NLOC); float* nst = (float*)(ws + WS_NST);
        for (int j = 0; j < NCHK; ++j) {
            if (j >= 2) nst[(size_t)(seq * 32 + j - 2) * 128 + dd] = n;
            if (j < NCHK - 1) { const float Bj = BL[(seq * NCHK + j) * 2], Lj = BL[(seq * NCHK + j) * 2 + 1];
                const float mn = fmaxf(Bj + m, Lj); n = __expf(Bj + m - mn) * n + __expf(Lj - mn) * nloc[(size_t)(seq * NCHK + j) * 128 + dd]; m = mn; }
        }
    }
}

__device__ __forceinline__ void mlstm_c_item(const Ctx& C, const Params& P, int item) {
    unsigned char* ws = P.ws;
    const int oc = item & 31, h = (item >> 5) & 3, b = item >> 7;
    LAS bf16_t* Qs = (LAS bf16_t*)C.lds; LAS bf16_t* Ks = Qs + 128 * MLP; LAS bf16_t* VT = Ks + 128 * MLP; LAS bf16_t* CT = VT + 128 * MLP;
    LAS float* li = (LAS float*)(C.lds + 4 * 128 * MLP * 2); LAS float* lf = li + 128; LAS float* bc = lf + 128; LAS float* rowf = bc + 128; LAS float* colf = rowf + 128;
    LAS float* ainter = colf + 128; LAS float* emneg = ainter + 128; LAS float* nsl = emneg + 128;
    const int lane = C.lane, w = C.wave, fr = lane & 15, fq = lane >> 4;
    const bf16_t* pml = (const bf16_t*)(ws + WS_PML) + (size_t)(b * SEQ + oc * 128) * 2048;
    const float* cw = P.in[17];
    f32x4 hacc[8];
#pragma unroll
    for (int nt = 0; nt < 8; ++nt) hacc[nt] = (f32x4){0.f, 0.f, 0.f, 0.f};
#pragma unroll 1
    for (int d = 0; d < 2; ++d) {
        ChunkRef r; r.isctx = 0; r.b = b; r.h = h; r.d = d; r.oc = oc;
        const int sidx = ((d * 8 + b) * 4 + h) * 32 + (d ? 31 - oc : oc);
        __syncthreads();
        chunk_gates(C, P, r, li, lf, bc);
        const float m0 = ((const float*)(ws + WS_MST))[sidx];
        if (C.tid < 128) { const int t = C.tid; float g = -3.0e38f;
            if (!d) { for (int q = 0; q <= t; ++q) g = fmaxf(g, li[q] - bc[q]); } else { for (int q = 127; q >= t; --q) g = fmaxf(g, li[q] - bc[q]); }
            const float mx = fmaxf(m0, g);
            rowf[t] = -mx; colf[t] = li[t] - bc[t]; ainter[t] = __expf(m0 - mx); emneg[t] = __expf(-(bc[t] + mx));
            nsl[t] = ((const float*)(ws + WS_NST))[(size_t)sidx * 128 + t]; }
        for (int idx = C.tid; idx < 128 * 16; idx += NTHR) { const int tau = idx >> 4, dc = (idx & 15) * 8; const int orig = oc * 128 + tau;
            float y[8]; conv_silu8(pml + (size_t)tau * 2048 + h * 128 + dc, 2048, orig, 64, cw, h * 128 + dc, 0.08838834764831845f, y);
            u32x4 o; o.x = pk2(y[0], y[1]); o.y = pk2(y[2], y[3]); o.z = pk2(y[4], y[5]); o.w = pk2(y[6], y[7]);
            *(LAS u32x4*)(Qs + tau * MLP + dc) = o;
            conv_silu8(pml + (size_t)tau * 2048 + 512 + h * 128 + dc, 2048, orig, 64, cw, 512 + h * 128 + dc, 1.f, y);
            o.x = pk2(y[0], y[1]); o.y = pk2(y[2], y[3]); o.z = pk2(y[4], y[5]); o.w = pk2(y[6], y[7]);
            *(LAS u32x4*)(Ks + tau * MLP + dc) = o;
            const u32x4 vv = *(const u32x4*)(pml + (size_t)tau * 2048 + 1024 + h * 128 + dc); const unsigned v4[4] = {vv.x, vv.y, vv.z, vv.w};
#pragma unroll
            for (int q = 0; q < 4; ++q) { VT[(dc + 2 * q) * MLP + tau] = (bf16_t)(v4[q] & 0xffffu); VT[(dc + 2 * q + 1) * MLP + tau] = (bf16_t)(v4[q] >> 16); }
            *(LAS u32x4*)(CT + tau * MLP + dc) = *(const u32x4*)((const bf16_t*)(ws + WS_CST) + (size_t)sidx * 16384 + tau * 128 + dc); }
        __syncthreads();
        bf16x8 qf[4];
#pragma unroll
        for (int ks = 0; ks < 4; ++ks) qf[ks] = *(const LAS bf16x8*)(Qs + (16 * w + fr) * MLP + 32 * ks + 8 * fq);
        f32x4 sacc[8];
#pragma unroll
        for (int nt = 0; nt < 8; ++nt) { f32x4 a = (f32x4){0.f, 0.f, 0.f, 0.f};
#pragma unroll
            for (int ks = 0; ks < 4; ++ks) { const bf16x8 kf = *(const LAS bf16x8*)(Ks + (16 * nt + fr) * MLP + 32 * ks + 8 * fq);
                a = __builtin_amdgcn_mfma_f32_16x16x32_bf16(qf[ks], kf, a, 0, 0, 0); }
            sacc[nt] = a; }
        float qn; { float s = 0.f; for (int q = 0; q < 32; ++q) s += bf2f(Qs[(16 * w + fr) * MLP + 32 * fq + q]) * nsl[32 * fq + q];
            s += __shfl_xor(s, 16); s += __shfl_xor(s, 32); qn = s; }
        __syncthreads();
        float rs[4] = {0.f, 0.f, 0.f, 0.f};
#pragma unroll
        for (int nt = 0; nt < 8; ++nt) { const int s = 16 * nt + fr; const float cf = colf[s];
#pragma unroll
            for (int q = 0; q < 4; ++q) { const int t = 16 * w + 4 * fq + q; const bool ok = d ? (s >= t) : (s <= t);
                const float pv = ok ? __expf(rowf[t] + cf) * sacc[nt][q] : 0.f; rs[q] += pv;
                Ks[t * MLP + s] = (bf16_t)f2bf(pv); } }
#pragma unroll
        for (int q = 0; q < 4; ++q) { rs[q] += __shfl_xor(rs[q], 1); rs[q] += __shfl_xor(rs[q], 2); rs[q] += __shfl_xor(rs[q], 4); rs[q] += __shfl_xor(rs[q], 8); }
        LDS_WAIT();
        bf16x8 pf[4];
#pragma unroll
        for (int ks = 0; ks < 4; ++ks) pf[ks] = *(const LAS bf16x8*)(Ks + (16 * w + fr) * MLP + 32 * ks + 8 * fq);
        float den[4], ai4[4], em4[4];
#pragma unroll
        for (int q = 0; q < 4; ++q) { const int t = 16 * w + 4 * fq + q; const float qnr = __shfl(qn, 4 * fq + q);
            ai4[q] = ainter[t]; em4[q] = emneg[t]; den[q] = rs[q] + ai4[q] * qnr; den[q] = 1.f / fmaxf(fabsf(den[q]), em4[q]); }
#pragma unroll
        for (int nt = 0; nt < 8; ++nt) { f32x4 a = (f32x4){0.f, 0.f, 0.f, 0.f}, c = (f32x4){0.f, 0.f, 0.f, 0.f};
#pragma unroll
            for (int ks = 0; ks < 4; ++ks) { const bf16x8 vf = *(const LAS bf16x8*)(VT + (16 * nt + fr) * MLP + 32 * ks + 8 * fq);
                a = __builtin_amdgcn_mfma_f32_16x16x32_bf16(pf[ks], vf, a, 0, 0, 0);
                const bf16x8 cf = *(const LAS bf16x8*)(CT + (16 * nt + fr) * MLP + 32 * ks + 8 * fq);
                c = __builtin_amdgcn_mfma_f32_16x16x32_bf16(qf[ks], cf, c, 0, 0, 0); }
#pragma unroll
            for (int q = 0; q < 4; ++q) hacc[nt][q] += (a[q] + ai4[q] * c[q]) * den[q]; }
    }
    float ss[4] = {0.f, 0.f, 0.f, 0.f};
#pragma unroll
    for (int nt = 0; nt < 8; ++nt)
#pragma unroll
        for (int q = 0; q < 4; ++q) ss[q] += hacc[nt][q] * hacc[nt][q];
#pragma unroll
    for (int q = 0; q < 4; ++q) { ss[q] += __shfl_xor(ss[q], 1); ss[q] += __shfl_xor(ss[q], 2); ss[q] += __shfl_xor(ss[q], 4); ss[q] += __shfl_xor(ss[q], 8);
        ss[q] = rsqrtf(ss[q] * (1.f / 128.f) + RMS_EPS); }
    const float* ng = P.in[18]; bf16_t* yb = (bf16_t*)(ws + WS_YB);
#pragma unroll
    for (int nt = 0; nt < 8; ++nt) { const int e = h * 128 + 16 * nt + fr; const float gn = ng[e];
#pragma unroll
        for (int q = 0; q < 4; ++q) { const int t = 16 * w + 4 * fq + q; const float og = bf2f(pml[(size_t)t * 2048 + 1536 + e]);
            yb[(size_t)(b * SEQ + oc * 128 + t) * 512 + e] = (bf16_t)f2bf(hacc[nt][q] * ss[q] * gn * sigm(og)); } }
}

__device__ __forceinline__ void transpose_z2(const Ctx& C, const Params& P) {
    unsigned char* ws = P.ws;
    const bf16_t* src = (const bf16_t*)(ws + WS_Z); bf16_t* dst = (bf16_t*)(ws + WS_YA);
    LAS bf16_t* tl = (LAS bf16_t*)(C.lds + 143360 - 20480);
    for (int it = C.bid; it < 8 * 256; it += C.G) {
        const int c0 = (it & 7) * 64, r0 = (it >> 3) * 128;
        __syncthreads();
        for (int idx = C.tid; idx < 64 * 16; idx += NTHR) { const int cc = idx >> 4, rc = (idx & 15) * 8;
            const u32x4 v = *(const u32x4*)(src + (size_t)(c0 + cc) * MX + r0 + rc); const unsigned v4[4] = {v.x, v.y, v.z, v.w};
#pragma unroll
            for (int q = 0; q < 4; ++q) { tl[(rc + 2 * q) * 72 + cc] = (bf16_t)(v4[q] & 0xffffu); tl[(rc + 2 * q + 1) * 72 + cc] = (bf16_t)(v4[q] >> 16); } }
        __syncthreads();
        for (int idx = C.tid; idx < 128 * 8; idx += NTHR) { const int rr = idx >> 3, c8 = (idx & 7) * 8;
            *(u32x4*)(dst + (size_t)(r0 + rr) * 512 + c0 + c8) = *(const LAS u32x4*)(tl + rr * 72 + c8); }
    }
}

__device__ __forceinline__ void phase6(const Ctx& C, const Params& P) {
    unsigned char* ws = P.ws;
    LAS float* Wr = (LAS float*)C.lds;
    for (int idx = C.tid; idx < 1024 * 16; idx += NTHR) Wr[idx] = P.in[22][idx];
    __syncthreads();
    const float* ada = (const float*)(ws + WS_ADA); const float* gffn = P.in[7];
    bf16_t* hx2 = (bf16_t*)(ws + WS_HX2); float* aff = (float*)(ws + WS_AFF); int* slot = (int*)(ws + WS_SLOT);
    for (int row = C.bid * 8 + C.wave; row < MX; row += C.G * 8) {
        const int b = row >> 12, n = row & 4095;
        const float* src = P.out + (size_t)row * DM;
        f32x4 v[4]; float ss = 0.f;
#pragma unroll
        for (int j = 0; j < 4; ++j) { v[j] = *(const f32x4*)(src + 4 * C.lane + 256 * j); ss += v[j][0] * v[j][0] + v[j][1] * v[j][1] + v[j][2] * v[j][2] + v[j][3] * v[j][3]; }
        const float rstd = rsqrtf(wave_sum(ss) * (1.f / DM) + RMS_EPS);
#pragma unroll
        for (int j = 0; j < 4; ++j) { const int k = 4 * C.lane + 256 * j; const f32x4 g = *(const f32x4*)(gffn + k);
            const f32x4 h4 = *(const f32x4*)(ada + (size_t)b * 6144 + 3072 + k), s4 = *(const f32x4*)(ada + (size_t)b * 6144 + 4096 + k);
#pragma unroll
            for (int q = 0; q < 4; ++q) v[j][q] = (v[j][q] * rstd * g[q]) * (1.f + s4[q]) + h4[q];
            u32x2 w; w.x = pk2(v[j][0], v[j][1]); w.y = pk2(v[j][2], v[j][3]);
            *(u32x2*)(hx2 + (size_t)row * DM + k) = w; }
        float lg[16]; row_dot16(v, Wr, C.lane, lg);
        float mx = lg[0];
#pragma unroll
        for (int e = 1; e < 16; ++e) mx = fmaxf(mx, lg[e]);
        float sum = 0.f;
#pragma unroll
        for (int e = 0; e < 16; ++e) { lg[e] = expf(lg[e] - mx); sum += lg[e]; }
        const float inv = 1.f / sum;
        if (C.lane < 16) { float o = 0.f;
#pragma unroll
            for (int e = 0; e < 16; ++e) o = (C.lane == e) ? lg[e] : o;
            aff[((size_t)b * NE + C.lane) * SEQ + n] = o * inv; slot[(size_t)row * 16 + C.lane] = -1; }
    }
}

__device__ __forceinline__ void topk_item(const Ctx& C, const Params& P, int item) {
    unsigned char* ws = P.ws;
    const int b = item >> 4, e = item & 15;
    const float* aff = (const float*)(ws + WS_AFF) + (size_t)item * SEQ;
    LAS unsigned* red = (LAS unsigned*)C.lds;
    unsigned v[8];
    { const u32x4 a = *(const u32x4*)(aff + 8 * C.tid), c = *(const u32x4*)(aff + 8 * C.tid + 4);
      v[0] = a.x; v[1] = a.y; v[2] = a.z; v[3] = a.w; v[4] = c.x; v[5] = c.y; v[6] = c.z; v[7] = c.w; }
    unsigned prefix = 0u;
    for (int bit = 30; bit >= 0; --bit) {
        const unsigned cand = prefix | (1u << bit); int cnt = 0;
#pragma unroll
        for (int q = 0; q < 8; ++q) cnt += (v[q] >= cand) ? 1 : 0;
        cnt = (int)wave_sum((float)cnt);
        __syncthreads();
        if (C.lane == 0) red[C.wave] = (unsigned)cnt;
        __syncthreads();
        int tot = 0;
#pragma unroll
        for (int q = 0; q < 8; ++q) tot += (int)red[q];
        if (tot >= CAP) prefix = cand;
    }
    int cg_ = 0, ce_ = 0;
#pragma unroll
    for (int q = 0; q < 8; ++q) { cg_ += (v[q] > prefix) ? 1 : 0; ce_ += (v[q] == prefix) ? 1 : 0; }
    int ig = cg_, ie = ce_;
#pragma unroll
    for (int o = 1; o < 64; o <<= 1) { const int tg = __shfl_up(ig, o), te = __shfl_up(ie, o); if (C.lane >= o) { ig += tg; ie += te; } }
    __syncthreads();
    if (C.lane == 63) { red[C.wave] = (unsigned)ig; red[8 + C.wave] = (unsigned)ie; }
    __syncthreads();
    int bg = 0, be = 0, totg = 0;
#pragma unroll
    for (int q = 0; q < 8; ++q) { const int xg = (int)red[q], xe = (int)red[8 + q]; if (q < C.wave) { bg += xg; be += xe; } totg += xg; }
    int pg = bg + ig - cg_, pe = be + ie - ce_;
    const int need = CAP - totg;
    int* sidx = (int*)(ws + WS_SIDX) + (size_t)item * CAP; float* sg = (float*)(ws + WS_SGATE) + (size_t)item * CAP; int* slot = (int*)(ws + WS_SLOT);
#pragma unroll
    for (int q = 0; q < 8; ++q) { const int n = 8 * C.tid + q; int s = -1;
        if (v[q] > prefix) s = pg++;
        else if (v[q] == prefix) { if (pe < need) s = totg + pe; ++pe; }
        if (s >= 0) { sidx[s] = n; sg[s] = __builtin_bit_cast(float, v[q]); slot[((size_t)b * SEQ + n) * 16 + e] = s; } }
}

__device__ __forceinline__ void gather_group(const Ctx& C, const Params& P, int g) {
    unsigned char* ws = P.ws;
    const int* sidx = (const int*)(ws + WS_SIDX); const bf16_t* hx2 = (const bf16_t*)(ws + WS_HX2); bf16_t* xg = (bf16_t*)(ws + WS_XG);
    for (int r = C.bid * 8 + C.wave; r < 8 * 4096; r += C.G * 8) {
        const int el = r >> 12, rr = r & 4095, b = rr >> 9, s = rr & 511, e = g * 8 + el;
        const int n = sidx[((size_t)b * NE + e) * CAP + s];
        const u32x4* src = (const u32x4*)(hx2 + ((size_t)b * SEQ + n) * DM); u32x4* dst = (u32x4*)(xg + (size_t)r * DM);
        dst[C.lane] = src[C.lane]; dst[C.lane + 64] = src[C.lane + 64];
    }
}

__device__ __forceinline__ void moe_gemm1(const Ctx& C, const Params& P) {
    unsigned char* ws = P.ws;
    pg8::SchedMoe S{(const char*)(ws + WS_XG), (const char*)(ws + WS_W13), (size_t)256 * 2048, (size_t)256 * 2048, (size_t)4096 * 2048, (size_t)4096 * 2048, 16, 16, C.G, C.bid};
    pg8::EpiMoe1 E{(bf16_t*)(ws + WS_ACT)};
    pg8::gemm_phase<pg8::EpiMoe1, pg8::SchedMoe, false>(C.lds, 1024, 2048, 2048, S, E);
}
__device__ __forceinline__ void moe_gemm2(const Ctx& C, const Params& P, int g) {
    unsigned char* ws = P.ws;
    pg8::SchedMoe S{(const char*)(ws + WS_ACT), (const char*)(ws + (g ? WS_W2B : WS_W2A)), (size_t)256 * 4096, (size_t)256 * 4096, (size_t)4096 * 4096, (size_t)1024 * 4096, 16, 4, C.G, C.bid};
    pg8::EpiMoe2 E{(bf16_t*)(ws + WS_YE), (const float*)(ws + WS_SGATE), g * 8};
    pg8::gemm_phase<pg8::EpiMoe2, pg8::SchedMoe, false>(C.lds, 2048, 4096, 4096, S, E);
}

__device__ __forceinline__ void phase_final(const Ctx& C, const Params& P) {
    unsigned char* ws = P.ws;
    const float* ada = (const float*)(ws + WS_ADA); const float* gfin = P.in[26];
    const int* slot = (const int*)(ws + WS_SLOT); const bf16_t* ye = (const bf16_t*)(ws + WS_YE);
    for (int row = C.bid * 8 + C.wave; row < MX; row += C.G * 8) {
        const int b = row >> 12;
        float* xr = P.out + (size_t)row * DM;
        f32x4 m[4];
#pragma unroll
        for (int j = 0; j < 4; ++j) m[j] = (f32x4){0.f, 0.f, 0.f, 0.f};
        for (int e = 0; e < NE; ++e) { const int s = slot[(size_t)row * 16 + e];
            if (s >= 0) { const bf16_t* yr = ye + ((size_t)e * 4096 + b * CAP + s) * DM;
#pragma unroll
                for (int j = 0; j < 4; ++j) { const u32x2 w = *(const u32x2*)(yr + 4 * C.lane + 256 * j);
                    m[j][0] += bflo(w.x); m[j][1] += bfhi(w.x); m[j][2] += bflo(w.y); m[j][3] += bfhi(w.y); } } }
        f32x4 v[4]; float ss = 0.f;
#pragma unroll
        for (int j = 0; j < 4; ++j) { const int k = 4 * C.lane + 256 * j; const f32x4 g5 = *(const f32x4*)(ada + (size_t)b * 6144 + 5120 + k);
            v[j] = *(const f32x4*)(xr + k) + g5 * m[j]; ss += v[j][0] * v[j][0] + v[j][1] * v[j][1] + v[j][2] * v[j][2] + v[j][3] * v[j][3]; }
        const float rstd = rsqrtf(wave_sum(ss) * (1.f / DM) + RMS_EPS);
#pragma unroll
        for (int j = 0; j < 4; ++j) { const int k = 4 * C.lane + 256 * j; const f32x4 g = *(const f32x4*)(gfin + k);
            *(f32x4*)(xr + k) = v[j] * rstd * g; }
    }
}

constexpr int N_PHASES = 16;
__global__ void __launch_bounds__(NTHR, 2) mega(Params P) {
    extern __shared__ __attribute__((aligned(16))) unsigned char lds_raw[];
    cg::grid_group grid = cg::this_grid();
    Ctx C; C.lds = (LAS unsigned char*)lds_raw; C.tid = threadIdx.x; C.lane = C.tid & 63; C.wave = __builtin_amdgcn_readfirstlane(C.tid >> 6); C.bid = blockIdx.x; C.G = gridDim.x;
    unsigned char* ws = P.ws;
    const int lo = P.ph_lo, hi = P.ph_hi;
    if (C.tid < 32) ((LAS unsigned*)(C.lds + LDS_MISC))[C.tid] = 0u;
    __syncthreads();
    XcdBarrier bar = xcd_barrier_post((unsigned*)(ws + WS_CTL), (volatile LAS unsigned*)(C.lds + LDS_MISC));
#define IN(k) (lo <= (k) && (k) < hi)
#define SEAM(k) do { if (IN(k) && IN((k) + 1)) { if ((k) == 0) { __threadfence(); grid.sync(); } else xcd_barrier(bar); } } while (0)
#define RUN(id, ...) do { __VA_ARGS__; if ((REPEAT >> (id)) & 1u) { __syncthreads(); __VA_ARGS__; } } while (0)
    if (IN(0)) RUN(0, phase0(C, P));
    SEAM(0);
    if (IN(1)) RUN(1, phase1(C, P));
    SEAM(1);
    if (IN(2)) {
        RUN(2, phase2a(C, P));
        RUN(3, phase2b(C, P));
    }
    SEAM(2);
    if (IN(3)) {
        RUN(4, for (int it = C.bid; it < 512; it += C.G) hyena_item(C, P, 0, it));
        RUN(5, for (int it = C.bid; it < 64 * NCHK; it += C.G) mlstm_a_item(C, P, it));
    }
    SEAM(3);
    if (IN(4)) {
        RUN(6, for (int it = C.bid; it < 512; it += C.G) hyena_item(C, P, 1, it));
        RUN(7, mlstm_scan(C, P));
    }
    SEAM(4);
    if (IN(5)) {
        RUN(8, for (int it = C.bid; it < 1024; it += C.G) mlstm_c_item(C, P, it));
        RUN(9, transpose_z2(C, P));
    }
    SEAM(5);
    if (IN(6)) RUN(10, phase_merge(C, P));
    SEAM(6);
    if (IN(7)) RUN(11, phase_outproj(C, P));
    SEAM(7);
    if (IN(8)) RUN(12, phase6(C, P));
    SEAM(8);
    if (IN(9)) {
        RUN(13, for (int it = C.bid; it < BATCH * NE; it += C.G) topk_item(C, P, it));
        __syncthreads();
        RUN(14, convert_expert_group(C, P, 0, (bf16_t*)(ws + WS_W13), (bf16_t*)(ws + WS_W2A)));
    }
    SEAM(9);
    if (IN(10)) RUN(15, gather_group(C, P, 0));
    SEAM(10);
    if (IN(11)) RUN(16, moe_gemm1(C, P));
    SEAM(11);
    if (IN(12)) {
        RUN(17, moe_gemm2(C, P, 0));
        __syncthreads();
        RUN(18, convert_expert_group(C, P, 1, (bf16_t*)(ws + WS_W13), (bf16_t*)(ws + WS_W2B)));
        RUN(19, gather_group(C, P, 1));
    }
    SEAM(12);
    if (IN(13)) RUN(20, moe_gemm1(C, P));
    SEAM(13);
    if (IN(14)) RUN(21, moe_gemm2(C, P, 1));
    SEAM(14);
    if (IN(15)) phase_final(C, P);
#undef IN
#undef SEAM
#undef RUN
}

extern "C" void kernel_launch(void* const* d_in, const int* in_sizes, int n_in, void* d_out, int out_size, void* d_ws, size_t ws_size, hipStream_t stream) {
    static int grid = 0;
    if (grid == 0) {
        if (n_in != 27 || out_size != MX * DM || ws_size < WS_END) { fprintf(stderr, "kernel_launch: unexpected shapes (n_in %d, out %d, ws %zu < %zu)\n", n_in, out_size, ws_size, (size_t)WS_END); grid = -1; return; }
        int dev = 0, cus = 0, per_cu = 0;
        hipGetDevice(&dev);
        hipDeviceGetAttribute(&cus, hipDeviceAttributeMultiprocessorCount, dev);
        if (hipFuncSetAttribute((const void*)mega, hipFuncAttributeMaxDynamicSharedMemorySize, LDS_BYTES) != hipSuccess) { fprintf(stderr, "kernel_launch: hipFuncSetAttribute failed\n"); grid = -1; return; }
        if (hipOccupancyMaxActiveBlocksPerMultiprocessor(&per_cu, (const void*)mega, NTHR, LDS_BYTES) != hipSuccess || per_cu < 1) { fprintf(stderr, "kernel_launch: occupancy query says %d\n", per_cu); per_cu = 1; }
        (void)hipGetLastError();
        grid = cus * 1;
        if (grid <= 0) grid = 256;
    }
    if (grid < 0) return;
    Params p; memset(&p, 0, sizeof(p));
    for (int i = 0; i < 27; ++i) p.in[i] = (const float*)d_in[i];
    p.out = (float*)d_out; p.ws = (unsigned char*)d_ws;
    (void)hipMemsetAsync((unsigned char*)d_ws + WS_CTL, 0, XCD_BAR_WORDS * 4, stream);
#if N_LAUNCH_MODE == 1
    p.ph_lo = 0; p.ph_hi = N_PHASES;
    void* args[] = {&p};
    hipError_t e = hipLaunchCooperativeKernel((const void*)mega, dim3(grid), dim3(NTHR), args, LDS_BYTES, stream);
    if (e != hipSuccess) fprintf(stderr, "kernel_launch: cooperative launch failed: %s (grid %d)\n", hipGetErrorString(e), grid);
#else
    for (int ph = 0; ph < N_PHASES; ++ph) {
        p.ph_lo = ph; p.ph_hi = ph + 1;
        void* args[] = {&p};
        hipError_t e = hipLaunchCooperativeKernel((const void*)mega, dim3(grid), dim3(NTHR), args, LDS_BYTES, stream);
        if (e != hipSuccess) { fprintf(stderr, "kernel_launch: launch %d failed: %s (grid %d)\n", ph, hipGetErrorString(e), grid); break; }
    }
#endif
}
```

```cpp
#include <hip/hip_runtime.h>
#include <hip/hip_cooperative_groups.h>
#include <cstdio>
#include <cstdint>
#include <cstring>
namespace cg = cooperative_groups;

#ifndef N_LAUNCH_MODE
#define N_LAUNCH_MODE 1
#endif

#define LAS __attribute__((address_space(3)))
typedef unsigned short bf16_t;
typedef short bf16x8 __attribute__((ext_vector_type(8)));
typedef float f32x4 __attribute__((ext_vector_type(4)));
typedef float f32x16 __attribute__((ext_vector_type(16)));
typedef unsigned u32x4 __attribute__((ext_vector_type(4)));
typedef unsigned u32x2 __attribute__((ext_vector_type(2)));

constexpr int NTHR = 512;
constexpr int BATCH = 8, SEQ = 4096, DM = 1024, CTXL = 256;
constexpr int MX = BATCH * SEQ;
constexpr int MC = BATCH * CTXL;
constexpr int DIN = 5648, NPROJ = 5632, GATE0 = 3584, MERGE0 = 3600;
constexpr int NE = 16, CAP = 512, DFF = 2048;
constexpr int MT = MX + MC;
constexpr int NCHK = 34;
constexpr float RMS_EPS = 1e-6f;

constexpr size_t MiB = 1u << 20;
constexpr size_t WS_ADAP = 0;
constexpr size_t WS_ADA = 7 * MiB;
constexpr size_t WS_CTL = 7 * MiB + 512 * 1024;
constexpr size_t WS_GATES = 8 * MiB;
constexpr size_t WS_KREV = 11 * MiB;
constexpr size_t WS_BL = 27 * MiB;
constexpr size_t WS_MST = 27 * MiB + 64 * 1024;
constexpr size_t WS_NLOC = 28 * MiB;
constexpr size_t WS_NST = 30 * MiB;
constexpr size_t WS_WIN = 32 * MiB;
constexpr size_t WS_WBH = 43 * MiB;
constexpr size_t WS_WBM = 44 * MiB;
constexpr size_t WS_WOUT = 45 * MiB;
constexpr size_t WS_HX = 48 * MiB;
constexpr size_t WS_PLOC = 48 * MiB;
constexpr size_t WS_PCM = 116 * MiB;
constexpr size_t WS_PML = 212 * MiB;
constexpr size_t WS_KVCM = 276 * MiB;
constexpr size_t WS_GC = 2 * MiB;
constexpr size_t WS_Z1 = 344 * MiB;
constexpr size_t WS_YA = 376 * MiB;
constexpr size_t WS_YB = 408 * MiB;
constexpr size_t WS_CST = 440 * MiB;
constexpr size_t WS_Z = 504 * MiB;
constexpr size_t WS_AFF = 0;
constexpr size_t WS_SLOT = 2 * MiB;
constexpr size_t WS_SIDX = 4 * MiB;
constexpr size_t WS_SGATE = 4 * MiB + 512 * 1024;
constexpr size_t WS_HX2 = 48 * MiB;
constexpr size_t WS_W13 = 80 * MiB;
constexpr size_t WS_W2 = 144 * MiB;
constexpr size_t WS_XG = 176 * MiB;
constexpr size_t WS_ACT = 240 * MiB;
constexpr size_t WS_YE = 368 * MiB;
constexpr size_t WS_END = 568 * MiB;

constexpr int LDS_BYTES = 147456;
constexpr int LDS_MISC = LDS_BYTES - 128;
constexpr int PREFIX = 0;
constexpr unsigned REPEAT = 0u;

__device__ __forceinline__ unsigned f2bf(float f) { unsigned u = __builtin_bit_cast(unsigned, f); return (u + 0x7fffu + ((u >> 16) & 1u)) >> 16; }
__device__ __forceinline__ unsigned pk2(float lo, float hi) { return f2bf(lo) | (f2bf(hi) << 16); }
__device__ __forceinline__ float bf2f(unsigned short b) { return __builtin_bit_cast(float, ((unsigned)b) << 16); }
__device__ __forceinline__ float bflo(unsigned w) { return __builtin_bit_cast(float, w << 16); }
__device__ __forceinline__ float bfhi(unsigned w) { return __builtin_bit_cast(float, w & 0xffff0000u); }
__device__ __forceinline__ float sigm(float x) { return 1.f / (1.f + __expf(-x)); }
__device__ __forceinline__ float siluf(float x) { return x / (1.f + __expf(-x)); }
__device__ __forceinline__ float logsig(float x) { return x >= 0.f ? -log1pf(expf(-x)) : x - log1pf(expf(x)); }
__device__ __forceinline__ float wave_sum(float v) {
#pragma unroll
    for (int o = 1; o < 64; o <<= 1) v += __shfl_xor(v, o);
    return v;
}
#define LDS_WAIT() asm volatile("s_waitcnt lgkmcnt(0)" ::: "memory")
__device__ __forceinline__ float clamp8(float x) { return fminf(fmaxf(x, -448.f), 448.f); }
__device__ __forceinline__ unsigned pk4_fp8(float a, float b, float c, float d) {
    int r = __builtin_amdgcn_cvt_pk_fp8_f32(clamp8(a), clamp8(b), 0, false); r = __builtin_amdgcn_cvt_pk_fp8_f32(clamp8(c), clamp8(d), r, true); return (unsigned)r; }
constexpr float W8_SCALE = 64.f, W8_INV = 1.f / 64.f;

struct Params {
    const float* in[27];
    float* out;
    unsigned char* ws;
    int ph_lo, ph_hi;
};


#define XB_TMO      128
#define XB_XCNT(j)  (256  + 64 * (j))
#define XB_XSUB(j)  (1280 + 64 * (j))
#define XB_XGEN(j)  (2304 + 64 * (j))
#define XB_TOP      3328
#define XB_TOPGEN   3392
#define XCD_BAR_WORDS 3456
#define XB_SPIN_CAP (1u << 18)
__device__ __forceinline__ unsigned xb_ld(unsigned* p)              { return __hip_atomic_load(p, __ATOMIC_RELAXED, __HIP_MEMORY_SCOPE_AGENT); }
__device__ __forceinline__ unsigned xb_add(unsigned* p, unsigned v) { return __hip_atomic_fetch_add(p, v, __ATOMIC_RELAXED, __HIP_MEMORY_SCOPE_AGENT); }
__device__ __forceinline__ unsigned xb_xcc_id() { return (unsigned)__builtin_amdgcn_s_getreg((3 << 11) | 20) & 0xFu; }
#define XB_SPIN(cond, bar) do { unsigned _sp = 0; while (cond) { __builtin_amdgcn_s_sleep(1); \
    if ((++_sp & 255u) == 0u) { if (xb_ld(&(bar)[XB_TMO])) break; if (_sp > XB_SPIN_CAP) { atomicAdd(&(bar)[XB_TMO], 1u); break; } } } } while (0)
struct XcdBarrier { unsigned* bar; unsigned x; volatile LAS unsigned* st; };
__device__ __forceinline__ XcdBarrier xcd_barrier_post(unsigned* bar, volatile LAS unsigned* st) {
    XcdBarrier b; b.bar = bar; b.x = xb_xcc_id(); b.st = st;
    if (threadIdx.x == 0) (void)xb_add(&bar[XB_XCNT(b.x)], 1u);
    return b;
}
__device__ __forceinline__ void xcd_barrier_complete(unsigned* bar, unsigned x, unsigned& nloc, unsigned& nx) {
    const unsigned G = gridDim.x * gridDim.y * gridDim.z;
    unsigned sum, cnt, mine, sp = 0u;
    for (;;) {
        sum = 0u; cnt = 0u; mine = 0u;
#pragma unroll
        for (unsigned j = 0; j < 16; ++j) { const unsigned c = xb_ld(&bar[XB_XCNT(j)]); sum += c; cnt += (c > 0u) ? 1u : 0u; mine = (j == x) ? c : mine; }
        if (sum == G) break;
        __builtin_amdgcn_s_sleep(1);
        if ((++sp & 255u) == 0u) { if (xb_ld(&bar[XB_TMO])) break; if (sp > XB_SPIN_CAP) { atomicAdd(&bar[XB_TMO], 1u); break; } }
    }
    nloc = mine > 0u ? mine : 1u; nx = cnt > 0u ? cnt : 1u;
}
__device__ __forceinline__ void xcd_barrier(const XcdBarrier& b) {
    asm volatile("s_waitcnt vmcnt(0)" ::: "memory");
    __syncthreads();
    if (threadIdx.x == 0) {
        unsigned* bar = b.bar;
        __builtin_amdgcn_s_waitcnt(0);
        unsigned nloc = b.st[0], nx = b.st[1];
        if (nloc == 0u) { xcd_barrier_complete(bar, b.x, nloc, nx); b.st[0] = nloc; b.st[1] = nx; }
        const unsigned old = xb_add(&bar[XB_XSUB(b.x)], 1u);
        const unsigned gen = old / nloc;
        if (old + 1u == (gen + 1u) * nloc) {
            __builtin_amdgcn_fence(__ATOMIC_RELEASE, "agent");
            asm volatile("s_waitcnt vmcnt(0)" ::: "memory");
            const unsigned og = xb_add(&bar[XB_TOP], 1u);
            const unsigned tg = og / nx;
            if (og + 1u == (tg + 1u) * nx) xb_add(&bar[XB_TOPGEN], 1u);
            else XB_SPIN(xb_ld(&bar[XB_TOPGEN]) == tg, bar);
            __builtin_amdgcn_fence(__ATOMIC_ACQUIRE, "agent");
            xb_add(&bar[XB_XGEN(b.x)], 1u);
            asm volatile("s_waitcnt vmcnt(0)" ::: "memory");
        } else {
            XB_SPIN(xb_ld(&bar[XB_XGEN(b.x)]) == gen, bar);
            __builtin_amdgcn_fence(__ATOMIC_ACQUIRE, "agent");
            asm volatile("s_waitcnt vmcnt(0)" ::: "memory");
        }
    }
    __syncthreads();
}

namespace pg8 {
constexpr int BM = 256, BK = 64, HALF = 128, HTB = HALF * BK * 2, STAGE_BYTES = 8 * HTB;
__device__ __forceinline__ int lds_byte(int r, int c) { const int st = (r >> 4) * 2 + (c >> 5), rr = r & 15, cc = c & 31, ob = rr * 64 + cc * 2; return st * 1024 + (ob ^ (((ob >> 9) & 1) << 5)); }
__device__ __forceinline__ void stage_rc(int b, int& R, int& C) { const int st = b / 1024, sb = b % 1024, swz = sb ^ (((sb >> 9) & 1) << 5); R = (st >> 1) * 16 + swz / 64; C = (st & 1) * 32 + (swz % 64) / 2; }
__device__ __forceinline__ int perm32(int rho) { const int n = rho >> 4, i = rho & 15; return 8 * (i >> 2) + 4 * n + (i & 3); }
__device__ __forceinline__ unsigned cvt_pk_bf16(float lo, float hi) { unsigned r; asm volatile("v_cvt_pk_bf16_f32 %0, %1, %2" : "=v"(r) : "v"(lo), "v"(hi)); return r; }

typedef int v4i_t __attribute__((ext_vector_type(4)));
typedef int v8i_t __attribute__((ext_vector_type(8)));
struct Unit { const char* A; const char* B; int pm, pn, aux; };

struct SchedGrid {
    const char* A; const char* B; size_t tstepA, tstepB; int nM, nN, pm0, pn0, G, c;
    int xN, xPm0, xPn0, xCnt;
    int split, gap;
    __device__ bool next(int i, Unit& u) const {
        const long L = (long)i * G + c; const int nwg = nM * nN;
        if (L >= nwg + xCnt) return false;
        if (L >= nwg) { const int q = (int)L - nwg; u.pm = xPm0 + q / xN; u.pn = xPn0 + q % xN; u.aux = 1; }
        else {
            int wgid = (int)L; { const int q = nwg / 8, r = nwg % 8, xcd = wgid % 8, off = wgid / 8; wgid = (xcd < r ? xcd * (q + 1) : r * (q + 1) + (xcd - r) * q) + off; }
            const int nig = 8 * nN, gid = wgid / nig, fm = gid * 8, gsz = (nM - fm) < 8 ? (nM - fm) : 8;
            u.pm = pm0 + fm + ((wgid % nig) % gsz); { const int idx = (wgid % nig) / gsz; u.pn = pn0 + idx + (idx >= split ? gap : 0); } u.aux = 0;
        }
        u.A = A + (size_t)u.pm * tstepA; u.B = B + (size_t)u.pn * tstepB; return true;
    }
};
struct SchedMoe {
    const char* A; const char* B; size_t tstepA, tstepB, estepA, estepB; int nM, nN, G, c;
    __device__ bool next(int i, Unit& u) const {
        const long L = (long)i * G + c; const int e8 = (int)(L % 8); const long ta = L / 8; const int per = nM * nN;
        if (ta >= 2L * per) return false;
        const int e = e8 + 8 * (int)(ta / per); const int t = (int)(ta % per);
        if (nN == 16) { const int blk = t >> 5, wi = t & 31; u.pm = 4 * (blk >> 1) + (wi >> 3); u.pn = 8 * (blk & 1) + (wi & 7); }
        else { u.pm = t / nN; u.pn = t % nN; }
        u.aux = e;
        u.A = A + (size_t)e * estepA + (size_t)u.pm * tstepA; u.B = B + (size_t)e * estepB + (size_t)u.pn * tstepB; return true;
    }
};

template <class Epi, class Sched, bool NORMAL, bool F8 = false>
__device__ __forceinline__ void gemm_phase(LAS unsigned char* lds, const int K  , const unsigned lda, const unsigned ldb, const Sched& S, const Epi& E) {
    const int tid = threadIdx.x, wid = __builtin_amdgcn_readfirstlane(tid >> 6), lane = tid & 63, wr = wid >> 2, wc = wid & 3, fr = lane & 15, fq = lane >> 4;
    const int nt = K / BK;
    unsigned voffA[2], voffB[2];
#pragma unroll
    for (int i = 0; i < 2; ++i) { int R, C; stage_rc(tid * 16 + i * 8192, R, C); const int Rb = Epi::PERM ? ((R & ~31) + perm32(R & 31)) : R;
        voffA[i] = (unsigned)R * lda + (unsigned)C * 2u; voffB[i] = (unsigned)Rb * ldb + (unsigned)C * 2u; }
    const size_t kstep = (size_t)(BK * 2);
    const size_t hstepA = (size_t)HALF * lda, hstepB = (size_t)HALF * ldb;
    const unsigned ldsw = (unsigned)wid * 1024u;
    const int aoff = lds_byte(wr * 64 + fr, fq * 8), boff = lds_byte(wc * 32 + fr, fq * 8);
#define PG8_SA(b, h) (((b) * 2 + (h)) * HTB)
#define PG8_SB(b, h) ((4 + (b) * 2 + (h)) * HTB)
#define PG8_STAGE(bufoff, gbase, voff) do { _Pragma("unroll") for (int _i = 0; _i < 2; ++_i) \
        __builtin_amdgcn_global_load_lds((const unsigned*)((const char*)(gbase) + (voff)[_i]), (LAS unsigned*)(lds + (bufoff) + ldsw + _i * 8192), 16, 0, 0); } while (0)
#define PG8_LDA(dst, b, h) do { if constexpr (F8) { _Pragma("unroll") for (int m = 0; m < 4; ++m) dst##8[m] = __builtin_shufflevector(*(const LAS v4i_t*)(lds + PG8_SA(b, h) + aoff + m * 2048), *(const LAS v4i_t*)(lds + PG8_SA(b, h) + aoff + m * 2048 + 1024), 0, 1, 2, 3, 4, 5, 6, 7); } \
        else { _Pragma("unroll") for (int m = 0; m < 4; ++m) _Pragma("unroll") for (int k = 0; k < 2; ++k) dst[m][k] = *(const LAS bf16x8*)(lds + PG8_SA(b, h) + aoff + m * 2048 + k * 1024); } } while (0)
#define PG8_LDB(dst, b, h) do { if constexpr (F8) { _Pragma("unroll") for (int n = 0; n < 2; ++n) dst##8[n] = __builtin_shufflevector(*(const LAS v4i_t*)(lds + PG8_SB(b, h) + boff + n * 2048), *(const LAS v4i_t*)(lds + PG8_SB(b, h) + boff + n * 2048 + 1024), 0, 1, 2, 3, 4, 5, 6, 7); } \
        else { _Pragma("unroll") for (int n = 0; n < 2; ++n) _Pragma("unroll") for (int k = 0; k < 2; ++k) dst[n][k] = *(const LAS bf16x8*)(lds + PG8_SB(b, h) + boff + n * 2048 + k * 1024); } } while (0)
#define PG8_MMA(ai, bj, At, Bt) do { __builtin_amdgcn_s_setprio(1); \
        if constexpr (F8) { _Pragma("unroll") for (int m = 0; m < 4; ++m) _Pragma("unroll") for (int n = 0; n < 2; ++n) \
            asm volatile("v_mfma_scale_f32_16x16x128_f8f6f4 %0, %1, %2, %0, %3, %3 op_sel_hi:[0,0,0]" : "+v"(acc[ai][bj][m][n]) : "v"(Bt##8[n]), "v"(At##8[m]), "v"(sc8)); } \
        else { _Pragma("unroll") for (int m = 0; m < 4; ++m) _Pragma("unroll") for (int n = 0; n < 2; ++n) _Pragma("unroll") for (int k = 0; k < 2; ++k) \
        acc[ai][bj][m][n] = NORMAL ? __builtin_amdgcn_mfma_f32_16x16x32_bf16(At[m][k], Bt[n][k], acc[ai][bj][m][n], 0, 0, 0) \
                                   : __builtin_amdgcn_mfma_f32_16x16x32_bf16(Bt[n][k], At[m][k], acc[ai][bj][m][n], 0, 0, 0); } __builtin_amdgcn_s_setprio(0); } while (0)
#define PG8_WAIT_V(n) asm volatile("s_waitcnt vmcnt(" #n ")" ::: "memory")
#define PG8_WAIT_L(n) asm volatile("s_waitcnt lgkmcnt(" #n ")" ::: "memory")
#define PG8_BAR __builtin_amdgcn_s_barrier()
#define PG8_SCHED __builtin_amdgcn_sched_barrier(0)
    Unit cur, nxt; int ui = 0;
    if (!S.next(0, cur)) return;
    f32x4 acc[2][2][4][2];
#pragma unroll
    for (int a = 0; a < 2; ++a)
#pragma unroll
        for (int b = 0; b < 2; ++b)
#pragma unroll
            for (int m = 0; m < 4; ++m)
#pragma unroll
                for (int n = 0; n < 2; ++n) acc[a][b][m][n] = (f32x4){0.f, 0.f, 0.f, 0.f};
    bf16x8 At[4][2], B0[2][2], B1[2][2];
    v8i_t At8[4], B08[2], B18[2]; const int sc8 = 0x7F7F7F7F;
    const char* cA = cur.A; const char* cB = cur.B;
    PG8_STAGE(PG8_SB(0, 0), cB, voffB); PG8_STAGE(PG8_SB(0, 1), cB + hstepB, voffB); PG8_STAGE(PG8_SA(0, 0), cA, voffA); PG8_STAGE(PG8_SA(0, 1), cA + hstepA, voffA);
    if (wr == 1) PG8_BAR;
    PG8_WAIT_V(2); PG8_BAR;
    PG8_STAGE(PG8_SB(1, 0), cB + kstep, voffB); PG8_STAGE(PG8_SA(1, 0), cA + kstep, voffA); PG8_STAGE(PG8_SB(1, 1), cB + hstepB + kstep, voffB);
    PG8_WAIT_V(6); PG8_BAR;
    for (;;) {
        const bool has_next = S.next(ui + 1, nxt);
        const char* nA = has_next ? nxt.A : cA; const char* nB = has_next ? nxt.B : cB;
#pragma unroll 1
        for (int t = 0; t < nt; t += 2) {
            const bool last = (t == nt - 2);
            const char* a1 = cA + (size_t)(t + 1) * kstep;
            const char* a2 = last ? nA : cA + (size_t)(t + 2) * kstep; const char* b2 = last ? nB : cB + (size_t)(t + 2) * kstep;
            const char* a3 = a2 + kstep; const char* b3 = b2 + kstep;
            PG8_LDB(B0, 0, 0); PG8_LDB(B1, 0, 1); PG8_SCHED; PG8_LDA(At, 0, 0); PG8_STAGE(PG8_SA(1, 1), a1 + hstepA, voffA);
            PG8_WAIT_V(8); PG8_WAIT_L(0); PG8_BAR; PG8_MMA(0, 0, At, B0); PG8_MMA(0, 1, At, B1); PG8_BAR; PG8_SCHED;
            PG8_LDA(At, 0, 1); PG8_STAGE(PG8_SB(0, 0), b2, voffB); PG8_STAGE(PG8_SB(0, 1), b2 + hstepB, voffB); PG8_STAGE(PG8_SA(0, 0), a2, voffA);
            PG8_WAIT_V(8); PG8_WAIT_L(0); PG8_BAR; PG8_MMA(1, 0, At, B0); PG8_MMA(1, 1, At, B1); PG8_BAR; PG8_SCHED;
            PG8_LDB(B0, 1, 0); PG8_LDB(B1, 1, 1); PG8_SCHED; PG8_LDA(At, 1, 0); PG8_STAGE(PG8_SA(0, 1), a2 + hstepA, voffA);
            PG8_WAIT_V(8); PG8_WAIT_L(0); PG8_BAR; PG8_MMA(0, 0, At, B0); PG8_MMA(0, 1, At, B1); PG8_BAR; PG8_SCHED;
            PG8_LDA(At, 1, 1); PG8_STAGE(PG8_SB(1, 0), b3, voffB); PG8_STAGE(PG8_SB(1, 1), b3 + hstepB, voffB); PG8_STAGE(PG8_SA(1, 0), a3, voffA);
            PG8_WAIT_V(8); PG8_WAIT_L(0); PG8_BAR; PG8_MMA(1, 0, At, B0); PG8_MMA(1, 1, At, B1); PG8_BAR; PG8_SCHED;
        }
        if (wr == 0) PG8_BAR;
        if constexpr (F8) asm volatile("s_nop 15\n\ts_nop 15" ::: "memory");
        E(acc, cur, wr, wc, fr, fq);
        if (!has_next) break;
#pragma unroll
        for (int a = 0; a < 2; ++a)
#pragma unroll
            for (int b = 0; b < 2; ++b)
#pragma unroll
                for (int m = 0; m < 4; ++m)
#pragma unroll
                    for (int n = 0; n < 2; ++n) acc[a][b][m][n] = (f32x4){0.f, 0.f, 0.f, 0.f};
        cur = nxt; cA = nA; cB = nB; ++ui;
        if (wr == 1) PG8_BAR;
    }
    PG8_WAIT_V(0);
    PG8_BAR;
#undef PG8_SA
#undef PG8_SB
#undef PG8_STAGE
#undef PG8_LDA
#undef PG8_LDB
#undef PG8_MMA
#undef PG8_WAIT_V
#undef PG8_WAIT_L
#undef PG8_BAR
#undef PG8_SCHED
}


struct EpiCM {
    static constexpr bool PERM = false;
    bf16_t* pcm; bf16_t* kvcm; const float* bias;
    __device__ __forceinline__ void operator()(const f32x4 (&acc)[2][2][4][2], const Unit& u, int wr, int wc, int fr, int fq) const {
        const bool kv = u.pn >= 8;
#pragma unroll
        for (int bj = 0; bj < 2; ++bj)
#pragma unroll
            for (int n = 0; n < 2; ++n) {
                const int c = u.pn * BM + bj * HALF + wc * 32 + n * 16 + fr; const float bv = bias[c];
                bf16_t* base = kv ? (kvcm + (size_t)(c - 2048) * MT) : (pcm + (size_t)c * MX);
#pragma unroll
                for (int ai = 0; ai < 2; ++ai)
#pragma unroll
                    for (int m = 0; m < 4; ++m) {
                        const int r = u.pm * BM + ai * HALF + wr * 64 + m * 16 + 4 * fq; const f32x4 v = acc[ai][bj][m][n] + bv;
                        u32x2 w; w.x = cvt_pk_bf16(v[0], v[1]); w.y = cvt_pk_bf16(v[2], v[3]);
                        *(u32x2*)(base + r) = w; }
                asm volatile("" ::: "memory");
            }
    }
};

struct EpiIn2 {
    static constexpr bool PERM = true;
    bf16_t* pml; bf16_t* pmg; const float* bias;
    __device__ __forceinline__ void operator()(const f32x4 (&acc)[2][2][4][2], const Unit& u, int wr, int wc, int fr, int fq) const {
        const int colt = u.pn * BM; bf16_t* base; int ldc, cbase, bofs = 0; const int row0 = u.pm * BM; bool sg = false;
        if (colt < 2048) { base = pml; ldc = 1024; cbase = colt - 1536; }
        else if (colt < GATE0) { base = pml; ldc = 1024; cbase = colt - 3072 + 512; }
        else { base = pmg; ldc = 2048; cbase = colt - GATE0; bofs = 16; sg = true; }
        const int col0 = cbase + wc * 32 + 8 * fq, bcol0 = colt + bofs + wc * 32 + 8 * fq;
        f32x4 bv[2][2];
#pragma unroll
        for (int bj = 0; bj < 2; ++bj)
#pragma unroll
            for (int n = 0; n < 2; ++n) bv[bj][n] = *(const f32x4*)(bias + bcol0 + bj * HALF + 4 * n);
#pragma unroll
        for (int ai = 0; ai < 2; ++ai)
#pragma unroll
            for (int m = 0; m < 4; ++m) { bf16_t* rowp = base + (size_t)(row0 + wr * 64 + fr + ai * HALF + m * 16) * ldc + col0;
#pragma unroll
                for (int bj = 0; bj < 2; ++bj) { f32x4 v0 = acc[ai][bj][m][0] + bv[bj][0], v1 = acc[ai][bj][m][1] + bv[bj][1];
                    if (sg) {
#pragma unroll
                        for (int j = 0; j < 4; ++j) { v0[j] = sigm(v0[j]); v1[j] = sigm(v1[j]); } }
                    u32x4 w; w.x = cvt_pk_bf16(v0[0], v0[1]); w.y = cvt_pk_bf16(v0[2], v0[3]); w.z = cvt_pk_bf16(v1[0], v1[1]); w.w = cvt_pk_bf16(v1[2], v1[3]);
                    *(u32x4*)(rowp + bj * HALF) = w; }
                asm volatile("" ::: "memory"); }
    }
};

template <int MODE  > struct EpiMerge {
    static constexpr bool PERM = true;
    bf16_t* Z; const bf16_t* pmg;
    __device__ __forceinline__ void operator()(const f32x4 (&acc)[2][2][4][2], const Unit& u, int wr, int wc, int fr, int fq) const {
        const int row0 = u.pm * BM + wr * 64 + fr, col0 = u.pn * BM + wc * 32 + 8 * fq;
#pragma unroll
        for (int ai = 0; ai < 2; ++ai)
#pragma unroll
            for (int m = 0; m < 4; ++m) { const size_t row = (size_t)(row0 + ai * HALF + m * 16);
#pragma unroll
                for (int bj = 0; bj < 2; ++bj) {
                    const u32x4 g = *(const u32x4*)(pmg + row * 2048 + (MODE ? 1024 : 0) + col0 + bj * HALF);
                    f32x4 v0 = acc[ai][bj][m][0], v1 = acc[ai][bj][m][1];
                    v0[0] *= bflo(g.x); v0[1] *= bfhi(g.x); v0[2] *= bflo(g.y); v0[3] *= bfhi(g.y);
                    v1[0] *= bflo(g.z); v1[1] *= bfhi(g.z); v1[2] *= bflo(g.w); v1[3] *= bfhi(g.w);
                    bf16_t* zp = Z + row * 1024 + col0 + bj * HALF;
                    if (MODE) { const u32x4 z = *(const u32x4*)zp;
                        v0[0] += bflo(z.x); v0[1] += bfhi(z.x); v0[2] += bflo(z.y); v0[3] += bfhi(z.y);
                        v1[0] += bflo(z.z); v1[1] += bfhi(z.z); v1[2] += bflo(z.w); v1[3] += bfhi(z.w); }
                    u32x4 w; w.x = cvt_pk_bf16(v0[0], v0[1]); w.y = cvt_pk_bf16(v0[2], v0[3]); w.z = cvt_pk_bf16(v1[0], v1[1]); w.w = cvt_pk_bf16(v1[2], v1[3]);
                    *(u32x4*)zp = w; }
                asm volatile("" ::: "memory"); }
    }
};

struct EpiOut {
    static constexpr bool PERM = false;
    const float* x; float* xmid; const float* ada;
    __device__ __forceinline__ void operator()(const f32x4 (&acc)[2][2][4][2], const Unit& u, int wr, int wc, int fr, int fq) const {
        const int row0 = u.pm * BM + wr * 64 + fr, col0 = u.pn * BM + wc * 32 + 4 * fq;
        const int b = (u.pm * BM) / SEQ;
        f32x4 gv[2][2];
#pragma unroll
        for (int bj = 0; bj < 2; ++bj)
#pragma unroll
            for (int n = 0; n < 2; ++n) gv[bj][n] = *(const f32x4*)(ada + (size_t)b * 6144 + 2048 + col0 + bj * HALF + n * 16);
#pragma unroll
        for (int ai = 0; ai < 2; ++ai)
#pragma unroll
            for (int m = 0; m < 4; ++m) { const size_t off = (size_t)(row0 + ai * HALF + m * 16) * DM + col0;
#pragma unroll
                for (int bj = 0; bj < 2; ++bj)
#pragma unroll
                    for (int n = 0; n < 2; ++n) { const f32x4 xv = *(const f32x4*)(x + off + bj * HALF + n * 16);
                        *(f32x4*)(xmid + off + bj * HALF + n * 16) = xv + gv[bj][n] * acc[ai][bj][m][n]; }
                asm volatile("" ::: "memory"); }
    }
};

struct EpiMoe1 {
    static constexpr bool PERM = true;
    unsigned char* act;
    __device__ __forceinline__ void operator()(const f32x4 (&acc)[2][2][4][2], const Unit& u, int wr, int wc, int fr, int fq) const {
        const int row0 = u.aux * 4096 + u.pm * BM + wr * 64 + fr, col0 = (u.pn * BM + wc * 32) / 2 + 4 * fq;
#pragma unroll
        for (int ai = 0; ai < 2; ++ai)
#pragma unroll
            for (int m = 0; m < 4; ++m) { unsigned char* rowp = act + (size_t)(row0 + ai * HALF + m * 16) * DFF + col0;
#pragma unroll
                for (int bj = 0; bj < 2; ++bj) { const f32x4 v0 = acc[ai][bj][m][0] * W8_INV, v1 = acc[ai][bj][m][1] * W8_INV;
                    *(unsigned*)(rowp + bj * (HALF / 2)) = pk4_fp8(siluf(v0[0]) * v0[1], siluf(v0[2]) * v0[3], siluf(v1[0]) * v1[1], siluf(v1[2]) * v1[3]); }
                asm volatile("" ::: "memory"); }
    }
};

struct EpiMoe2 {
    static constexpr bool PERM = true;
    bf16_t* ye; const float* sgate;
    __device__ __forceinline__ void operator()(const f32x4 (&acc)[2][2][4][2], const Unit& u, int wr, int wc, int fr, int fq) const {
        const int e = u.aux, col0 = u.pn * BM + wc * 32 + 8 * fq;
#pragma unroll
        for (int ai = 0; ai < 2; ++ai)
#pragma unroll
            for (int m = 0; m < 4; ++m) { const int rr = u.pm * BM + wr * 64 + fr + ai * HALF + m * 16;
                const float g = sgate[((rr >> 9) * NE + e) * CAP + (rr & 511)] * W8_INV;
                bf16_t* rowp = ye + ((size_t)e * 4096 + rr) * DM + col0;
#pragma unroll
                for (int bj = 0; bj < 2; ++bj) { const f32x4 v0 = acc[ai][bj][m][0] * g, v1 = acc[ai][bj][m][1] * g;
                    u32x4 w; w.x = cvt_pk_bf16(v0[0], v0[1]); w.y = cvt_pk_bf16(v0[2], v0[3]); w.z = cvt_pk_bf16(v1[0], v1[1]); w.w = cvt_pk_bf16(v1[2], v1[3]);
                    *(u32x4*)(rowp + bj * HALF) = w; }
                asm volatile("" ::: "memory"); }
    }
};
}

struct Ctx {
    LAS unsigned char* lds;
    int tid, lane, wave, bid, G;
};

__device__ __forceinline__ void transpose_item(const float* W, int ldw, int K, int ncol0, bf16_t* WT, int dst_row0, int rmul, LAS float* scr, int kb, int nb, int lane) {
    const int k0 = 64 * kb, n0 = 32 * nb;
#pragma unroll 8
    for (int i = 0; i < 32; ++i) { const int kk = 2 * i + (lane >> 5); scr[kk * 33 + (lane & 31)] = W[(size_t)(k0 + kk) * ldw + ncol0 + n0 + (lane & 31)]; }
    LDS_WAIT();
    const int c = lane & 7;
#pragma unroll
    for (int j = 0; j < 4; ++j) { const int n = (lane >> 3) + 8 * j; const LAS float* s = scr + (8 * c) * 33 + n;
        u32x4 o; o.x = pk2(s[0 * 33], s[1 * 33]); o.y = pk2(s[2 * 33], s[3 * 33]); o.z = pk2(s[4 * 33], s[5 * 33]); o.w = pk2(s[6 * 33], s[7 * 33]);
        *(u32x4*)(WT + (size_t)(dst_row0 + (n0 + n) * rmul) * K + k0 + 8 * c) = o; }
    LDS_WAIT();
}

__device__ __forceinline__ void transpose_item_f8(const float* W, int ldw, int K, unsigned char* WT, int dst_row0, int rmul, LAS float* scr, int kb, int nb, int lane) {
    const int k0 = 64 * kb, n0 = 32 * nb;
#pragma unroll 8
    for (int i = 0; i < 32; ++i) { const int kk = 2 * i + (lane >> 5); scr[kk * 33 + (lane & 31)] = W[(size_t)(k0 + kk) * ldw + n0 + (lane & 31)]; }
    LDS_WAIT();
    const int c = lane & 3;
#pragma unroll
    for (int j = 0; j < 2; ++j) { const int n = (lane >> 2) + 16 * j; const LAS float* s = scr + (16 * c) * 33 + n;
        u32x4 o;
        o.x = pk4_fp8(s[0 * 33] * W8_SCALE, s[1 * 33] * W8_SCALE, s[2 * 33] * W8_SCALE, s[3 * 33] * W8_SCALE);
        o.y = pk4_fp8(s[4 * 33] * W8_SCALE, s[5 * 33] * W8_SCALE, s[6 * 33] * W8_SCALE, s[7 * 33] * W8_SCALE);
        o.z = pk4_fp8(s[8 * 33] * W8_SCALE, s[9 * 33] * W8_SCALE, s[10 * 33] * W8_SCALE, s[11 * 33] * W8_SCALE);
        o.w = pk4_fp8(s[12 * 33] * W8_SCALE, s[13 * 33] * W8_SCALE, s[14 * 33] * W8_SCALE, s[15 * 33] * W8_SCALE);
        *(u32x4*)(WT + (size_t)(dst_row0 + (n0 + n) * rmul) * K + k0 + 16 * c) = o; }
    LDS_WAIT();
}

__device__ __forceinline__ void convert_experts(const Ctx& C, const Params& P) {
    unsigned char* w13 = P.ws + WS_W13; unsigned char* w2 = P.ws + WS_W2;
    LAS float* scr = (LAS float*)(C.lds + C.wave * 8448);
    const int gw = C.bid * 8 + C.wave, NGW = C.G * 8;
    const int PER_E = 3072;
    for (int it = gw; it < NE * PER_E; it += NGW) {
        const int e = it / PER_E, r = it % PER_E;
        if (r < 1024) transpose_item_f8(P.in[23] + (size_t)e * DM * DFF, DFF, DM, w13 + (size_t)e * 4096 * DM, 0, 2, scr, r / 64, r % 64, C.lane);
        else if (r < 2048) transpose_item_f8(P.in[24] + (size_t)e * DM * DFF, DFF, DM, w13 + (size_t)e * 4096 * DM, 1, 2, scr, (r - 1024) / 64, (r - 1024) % 64, C.lane);
        else transpose_item_f8(P.in[25] + (size_t)e * DFF * DM, DM, DFF, w2 + (size_t)e * DM * DFF, 0, 1, scr, (r - 2048) / 32, (r - 2048) % 32, C.lane);
    }
}

__device__ __forceinline__ void phase0(const Ctx& C, const Params& P) {
    unsigned char* ws = P.ws;
    const int gw = C.bid * 8 + C.wave, NGW = C.G * 8;
    {
        LAS float* scr = (LAS float*)(C.lds + C.wave * 8448);
        const int I_IN1 = 16 * 112, I_IN2 = 16 * 64, I_BH = 8 * 32, I_BM = 8 * 32, I_OUT = 16 * 32;
        const int NIT = I_IN1 + I_IN2 + I_BH + I_BM + I_OUT;
        for (int it = gw; it < NIT; it += NGW) {
            int r = it;
            if (r < I_IN1) { transpose_item(P.in[8], DIN, DM, 0, (bf16_t*)(ws + WS_WIN), 0, 1, scr, r / 112, r % 112, C.lane); continue; } r -= I_IN1;
            if (r < I_IN2) { transpose_item(P.in[8], DIN, DM, MERGE0, (bf16_t*)(ws + WS_WIN), GATE0, 1, scr, r / 64, r % 64, C.lane); continue; } r -= I_IN2;
            if (r < I_BH) { transpose_item(P.in[19], DM, 512, 0, (bf16_t*)(ws + WS_WBH), 0, 1, scr, r / 32, r % 32, C.lane); continue; } r -= I_BH;
            if (r < I_BM) { transpose_item(P.in[20], DM, 512, 0, (bf16_t*)(ws + WS_WBM), 0, 1, scr, r / 32, r % 32, C.lane); continue; } r -= I_BM;
            transpose_item(P.in[21], DM, DM, 0, (bf16_t*)(ws + WS_WOUT), 0, 1, scr, r / 32, r % 32, C.lane);
        }
    }
    {
        const float* wada = P.in[4]; const float* bada = P.in[5]; float* part = (float*)(ws + WS_ADAP);
        for (int it = gw; it < 96 * 8; it += NGW) {
            const int cgp = it % 96, ks = it / 96, n = cgp * 64 + C.lane;
            float a[9];
#pragma unroll
            for (int r = 0; r < 9; ++r) a[r] = 0.f;
#pragma unroll 1
            for (int k1 = 0; k1 < 4; ++k1) {
                const int k0 = ks * 128 + k1 * 32;
                float sv[9];
                { const int k = k0 + (C.lane & 31);
#pragma unroll
                  for (int r = 0; r < 8; ++r) sv[r] = siluf(P.in[1][r * DM + k]);
                  sv[8] = siluf(P.in[3][k]); }
                float wv[32];
#pragma unroll
                for (int kk = 0; kk < 32; ++kk) wv[kk] = wada[(size_t)(k0 + kk) * 6144 + n];
#pragma unroll
                for (int kk = 0; kk < 32; ++kk) {
#pragma unroll
                    for (int r = 0; r < 9; ++r) a[r] += __shfl(sv[r], kk) * wv[kk]; }
            }
            const float bb = (ks == 0) ? bada[n] : 0.f;
#pragma unroll
            for (int r = 0; r < 9; ++r) part[((size_t)ks * 9 + r) * 6144 + n] = a[r] + bb;
        }
    }
    __syncthreads();
    {
        LAS float* zs = (LAS float*)C.lds;
        LAS float* h1 = zs + 16 * 33;
        LAS float* h2 = h1 + 16 * 64;
        bf16_t* krev = (bf16_t*)(ws + WS_KREV);
        const float* w1 = P.in[11]; const float* b1 = P.in[12]; const float* w2 = P.in[13]; const float* b2 = P.in[14]; const float* w3 = P.in[15];
        for (int it = C.bid; it < 256; it += C.G) {
            const int l0 = it * 16;
            __syncthreads();
            for (int idx = C.tid; idx < 16 * 33; idx += NTHR) { const int pos = idx / 33, m = idx % 33, l = l0 + pos; float v;
                if (m == 0) v = (float)l / 4095.0f;
                else { const int bi = (m - 1) & 15; const float band = 1e-4f + (float)bi * ((15.0f - 1e-4f) / 15.0f);
                    const float ang = ((float)(2.0 * 3.14159265358979323846 / 4096.0) * (float)l) * band; v = (m <= 16) ? cosf(ang) : sinf(ang); }
                zs[idx] = v; }
            __syncthreads();
            for (int idx = C.tid; idx < 16 * 64; idx += NTHR) { const int pos = idx >> 6, j = idx & 63; float s = b1[j];
                for (int m = 0; m < 33; ++m) s += zs[pos * 33 + m] * w1[m * 64 + j];
                h1[idx] = sinf(s); }
            __syncthreads();
            for (int idx = C.tid; idx < 16 * 64; idx += NTHR) { const int pos = idx >> 6, j = idx & 63; float s = b2[j];
                for (int k = 0; k < 64; ++k) s += h1[pos * 64 + k] * w2[k * 64 + j];
                h2[idx] = sinf(s); }
            __syncthreads();
#pragma unroll 1
            for (int q = 0; q < 4; ++q) {
                const int n = C.tid + NTHR * q;
                float a[16];
#pragma unroll
                for (int p = 0; p < 16; ++p) a[p] = 0.f;
                for (int k = 0; k < 64; ++k) { const float w = w3[k * 2048 + n];
#pragma unroll
                    for (int p = 0; p < 16; ++p) a[p] += h2[p * 64 + k] * w; }
                const int o = n >> 10, side = (n >> 9) & 1, c = n & 511;
                const float delta = fabsf(-3.0701134573253944f + (float)c * ((-15.350567286626972f + 3.0701134573253944f) / 511.0f));
                bf16_t* dst = krev + ((size_t)o * 512 + c) * 8192;
#pragma unroll
                for (int p = 0; p < 16; ++p) { const int l = l0 + p; const float t = (float)l / 4095.0f; const float v = a[p] * expf(-t * delta);
                    if (side == 0) dst[4096 - l] = (bf16_t)f2bf(v);
                    else if (l > 0) dst[4096 + l] = (bf16_t)f2bf(v);
                    else dst[0] = 0; }
            }
        }
    }
}

__device__ __forceinline__ int wl_pos(int k) { return ((k & 3) + 4 * (k >> 8)) * 64 + ((k >> 2) & 63); }
__device__ __forceinline__ float row_dot16(const f32x4 (&y)[4], const LAS float* Wl, int lane) {
    float r[16];
#pragma unroll
    for (int e = 0; e < 16; ++e) r[e] = 0.f;
#pragma unroll
    for (int j = 0; j < 4; ++j) {
#pragma unroll
        for (int q = 0; q < 4; ++q) { const float v = y[j][q]; const LAS float* wp = Wl + ((q + 4 * j) * 64 + lane) * 20;
#pragma unroll
            for (int e4 = 0; e4 < 4; ++e4) { const f32x4 w = *(const LAS f32x4*)(wp + e4 * 4);
                r[e4 * 4 + 0] += v * w[0]; r[e4 * 4 + 1] += v * w[1]; r[e4 * 4 + 2] += v * w[2]; r[e4 * 4 + 3] += v * w[3]; } }
        asm volatile("" ::: "memory"); }
    const bool b5 = (lane & 32) != 0, b4 = (lane & 16) != 0, b3 = (lane & 8) != 0, b2 = (lane & 4) != 0;
    float t[8];
#pragma unroll
    for (int e = 0; e < 8; ++e) { const float snd = b5 ? r[e] : r[e + 8], kp = b5 ? r[e + 8] : r[e]; t[e] = kp + __shfl_xor(snd, 32); }
    float u[4];
#pragma unroll
    for (int e = 0; e < 4; ++e) { const float snd = b4 ? t[e] : t[e + 4], kp = b4 ? t[e + 4] : t[e]; u[e] = kp + __shfl_xor(snd, 16); }
    float v2[2];
#pragma unroll
    for (int e = 0; e < 2; ++e) { const float snd = b3 ? u[e] : u[e + 2], kp = b3 ? u[e + 2] : u[e]; v2[e] = kp + __shfl_xor(snd, 8); }
    float s; { const float snd = b2 ? v2[0] : v2[1], kp = b2 ? v2[1] : v2[0]; s = kp + __shfl_xor(snd, 4); }
    s += __shfl_xor(s, 2); s += __shfl_xor(s, 1);
    return s;
}

__device__ __forceinline__ void phase1(const Ctx& C, const Params& P) {
    unsigned char* ws = P.ws;
    const float* part = (const float*)(ws + WS_ADAP); float* ada = (float*)(ws + WS_ADA);
    for (int o = C.bid * NTHR + C.tid; o < 9 * 6144; o += C.G * NTHR) { float s = 0.f;
#pragma unroll
        for (int ks = 0; ks < 8; ++ks) s += part[(size_t)ks * 9 * 6144 + o];
        ada[o] = s; }
    LAS float* Wg = (LAS float*)C.lds;
    LAS float* mod = Wg + 1024 * 20;
    for (int idx = C.tid; idx < 1024 * 16; idx += NTHR) Wg[wl_pos(idx >> 4) * 20 + (idx & 15)] = P.in[8][(size_t)(idx >> 4) * DIN + GATE0 + (idx & 15)];
    const float* gmix = P.in[6]; const float* bin = P.in[9];
    bf16_t* hx = (bf16_t*)(ws + WS_HX); float* gates = (float*)(ws + WS_GATES);
    for (int rg = C.bid; rg < 256; rg += C.G) {
        const int b = rg >> 5;
        __syncthreads();
        for (int idx = C.tid; idx < 4096; idx += NTHR) { const int which = idx >> 10, k = idx & 1023; const int r = (which < 2) ? b : 8; const int col = (which & 1) * 1024 + k;
            float s = 0.f;
#pragma unroll
            for (int ks = 0; ks < 8; ++ks) s += part[((size_t)ks * 9 + r) * 6144 + col];
            mod[idx] = s; }
        __syncthreads();
        auto rowsrc = [&](int rr) -> const float* { return (rr < 128) ? (P.in[0] + (size_t)(rg * 128 + rr) * DM) : (P.in[2] + (size_t)(rg * 8 + (rr - 128)) * DM); };
        f32x4 nx[4];
        { const float* s0 = rowsrc(C.wave);
#pragma unroll
          for (int j = 0; j < 4; ++j) nx[j] = *(const f32x4*)(s0 + 4 * C.lane + 256 * j); }
        for (int rr = C.wave; rr < 136; rr += 8) {
            const bool isx = rr < 128; const int grow = isx ? (rg * 128 + rr) : (MX + rg * 8 + (rr - 128));
            const LAS float* sh = mod + (isx ? 0 : 2048); const LAS float* sc = sh + 1024;
            f32x4 v[4]; float ss = 0.f;
#pragma unroll
            for (int j = 0; j < 4; ++j) { v[j] = nx[j]; ss += v[j][0] * v[j][0] + v[j][1] * v[j][1] + v[j][2] * v[j][2] + v[j][3] * v[j][3]; }
            if (rr + 8 < 136) { const float* s1 = rowsrc(rr + 8);
#pragma unroll
                for (int j = 0; j < 4; ++j) nx[j] = *(const f32x4*)(s1 + 4 * C.lane + 256 * j); }
            const float rstd = rsqrtf(wave_sum(ss) * (1.f / DM) + RMS_EPS);
#pragma unroll
            for (int j = 0; j < 4; ++j) { const int k = 4 * C.lane + 256 * j; const f32x4 g = *(const f32x4*)(gmix + k);
                const f32x4 s4 = *(const LAS f32x4*)(sc + k), h4 = *(const LAS f32x4*)(sh + k);
#pragma unroll
                for (int q = 0; q < 4; ++q) v[j][q] = (v[j][q] * rstd * g[q]) * (1.f + s4[q]) + h4[q];
                u32x2 w; w.x = pk2(v[j][0], v[j][1]); w.y = pk2(v[j][2], v[j][3]);
                *(u32x2*)(hx + (size_t)grow * DM + k) = w; }
            const float gsum = row_dot16(v, Wg, C.lane);
            if ((C.lane & 3) == 0) gates[(size_t)grow * 16 + (C.lane >> 2)] = gsum + bin[GATE0 + (C.lane >> 2)];
        }
    }
}

__device__ __forceinline__ void phase2a(const Ctx& C, const Params& P) {
    unsigned char* ws = P.ws;
    pg8::SchedGrid S{(const char*)(ws + WS_HX), (const char*)(ws + WS_WIN), (size_t)256 * 2048, (size_t)256 * 2048, 128, 10, 0, 0, C.G, C.bid, 4, 128, 8, 32, 6, 2};
    pg8::EpiCM E{(bf16_t*)(ws + WS_PCM), (bf16_t*)(ws + WS_KVCM), P.in[9]};
    pg8::gemm_phase<pg8::EpiCM, pg8::SchedGrid, true>(C.lds, 1024, 2048, 2048, S, E);
}
__device__ __forceinline__ void phase2b(const Ctx& C, const Params& P) {
    unsigned char* ws = P.ws;
    pg8::SchedGrid S{(const char*)(ws + WS_HX), (const char*)(ws + WS_WIN), (size_t)256 * 2048, (size_t)256 * 2048, 128, 12, 0, 6, C.G, C.bid, 1, 0, 0, 0, 2, 4};
    pg8::EpiIn2 E{(bf16_t*)(ws + WS_PML), (bf16_t*)P.out, P.in[9]};
    pg8::gemm_phase<pg8::EpiIn2, pg8::SchedGrid, false>(C.lds, 1024, 2048, 2048, S, E);
}
__device__ __forceinline__ void phase_merge(const Ctx& C, const Params& P) {
    unsigned char* ws = P.ws;
    pg8::SchedGrid S{(const char*)(ws + WS_YA), (const char*)(ws + WS_WBH), (size_t)256 * 1024, (size_t)256 * 1024, 128, 4, 0, 0, C.G, C.bid, 1, 0, 0, 0, 1 << 30, 0};
    pg8::EpiMerge<0> E0{(bf16_t*)(ws + WS_Z), (const bf16_t*)P.out};
    pg8::gemm_phase<pg8::EpiMerge<0>, pg8::SchedGrid, false>(C.lds, 512, 1024, 1024, S, E0);
    S.A = (const char*)(ws + WS_YB); S.B = (const char*)(ws + WS_WBM);
    pg8::EpiMerge<1> E1{(bf16_t*)(ws + WS_Z), (const bf16_t*)P.out};
    pg8::gemm_phase<pg8::EpiMerge<1>, pg8::SchedGrid, false>(C.lds, 512, 1024, 1024, S, E1);
}
__device__ __forceinline__ void phase_outproj(const Ctx& C, const Params& P) {
    unsigned char* ws = P.ws;
    pg8::SchedGrid S{(const char*)(ws + WS_Z), (const char*)(ws + WS_WOUT), (size_t)256 * 2048, (size_t)256 * 2048, 128, 4, 0, 0, C.G, C.bid, 1, 0, 0, 0, 1 << 30, 0};
    pg8::EpiOut E{P.in[0], P.out, (const float*)(ws + WS_ADA)};
    pg8::gemm_phase<pg8::EpiOut, pg8::SchedGrid, false>(C.lds, 1024, 2048, 2048, S, E);
}

constexpr int HY_KSTR = 16448;
constexpr int HY_UOFF = 4 * HY_KSTR;
constexpr int HY_USTR = 4360;
__device__ __forceinline__ void hyena_item(const Ctx& C, const Params& P, int o, int c) {
    unsigned char* ws = P.ws;
    LAS bf16_t* krv = (LAS bf16_t*)C.lds;
    LAS bf16_t* up = (LAS bf16_t*)(C.lds + HY_UOFF);
    const bf16_t* pcm = (const bf16_t*)(ws + WS_PCM);
    const float* hconv = P.in[10];
    __syncthreads();
    {
        const u32x4* src = (const u32x4*)((const bf16_t*)(ws + WS_KREV) + ((size_t)o * 512 + c) * 8192);
        for (int i = C.tid; i < 1024; i += NTHR) *(LAS u32x4*)(krv + 8 * i) = src[i];
        for (int i = C.tid; i < 8 * 32; i += NTHR) { const int b = i >> 5, q = i & 31; const int off = (q < 16) ? 8 * q : (4224 + 8 * (q - 16));
            *(LAS u32x4*)(up + b * HY_USTR + off) = (u32x4){0u, 0u, 0u, 0u}; }
        if (o == 0) {
            const bf16_t* src0 = pcm + (size_t)c * MX; const float w0 = hconv[c], w1 = hconv[1536 + c], w2 = hconv[3072 + c];
            for (int i = C.tid; i < 4096; i += NTHR) { const int r0 = 8 * i; const u32x4 v = *(const u32x4*)(src0 + r0);
                float x[10]; x[1] = bflo(v.x); x[2] = bfhi(v.x); x[3] = bflo(v.y); x[4] = bfhi(v.y); x[5] = bflo(v.z); x[6] = bfhi(v.z); x[7] = bflo(v.w); x[8] = bfhi(v.w);
                x[0] = ((r0 & 63) != 0) ? bf2f(src0[r0 - 1]) : 0.f; x[9] = ((r0 & 63) != 56) ? bf2f(src0[r0 + 8]) : 0.f;
                float y[8];
#pragma unroll
                for (int j = 0; j < 8; ++j) y[j] = w0 * x[j] + w1 * x[j + 1] + w2 * x[j + 2];
                u32x4 w; w.x = pk2(y[0], y[1]); w.y = pk2(y[2], y[3]); w.z = pk2(y[4], y[5]); w.w = pk2(y[6], y[7]);
                *(LAS u32x4*)(up + (r0 >> 12) * HY_USTR + 128 + (r0 & 4095)) = w; }
        } else {
            const u32x4* src1 = (const u32x4*)((const bf16_t*)(ws + WS_Z1) + (size_t)c * MX);
            for (int i = C.tid; i < 4096; i += NTHR) { const int r0 = 8 * i; *(LAS u32x4*)(up + (r0 >> 12) * HY_USTR + 128 + (r0 & 4095)) = src1[i]; }
        }
    }
    __syncthreads();
    for (int idx = C.tid; idx < 3 * 1025; idx += NTHR) { const int rho = 1 + idx / 1025, ch = idx % 1025; unsigned short e[8];
#pragma unroll
        for (int j = 0; j < 8; ++j) { const int z = 8 * ch + j - rho; e[j] = (z >= 0 && z < 8192) ? krv[z] : (unsigned short)0; }
        u32x4 w; w.x = e[0] | ((unsigned)e[1] << 16); w.y = e[2] | ((unsigned)e[3] << 16); w.z = e[4] | ((unsigned)e[5] << 16); w.w = e[6] | ((unsigned)e[7] << 16);
        *(LAS u32x4*)(C.lds + rho * HY_KSTR + 16 * ch) = w; }
    if (C.tid == 0) *(LAS u32x4*)(C.lds + 16 * 1024) = (u32x4){0u, 0u, 0u, 0u};
    __syncthreads();
    const int lane = C.lane, w = C.wave, i = lane & 31, kq = lane >> 5, nb = (lane >> 2) & 7, np = lane & 3, rho = i & 3;
    f32x16 acc[4];
#pragma unroll
    for (int a = 0; a < 4; ++a)
#pragma unroll
        for (int r = 0; r < 16; ++r) acc[a][r] = 0.f;
    const int abase = rho * HY_KSTR + 2 * (4096 - i + 8 * kq + rho) - 1024 * w - 768;
    const int bbase = HY_UOFF + 2 * (nb * HY_USTR + 128 + 32 * np + 8 * kq);
    typedef const volatile LAS u32x2* vp2;
#define HY_LOAD(AF, BF, s0) do { const int _a = abase + 2 * (s0); BF = *(const LAS bf16x8*)(C.lds + bbase + 2 * (s0)); \
        _Pragma("unroll") for (int a = 0; a < 4; ++a) { const u32x2 lo = *(vp2)(C.lds + _a + 256 * (3 - a)), hi = *(vp2)(C.lds + _a + 256 * (3 - a) + 8); \
            AF[a] = __builtin_bit_cast(bf16x8, (u32x4){lo.x, lo.y, hi.x, hi.y}); } } while (0)
    bf16x8 a0[4], a1[4], b0, b1;
    HY_LOAD(a0, b0, -96);
    for (int s0 = -96; s0 < 4096; s0 += 32) {
        HY_LOAD(a1, b1, s0 + 16);
#pragma unroll
        for (int a = 0; a < 4; ++a) acc[a] = __builtin_amdgcn_mfma_f32_32x32x16_bf16(a0[a], b0, acc[a], 0, 0, 0);
        if (s0 + 32 < 4096) HY_LOAD(a0, b0, s0 + 32);
#pragma unroll
        for (int a = 0; a < 4; ++a) acc[a] = __builtin_amdgcn_mfma_f32_32x32x16_bf16(a1[a], b1, acc[a], 0, 0, 0);
    }
#undef HY_LOAD
    const int gch = (o == 0 ? 512 : 1024) + c;
    const float w0 = hconv[gch], w1 = hconv[1536 + gch], w2 = hconv[3072 + gch], skip = P.in[16][o * 512 + c];
    const bf16_t* gsrc = pcm + (size_t)gch * MX + (size_t)nb * SEQ;
    bf16_t* dst = (bf16_t*)(ws + (o == 0 ? WS_Z1 : WS_Z)) + (size_t)c * MX + (size_t)nb * SEQ;
#pragma unroll
    for (int a = 0; a < 4; ++a)
#pragma unroll
        for (int g = 0; g < 4; ++g) {
            const int t0 = 128 * (4 * w + a) + 32 * np + 8 * g + 4 * kq;
            const u32x2 gv = *(const u32x2*)(gsrc + t0);
            float x[6]; x[1] = bflo(gv.x); x[2] = bfhi(gv.x); x[3] = bflo(gv.y); x[4] = bfhi(gv.y);
            x[0] = ((t0 & 63) != 0) ? bf2f(gsrc[t0 - 1]) : 0.f; x[5] = ((t0 & 63) != 60) ? bf2f(gsrc[t0 + 4]) : 0.f;
            const u32x2 uv = *(const LAS u32x2*)(up + nb * HY_USTR + 128 + t0);
            const float uu[4] = {bflo(uv.x), bfhi(uv.x), bflo(uv.y), bfhi(uv.y)};
            float z[4];
#pragma unroll
            for (int j = 0; j < 4; ++j) { const float gate = w0 * x[j] + w1 * x[j + 1] + w2 * x[j + 2]; z[j] = gate * (acc[a][4 * g + j] + skip * uu[j]); }
            u32x2 wv; wv.x = pk2(z[0], z[1]); wv.y = pk2(z[2], z[3]);
            *(u32x2*)(dst + t0) = wv;
        }
}

typedef short s16x4 __attribute__((ext_vector_type(4)));
__device__ __forceinline__ unsigned off_b(unsigned row, unsigned ch) { return 256u * row + 16u * (ch ^ (((row & 3) << 2) | ((row >> 2) & 3))); }
__device__ __forceinline__ bf16x8 tile_row_read(const LAS unsigned char* T, int lane, int rb, int s) { return *(const LAS bf16x8*)(T + off_b((lane & 15) + 16 * rb, 4 * s + (lane >> 4))); }
__device__ __forceinline__ bf16x8 tile_tr_read(const LAS unsigned char* T, int lane, int c, int ks) {
    const unsigned g = lane >> 4, q = (lane & 15) >> 2, p = lane & 3;
    const unsigned a0 = off_b(32 * ks + 8 * g + q, 2 * c + (p >> 1)) + 8 * (p & 1), a1 = off_b(32 * ks + 8 * g + 4 + q, 2 * c + (p >> 1)) + 8 * (p & 1);
    const s16x4 lo = __builtin_amdgcn_ds_read_tr16_b64_v4i16((LAS s16x4*)(T + a0)), hi = __builtin_amdgcn_ds_read_tr16_b64_v4i16((LAS s16x4*)(T + a1));
    return __builtin_shufflevector(lo, hi, 0, 1, 2, 3, 4, 5, 6, 7);
}
struct ChunkRef { int isctx, b, h, d, oc; };
__device__ __forceinline__ int chunk_row0(const ChunkRef& r) { return r.isctx ? (MX + r.b * CTXL + r.oc * 128) : (r.b * SEQ + r.oc * 128); }

__device__ __forceinline__ void load_kv_tiles(const Ctx& C, const Params& P, const ChunkRef& r, LAS unsigned char* KT, LAS unsigned char* VT, const LAS float* vscale) {
    const bf16_t* kvcm = (const bf16_t*)(P.ws + WS_KVCM); const float* cw = P.in[17];
    const int col0 = chunk_row0(r), rowlen = r.isctx ? CTXL : 64, orig0 = r.oc * 128;
    for (int idx = C.tid; idx < 2048; idx += NTHR) { const int d = idx >> 4, ch = idx & 15, s0 = 8 * ch;
        const bf16_t* src = kvcm + (size_t)(r.h * 128 + d) * MT + col0 + s0;
        const u32x4 v = *(const u32x4*)src;
        float x[10]; x[1] = bflo(v.x); x[2] = bfhi(v.x); x[3] = bflo(v.y); x[4] = bfhi(v.y); x[5] = bflo(v.z); x[6] = bfhi(v.z); x[7] = bflo(v.w); x[8] = bfhi(v.w);
        x[0] = (((orig0 + s0) % rowlen) != 0) ? bf2f(src[-1]) : 0.f; x[9] = (((orig0 + s0 + 7) % rowlen) != rowlen - 1) ? bf2f(src[8]) : 0.f;
        const int cc = 512 + r.h * 128 + d; const float w0 = cw[cc], w1 = cw[1024 + cc], w2 = cw[2048 + cc];
        float y[8];
#pragma unroll
        for (int j = 0; j < 8; ++j) y[j] = siluf(w0 * x[j] + w1 * x[j + 1] + w2 * x[j + 2]);
        u32x4 o; o.x = pk2(y[0], y[1]); o.y = pk2(y[2], y[3]); o.z = pk2(y[4], y[5]); o.w = pk2(y[6], y[7]);
        *(LAS u32x4*)(KT + off_b(d, ch)) = o;
        const u32x4 vv = *(const u32x4*)(kvcm + (size_t)(512 + r.h * 128 + d) * MT + col0 + s0);
        if (vscale) { const f32x4 sa = *(const LAS f32x4*)(vscale + s0), sb = *(const LAS f32x4*)(vscale + s0 + 4);
            u32x4 ov; ov.x = pk2(bflo(vv.x) * sa[0], bfhi(vv.x) * sa[1]); ov.y = pk2(bflo(vv.y) * sa[2], bfhi(vv.y) * sa[3]);
            ov.z = pk2(bflo(vv.z) * sb[0], bfhi(vv.z) * sb[1]); ov.w = pk2(bflo(vv.w) * sb[2], bfhi(vv.w) * sb[3]);
            *(LAS u32x4*)(VT + off_b(d, ch)) = ov; }
        else *(LAS u32x4*)(VT + off_b(d, ch)) = vv; }
}

__device__ __forceinline__ void mlstm_a_item(const Ctx& C, const Params& P, int item) {
    unsigned char* ws = P.ws;
    const int j = item % NCHK, seq = item / NCHK, h = seq & 3, b = (seq >> 2) & 7, d = seq >> 5;
    ChunkRef r; r.isctx = j < 2; r.b = b; r.h = h; r.d = d; { const int jj = r.isctx ? j : j - 2, nch = r.isctx ? 2 : 32; r.oc = d ? (nch - 1 - jj) : jj; }
    LAS unsigned char* KT = C.lds; LAS unsigned char* VT = C.lds + 32768;
    LAS float* wl = (LAS float*)(C.lds + 65536); LAS float* sc2 = wl + 128;
    __syncthreads();
    if (C.wave == 0) {
        const float* gates = (const float*)(ws + WS_GATES) + (size_t)chunk_row0(r) * 16;
        const int p0 = 2 * C.lane, t0 = d ? 127 - p0 : p0, t1 = d ? 126 - p0 : p0 + 1;
        const float li0 = gates[(size_t)t0 * 16 + (d ? 8 : 0) + h], li1 = gates[(size_t)t1 * 16 + (d ? 8 : 0) + h];
        const float lf0 = logsig(gates[(size_t)t0 * 16 + (d ? 12 : 4) + h]), lf1 = logsig(gates[(size_t)t1 * 16 + (d ? 12 : 4) + h]);
        float run = lf0 + lf1;
#pragma unroll
        for (int o = 1; o < 64; o <<= 1) { const float t = __shfl_up(run, o); if (C.lane >= o) run += t; }
        const float b1 = run, b0 = run - lf1;
        const float c0 = li0 - b0, c1 = li1 - b1;
        float gm = fmaxf(c0, c1);
#pragma unroll
        for (int o = 1; o < 64; o <<= 1) { const float t = __shfl_up(gm, o); if (C.lane >= o) gm = fmaxf(gm, t); }
        float gprev = __shfl_up(gm, 1); if (C.lane == 0) gprev = -3.0e38f;
        const float g0 = fmaxf(gprev, c0), g1 = gm;
        const float Bj = __shfl(b1, 63), gfin = __shfl(gm, 63);
        wl[t0] = __expf(c0 - gfin); wl[t1] = __expf(c1 - gfin);
        float* gc = (float*)(ws + WS_GC) + (size_t)item * 384;
        gc[t0] = c0; gc[t1] = c1; gc[128 + t0] = b0; gc[128 + t1] = b1; gc[256 + t0] = g0; gc[256 + t1] = g1;
        if (C.lane == 0) { float* bl = (float*)(ws + WS_BL) + (size_t)item * 2; bl[0] = Bj; bl[1] = Bj + gfin; }
    }
    __syncthreads();
    load_kv_tiles(C, P, r, KT, VT, wl);
    __syncthreads();
    if (C.tid < 128) { float s = 0.f;
        for (int ch = 0; ch < 16; ++ch) { const u32x4 kv = *(const LAS u32x4*)(KT + off_b(C.tid, ch)); const f32x4 wa = *(const LAS f32x4*)(wl + 8 * ch), wb = *(const LAS f32x4*)(wl + 8 * ch + 4);
            s += bflo(kv.x) * wa[0] + bfhi(kv.x) * wa[1] + bflo(kv.y) * wa[2] + bfhi(kv.y) * wa[3] + bflo(kv.z) * wb[0] + bfhi(kv.z) * wb[1] + bflo(kv.w) * wb[2] + bfhi(kv.w) * wb[3]; }
        ((float*)(ws + WS_NLOC))[(size_t)item * 128 + C.tid] = s; }
    const int lane = C.lane, w = C.wave, fr = lane & 15, fq = lane >> 4;
    bf16x8 af[4];
#pragma unroll
    for (int ks = 0; ks < 4; ++ks) af[ks] = tile_row_read(VT, lane, w, ks);
    bf16_t* dst = (bf16_t*)(ws + WS_PLOC) + (size_t)item * 16384;
#pragma unroll
    for (int nt = 0; nt < 8; ++nt) { f32x4 acc = (f32x4){0.f, 0.f, 0.f, 0.f};
#pragma unroll
        for (int ks = 0; ks < 4; ++ks) acc = __builtin_amdgcn_mfma_f32_16x16x32_bf16(af[ks], tile_row_read(KT, lane, nt, ks), acc, 0, 0, 0);
#pragma unroll
        for (int q = 0; q < 4; ++q) dst[(16 * w + 4 * fq + q) * 128 + 16 * nt + fr] = (bf16_t)f2bf(acc[q]); }
}

__device__ __forceinline__ void mlstm_scan(const Ctx& C, const Params& P) {
    unsigned char* ws = P.ws;
    const float* BL = (const float*)(ws + WS_BL); const bf16_t* ploc = (const bf16_t*)(ws + WS_PLOC); bf16_t* cst = (bf16_t*)(ws + WS_CST);
    for (int slot = C.bid * NTHR + C.tid; slot < 64 * 2048; slot += C.G * NTHR) {
        const int seq = slot >> 11, off = (slot & 2047) * 8;
        float cs[8];
#pragma unroll
        for (int q = 0; q < 8; ++q) cs[q] = 0.f;
        float m = 0.f;
        u32x4 pl[NCHK - 1];
#pragma unroll
        for (int j = 0; j < NCHK - 1; ++j) pl[j] = *(const u32x4*)(ploc + ((size_t)(seq * NCHK + j)) * 16384 + off);
#pragma unroll
        for (int j = 0; j < NCHK; ++j) {
            if (j >= 2) { u32x4 o; o.x = pk2(cs[0], cs[1]); o.y = pk2(cs[2], cs[3]); o.z = pk2(cs[4], cs[5]); o.w = pk2(cs[6], cs[7]);
                *(u32x4*)(cst + ((size_t)(seq * 32 + j - 2)) * 16384 + off) = o;
                if (off == 0) ((float*)(ws + WS_MST))[seq * 32 + j - 2] = m; }
            if (j < NCHK - 1) {
                const float Bj = BL[(seq * NCHK + j) * 2], Lj = BL[(seq * NCHK + j) * 2 + 1];
                const float mn = fmaxf(Bj + m, Lj), dec = __expf(Bj + m - mn), sc = __expf(Lj - mn);
                const unsigned p4[4] = {pl[j].x, pl[j].y, pl[j].z, pl[j].w};
#pragma unroll
                for (int q = 0; q < 4; ++q) { cs[2 * q] = dec * cs[2 * q] + sc * bflo(p4[q]); cs[2 * q + 1] = dec * cs[2 * q + 1] + sc * bfhi(p4[q]); }
                m = mn; }
        }
    }
    for (int idx = C.bid * NTHR + C.tid; idx < 64 * 128; idx += C.G * NTHR) {
        const int seq = idx >> 7, dd = idx & 127; float n = 0.f, m = 0.f;
        const float* nloc = (const float*)(ws + WS_NLOC); float* nst = (float*)(ws + WS_NST);
        for (int j = 0; j < NCHK; ++j) {
            if (j >= 2) nst[(size_t)(seq * 32 + j - 2) * 128 + dd] = n;
            if (j < NCHK - 1) { const float Bj = BL[(seq * NCHK + j) * 2], Lj = BL[(seq * NCHK + j) * 2 + 1];
                const float mn = fmaxf(Bj + m, Lj); n = __expf(Bj + m - mn) * n + __expf(Lj - mn) * nloc[(size_t)(seq * NCHK + j) * 128 + dd]; m = mn; }
        }
    }
}

__device__ __forceinline__ void mlstm_c_item(const Ctx& C, const Params& P, int item) {
    unsigned char* ws = P.ws;
    const int oc = item & 31, h = (item >> 5) & 3, b = item >> 7;
    LAS unsigned char* KT = C.lds; LAS unsigned char* VT = C.lds + 32768; LAS unsigned char* CT = C.lds + 65536; LAS unsigned char* PS = C.lds + 98304;
    LAS float* colf = (LAS float*)(C.lds + 131072); LAS float* bcs = colf + 128; LAS float* gms = bcs + 128; LAS float* nsl = gms + 128;
    const int lane = C.lane, w = C.wave, fr = lane & 15, fq = lane >> 4;
    const bf16_t* pml = (const bf16_t*)(ws + WS_PML) + (size_t)(b * SEQ + oc * 128) * 1024;
    const float* cw = P.in[17];
    bf16x8 qf[4];
    { const int tau = 16 * w + fr, orig = oc * 128 + tau; const bool hl = (orig & 63) != 0, hr = (orig & 63) != 63;
#pragma unroll
      for (int ks = 0; ks < 4; ++ks) { const int dc = 32 * ks + 8 * fq; const bf16_t* base = pml + (size_t)tau * 1024 + h * 128 + dc;
        const u32x4 vc = *(const u32x4*)base; u32x4 vl = (u32x4){0u, 0u, 0u, 0u}, vr = (u32x4){0u, 0u, 0u, 0u};
        if (hl) vl = *(const u32x4*)(base - 1024); if (hr) vr = *(const u32x4*)(base + 1024);
        const unsigned l4[4] = {vl.x, vl.y, vl.z, vl.w}, c4[4] = {vc.x, vc.y, vc.z, vc.w}, r4[4] = {vr.x, vr.y, vr.z, vr.w}; const int col = h * 128 + dc; unsigned o4[4];
#pragma unroll
        for (int q = 0; q < 4; ++q) {
            const float a0 = cw[col + 2 * q] * bflo(l4[q]) + cw[1024 + col + 2 * q] * bflo(c4[q]) + cw[2048 + col + 2 * q] * bflo(r4[q]);
            const float a1 = cw[col + 2 * q + 1] * bfhi(l4[q]) + cw[1024 + col + 2 * q + 1] * bfhi(c4[q]) + cw[2048 + col + 2 * q + 1] * bfhi(r4[q]);
            o4[q] = pk2(siluf(a0) * 0.08838834764831845f, siluf(a1) * 0.08838834764831845f); }
        qf[ks] = __builtin_bit_cast(bf16x8, (u32x4){o4[0], o4[1], o4[2], o4[3]}); } }
    f32x4 hacc[8];
#pragma unroll
    for (int nt = 0; nt < 8; ++nt) hacc[nt] = (f32x4){0.f, 0.f, 0.f, 0.f};
#pragma unroll 1
    for (int d = 0; d < 2; ++d) {
        ChunkRef r; r.isctx = 0; r.b = b; r.h = h; r.d = d; r.oc = oc;
        const int seq = (d * 8 + b) * 4 + h, jj = d ? 31 - oc : oc, sidx = seq * 32 + jj, aitem = seq * NCHK + 2 + jj;
        __syncthreads();
        load_kv_tiles(C, P, r, KT, VT, nullptr);
        for (int idx = C.tid; idx < 2048; idx += NTHR) { const int e = idx >> 4, ch = idx & 15;
            *(LAS u32x4*)(CT + off_b(e, ch)) = *(const u32x4*)((const bf16_t*)(ws + WS_CST) + (size_t)sidx * 16384 + e * 128 + 8 * ch); }
        if (C.tid < 384) colf[C.tid] = ((const float*)(ws + WS_GC))[(size_t)aitem * 384 + C.tid];
        else nsl[C.tid - 384] = ((const float*)(ws + WS_NST))[(size_t)sidx * 128 + (C.tid - 384)];
        const float m0 = ((const float*)(ws + WS_MST))[sidx];
        __syncthreads();
        int t = 16 * w + fr, lane = C.lane; asm volatile("" : "+v"(t), "+v"(lane));
        const int fq = lane >> 4;
        const float mx = fmaxf(m0, gms[t]), rowf = -mx, ainter = __expf(m0 - mx), emneg = __expf(-(bcs[t] + mx));
        float qn = 0.f;
#pragma unroll
        for (int ks = 0; ks < 4; ++ks) { const u32x4 qq = __builtin_bit_cast(u32x4, qf[ks]); const LAS float* np_ = nsl + 32 * ks + 8 * fq; const f32x4 na = *(const LAS f32x4*)np_, nb = *(const LAS f32x4*)(np_ + 4);
            qn += bflo(qq.x) * na[0] + bfhi(qq.x) * na[1] + bflo(qq.y) * na[2] + bfhi(qq.y) * na[3] + bflo(qq.z) * nb[0] + bfhi(qq.z) * nb[1] + bflo(qq.w) * nb[2] + bfhi(qq.w) * nb[3]; }
        qn += __shfl_xor(qn, 16); qn += __shfl_xor(qn, 32);
        float rs = 0.f;
#pragma unroll
        for (int nt = 0; nt < 8; ++nt) { f32x4 a = (f32x4){0.f, 0.f, 0.f, 0.f};
#pragma unroll
            for (int ks = 0; ks < 4; ++ks) a = __builtin_amdgcn_mfma_f32_16x16x32_bf16(tile_tr_read(KT, lane, nt, ks), qf[ks], a, 0, 0, 0);
            const int s0 = 16 * nt + 4 * fq; const f32x4 cf = *(const LAS f32x4*)(colf + s0); float pv[4];
#pragma unroll
            for (int q = 0; q < 4; ++q) { const int s = s0 + q; const bool ok = d ? (s >= t) : (s <= t); pv[q] = ok ? __expf(rowf + cf[q]) * a[q] : 0.f; rs += pv[q]; }
            u32x2 pw; pw.x = pk2(pv[0], pv[1]); pw.y = pk2(pv[2], pv[3]);
            *(LAS u32x2*)(PS + off_b(t, 2 * nt + (fq >> 1)) + 8 * (fq & 1)) = pw; }
        rs += __shfl_xor(rs, 16); rs += __shfl_xor(rs, 32);
        const float inv = 1.f / fmaxf(fabsf(rs + ainter * qn), emneg);
        LDS_WAIT();
        bf16x8 pf[4];
#pragma unroll
        for (int ks = 0; ks < 4; ++ks) pf[ks] = tile_row_read(PS, lane, w, ks);
        float ai4[4], iv4[4];
#pragma unroll
        for (int q = 0; q < 4; ++q) { ai4[q] = __shfl(ainter, 4 * fq + q); iv4[q] = __shfl(inv, 4 * fq + q); }
#pragma unroll
        for (int nt = 0; nt < 8; ++nt) { f32x4 a = (f32x4){0.f, 0.f, 0.f, 0.f}, c = (f32x4){0.f, 0.f, 0.f, 0.f};
#pragma unroll
            for (int ks = 0; ks < 4; ++ks) { a = __builtin_amdgcn_mfma_f32_16x16x32_bf16(pf[ks], tile_row_read(VT, lane, nt, ks), a, 0, 0, 0);
                c = __builtin_amdgcn_mfma_f32_16x16x32_bf16(qf[ks], tile_row_read(CT, lane, nt, ks), c, 0, 0, 0); }
#pragma unroll
            for (int q = 0; q < 4; ++q) hacc[nt][q] += (a[q] + ai4[q] * c[q]) * iv4[q]; }
    }
    float ss[4] = {0.f, 0.f, 0.f, 0.f};
#pragma unroll
    for (int nt = 0; nt < 8; ++nt)
#pragma unroll
        for (int q = 0; q < 4; ++q) ss[q] += hacc[nt][q] * hacc[nt][q];
#pragma unroll
    for (int q = 0; q < 4; ++q) { ss[q] += __shfl_xor(ss[q], 1); ss[q] += __shfl_xor(ss[q], 2); ss[q] += __shfl_xor(ss[q], 4); ss[q] += __shfl_xor(ss[q], 8);
        ss[q] = rsqrtf(ss[q] * (1.f / 128.f) + RMS_EPS); }
    const float* ng = P.in[18]; bf16_t* yb = (bf16_t*)(ws + WS_YB);
#pragma unroll
    for (int nt = 0; nt < 8; ++nt) { const int e = h * 128 + 16 * nt + fr; const float gn = ng[e];
#pragma unroll
        for (int q = 0; q < 4; ++q) { const int t = 16 * w + 4 * fq + q; const float og = bf2f(pml[(size_t)t * 1024 + 512 + e]);
            yb[(size_t)(b * SEQ + oc * 128 + t) * 512 + e] = (bf16_t)f2bf(hacc[nt][q] * ss[q] * gn * sigm(og)); } }
}

__device__ __forceinline__ void transpose_z2(const Ctx& C, const Params& P) {
    unsigned char* ws = P.ws;
    const bf16_t* src = (const bf16_t*)(ws + WS_Z); bf16_t* dst = (bf16_t*)(ws + WS_YA);
    LAS bf16_t* tl = (LAS bf16_t*)(C.lds + 143360 - 20480);
    for (int it = C.bid; it < 8 * 256; it += C.G) {
        const int c0 = (it & 7) * 64, r0 = (it >> 3) * 128;
        __syncthreads();
        for (int idx = C.tid; idx < 64 * 16; idx += NTHR) { const int cc = idx >> 4, rc = (idx & 15) * 8;
            const u32x4 v = *(const u32x4*)(src + (size_t)(c0 + cc) * MX + r0 + rc); const unsigned v4[4] = {v.x, v.y, v.z, v.w};
#pragma unroll
            for (int q = 0; q < 4; ++q) { tl[(rc + 2 * q) * 72 + cc] = (bf16_t)(v4[q] & 0xffffu); tl[(rc + 2 * q + 1) * 72 + cc] = (bf16_t)(v4[q] >> 16); } }
        __syncthreads();
        for (int idx = C.tid; idx < 128 * 8; idx += NTHR) { const int rr = idx >> 3, c8 = (idx & 7) * 8;
            *(u32x4*)(dst + (size_t)(r0 + rr) * 512 + c0 + c8) = *(const LAS u32x4*)(tl + rr * 72 + c8); }
    }
}

__device__ __forceinline__ void phase6(const Ctx& C, const Params& P) {
    unsigned char* ws = P.ws;
    LAS float* Wr = (LAS float*)C.lds;
    for (int idx = C.tid; idx < 1024 * 16; idx += NTHR) Wr[wl_pos(idx >> 4) * 20 + (idx & 15)] = P.in[22][idx];
    __syncthreads();
    const float* ada = (const float*)(ws + WS_ADA); const float* gffn = P.in[7];
    unsigned char* hx2 = ws + WS_HX2; float* aff = (float*)(ws + WS_AFF); int* slot = (int*)(ws + WS_SLOT);
    f32x4 nx[4];
    { const int row0 = C.bid * 8 + C.wave;
      if (row0 < MX) {
#pragma unroll
        for (int j = 0; j < 4; ++j) nx[j] = *(const f32x4*)(P.out + (size_t)row0 * DM + 4 * C.lane + 256 * j); } }
    for (int row = C.bid * 8 + C.wave; row < MX; row += C.G * 8) {
        const int b = row >> 12, n = row & 4095;
        f32x4 v[4]; float ss = 0.f;
#pragma unroll
        for (int j = 0; j < 4; ++j) { v[j] = nx[j]; ss += v[j][0] * v[j][0] + v[j][1] * v[j][1] + v[j][2] * v[j][2] + v[j][3] * v[j][3]; }
        if (row + C.G * 8 < MX) {
#pragma unroll
            for (int j = 0; j < 4; ++j) nx[j] = *(const f32x4*)(P.out + (size_t)(row + C.G * 8) * DM + 4 * C.lane + 256 * j); }
        const float rstd = rsqrtf(wave_sum(ss) * (1.f / DM) + RMS_EPS);
#pragma unroll
        for (int j = 0; j < 4; ++j) { const int k = 4 * C.lane + 256 * j; const f32x4 g = *(const f32x4*)(gffn + k);
            const f32x4 h4 = *(const f32x4*)(ada + (size_t)b * 6144 + 3072 + k), s4 = *(const f32x4*)(ada + (size_t)b * 6144 + 4096 + k);
#pragma unroll
            for (int q = 0; q < 4; ++q) v[j][q] = (v[j][q] * rstd * g[q]) * (1.f + s4[q]) + h4[q];
            *(unsigned*)(hx2 + (size_t)row * DM + k) = pk4_fp8(v[j][0], v[j][1], v[j][2], v[j][3]); }
        const float lg = row_dot16(v, Wr, C.lane);
        float mx = lg;
        mx = fmaxf(mx, __shfl_xor(mx, 4)); mx = fmaxf(mx, __shfl_xor(mx, 8)); mx = fmaxf(mx, __shfl_xor(mx, 16)); mx = fmaxf(mx, __shfl_xor(mx, 32));
        const float ex = expf(lg - mx);
        float sum = ex;
        sum += __shfl_xor(sum, 4); sum += __shfl_xor(sum, 8); sum += __shfl_xor(sum, 16); sum += __shfl_xor(sum, 32);
        if ((C.lane & 3) == 0) { const int e = C.lane >> 2; aff[((size_t)b * NE + e) * SEQ + n] = ex / sum; slot[(size_t)row * 16 + e] = -1; }
    }
}

__device__ __forceinline__ void topk_item(const Ctx& C, const Params& P, int item) {
    unsigned char* ws = P.ws;
    const int b = item >> 4, e = item & 15;
    const float* aff = (const float*)(ws + WS_AFF) + (size_t)item * SEQ;
    LAS unsigned* red = (LAS unsigned*)C.lds;
    unsigned v[8];
    { const u32x4 a = *(const u32x4*)(aff + 8 * C.tid), c = *(const u32x4*)(aff + 8 * C.tid + 4);
      v[0] = a.x; v[1] = a.y; v[2] = a.z; v[3] = a.w; v[4] = c.x; v[5] = c.y; v[6] = c.z; v[7] = c.w; }
    unsigned prefix = 0u;
    for (int bit = 30; bit >= 0; --bit) {
        const unsigned cand = prefix | (1u << bit); int cnt = 0;
#pragma unroll
        for (int q = 0; q < 8; ++q) cnt += (v[q] >= cand) ? 1 : 0;
        cnt = (int)wave_sum((float)cnt);
        __syncthreads();
        if (C.lane == 0) red[C.wave] = (unsigned)cnt;
        __syncthreads();
        int tot = 0;
#pragma unroll
        for (int q = 0; q < 8; ++q) tot += (int)red[q];
        if (tot >= CAP) prefix = cand;
    }
    int cg_ = 0, ce_ = 0;
#pragma unroll
    for (int q = 0; q < 8; ++q) { cg_ += (v[q] > prefix) ? 1 : 0; ce_ += (v[q] == prefix) ? 1 : 0; }
    int ig = cg_, ie = ce_;
#pragma unroll
    for (int o = 1; o < 64; o <<= 1) { const int tg = __shfl_up(ig, o), te = __shfl_up(ie, o); if (C.lane >= o) { ig += tg; ie += te; } }
    __syncthreads();
    if (C.lane == 63) { red[C.wave] = (unsigned)ig; red[8 + C.wave] = (unsigned)ie; }
    __syncthreads();
    int bg = 0, be = 0, totg = 0;
#pragma unroll
    for (int q = 0; q < 8; ++q) { const int xg = (int)red[q], xe = (int)red[8 + q]; if (q < C.wave) { bg += xg; be += xe; } totg += xg; }
    int pg = bg + ig - cg_, pe = be + ie - ce_;
    const int need = CAP - totg;
    int* sidx = (int*)(ws + WS_SIDX) + (size_t)item * CAP; float* sg = (float*)(ws + WS_SGATE) + (size_t)item * CAP; int* slot = (int*)(ws + WS_SLOT);
#pragma unroll
    for (int q = 0; q < 8; ++q) { const int n = 8 * C.tid + q; int s = -1;
        if (v[q] > prefix) s = pg++;
        else if (v[q] == prefix) { if (pe < need) s = totg + pe; ++pe; }
        if (s >= 0) { sidx[s] = n; sg[s] = __builtin_bit_cast(float, v[q]); slot[((size_t)b * SEQ + n) * 16 + e] = s; } }
}

__device__ __forceinline__ void gather_all(const Ctx& C, const Params& P) {
    unsigned char* ws = P.ws;
    const int* sidx = (const int*)(ws + WS_SIDX); const unsigned char* hx2 = ws + WS_HX2; unsigned char* xg = ws + WS_XG;
    for (int r = C.bid * 8 + C.wave; r < NE * 4096; r += C.G * 8) {
        const int e = r >> 12, rr = r & 4095, b = rr >> 9, s = rr & 511;
        const int n = sidx[((size_t)b * NE + e) * CAP + s];
        const u32x4* src = (const u32x4*)(hx2 + ((size_t)b * SEQ + n) * DM); u32x4* dst = (u32x4*)(xg + (size_t)r * DM);
        dst[C.lane] = src[C.lane];
    }
}

__device__ __forceinline__ void moe_gemm1(const Ctx& C, const Params& P) {
    unsigned char* ws = P.ws;
    pg8::SchedMoe S{(const char*)(ws + WS_XG), (const char*)(ws + WS_W13), (size_t)256 * 1024, (size_t)256 * 1024, (size_t)4096 * 1024, (size_t)4096 * 1024, 16, 16, C.G, C.bid};
    pg8::EpiMoe1 E{ws + WS_ACT};
    pg8::gemm_phase<pg8::EpiMoe1, pg8::SchedMoe, false, true>(C.lds, 512, 1024, 1024, S, E);
}
__device__ __forceinline__ void moe_gemm2(const Ctx& C, const Params& P) {
    unsigned char* ws = P.ws;
    pg8::SchedMoe S{(const char*)(ws + WS_ACT), (const char*)(ws + WS_W2), (size_t)256 * 2048, (size_t)256 * 2048, (size_t)4096 * 2048, (size_t)1024 * 2048, 16, 4, C.G, C.bid};
    pg8::EpiMoe2 E{(bf16_t*)(ws + WS_YE), (const float*)(ws + WS_SGATE)};
    pg8::gemm_phase<pg8::EpiMoe2, pg8::SchedMoe, false, true>(C.lds, 1024, 2048, 2048, S, E);
}

__device__ __forceinline__ void phase_final(const Ctx& C, const Params& P) {
    unsigned char* ws = P.ws;
    const float* ada = (const float*)(ws + WS_ADA); const float* gfin = P.in[26];
    const int* slot = (const int*)(ws + WS_SLOT); const bf16_t* ye = (const bf16_t*)(ws + WS_YE);
    f32x4 nx[4]; int nslot = -1;
    { const int row0 = C.bid * 8 + C.wave;
      if (row0 < MX) { if (C.lane < 16) nslot = slot[(size_t)row0 * 16 + C.lane];
#pragma unroll
        for (int j = 0; j < 4; ++j) nx[j] = *(const f32x4*)(P.out + (size_t)row0 * DM + 4 * C.lane + 256 * j); } }
    for (int row = C.bid * 8 + C.wave; row < MX; row += C.G * 8) {
        const int b = row >> 12;
        float* xr = P.out + (size_t)row * DM;
        f32x4 xv[4]; const int myslot = nslot;
#pragma unroll
        for (int j = 0; j < 4; ++j) xv[j] = nx[j];
        f32x4 m[4];
#pragma unroll
        for (int j = 0; j < 4; ++j) m[j] = (f32x4){0.f, 0.f, 0.f, 0.f};
        for (int e = 0; e < NE; ++e) { const int s = __shfl(myslot, e);
            if (s >= 0) { const bf16_t* yr = ye + ((size_t)e * 4096 + b * CAP + s) * DM;
#pragma unroll
                for (int j = 0; j < 4; ++j) { const u32x2 w = *(const u32x2*)(yr + 4 * C.lane + 256 * j);
                    m[j][0] += bflo(w.x); m[j][1] += bfhi(w.x); m[j][2] += bflo(w.y); m[j][3] += bfhi(w.y); } } }
        if (row + C.G * 8 < MX) { const int r1 = row + C.G * 8; nslot = (C.lane < 16) ? slot[(size_t)r1 * 16 + C.lane] : -1;
#pragma unroll
            for (int j = 0; j < 4; ++j) nx[j] = *(const f32x4*)(P.out + (size_t)r1 * DM + 4 * C.lane + 256 * j); }
        f32x4 v[4]; float ss = 0.f;
#pragma unroll
        for (int j = 0; j < 4; ++j) { const int k = 4 * C.lane + 256 * j; const f32x4 g5 = *(const f32x4*)(ada + (size_t)b * 6144 + 5120 + k);
            v[j] = xv[j] + g5 * m[j]; ss += v[j][0] * v[j][0] + v[j][1] * v[j][1] + v[j][2] * v[j][2] + v[j][3] * v[j][3]; }
        const float rstd = rsqrtf(wave_sum(ss) * (1.f / DM) + RMS_EPS);
#pragma unroll
        for (int j = 0; j < 4; ++j) { const int k = 4 * C.lane + 256 * j; const f32x4 g = *(const f32x4*)(gfin + k);
            *(f32x4*)(xr + k) = v[j] * rstd * g; }
    }
}

constexpr int N_PHASES = 14;
__global__ void __launch_bounds__(NTHR, 2) mega(Params P) {
    extern __shared__ __attribute__((aligned(16))) unsigned char lds_raw[];
    cg::grid_group grid = cg::this_grid();
    Ctx C; C.lds = (LAS unsigned char*)lds_raw; C.tid = threadIdx.x; C.lane = C.tid & 63; C.wave = __builtin_amdgcn_readfirstlane(C.tid >> 6); C.bid = blockIdx.x; C.G = gridDim.x;
    unsigned char* ws = P.ws;
    if (C.tid < 32) ((LAS unsigned*)(C.lds + LDS_MISC))[C.tid] = 0u;
    __syncthreads();
    XcdBarrier bar = xcd_barrier_post((unsigned*)(ws + WS_CTL), (volatile LAS unsigned*)(C.lds + LDS_MISC));
#define IN(k) (lo <= (k) && (k) < hi)
#define SEAM(k) do { if (IN(k) && IN((k) + 1)) { if ((k) == 0) { __threadfence(); grid.sync(); } else { xcd_barrier(bar); if ((REPEAT >> 23) & 1u) xcd_barrier(bar); } } } while (0)
#define RUN(id, ...) do { __VA_ARGS__; if ((REPEAT >> (id)) & 1u) { __syncthreads(); __VA_ARGS__; } } while (0)
#define PHASE_PROGRAM(LO, HI) do { const int lo = (LO), hi = (HI); \
    if (IN(0)) RUN(0, phase0(C, P)); \
    SEAM(0); \
    if (IN(1)) RUN(1, phase1(C, P)); \
    SEAM(1); \
    if (IN(2)) { \
        RUN(2, phase2a(C, P)); \
        RUN(3, phase2b(C, P)); \
    } \
    SEAM(2); \
    if (IN(3)) { \
        RUN(4, for (int it = C.bid; it < 512; it += C.G) hyena_item(C, P, 0, it)); \
        RUN(5, for (int it = C.bid; it < 64 * NCHK; it += C.G) mlstm_a_item(C, P, it)); \
    } \
    SEAM(3); \
    if (IN(4)) { \
        RUN(6, for (int it = C.bid; it < 512; it += C.G) hyena_item(C, P, 1, it)); \
        RUN(7, mlstm_scan(C, P)); \
    } \
    SEAM(4); \
    if (IN(5)) { \
        RUN(8, for (int it = C.bid; it < 1024; it += C.G) mlstm_c_item(C, P, it)); \
        RUN(9, transpose_z2(C, P)); \
    } \
    SEAM(5); \
    if (IN(6)) RUN(10, phase_merge(C, P)); \
    SEAM(6); \
    if (IN(7)) RUN(11, phase_outproj(C, P)); \
    SEAM(7); \
    if (IN(8)) RUN(12, phase6(C, P)); \
    SEAM(8); \
    if (IN(9)) { \
        RUN(13, for (int it = C.bid; it < BATCH * NE; it += C.G) topk_item(C, P, it)); \
        __syncthreads(); \
        RUN(14, convert_experts(C, P)); \
    } \
    SEAM(9); \
    if (IN(10)) RUN(15, gather_all(C, P)); \
    SEAM(10); \
    if (IN(11)) RUN(16, moe_gemm1(C, P)); \
    SEAM(11); \
    if (IN(12)) RUN(17, moe_gemm2(C, P)); \
    SEAM(12); \
    if (IN(13)) phase_final(C, P); \
} while (0)
    PHASE_PROGRAM(P.ph_lo, P.ph_hi);
#undef PHASE_PROGRAM
#undef IN
#undef SEAM
#undef RUN
}

extern "C" void kernel_launch(void* const* d_in, const int* in_sizes, int n_in, void* d_out, int out_size, void* d_ws, size_t ws_size, hipStream_t stream) {
    static int grid = 0;
    if (grid == 0) {
        if (n_in != 27 || out_size != MX * DM || ws_size < WS_END) { fprintf(stderr, "kernel_launch: unexpected shapes (n_in %d, out %d, ws %zu < %zu)\n", n_in, out_size, ws_size, (size_t)WS_END); grid = -1; return; }
        int dev = 0, cus = 0, per_cu = 0;
        hipGetDevice(&dev);
        hipDeviceGetAttribute(&cus, hipDeviceAttributeMultiprocessorCount, dev);
        if (hipFuncSetAttribute((const void*)mega, hipFuncAttributeMaxDynamicSharedMemorySize, LDS_BYTES) != hipSuccess) { fprintf(stderr, "kernel_launch: hipFuncSetAttribute failed\n"); grid = -1; return; }
        if (hipOccupancyMaxActiveBlocksPerMultiprocessor(&per_cu, (const void*)mega, NTHR, LDS_BYTES) != hipSuccess || per_cu < 1) { fprintf(stderr, "kernel_launch: occupancy query says %d\n", per_cu); per_cu = 1; }
        (void)hipGetLastError();
        grid = cus * 1;
        if (grid <= 0) grid = 256;
    }
    if (grid < 0) return;
    Params p; memset(&p, 0, sizeof(p));
    for (int i = 0; i < 27; ++i) p.in[i] = (const float*)d_in[i];
    p.out = (float*)d_out; p.ws = (unsigned char*)d_ws;
    (void)hipMemsetAsync((unsigned char*)d_ws + WS_CTL, 0, XCD_BAR_WORDS * 4, stream);
#if N_LAUNCH_MODE == 1
    if (PREFIX > 0) {
        p.ph_lo = 0; p.ph_hi = PREFIX;
        void* pargs[] = {&p};
        (void)hipLaunchCooperativeKernel((const void*)mega, dim3(grid), dim3(NTHR), pargs, LDS_BYTES, stream);
        (void)hipMemsetAsync((unsigned char*)d_ws + WS_CTL, 0, XCD_BAR_WORDS * 4, stream);
    }
    p.ph_lo = 0; p.ph_hi = N_PHASES;
    void* args[] = {&p};
    hipError_t e = hipLaunchCooperativeKernel((const void*)mega, dim3(grid), dim3(NTHR), args, LDS_BYTES, stream);
    if (e != hipSuccess) fprintf(stderr, "kernel_launch: cooperative launch failed: %s (grid %d)\n", hipGetErrorString(e), grid);
#else
    for (int ph = 0; ph < N_PHASES; ++ph) {
        p.ph_lo = ph; p.ph_hi = ph + 1;
        void* args[] = {&p};
        hipError_t e = hipLaunchCooperativeKernel((const void*)mega, dim3(grid), dim3(NTHR), args, LDS_BYTES, stream);
        if (e != hipSuccess) { fprintf(stderr, "kernel_launch: launch %d failed: %s (grid %d)\n", ph, hipGetErrorString(e), grid); break; }
    }
#endif
}
```

```cpp
#include <hip/hip_runtime.h>
#include <hip/hip_cooperative_groups.h>
#include <cstdio>
#include <cstdint>
#include <cstring>
namespace cg = cooperative_groups;

#ifndef N_LAUNCH_MODE
#define N_LAUNCH_MODE 1
#endif

#define LAS __attribute__((address_space(3)))
typedef unsigned short bf16_t;
typedef short bf16x8 __attribute__((ext_vector_type(8)));
typedef float f32x4 __attribute__((ext_vector_type(4)));
typedef float f32x16 __attribute__((ext_vector_type(16)));
typedef unsigned u32x4 __attribute__((ext_vector_type(4)));
typedef unsigned u32x2 __attribute__((ext_vector_type(2)));

constexpr int NTHR = 512;
constexpr int BATCH = 8, SEQ = 4096, DM = 1024, CTXL = 256;
constexpr int MX = BATCH * SEQ;
constexpr int MC = BATCH * CTXL;
constexpr int DIN = 5648, NPROJ = 5632, GATE0 = 3584, MERGE0 = 3600;
constexpr int NE = 16, CAP = 512, DFF = 2048;
constexpr int MT = MX + MC;
constexpr int NCHK = 34;
constexpr float RMS_EPS = 1e-6f;

constexpr size_t MiB = 1u << 20;
constexpr size_t WS_ADAP = 0;
constexpr size_t WS_ADA = 7 * MiB;
constexpr size_t WS_CTL = 7 * MiB + 512 * 1024;
constexpr size_t WS_GATES = 8 * MiB;
constexpr size_t WS_KREV = 11 * MiB;
constexpr size_t WS_BL = 27 * MiB;
constexpr size_t WS_MST = 27 * MiB + 64 * 1024;
constexpr size_t WS_NLOC = 28 * MiB;
constexpr size_t WS_NST = 30 * MiB;
constexpr size_t WS_WIN = 32 * MiB;
constexpr size_t WS_WB = 43 * MiB;
constexpr size_t WS_WOUT = 45 * MiB;
constexpr size_t WS_HX = 48 * MiB;
constexpr size_t WS_PLOC = 48 * MiB;
constexpr size_t WS_PCM = 116 * MiB;
constexpr size_t WS_PML = 212 * MiB;
constexpr size_t WS_KVCM = 276 * MiB;
constexpr size_t WS_GC = 2 * MiB;
constexpr size_t WS_Z1 = 344 * MiB;
constexpr size_t WS_YAB = 376 * MiB;
constexpr size_t WS_CST = 440 * MiB;
constexpr size_t WS_Z2CM = 504 * MiB;
constexpr size_t WS_Z = 48 * MiB;
constexpr size_t WS_XMID = 496 * MiB;
constexpr size_t WS_AFF = 0;
constexpr size_t WS_SLOT = 2 * MiB;
constexpr size_t WS_SIDX = 4 * MiB;
constexpr size_t WS_SGATE = 4 * MiB + 512 * 1024;
constexpr size_t WS_HX2 = 48 * MiB;
constexpr size_t WS_W13 = 80 * MiB;
constexpr size_t WS_W2 = 144 * MiB;
constexpr size_t WS_XG = 176 * MiB;
constexpr size_t WS_ACT = 240 * MiB;
constexpr size_t WS_YE = 368 * MiB;
constexpr size_t WS_END = 568 * MiB;

constexpr int LDS_BYTES = 147456;
constexpr int LDS_MISC = LDS_BYTES - 128;
constexpr int PREFIX = 0;
constexpr unsigned REPEAT = 0u;

__device__ __forceinline__ unsigned f2bf(float f) { unsigned u = __builtin_bit_cast(unsigned, f); return (u + 0x7fffu + ((u >> 16) & 1u)) >> 16; }
__device__ __forceinline__ unsigned pk2(float lo, float hi) { return f2bf(lo) | (f2bf(hi) << 16); }
__device__ __forceinline__ float bf2f(unsigned short b) { return __builtin_bit_cast(float, ((unsigned)b) << 16); }
__device__ __forceinline__ float bflo(unsigned w) { return __builtin_bit_cast(float, w << 16); }
__device__ __forceinline__ float bfhi(unsigned w) { return __builtin_bit_cast(float, w & 0xffff0000u); }
__device__ __forceinline__ float sigm(float x) { return __builtin_amdgcn_rcpf(1.f + __expf(-x)); }
__device__ __forceinline__ float siluf(float x) { return x * __builtin_amdgcn_rcpf(1.f + __expf(-x)); }
__device__ __forceinline__ float logsig(float x) { return x >= 0.f ? -log1pf(expf(-x)) : x - log1pf(expf(x)); }
__device__ __forceinline__ float wave_sum(float v) {
#pragma unroll
    for (int o = 1; o < 64; o <<= 1) v += __shfl_xor(v, o);
    return v;
}
#define LDS_WAIT() asm volatile("s_waitcnt lgkmcnt(0)" ::: "memory")
__device__ __forceinline__ float clamp8(float x) { return __builtin_amdgcn_fmed3f(x, -448.f, 448.f); }
__device__ __forceinline__ unsigned pk4_fp8(float a, float b, float c, float d) {
    int r = __builtin_amdgcn_cvt_pk_fp8_f32(clamp8(a), clamp8(b), 0, false); r = __builtin_amdgcn_cvt_pk_fp8_f32(clamp8(c), clamp8(d), r, true); return (unsigned)r; }
constexpr float W8_SCALE = 64.f, W8_INV = 1.f / 64.f;

struct Params {
    const float* in[27];
    float* out;
    unsigned char* ws;
    int ph_lo, ph_hi;
};


#define XB_TMO      128
#define XB_XCNT(j)  (256  + 64 * (j))
#define XB_XSUB(j)  (1280 + 64 * (j))
#define XB_XGEN(j)  (2304 + 64 * (j))
#define XB_TOP      3328
#define XB_TOPGEN   3392
#define XCD_BAR_WORDS 3456
#define XB_SPIN_CAP (1u << 18)
__device__ __forceinline__ unsigned xb_ld(unsigned* p)              { return __hip_atomic_load(p, __ATOMIC_RELAXED, __HIP_MEMORY_SCOPE_AGENT); }
__device__ __forceinline__ unsigned xb_add(unsigned* p, unsigned v) { return __hip_atomic_fetch_add(p, v, __ATOMIC_RELAXED, __HIP_MEMORY_SCOPE_AGENT); }
__device__ __forceinline__ unsigned xb_xcc_id() { return (unsigned)__builtin_amdgcn_s_getreg((3 << 11) | 20) & 0xFu; }
#define XB_SPIN(cond, bar) do { unsigned _sp = 0; while (cond) { __builtin_amdgcn_s_sleep(1); \
    if ((++_sp & 255u) == 0u) { if (xb_ld(&(bar)[XB_TMO])) break; if (_sp > XB_SPIN_CAP) { atomicAdd(&(bar)[XB_TMO], 1u); break; } } } } while (0)
struct XcdBarrier { unsigned* bar; unsigned x; volatile LAS unsigned* st; };
__device__ __forceinline__ XcdBarrier xcd_barrier_post(unsigned* bar, volatile LAS unsigned* st) {
    XcdBarrier b; b.bar = bar; b.x = xb_xcc_id(); b.st = st;
    if (threadIdx.x == 0) (void)xb_add(&bar[XB_XCNT(b.x)], 1u);
    return b;
}
__device__ __forceinline__ void xcd_barrier_complete(unsigned* bar, unsigned x, unsigned& nloc, unsigned& nx) {
    const unsigned G = gridDim.x * gridDim.y * gridDim.z;
    unsigned sum, cnt, mine, sp = 0u;
    for (;;) {
        sum = 0u; cnt = 0u; mine = 0u;
#pragma unroll
        for (unsigned j = 0; j < 16; ++j) { const unsigned c = xb_ld(&bar[XB_XCNT(j)]); sum += c; cnt += (c > 0u) ? 1u : 0u; mine = (j == x) ? c : mine; }
        if (sum == G) break;
        __builtin_amdgcn_s_sleep(1);
        if ((++sp & 255u) == 0u) { if (xb_ld(&bar[XB_TMO])) break; if (sp > XB_SPIN_CAP) { atomicAdd(&bar[XB_TMO], 1u); break; } }
    }
    nloc = mine > 0u ? mine : 1u; nx = cnt > 0u ? cnt : 1u;
}
__device__ __forceinline__ void xcd_barrier(const XcdBarrier& b) {
    asm volatile("s_waitcnt vmcnt(0)" ::: "memory");
    __syncthreads();
    if (threadIdx.x == 0) {
        unsigned* bar = b.bar;
        __builtin_amdgcn_s_waitcnt(0);
        unsigned nloc = b.st[0], nx = b.st[1];
        if (nloc == 0u) { xcd_barrier_complete(bar, b.x, nloc, nx); b.st[0] = nloc; b.st[1] = nx; }
        const unsigned old = xb_add(&bar[XB_XSUB(b.x)], 1u);
        const unsigned gen = old / nloc;
        if (old + 1u == (gen + 1u) * nloc) {
            __builtin_amdgcn_fence(__ATOMIC_RELEASE, "agent");
            asm volatile("s_waitcnt vmcnt(0)" ::: "memory");
            const unsigned og = xb_add(&bar[XB_TOP], 1u);
            const unsigned tg = og / nx;
            if (og + 1u == (tg + 1u) * nx) xb_add(&bar[XB_TOPGEN], 1u);
            else XB_SPIN(xb_ld(&bar[XB_TOPGEN]) == tg, bar);
            __builtin_amdgcn_fence(__ATOMIC_ACQUIRE, "agent");
            xb_add(&bar[XB_XGEN(b.x)], 1u);
            asm volatile("s_waitcnt vmcnt(0)" ::: "memory");
        } else {
            XB_SPIN(xb_ld(&bar[XB_XGEN(b.x)]) == gen, bar);
            __builtin_amdgcn_fence(__ATOMIC_ACQUIRE, "agent");
            asm volatile("s_waitcnt vmcnt(0)" ::: "memory");
        }
    }
    __syncthreads();
}

namespace pg8 {
constexpr int BM = 256, BK = 64, HALF = 128, HTB = HALF * BK * 2, STAGE_BYTES = 8 * HTB;
__device__ __forceinline__ int lds_byte(int r, int c) { const int st = (r >> 4) * 2 + (c >> 5), rr = r & 15, cc = c & 31, ob = rr * 64 + cc * 2; return st * 1024 + (ob ^ (((ob >> 9) & 1) << 5)); }
__device__ __forceinline__ void stage_rc(int b, int& R, int& C) { const int st = b / 1024, sb = b % 1024, swz = sb ^ (((sb >> 9) & 1) << 5); R = (st >> 1) * 16 + swz / 64; C = (st & 1) * 32 + (swz % 64) / 2; }
__device__ __forceinline__ int perm32(int rho) { const int n = rho >> 4, i = rho & 15; return 8 * (i >> 2) + 4 * n + (i & 3); }
__device__ __forceinline__ unsigned cvt_pk_bf16(float lo, float hi) { unsigned r; asm volatile("v_cvt_pk_bf16_f32 %0, %1, %2" : "=v"(r) : "v"(lo), "v"(hi)); return r; }

typedef int v4i_t __attribute__((ext_vector_type(4)));
typedef int v8i_t __attribute__((ext_vector_type(8)));
struct Unit { const char* A; const char* B; int pm, pn, aux; };

struct SchedGrid {
    const char* A; const char* B; size_t tstepA, tstepB; int nM, nN, pm0, pn0, G, c;
    int xN, xPm0, xPn0, xCnt;
    int split, gap;
    __device__ bool next(int i, Unit& u) const {
        const long L = (long)i * G + c; const int nwg = nM * nN;
        if (L >= nwg + xCnt) return false;
        if (L >= nwg) { const int q = (int)L - nwg; u.pm = xPm0 + q / xN; u.pn = xPn0 + q % xN; u.aux = 1; }
        else {
            int wgid = (int)L; { const int q = nwg / 8, r = nwg % 8, xcd = wgid % 8, off = wgid / 8; wgid = (xcd < r ? xcd * (q + 1) : r * (q + 1) + (xcd - r) * q) + off; }
            const int nig = 8 * nN, gid = wgid / nig, fm = gid * 8, gsz = (nM - fm) < 8 ? (nM - fm) : 8;
            u.pm = pm0 + fm + ((wgid % nig) % gsz); { const int idx = (wgid % nig) / gsz; u.pn = pn0 + idx + (idx >= split ? gap : 0); } u.aux = 0;
        }
        u.A = A + (size_t)u.pm * tstepA; u.B = B + (size_t)u.pn * tstepB; return true;
    }
};
struct SchedChain {
    SchedGrid G; size_t half;
    __device__ bool next(int i, Unit& u) const {
        if (!G.next(i >> 1, u)) return false;
        u.aux = i & 1; u.A += (size_t)(i & 1) * half; u.B += (size_t)(i & 1) * half; return true;
    }
};

struct SchedMoe {
    const char* A; const char* B; size_t tstepA, tstepB, estepA, estepB; int nM, nN, G, c;
    __device__ bool next(int i, Unit& u) const {
        const long L = (long)i * G + c; const int e8 = (int)(L % 8); const long ta = L / 8; const int per = nM * nN;
        if (ta >= 2L * per) return false;
        const int e = e8 + 8 * (int)(ta / per); const int t = (int)(ta % per);
        if (nN == 16) { const int blk = t >> 5, wi = t & 31; u.pm = 4 * (blk >> 1) + (wi >> 3); u.pn = 8 * (blk & 1) + (wi & 7); }
        else { u.pm = t / nN; u.pn = t % nN; }
        u.aux = e;
        u.A = A + (size_t)e * estepA + (size_t)u.pm * tstepA; u.B = B + (size_t)e * estepB + (size_t)u.pn * tstepB; return true;
    }
};

template <class Epi, class Sched, bool NORMAL, bool F8 = false>
__device__ __forceinline__ void gemm_phase(LAS unsigned char* lds, const int K  , const unsigned lda, const unsigned ldb, const Sched& S, const Epi& E) {
    const int tid = threadIdx.x, wid = __builtin_amdgcn_readfirstlane(tid >> 6), lane = tid & 63, wr = wid >> 2, wc = wid & 3, fr = lane & 15, fq = lane >> 4;
    const int nt = K / BK;
    unsigned voffA[2], voffB[2];
#pragma unroll
    for (int i = 0; i < 2; ++i) { int R, C; stage_rc(tid * 16 + i * 8192, R, C); const int Rb = Epi::PERM ? ((R & ~31) + perm32(R & 31)) : R;
        voffA[i] = (unsigned)R * lda + (unsigned)C * 2u; voffB[i] = (unsigned)Rb * ldb + (unsigned)C * 2u; }
    const size_t kstep = (size_t)(BK * 2);
    const size_t hstepA = (size_t)HALF * lda, hstepB = (size_t)HALF * ldb;
    const unsigned ldsw = (unsigned)wid * 1024u;
    const int aoff = lds_byte(wr * 64 + fr, fq * 8), boff = lds_byte(wc * 32 + fr, fq * 8);
#define PG8_SA(b, h) (((b) * 2 + (h)) * HTB)
#define PG8_SB(b, h) ((4 + (b) * 2 + (h)) * HTB)
#define PG8_STAGE(bufoff, gbase, voff) do { _Pragma("unroll") for (int _i = 0; _i < 2; ++_i) \
        __builtin_amdgcn_global_load_lds((const unsigned*)((const char*)(gbase) + (voff)[_i]), (LAS unsigned*)(lds + (bufoff) + ldsw + _i * 8192), 16, 0, 0); } while (0)
#define PG8_LDA(dst, b, h) do { if constexpr (F8) { _Pragma("unroll") for (int m = 0; m < 4; ++m) dst##8[m] = __builtin_shufflevector(*(const LAS v4i_t*)(lds + PG8_SA(b, h) + aoff + m * 2048), *(const LAS v4i_t*)(lds + PG8_SA(b, h) + aoff + m * 2048 + 1024), 0, 1, 2, 3, 4, 5, 6, 7); } \
        else { _Pragma("unroll") for (int m = 0; m < 4; ++m) _Pragma("unroll") for (int k = 0; k < 2; ++k) dst[m][k] = *(const LAS bf16x8*)(lds + PG8_SA(b, h) + aoff + m * 2048 + k * 1024); } } while (0)
#define PG8_LDB(dst, b, h) do { if constexpr (F8) { _Pragma("unroll") for (int n = 0; n < 2; ++n) dst##8[n] = __builtin_shufflevector(*(const LAS v4i_t*)(lds + PG8_SB(b, h) + boff + n * 2048), *(const LAS v4i_t*)(lds + PG8_SB(b, h) + boff + n * 2048 + 1024), 0, 1, 2, 3, 4, 5, 6, 7); } \
        else { _Pragma("unroll") for (int n = 0; n < 2; ++n) _Pragma("unroll") for (int k = 0; k < 2; ++k) dst[n][k] = *(const LAS bf16x8*)(lds + PG8_SB(b, h) + boff + n * 2048 + k * 1024); } } while (0)
#define PG8_MMA(ai, bj, At, Bt) do { __builtin_amdgcn_s_setprio(1); \
        if constexpr (F8) { _Pragma("unroll") for (int m = 0; m < 4; ++m) _Pragma("unroll") for (int n = 0; n < 2; ++n) \
            asm volatile("v_mfma_scale_f32_16x16x128_f8f6f4 %0, %1, %2, %0, %3, %3 op_sel_hi:[0,0,0]" : "+v"(acc[ai][bj][m][n]) : "v"(Bt##8[n]), "v"(At##8[m]), "v"(sc8)); } \
        else { _Pragma("unroll") for (int m = 0; m < 4; ++m) _Pragma("unroll") for (int n = 0; n < 2; ++n) _Pragma("unroll") for (int k = 0; k < 2; ++k) \
        acc[ai][bj][m][n] = NORMAL ? __builtin_amdgcn_mfma_f32_16x16x32_bf16(At[m][k], Bt[n][k], acc[ai][bj][m][n], 0, 0, 0) \
                                   : __builtin_amdgcn_mfma_f32_16x16x32_bf16(Bt[n][k], At[m][k], acc[ai][bj][m][n], 0, 0, 0); } __builtin_amdgcn_s_setprio(0); } while (0)
#define PG8_WAIT_V(n) asm volatile("s_waitcnt vmcnt(" #n ")" ::: "memory")
#define PG8_WAIT_L(n) asm volatile("s_waitcnt lgkmcnt(" #n ")" ::: "memory")
#define PG8_BAR __builtin_amdgcn_s_barrier()
#define PG8_SCHED __builtin_amdgcn_sched_barrier(0)
    Unit cur, nxt; int ui = 0;
    if (!S.next(0, cur)) return;
    f32x4 acc[2][2][4][2];
#pragma unroll
    for (int a = 0; a < 2; ++a)
#pragma unroll
        for (int b = 0; b < 2; ++b)
#pragma unroll
            for (int m = 0; m < 4; ++m)
#pragma unroll
                for (int n = 0; n < 2; ++n) acc[a][b][m][n] = (f32x4){0.f, 0.f, 0.f, 0.f};
    bf16x8 At[4][2], B0[2][2], B1[2][2];
    v8i_t At8[4], B08[2], B18[2]; const int sc8 = 0x7F7F7F7F;
    const char* cA = cur.A; const char* cB = cur.B;
    PG8_STAGE(PG8_SB(0, 0), cB, voffB); PG8_STAGE(PG8_SB(0, 1), cB + hstepB, voffB); PG8_STAGE(PG8_SA(0, 0), cA, voffA); PG8_STAGE(PG8_SA(0, 1), cA + hstepA, voffA);
    if (wr == 1) PG8_BAR;
    PG8_WAIT_V(2); PG8_BAR;
    PG8_STAGE(PG8_SB(1, 0), cB + kstep, voffB); PG8_STAGE(PG8_SA(1, 0), cA + kstep, voffA); PG8_STAGE(PG8_SB(1, 1), cB + hstepB + kstep, voffB);
    PG8_WAIT_V(6); PG8_BAR;
    for (;;) {
        const bool has_next = S.next(ui + 1, nxt);
        const char* nA = has_next ? nxt.A : cA; const char* nB = has_next ? nxt.B : cB;
#pragma unroll 1
        for (int t = 0; t < nt; t += 2) {
            const bool last = (t == nt - 2);
            const char* a1 = cA + (size_t)(t + 1) * kstep;
            const char* a2 = last ? nA : cA + (size_t)(t + 2) * kstep; const char* b2 = last ? nB : cB + (size_t)(t + 2) * kstep;
            const char* a3 = a2 + kstep; const char* b3 = b2 + kstep;
            PG8_LDB(B0, 0, 0); PG8_LDB(B1, 0, 1); PG8_SCHED; PG8_LDA(At, 0, 0); PG8_STAGE(PG8_SA(1, 1), a1 + hstepA, voffA);
            PG8_WAIT_V(8); PG8_WAIT_L(0); PG8_BAR; PG8_MMA(0, 0, At, B0); PG8_MMA(0, 1, At, B1); PG8_BAR; PG8_SCHED;
            PG8_LDA(At, 0, 1); PG8_STAGE(PG8_SB(0, 0), b2, voffB); PG8_STAGE(PG8_SB(0, 1), b2 + hstepB, voffB); PG8_STAGE(PG8_SA(0, 0), a2, voffA);
            PG8_WAIT_V(8); PG8_WAIT_L(0); PG8_BAR; PG8_MMA(1, 0, At, B0); PG8_MMA(1, 1, At, B1); PG8_BAR; PG8_SCHED;
            PG8_LDB(B0, 1, 0); PG8_LDB(B1, 1, 1); PG8_SCHED; PG8_LDA(At, 1, 0); PG8_STAGE(PG8_SA(0, 1), a2 + hstepA, voffA);
            PG8_WAIT_V(8); PG8_WAIT_L(0); PG8_BAR; PG8_MMA(0, 0, At, B0); PG8_MMA(0, 1, At, B1); PG8_BAR; PG8_SCHED;
            PG8_LDA(At, 1, 1); PG8_STAGE(PG8_SB(1, 0), b3, voffB); PG8_STAGE(PG8_SB(1, 1), b3 + hstepB, voffB); PG8_STAGE(PG8_SA(1, 0), a3, voffA);
            PG8_WAIT_V(8); PG8_WAIT_L(0); PG8_BAR; PG8_MMA(1, 0, At, B0); PG8_MMA(1, 1, At, B1); PG8_BAR; PG8_SCHED;
        }
        if (wr == 0) PG8_BAR;
        if constexpr (F8) asm volatile("s_nop 15\n\ts_nop 15" ::: "memory");
        bool keep = false;
        if constexpr (Epi::HAS_MID) { if (cur.aux == 0) { E.mid(acc, cur, wr, wc, fr, fq); keep = true; } else E(acc, cur, wr, wc, fr, fq); }
        else E(acc, cur, wr, wc, fr, fq);
        if (!has_next) break;
        if (!keep) {
#pragma unroll
        for (int a = 0; a < 2; ++a)
#pragma unroll
            for (int b = 0; b < 2; ++b)
#pragma unroll
                for (int m = 0; m < 4; ++m)
#pragma unroll
                    for (int n = 0; n < 2; ++n) acc[a][b][m][n] = (f32x4){0.f, 0.f, 0.f, 0.f};
        }
        cur = nxt; cA = nA; cB = nB; ++ui;
        if (wr == 1) PG8_BAR;
    }
    PG8_WAIT_V(0);
    PG8_BAR;
#undef PG8_SA
#undef PG8_SB
#undef PG8_STAGE
#undef PG8_LDA
#undef PG8_LDB
#undef PG8_MMA
#undef PG8_WAIT_V
#undef PG8_WAIT_L
#undef PG8_BAR
#undef PG8_SCHED
}


struct EpiCM {
    static constexpr bool PERM = false, HAS_MID = false;
    bf16_t* pcm; bf16_t* kvcm; const float* bias;
    __device__ __forceinline__ void operator()(const f32x4 (&acc)[2][2][4][2], const Unit& u, int wr, int wc, int fr, int fq) const {
        const bool kv = u.pn >= 8;
#pragma unroll
        for (int bj = 0; bj < 2; ++bj)
#pragma unroll
            for (int n = 0; n < 2; ++n) {
                const int c = u.pn * BM + bj * HALF + wc * 32 + n * 16 + fr; const float bv = bias[c];
                bf16_t* base = kv ? (kvcm + (size_t)(c - 2048) * MT) : (pcm + (size_t)c * MX);
#pragma unroll
                for (int ai = 0; ai < 2; ++ai)
#pragma unroll
                    for (int m = 0; m < 4; ++m) {
                        const int r = u.pm * BM + ai * HALF + wr * 64 + m * 16 + 4 * fq; const f32x4 v = acc[ai][bj][m][n] + bv;
                        u32x2 w; w.x = cvt_pk_bf16(v[0], v[1]); w.y = cvt_pk_bf16(v[2], v[3]);
                        *(u32x2*)(base + r) = w; }
                asm volatile("" ::: "memory");
            }
    }
};

struct EpiIn2 {
    static constexpr bool PERM = true, HAS_MID = false;
    bf16_t* pml; bf16_t* pmg; const float* bias;
    __device__ __forceinline__ void operator()(const f32x4 (&acc)[2][2][4][2], const Unit& u, int wr, int wc, int fr, int fq) const {
        const int colt = u.pn * BM; bf16_t* base; int ldc, cbase, bofs = 0; const int row0 = u.pm * BM; bool sg = false;
        if (colt < 2048) { base = pml; ldc = 1024; cbase = colt - 1536; }
        else if (colt < GATE0) { base = pml; ldc = 1024; cbase = colt - 3072 + 512; }
        else { base = pmg; ldc = 2048; cbase = colt - GATE0; bofs = 16; sg = true; }
        const int col0 = cbase + wc * 32 + 8 * fq, bcol0 = colt + bofs + wc * 32 + 8 * fq;
        f32x4 bv[2][2];
#pragma unroll
        for (int bj = 0; bj < 2; ++bj)
#pragma unroll
            for (int n = 0; n < 2; ++n) bv[bj][n] = *(const f32x4*)(bias + bcol0 + bj * HALF + 4 * n);
#pragma unroll
        for (int ai = 0; ai < 2; ++ai)
#pragma unroll
            for (int m = 0; m < 4; ++m) { bf16_t* rowp = base + (size_t)(row0 + wr * 64 + fr + ai * HALF + m * 16) * ldc + col0;
#pragma unroll
                for (int bj = 0; bj < 2; ++bj) { f32x4 v0 = acc[ai][bj][m][0] + bv[bj][0], v1 = acc[ai][bj][m][1] + bv[bj][1];
                    if (sg) {
#pragma unroll
                        for (int j = 0; j < 4; ++j) { v0[j] = sigm(v0[j]); v1[j] = sigm(v1[j]); } }
                    u32x4 w; w.x = cvt_pk_bf16(v0[0], v0[1]); w.y = cvt_pk_bf16(v0[2], v0[3]); w.z = cvt_pk_bf16(v1[0], v1[1]); w.w = cvt_pk_bf16(v1[2], v1[3]);
                    *(u32x4*)(rowp + bj * HALF) = w; }
                asm volatile("" ::: "memory"); }
    }
};

struct EpiMerge {
    static constexpr bool PERM = true, HAS_MID = true;
    bf16_t* Z; const bf16_t* pmg;
    __device__ __forceinline__ void mid(f32x4 (&acc)[2][2][4][2], const Unit& u, int wr, int wc, int fr, int fq) const {
        const int row0 = u.pm * BM + wr * 64 + fr, col0 = u.pn * BM + wc * 32 + 8 * fq;
#pragma unroll
        for (int ai = 0; ai < 2; ++ai)
#pragma unroll
            for (int m = 0; m < 4; ++m) {
                u32x4 ga[2], gb[2];
#pragma unroll
                for (int bj = 0; bj < 2; ++bj) { const bf16_t* gp = pmg + (size_t)(row0 + ai * HALF + m * 16) * 2048 + col0 + bj * HALF;
                    ga[bj] = *(const u32x4*)gp; gb[bj] = *(const u32x4*)(gp + 1024); }
#pragma unroll
                for (int bj = 0; bj < 2; ++bj) { const u32x4 a = ga[bj], b = gb[bj];
                    f32x4& v0 = acc[ai][bj][m][0]; f32x4& v1 = acc[ai][bj][m][1];
                    v0[0] *= bflo(a.x) * __builtin_amdgcn_rcpf(bflo(b.x)); v0[1] *= bfhi(a.x) * __builtin_amdgcn_rcpf(bfhi(b.x));
                    v0[2] *= bflo(a.y) * __builtin_amdgcn_rcpf(bflo(b.y)); v0[3] *= bfhi(a.y) * __builtin_amdgcn_rcpf(bfhi(b.y));
                    v1[0] *= bflo(a.z) * __builtin_amdgcn_rcpf(bflo(b.z)); v1[1] *= bfhi(a.z) * __builtin_amdgcn_rcpf(bfhi(b.z));
                    v1[2] *= bflo(a.w) * __builtin_amdgcn_rcpf(bflo(b.w)); v1[3] *= bfhi(a.w) * __builtin_amdgcn_rcpf(bfhi(b.w)); }
                if (m & 1) asm volatile("" ::: "memory"); }
    }
    __device__ __forceinline__ void operator()(const f32x4 (&acc)[2][2][4][2], const Unit& u, int wr, int wc, int fr, int fq) const {
        const int row0 = u.pm * BM + wr * 64 + fr, col0 = u.pn * BM + wc * 32 + 8 * fq;
#pragma unroll
        for (int ai = 0; ai < 2; ++ai) {
            u32x4 g[4][2];
#pragma unroll
            for (int m = 0; m < 4; ++m)
#pragma unroll
                for (int bj = 0; bj < 2; ++bj) g[m][bj] = *(const u32x4*)(pmg + (size_t)(row0 + ai * HALF + m * 16) * 2048 + 1024 + col0 + bj * HALF);
#pragma unroll
            for (int m = 0; m < 4; ++m)
#pragma unroll
                for (int bj = 0; bj < 2; ++bj) { const size_t row = (size_t)(row0 + ai * HALF + m * 16); const u32x4 gg = g[m][bj];
                    f32x4 v0 = acc[ai][bj][m][0], v1 = acc[ai][bj][m][1];
                    v0[0] *= bflo(gg.x); v0[1] *= bfhi(gg.x); v0[2] *= bflo(gg.y); v0[3] *= bfhi(gg.y);
                    v1[0] *= bflo(gg.z); v1[1] *= bfhi(gg.z); v1[2] *= bflo(gg.w); v1[3] *= bfhi(gg.w);
                    u32x4 w; w.x = cvt_pk_bf16(v0[0], v0[1]); w.y = cvt_pk_bf16(v0[2], v0[3]); w.z = cvt_pk_bf16(v1[0], v1[1]); w.w = cvt_pk_bf16(v1[2], v1[3]);
                    *(u32x4*)(Z + row * 1024 + col0 + bj * HALF) = w; }
            asm volatile("" ::: "memory"); }
    }
};

struct EpiOut {
    static constexpr bool PERM = true, HAS_MID = false;
    const float* x; bf16_t* xmid; const float* ada;
    __device__ __forceinline__ void operator()(const f32x4 (&acc)[2][2][4][2], const Unit& u, int wr, int wc, int fr, int fq) const {
        const int row0 = u.pm * BM + wr * 64 + fr, col0 = u.pn * BM + wc * 32 + 8 * fq;
        const int b = (u.pm * BM) / SEQ;
        f32x4 gv[2][2];
#pragma unroll
        for (int bj = 0; bj < 2; ++bj)
#pragma unroll
            for (int n = 0; n < 2; ++n) gv[bj][n] = *(const f32x4*)(ada + (size_t)b * 6144 + 2048 + col0 + bj * HALF + 4 * n);
#pragma unroll
        for (int ai = 0; ai < 2; ++ai)
#pragma unroll
            for (int m = 0; m < 4; ++m) {
                f32x4 xv[2][2]; const size_t off = (size_t)(row0 + ai * HALF + m * 16) * DM + col0;
#pragma unroll
                for (int bj = 0; bj < 2; ++bj)
#pragma unroll
                    for (int n = 0; n < 2; ++n) xv[bj][n] = *(const f32x4*)(x + off + bj * HALF + 4 * n);
#pragma unroll
                for (int bj = 0; bj < 2; ++bj) { const f32x4 v0 = xv[bj][0] + gv[bj][0] * acc[ai][bj][m][0], v1 = xv[bj][1] + gv[bj][1] * acc[ai][bj][m][1];
                    u32x4 w; w.x = cvt_pk_bf16(v0[0], v0[1]); w.y = cvt_pk_bf16(v0[2], v0[3]); w.z = cvt_pk_bf16(v1[0], v1[1]); w.w = cvt_pk_bf16(v1[2], v1[3]);
                    *(u32x4*)(xmid + off + bj * HALF) = w; }
                if (m & 1) asm volatile("" ::: "memory"); }
    }
};

struct EpiMoe1 {
    static constexpr bool PERM = true, HAS_MID = false;
    unsigned char* act; bool skip;
    __device__ __forceinline__ void operator()(const f32x4 (&acc)[2][2][4][2], const Unit& u, int wr, int wc, int fr, int fq) const {
        if (skip) { asm volatile("" :: "v"(acc[0][0][0][0]), "v"(acc[1][1][3][1])); return; }
        const int row0 = u.aux * 4096 + u.pm * BM + wr * 64 + fr, col0 = (u.pn * BM + wc * 32) / 2 + 4 * fq;
#pragma unroll
        for (int ai = 0; ai < 2; ++ai)
#pragma unroll
            for (int m = 0; m < 4; ++m) { unsigned char* rowp = act + (size_t)(row0 + ai * HALF + m * 16) * DFF + col0;
#pragma unroll
                for (int bj = 0; bj < 2; ++bj) { const f32x4 v0 = acc[ai][bj][m][0] * W8_INV, v1 = acc[ai][bj][m][1] * W8_INV;
                    *(unsigned*)(rowp + bj * (HALF / 2)) = pk4_fp8(siluf(v0[0]) * v0[1], siluf(v0[2]) * v0[3], siluf(v1[0]) * v1[1], siluf(v1[2]) * v1[3]); }
                asm volatile("" ::: "memory"); }
    }
};

struct EpiMoe2 {
    static constexpr bool PERM = true, HAS_MID = false;
    bf16_t* ye; const float* sgate; bool skip;
    __device__ __forceinline__ void operator()(const f32x4 (&acc)[2][2][4][2], const Unit& u, int wr, int wc, int fr, int fq) const {
        if (skip) { asm volatile("" :: "v"(acc[0][0][0][0]), "v"(acc[1][1][3][1])); return; }
        const int e = u.aux, col0 = u.pn * BM + wc * 32 + 8 * fq;
        float gt[2][4];
#pragma unroll
        for (int ai = 0; ai < 2; ++ai)
#pragma unroll
            for (int m = 0; m < 4; ++m) { const int rr = u.pm * BM + wr * 64 + fr + ai * HALF + m * 16; gt[ai][m] = sgate[((rr >> 9) * NE + e) * CAP + (rr & 511)] * W8_INV; }
#pragma unroll
        for (int ai = 0; ai < 2; ++ai)
#pragma unroll
            for (int m = 0; m < 4; ++m) { const int rr = u.pm * BM + wr * 64 + fr + ai * HALF + m * 16;
                const float g = gt[ai][m];
                bf16_t* rowp = ye + ((size_t)e * 4096 + rr) * DM + col0;
#pragma unroll
                for (int bj = 0; bj < 2; ++bj) { const f32x4 v0 = acc[ai][bj][m][0] * g, v1 = acc[ai][bj][m][1] * g;
                    u32x4 w; w.x = cvt_pk_bf16(v0[0], v0[1]); w.y = cvt_pk_bf16(v0[2], v0[3]); w.z = cvt_pk_bf16(v1[0], v1[1]); w.w = cvt_pk_bf16(v1[2], v1[3]);
                    *(u32x4*)(rowp + bj * HALF) = w; }
                asm volatile("" ::: "memory"); }
    }
};
}

struct Ctx {
    LAS unsigned char* lds;
    int tid, lane, wave, bid, G;
};

__device__ __forceinline__ void transpose_item(const float* W, int ldw, int ldt, int ncol0, bf16_t* WT, int dst_row0, int rmul, LAS float* scr, int kb, int nb, int lane) {
    const int k0 = 64 * kb, n0 = 32 * nb;
#pragma unroll 8
    for (int i = 0; i < 32; ++i) { const int kk = 2 * i + (lane >> 5); scr[kk * 33 + (lane & 31)] = W[(size_t)(k0 + kk) * ldw + ncol0 + n0 + (lane & 31)]; }
    LDS_WAIT();
    const int c = lane & 7;
#pragma unroll
    for (int j = 0; j < 4; ++j) { const int n = (lane >> 3) + 8 * j; const LAS float* s = scr + (8 * c) * 33 + n;
        u32x4 o; o.x = pk2(s[0 * 33], s[1 * 33]); o.y = pk2(s[2 * 33], s[3 * 33]); o.z = pk2(s[4 * 33], s[5 * 33]); o.w = pk2(s[6 * 33], s[7 * 33]);
        *(u32x4*)(WT + (size_t)(dst_row0 + (n0 + n) * rmul) * ldt + k0 + 8 * c) = o; }
    LDS_WAIT();
}

__device__ __forceinline__ void transpose_item_f8(const float* W, int ldw, int K, unsigned char* WT, int dst_row0, int rmul, LAS float* scr, int kb, int nb, int lane) {
    const int k0 = 64 * kb, n0 = 32 * nb;
#pragma unroll 8
    for (int i = 0; i < 32; ++i) { const int kk = 2 * i + (lane >> 5); scr[kk * 33 + (lane & 31)] = W[(size_t)(k0 + kk) * ldw + n0 + (lane & 31)]; }
    LDS_WAIT();
    const int c = lane & 3;
#pragma unroll
    for (int j = 0; j < 2; ++j) { const int n = (lane >> 2) + 16 * j; const LAS float* s = scr + (16 * c) * 33 + n;
        u32x4 o;
        o.x = pk4_fp8(s[0 * 33] * W8_SCALE, s[1 * 33] * W8_SCALE, s[2 * 33] * W8_SCALE, s[3 * 33] * W8_SCALE);
        o.y = pk4_fp8(s[4 * 33] * W8_SCALE, s[5 * 33] * W8_SCALE, s[6 * 33] * W8_SCALE, s[7 * 33] * W8_SCALE);
        o.z = pk4_fp8(s[8 * 33] * W8_SCALE, s[9 * 33] * W8_SCALE, s[10 * 33] * W8_SCALE, s[11 * 33] * W8_SCALE);
        o.w = pk4_fp8(s[12 * 33] * W8_SCALE, s[13 * 33] * W8_SCALE, s[14 * 33] * W8_SCALE, s[15 * 33] * W8_SCALE);
        *(u32x4*)(WT + (size_t)(dst_row0 + (n0 + n) * rmul) * K + k0 + 16 * c) = o; }
    LDS_WAIT();
}

__device__ __forceinline__ void convert_experts(const Ctx& C, const Params& P) {
    unsigned char* w13 = P.ws + WS_W13; unsigned char* w2 = P.ws + WS_W2;
    LAS float* scr = (LAS float*)(C.lds + C.wave * 8448);
    const int gw = C.bid * 8 + C.wave, NGW = C.G * 8;
    const int PER_E = 3072;
    for (int it = gw; it < NE * PER_E; it += NGW) {
        const int e = it / PER_E, r = it % PER_E;
        if (r < 1024) transpose_item_f8(P.in[23] + (size_t)e * DM * DFF, DFF, DM, w13 + (size_t)e * 4096 * DM, 0, 2, scr, r / 64, r % 64, C.lane);
        else if (r < 2048) transpose_item_f8(P.in[24] + (size_t)e * DM * DFF, DFF, DM, w13 + (size_t)e * 4096 * DM, 1, 2, scr, (r - 1024) / 64, (r - 1024) % 64, C.lane);
        else transpose_item_f8(P.in[25] + (size_t)e * DFF * DM, DM, DFF, w2 + (size_t)e * DM * DFF, 0, 1, scr, (r - 2048) / 32, (r - 2048) % 32, C.lane);
    }
}

__device__ __forceinline__ void phase0(const Ctx& C, const Params& P) {
    unsigned char* ws = P.ws;
    const int gw = C.bid * 8 + C.wave, NGW = C.G * 8;
    {
        LAS float* scr = (LAS float*)(C.lds + C.wave * 8448);
        const int I_IN1 = 16 * 112, I_IN2 = 16 * 64, I_BH = 8 * 32, I_BM = 8 * 32, I_OUT = 16 * 32;
        const int NIT = I_IN1 + I_IN2 + I_BH + I_BM + I_OUT;
        for (int it = gw; it < NIT; it += NGW) {
            int r = it;
            if (r < I_IN1) { transpose_item(P.in[8], DIN, DM, 0, (bf16_t*)(ws + WS_WIN), 0, 1, scr, r / 112, r % 112, C.lane); continue; } r -= I_IN1;
            if (r < I_IN2) { transpose_item(P.in[8], DIN, DM, MERGE0, (bf16_t*)(ws + WS_WIN), GATE0, 1, scr, r / 64, r % 64, C.lane); continue; } r -= I_IN2;
            if (r < I_BH) { transpose_item(P.in[19], DM, 1024, 0, (bf16_t*)(ws + WS_WB), 0, 1, scr, r / 32, r % 32, C.lane); continue; } r -= I_BH;
            if (r < I_BM) { transpose_item(P.in[20], DM, 1024, 0, (bf16_t*)(ws + WS_WB) + 512, 0, 1, scr, r / 32, r % 32, C.lane); continue; } r -= I_BM;
            transpose_item(P.in[21], DM, DM, 0, (bf16_t*)(ws + WS_WOUT), 0, 1, scr, r / 32, r % 32, C.lane);
        }
    }
    {
        const float* wada = P.in[4]; const float* bada = P.in[5]; float* part = (float*)(ws + WS_ADAP);
        for (int it = gw; it < 96 * 8; it += NGW) {
            const int cgp = it % 96, ks = it / 96, n = cgp * 64 + C.lane;
            float a[9];
#pragma unroll
            for (int r = 0; r < 9; ++r) a[r] = 0.f;
#pragma unroll 1
            for (int k1 = 0; k1 < 4; ++k1) {
                const int k0 = ks * 128 + k1 * 32;
                float sv[9];
                { const int k = k0 + (C.lane & 31);
#pragma unroll
                  for (int r = 0; r < 8; ++r) sv[r] = siluf(P.in[1][r * DM + k]);
                  sv[8] = siluf(P.in[3][k]); }
                float wv[32];
#pragma unroll
                for (int kk = 0; kk < 32; ++kk) wv[kk] = wada[(size_t)(k0 + kk) * 6144 + n];
#pragma unroll
                for (int kk = 0; kk < 32; ++kk) {
#pragma unroll
                    for (int r = 0; r < 9; ++r) a[r] += __shfl(sv[r], kk) * wv[kk]; }
            }
            const float bb = (ks == 0) ? bada[n] : 0.f;
#pragma unroll
            for (int r = 0; r < 9; ++r) part[((size_t)ks * 9 + r) * 6144 + n] = a[r] + bb;
        }
    }
    __syncthreads();
    {
        LAS float* zs = (LAS float*)C.lds;
        LAS float* h1 = zs + 16 * 33;
        LAS float* h2 = h1 + 16 * 64;
        bf16_t* krev = (bf16_t*)(ws + WS_KREV);
        const float* w1 = P.in[11]; const float* b1 = P.in[12]; const float* w2 = P.in[13]; const float* b2 = P.in[14]; const float* w3 = P.in[15];
        for (int it = C.bid; it < 256; it += C.G) {
            const int l0 = it * 16;
            __syncthreads();
            for (int idx = C.tid; idx < 16 * 33; idx += NTHR) { const int pos = idx / 33, m = idx % 33, l = l0 + pos; float v;
                if (m == 0) v = (float)l / 4095.0f;
                else { const int bi = (m - 1) & 15; const float band = 1e-4f + (float)bi * ((15.0f - 1e-4f) / 15.0f);
                    const float ang = ((float)(2.0 * 3.14159265358979323846 / 4096.0) * (float)l) * band; v = (m <= 16) ? cosf(ang) : sinf(ang); }
                zs[idx] = v; }
            __syncthreads();
            for (int idx = C.tid; idx < 16 * 64; idx += NTHR) { const int pos = idx >> 6, j = idx & 63; float s = b1[j];
                for (int m = 0; m < 33; ++m) s += zs[pos * 33 + m] * w1[m * 64 + j];
                h1[idx] = sinf(s); }
            __syncthreads();
            for (int idx = C.tid; idx < 16 * 64; idx += NTHR) { const int pos = idx >> 6, j = idx & 63; float s = b2[j];
                for (int k = 0; k < 64; ++k) s += h1[pos * 64 + k] * w2[k * 64 + j];
                h2[idx] = sinf(s); }
            __syncthreads();
#pragma unroll 1
            for (int q = 0; q < 4; ++q) {
                const int n = C.tid + NTHR * q;
                float a[16];
#pragma unroll
                for (int p = 0; p < 16; ++p) a[p] = 0.f;
                for (int k = 0; k < 64; ++k) { const float w = w3[k * 2048 + n];
#pragma unroll
                    for (int p = 0; p < 16; ++p) a[p] += h2[p * 64 + k] * w; }
                const int o = n >> 10, side = (n >> 9) & 1, c = n & 511;
                const float delta = fabsf(-3.0701134573253944f + (float)c * ((-15.350567286626972f + 3.0701134573253944f) / 511.0f));
                bf16_t* dst = krev + ((size_t)o * 512 + c) * 8192;
#pragma unroll
                for (int p = 0; p < 16; ++p) { const int l = l0 + p; const float t = (float)l / 4095.0f; const float v = a[p] * expf(-t * delta);
                    if (side == 0) dst[4096 - l] = (bf16_t)f2bf(v);
                    else if (l > 0) dst[4096 + l] = (bf16_t)f2bf(v);
                    else dst[0] = 0; }
            }
        }
    }
}

__device__ __forceinline__ int wl_pos(int k) { return ((k & 3) + 4 * (k >> 8)) * 64 + ((k >> 2) & 63); }
__device__ __forceinline__ float row_dot16(const f32x4 (&y)[4], const LAS float* Wl, int lane) {
    float r[16];
#pragma unroll
    for (int e = 0; e < 16; ++e) r[e] = 0.f;
#pragma unroll
    for (int j = 0; j < 4; ++j) {
#pragma unroll
        for (int q = 0; q < 4; ++q) { const float v = y[j][q]; const LAS float* wp = Wl + ((q + 4 * j) * 64 + lane) * 20;
#pragma unroll
            for (int e4 = 0; e4 < 4; ++e4) { const f32x4 w = *(const LAS f32x4*)(wp + e4 * 4);
                r[e4 * 4 + 0] += v * w[0]; r[e4 * 4 + 1] += v * w[1]; r[e4 * 4 + 2] += v * w[2]; r[e4 * 4 + 3] += v * w[3]; } }
        asm volatile("" ::: "memory"); }
    const bool b5 = (lane & 32) != 0, b4 = (lane & 16) != 0, b3 = (lane & 8) != 0, b2 = (lane & 4) != 0;
    float t[8];
#pragma unroll
    for (int e = 0; e < 8; ++e) { const float snd = b5 ? r[e] : r[e + 8], kp = b5 ? r[e + 8] : r[e]; t[e] = kp + __shfl_xor(snd, 32); }
    float u[4];
#pragma unroll
    for (int e = 0; e < 4; ++e) { const float snd = b4 ? t[e] : t[e + 4], kp = b4 ? t[e + 4] : t[e]; u[e] = kp + __shfl_xor(snd, 16); }
    float v2[2];
#pragma unroll
    for (int e = 0; e < 2; ++e) { const float snd = b3 ? u[e] : u[e + 2], kp = b3 ? u[e + 2] : u[e]; v2[e] = kp + __shfl_xor(snd, 8); }
    float s; { const float snd = b2 ? v2[0] : v2[1], kp = b2 ? v2[1] : v2[0]; s = kp + __shfl_xor(snd, 4); }
    s += __shfl_xor(s, 2); s += __shfl_xor(s, 1);
    return s;
}

__device__ __forceinline__ void phase1(const Ctx& C, const Params& P) {
    unsigned char* ws = P.ws;
    const float* part = (const float*)(ws + WS_ADAP); float* ada = (float*)(ws + WS_ADA);
    for (int o = C.bid * NTHR + C.tid; o < 9 * 6144; o += C.G * NTHR) { float s = 0.f;
#pragma unroll
        for (int ks = 0; ks < 8; ++ks) s += part[(size_t)ks * 9 * 6144 + o];
        ada[o] = s; }
    LAS float* Wg = (LAS float*)C.lds;
    LAS float* mod = Wg + 1024 * 20;
    for (int idx = C.tid; idx < 1024 * 16; idx += NTHR) Wg[wl_pos(idx >> 4) * 20 + (idx & 15)] = P.in[8][(size_t)(idx >> 4) * DIN + GATE0 + (idx & 15)];
    const float* gmix = P.in[6]; const float* bin = P.in[9];
    bf16_t* hx = (bf16_t*)(ws + WS_HX); float* gates = (float*)(ws + WS_GATES);
    for (int rg = C.bid; rg < 256; rg += C.G) {
        const int b = rg >> 5;
        __syncthreads();
        for (int idx = C.tid; idx < 4096; idx += NTHR) { const int which = idx >> 10, k = idx & 1023; const int r = (which < 2) ? b : 8; const int col = (which & 1) * 1024 + k;
            float s = 0.f;
#pragma unroll
            for (int ks = 0; ks < 8; ++ks) s += part[((size_t)ks * 9 + r) * 6144 + col];
            mod[idx] = s; }
        __syncthreads();
        auto rowsrc = [&](int rr) -> const float* { return (rr < 128) ? (P.in[0] + (size_t)(rg * 128 + rr) * DM) : (P.in[2] + (size_t)(rg * 8 + (rr - 128)) * DM); };
        f32x4 nx[4];
        { const float* s0 = rowsrc(C.wave);
#pragma unroll
          for (int j = 0; j < 4; ++j) nx[j] = *(const f32x4*)(s0 + 4 * C.lane + 256 * j); }
        for (int rr = C.wave; rr < 136; rr += 8) {
            const bool isx = rr < 128; const int grow = isx ? (rg * 128 + rr) : (MX + rg * 8 + (rr - 128));
            const LAS float* sh = mod + (isx ? 0 : 2048); const LAS float* sc = sh + 1024;
            f32x4 v[4]; float ss = 0.f;
#pragma unroll
            for (int j = 0; j < 4; ++j) { v[j] = nx[j]; ss += v[j][0] * v[j][0] + v[j][1] * v[j][1] + v[j][2] * v[j][2] + v[j][3] * v[j][3]; }
            if (rr + 8 < 136) { const float* s1 = rowsrc(rr + 8);
#pragma unroll
                for (int j = 0; j < 4; ++j) nx[j] = *(const f32x4*)(s1 + 4 * C.lane + 256 * j); }
            const float rstd = rsqrtf(wave_sum(ss) * (1.f / DM) + RMS_EPS);
#pragma unroll
            for (int j = 0; j < 4; ++j) { const int k = 4 * C.lane + 256 * j; const f32x4 g = *(const f32x4*)(gmix + k);
                const f32x4 s4 = *(const LAS f32x4*)(sc + k), h4 = *(const LAS f32x4*)(sh + k);
#pragma unroll
                for (int q = 0; q < 4; ++q) v[j][q] = (v[j][q] * rstd * g[q]) * (1.f + s4[q]) + h4[q];
                u32x2 w; w.x = pk2(v[j][0], v[j][1]); w.y = pk2(v[j][2], v[j][3]);
                *(u32x2*)(hx + (size_t)grow * DM + k) = w; }
            const float gsum = row_dot16(v, Wg, C.lane);
            if ((C.lane & 3) == 0) gates[(size_t)grow * 16 + (C.lane >> 2)] = gsum + bin[GATE0 + (C.lane >> 2)];
        }
    }
}

__device__ __forceinline__ void phase2a(const Ctx& C, const Params& P) {
    unsigned char* ws = P.ws;
    pg8::SchedGrid S{(const char*)(ws + WS_HX), (const char*)(ws + WS_WIN), (size_t)256 * 2048, (size_t)256 * 2048, 128, 10, 0, 0, C.G, C.bid, 4, 128, 8, 32, 6, 2};
    pg8::EpiCM E{(bf16_t*)(ws + WS_PCM), (bf16_t*)(ws + WS_KVCM), P.in[9]};
    pg8::gemm_phase<pg8::EpiCM, pg8::SchedGrid, true>(C.lds, 1024, 2048, 2048, S, E);
}
__device__ __forceinline__ void phase2b(const Ctx& C, const Params& P) {
    unsigned char* ws = P.ws;
    pg8::SchedGrid S{(const char*)(ws + WS_HX), (const char*)(ws + WS_WIN), (size_t)256 * 2048, (size_t)256 * 2048, 128, 12, 0, 6, C.G, C.bid, 1, 0, 0, 0, 2, 4};
    pg8::EpiIn2 E{(bf16_t*)(ws + WS_PML), (bf16_t*)P.out, P.in[9]};
    pg8::gemm_phase<pg8::EpiIn2, pg8::SchedGrid, false>(C.lds, 1024, 2048, 2048, S, E);
}
__device__ __forceinline__ void phase_merge(const Ctx& C, const Params& P) {
    unsigned char* ws = P.ws;
    pg8::SchedChain S{{(const char*)(ws + WS_YAB), (const char*)(ws + WS_WB), (size_t)256 * 2048, (size_t)256 * 2048, 128, 4, 0, 0, C.G, C.bid, 1, 0, 0, 0, 1 << 30, 0}, 1024};
    pg8::EpiMerge E{(bf16_t*)(ws + WS_Z), (const bf16_t*)P.out};
    pg8::gemm_phase<pg8::EpiMerge, pg8::SchedChain, false>(C.lds, 512, 2048, 2048, S, E);
}
__device__ __forceinline__ void phase_outproj(const Ctx& C, const Params& P) {
    unsigned char* ws = P.ws;
    pg8::SchedGrid S{(const char*)(ws + WS_Z), (const char*)(ws + WS_WOUT), (size_t)256 * 2048, (size_t)256 * 2048, 128, 4, 0, 0, C.G, C.bid, 1, 0, 0, 0, 1 << 30, 0};
    pg8::EpiOut E{P.in[0], (bf16_t*)(ws + WS_XMID), (const float*)(ws + WS_ADA)};
    pg8::gemm_phase<pg8::EpiOut, pg8::SchedGrid, false>(C.lds, 1024, 2048, 2048, S, E);
}

constexpr int HY_KSTR = 16448;
constexpr int HY_UOFF = 4 * HY_KSTR;
constexpr int HY_USTR = 4616;
template <int MODE>
__device__ __forceinline__ void hyena_item(const Ctx& C, const Params& P, int o, int c) {
    unsigned char* ws = P.ws;
    LAS bf16_t* krv = (LAS bf16_t*)C.lds;
    LAS bf16_t* up = (LAS bf16_t*)(C.lds + HY_UOFF);
    const bf16_t* pcm = (const bf16_t*)(ws + WS_PCM);
    const float* hconv = P.in[10];
    __syncthreads();
    {
        const u32x4* src = (const u32x4*)((const bf16_t*)(ws + WS_KREV) + ((size_t)o * 512 + c) * 8192);
        for (int i = C.tid; i < 1024; i += NTHR) *(LAS u32x4*)(krv + 8 * i) = src[i];
        for (int i = C.tid; i < 8 * 65; i += NTHR) { const int b = i / 65, q = i % 65; const int off = (q < 32) ? 8 * q : (4352 + 8 * (q - 32));
            *(LAS u32x4*)(up + b * HY_USTR + off) = (u32x4){0u, 0u, 0u, 0u}; }
        if (o == 0) {
            const bf16_t* src0 = pcm + (size_t)c * MX; const float w0 = hconv[c], w1 = hconv[1536 + c], w2 = hconv[3072 + c];
            u32x4 vv[8]; unsigned vl[8], vr[8];
#pragma unroll
            for (int it = 0; it < 8; ++it) { const int r0 = 8 * (C.tid + NTHR * it); vv[it] = *(const u32x4*)(src0 + r0); vl[it] = *(const unsigned*)(src0 + r0 - 2); vr[it] = *(const unsigned*)(src0 + r0 + 8); }
#pragma unroll
            for (int it = 0; it < 8; ++it) { const int r0 = 8 * (C.tid + NTHR * it); const u32x4 v = vv[it];
                float x[10]; x[1] = bflo(v.x); x[2] = bfhi(v.x); x[3] = bflo(v.y); x[4] = bfhi(v.y); x[5] = bflo(v.z); x[6] = bfhi(v.z); x[7] = bflo(v.w); x[8] = bfhi(v.w);
                x[0] = ((r0 & 63) != 0) ? bfhi(vl[it]) : 0.f; x[9] = ((r0 & 63) != 56) ? bflo(vr[it]) : 0.f;
                float y[8];
#pragma unroll
                for (int j = 0; j < 8; ++j) y[j] = w0 * x[j] + w1 * x[j + 1] + w2 * x[j + 2];
                u32x4 w; w.x = pk2(y[0], y[1]); w.y = pk2(y[2], y[3]); w.z = pk2(y[4], y[5]); w.w = pk2(y[6], y[7]);
                *(LAS u32x4*)(up + (r0 >> 12) * HY_USTR + 256 + (r0 & 4095)) = w; }
        } else {
            const u32x4* src1 = (const u32x4*)((const bf16_t*)(ws + WS_Z1) + (size_t)c * MX);
            u32x4 vv[8];
#pragma unroll
            for (int it = 0; it < 8; ++it) vv[it] = src1[C.tid + NTHR * it];
#pragma unroll
            for (int it = 0; it < 8; ++it) { const int r0 = 8 * (C.tid + NTHR * it); *(LAS u32x4*)(up + (r0 >> 12) * HY_USTR + 256 + (r0 & 4095)) = vv[it]; }
        }
    }
    __syncthreads();
    for (int idx = C.tid; idx < 3 * 1025; idx += NTHR) { const int rho = 1 + idx / 1025, ch = idx % 1025; unsigned short e[8];
#pragma unroll
        for (int j = 0; j < 8; ++j) { const int z = 8 * ch + j - rho; e[j] = (z >= 0 && z < 8192) ? krv[z] : (unsigned short)0; }
        u32x4 w; w.x = e[0] | ((unsigned)e[1] << 16); w.y = e[2] | ((unsigned)e[3] << 16); w.z = e[4] | ((unsigned)e[5] << 16); w.w = e[6] | ((unsigned)e[7] << 16);
        *(LAS u32x4*)(C.lds + rho * HY_KSTR + 16 * ch) = w; }
    if (C.tid == 0) *(LAS u32x4*)(C.lds + 16 * 1024) = (u32x4){0u, 0u, 0u, 0u};
    __syncthreads();
    const int lane = C.lane, w = C.wave, kh = w >> 2, wq = w & 3, i = lane & 31, kq = lane >> 5, nb = (lane >> 2) & 7, np = lane & 3, rho = i & 3;
    f32x16 acc[4][2];
#pragma unroll
    for (int a = 0; a < 4; ++a)
#pragma unroll
        for (int pg = 0; pg < 2; ++pg)
#pragma unroll
            for (int r = 0; r < 16; ++r) acc[a][pg][r] = 0.f;
    const int abase = rho * HY_KSTR + 2 * (4096 - i + 8 * kq + rho) - 2048 * wq - 1536;
    const int bbase = HY_UOFF + 2 * (nb * HY_USTR + 256 + 32 * np + 8 * kq);
    typedef const volatile LAS u32x2* vp2;
#define HY_LOAD(AF, BF, s0) do { const int _a = abase + 2 * (s0), _b = bbase + 2 * (s0); \
        BF[0] = *(const LAS bf16x8*)(C.lds + _b); BF[1] = *(const LAS bf16x8*)(C.lds + _b + 256); \
        _Pragma("unroll") for (int a = 0; a < 4; ++a) { const u32x2 lo = *(vp2)(C.lds + _a + 512 * (3 - a)), hi = *(vp2)(C.lds + _a + 512 * (3 - a) + 8); \
            AF[a] = __builtin_bit_cast(bf16x8, (u32x4){lo.x, lo.y, hi.x, hi.y}); } } while (0)
#define HY_MMA(AF, BF) do { _Pragma("unroll") for (int a = 0; a < 4; ++a) _Pragma("unroll") for (int pg = 0; pg < 2; ++pg) \
        acc[a][pg] = __builtin_amdgcn_mfma_f32_32x32x16_bf16(AF[a], BF[pg], acc[a][pg], 0, 0, 0); } while (0)
    bf16x8 a0[4], a1[4], b0[2], b1[2];
    const int sbeg = -224 + 16 * 135 * kh;
    HY_LOAD(a0, b0, sbeg);
#pragma unroll 1
    for (int j = 0; j < (MODE == 1 ? 0 : 134); j += 2) {
        HY_LOAD(a1, b1, sbeg + 16 * (j + 1));
        __builtin_amdgcn_sched_barrier(0);
        HY_MMA(a0, b0);
        __builtin_amdgcn_sched_barrier(0);
        HY_LOAD(a0, b0, sbeg + 16 * (j + 2));
        __builtin_amdgcn_sched_barrier(0);
        HY_MMA(a1, b1);
        __builtin_amdgcn_sched_barrier(0);
    }
    HY_MMA(a0, b0);
#undef HY_LOAD
#undef HY_MMA
    const float skip = P.in[16][o * 512 + c];
    if (kh == 0) {
#pragma unroll
        for (int a = 0; a < 4; ++a)
#pragma unroll
            for (int pg = 0; pg < 2; ++pg)
#pragma unroll
                for (int g = 0; g < 4; ++g) { const int t0 = 1024 * wq + 256 * a + 128 * pg + 32 * np + 8 * g + 4 * kq;
                    const u32x2 uv = *(const LAS u32x2*)(up + nb * HY_USTR + 256 + t0);
                    acc[a][pg][4 * g + 0] += skip * bflo(uv.x); acc[a][pg][4 * g + 1] += skip * bfhi(uv.x); acc[a][pg][4 * g + 2] += skip * bflo(uv.y); acc[a][pg][4 * g + 3] += skip * bfhi(uv.y); }
    }
    __syncthreads();
    {
        LAS f32x4* slot = (LAS f32x4*)(C.lds + w * 16384);
#pragma unroll
        for (int al = 0; al < 2; ++al)
#pragma unroll
            for (int pg = 0; pg < 2; ++pg)
#pragma unroll
                for (int g = 0; g < 4; ++g) { const int a = kh ? al : 2 + al; const f32x16& v = acc[a][pg];
                    slot[((al * 2 + pg) * 4 + g) * 64 + lane] = (f32x4){v[4 * g], v[4 * g + 1], v[4 * g + 2], v[4 * g + 3]}; }
    }
    __syncthreads();
    const int gch = (o == 0 ? 512 : 1024) + c;
    const float w0 = hconv[gch], w1 = hconv[1536 + gch], w2 = hconv[3072 + gch];
    const bf16_t* gsrc = pcm + (size_t)gch * MX + (size_t)nb * SEQ;
    bf16_t* dst = (bf16_t*)(ws + (o == 0 ? WS_Z1 : WS_Z2CM)) + (size_t)c * MX + (size_t)nb * SEQ;
    const LAS f32x4* pslot = (const LAS f32x4*)(C.lds + (w ^ 4) * 16384);
#pragma unroll
    for (int al = 0; al < 2; ++al) {
        const int a = kh ? 2 + al : al;
        u32x2 gvv[2][4]; unsigned gl[2][4], gr[2][4];
#pragma unroll
        for (int pg = 0; pg < 2; ++pg)
#pragma unroll
            for (int g = 0; g < 4; ++g) { const int t0 = 1024 * wq + 256 * a + 128 * pg + 32 * np + 8 * g + 4 * kq;
                gvv[pg][g] = *(const u32x2*)(gsrc + t0); gl[pg][g] = *(const unsigned*)(gsrc + t0 - 2); gr[pg][g] = *(const unsigned*)(gsrc + t0 + 4); }
#pragma unroll
        for (int pg = 0; pg < 2; ++pg)
#pragma unroll
            for (int g = 0; g < 4; ++g) {
                const int t0 = 1024 * wq + 256 * a + 128 * pg + 32 * np + 8 * g + 4 * kq;
                const f32x4 pv = pslot[((al * 2 + pg) * 4 + g) * 64 + lane];
                const u32x2 gv = gvv[pg][g];
                float x[6]; x[1] = bflo(gv.x); x[2] = bfhi(gv.x); x[3] = bflo(gv.y); x[4] = bfhi(gv.y);
                x[0] = ((t0 & 63) != 0) ? bfhi(gl[pg][g]) : 0.f; x[5] = ((t0 & 63) != 60) ? bflo(gr[pg][g]) : 0.f;
                float z[4];
#pragma unroll
                for (int j = 0; j < 4; ++j) { const float gate = w0 * x[j] + w1 * x[j + 1] + w2 * x[j + 2]; z[j] = gate * (acc[a][pg][4 * g + j] + pv[j]); }
                u32x2 wv; wv.x = pk2(z[0], z[1]); wv.y = pk2(z[2], z[3]);
                if (MODE == 1) { if (z[0] == 12345.678f) *(u32x2*)(dst + t0) = wv; } else *(u32x2*)(dst + t0) = wv;
            }
    }
}

typedef short s16x4 __attribute__((ext_vector_type(4)));
__device__ __forceinline__ unsigned off_b(unsigned row, unsigned ch) { return 256u * row + 16u * (ch ^ (((row & 3) << 2) | ((row >> 2) & 3))); }
__device__ __forceinline__ bf16x8 tile_row_read(const LAS unsigned char* T, int lane, int rb, int s) { return *(const LAS bf16x8*)(T + off_b((lane & 15) + 16 * rb, 4 * s + (lane >> 4))); }
__device__ __forceinline__ bf16x8 tile_tr_read(const LAS unsigned char* T, int lane, int c, int ks) {
    const unsigned g = lane >> 4, q = (lane & 15) >> 2, p = lane & 3;
    const unsigned a0 = off_b(32 * ks + 8 * g + q, 2 * c + (p >> 1)) + 8 * (p & 1), a1 = off_b(32 * ks + 8 * g + 4 + q, 2 * c + (p >> 1)) + 8 * (p & 1);
    const s16x4 lo = __builtin_amdgcn_ds_read_tr16_b64_v4i16((LAS s16x4*)(T + a0)), hi = __builtin_amdgcn_ds_read_tr16_b64_v4i16((LAS s16x4*)(T + a1));
    return __builtin_shufflevector(lo, hi, 0, 1, 2, 3, 4, 5, 6, 7);
}
struct ChunkRef { int isctx, b, h, d, oc; };
__device__ __forceinline__ int chunk_row0(const ChunkRef& r) { return r.isctx ? (MX + r.b * CTXL + r.oc * 128) : (r.b * SEQ + r.oc * 128); }

__device__ __forceinline__ void load_kv_tiles(const Ctx& C, const Params& P, const ChunkRef& r, LAS unsigned char* KT, LAS unsigned char* VT, const LAS float* vscale) {
    const bf16_t* kvcm = (const bf16_t*)(P.ws + WS_KVCM); const float* cw = P.in[17];
    const int col0 = chunk_row0(r), rowlen = r.isctx ? CTXL : 64, orig0 = r.oc * 128;
    for (int idx = C.tid; idx < 2048; idx += NTHR) { const int d = idx >> 4, ch = idx & 15, s0 = 8 * ch;
        const bf16_t* src = kvcm + (size_t)(r.h * 128 + d) * MT + col0 + s0;
        const u32x4 v = *(const u32x4*)src;
        float x[10]; x[1] = bflo(v.x); x[2] = bfhi(v.x); x[3] = bflo(v.y); x[4] = bfhi(v.y); x[5] = bflo(v.z); x[6] = bfhi(v.z); x[7] = bflo(v.w); x[8] = bfhi(v.w);
        x[0] = (((orig0 + s0) % rowlen) != 0) ? bf2f(src[-1]) : 0.f; x[9] = (((orig0 + s0 + 7) % rowlen) != rowlen - 1) ? bf2f(src[8]) : 0.f;
        const int cc = 512 + r.h * 128 + d; const float w0 = cw[cc], w1 = cw[1024 + cc], w2 = cw[2048 + cc];
        float y[8];
#pragma unroll
        for (int j = 0; j < 8; ++j) y[j] = siluf(w0 * x[j] + w1 * x[j + 1] + w2 * x[j + 2]);
        u32x4 o; o.x = pk2(y[0], y[1]); o.y = pk2(y[2], y[3]); o.z = pk2(y[4], y[5]); o.w = pk2(y[6], y[7]);
        *(LAS u32x4*)(KT + off_b(d, ch)) = o;
        const u32x4 vv = *(const u32x4*)(kvcm + (size_t)(512 + r.h * 128 + d) * MT + col0 + s0);
        if (vscale) { const f32x4 sa = *(const LAS f32x4*)(vscale + s0), sb = *(const LAS f32x4*)(vscale + s0 + 4);
            u32x4 ov; ov.x = pk2(bflo(vv.x) * sa[0], bfhi(vv.x) * sa[1]); ov.y = pk2(bflo(vv.y) * sa[2], bfhi(vv.y) * sa[3]);
            ov.z = pk2(bflo(vv.z) * sb[0], bfhi(vv.z) * sb[1]); ov.w = pk2(bflo(vv.w) * sb[2], bfhi(vv.w) * sb[3]);
            *(LAS u32x4*)(VT + off_b(d, ch)) = ov; }
        else *(LAS u32x4*)(VT + off_b(d, ch)) = vv; }
}

__device__ __forceinline__ void mlstm_a_item(const Ctx& C, const Params& P, int item) {
    unsigned char* ws = P.ws;
    const int j = item % NCHK, seq = item / NCHK, h = seq & 3, b = (seq >> 2) & 7, d = seq >> 5;
    ChunkRef r; r.isctx = j < 2; r.b = b; r.h = h; r.d = d; { const int jj = r.isctx ? j : j - 2, nch = r.isctx ? 2 : 32; r.oc = d ? (nch - 1 - jj) : jj; }
    LAS unsigned char* KT = C.lds; LAS unsigned char* VT = C.lds + 32768;
    LAS float* wl = (LAS float*)(C.lds + 65536); LAS float* sc2 = wl + 128;
    __syncthreads();
    if (C.wave == 0) {
        const float* gates = (const float*)(ws + WS_GATES) + (size_t)chunk_row0(r) * 16;
        const int p0 = 2 * C.lane, t0 = d ? 127 - p0 : p0, t1 = d ? 126 - p0 : p0 + 1;
        const float li0 = gates[(size_t)t0 * 16 + (d ? 8 : 0) + h], li1 = gates[(size_t)t1 * 16 + (d ? 8 : 0) + h];
        const float lf0 = logsig(gates[(size_t)t0 * 16 + (d ? 12 : 4) + h]), lf1 = logsig(gates[(size_t)t1 * 16 + (d ? 12 : 4) + h]);
        float run = lf0 + lf1;
#pragma unroll
        for (int o = 1; o < 64; o <<= 1) { const float t = __shfl_up(run, o); if (C.lane >= o) run += t; }
        const float b1 = run, b0 = run - lf1;
        const float c0 = li0 - b0, c1 = li1 - b1;
        float gm = fmaxf(c0, c1);
#pragma unroll
        for (int o = 1; o < 64; o <<= 1) { const float t = __shfl_up(gm, o); if (C.lane >= o) gm = fmaxf(gm, t); }
        float gprev = __shfl_up(gm, 1); if (C.lane == 0) gprev = -3.0e38f;
        const float g0 = fmaxf(gprev, c0), g1 = gm;
        const float Bj = __shfl(b1, 63), gfin = __shfl(gm, 63);
        wl[t0] = __expf(c0 - gfin); wl[t1] = __expf(c1 - gfin);
        float* gc = (float*)(ws + WS_GC) + (size_t)item * 384;
        gc[t0] = c0; gc[t1] = c1; gc[128 + t0] = b0; gc[128 + t1] = b1; gc[256 + t0] = g0; gc[256 + t1] = g1;
        if (C.lane == 0) { float* bl = (float*)(ws + WS_BL) + (size_t)item * 2; bl[0] = Bj; bl[1] = Bj + gfin; }
    }
    __syncthreads();
    load_kv_tiles(C, P, r, KT, VT, wl);
    __syncthreads();
    if (C.tid < 128) { float s = 0.f;
        for (int ch = 0; ch < 16; ++ch) { const u32x4 kv = *(const LAS u32x4*)(KT + off_b(C.tid, ch)); const f32x4 wa = *(const LAS f32x4*)(wl + 8 * ch), wb = *(const LAS f32x4*)(wl + 8 * ch + 4);
            s += bflo(kv.x) * wa[0] + bfhi(kv.x) * wa[1] + bflo(kv.y) * wa[2] + bfhi(kv.y) * wa[3] + bflo(kv.z) * wb[0] + bfhi(kv.z) * wb[1] + bflo(kv.w) * wb[2] + bfhi(kv.w) * wb[3]; }
        ((float*)(ws + WS_NLOC))[(size_t)item * 128 + C.tid] = s; }
    const int lane = C.lane, w = C.wave, fr = lane & 15, fq = lane >> 4;
    bf16x8 af[4];
#pragma unroll
    for (int ks = 0; ks < 4; ++ks) af[ks] = tile_row_read(VT, lane, w, ks);
    bf16_t* dst = (bf16_t*)(ws + WS_PLOC) + (size_t)item * 16384;
#pragma unroll
    for (int nt = 0; nt < 8; ++nt) { f32x4 acc = (f32x4){0.f, 0.f, 0.f, 0.f};
#pragma unroll
        for (int ks = 0; ks < 4; ++ks) acc = __builtin_amdgcn_mfma_f32_16x16x32_bf16(af[ks], tile_row_read(KT, lane, nt, ks), acc, 0, 0, 0);
#pragma unroll
        for (int q = 0; q < 4; ++q) dst[(16 * w + 4 * fq + q) * 128 + 16 * nt + fr] = (bf16_t)f2bf(acc[q]); }
}

__device__ __forceinline__ void mlstm_scan(const Ctx& C, const Params& P) {
    unsigned char* ws = P.ws;
    const float* BL = (const float*)(ws + WS_BL); const bf16_t* ploc = (const bf16_t*)(ws + WS_PLOC); bf16_t* cst = (bf16_t*)(ws + WS_CST);
    for (int slot = C.bid * NTHR + C.tid; slot < 64 * 2048; slot += C.G * NTHR) {
        const int seq = slot >> 11, off = (slot & 2047) * 8;
        float cs[8];
#pragma unroll
        for (int q = 0; q < 8; ++q) cs[q] = 0.f;
        float m = 0.f;
        u32x4 pl[NCHK - 1];
#pragma unroll
        for (int j = 0; j < NCHK - 1; ++j) pl[j] = *(const u32x4*)(ploc + ((size_t)(seq * NCHK + j)) * 16384 + off);
#pragma unroll
        for (int j = 0; j < NCHK; ++j) {
            if (j >= 2) { u32x4 o; o.x = pk2(cs[0], cs[1]); o.y = pk2(cs[2], cs[3]); o.z = pk2(cs[4], cs[5]); o.w = pk2(cs[6], cs[7]);
                *(u32x4*)(cst + ((size_t)(seq * 32 + j - 2)) * 16384 + off) = o;
                if (off == 0) ((float*)(ws + WS_MST))[seq * 32 + j - 2] = m; }
            if (j < NCHK - 1) {
                const float Bj = BL[(seq * NCHK + j) * 2], Lj = BL[(seq * NCHK + j) * 2 + 1];
                const float mn = fmaxf(Bj + m, Lj), dec = __expf(Bj + m - mn), sc = __expf(Lj - mn);
                const unsigned p4[4] = {pl[j].x, pl[j].y, pl[j].z, pl[j].w};
#pragma unroll
                for (int q = 0; q < 4; ++q) { cs[2 * q] = dec * cs[2 * q] + sc * bflo(p4[q]); cs[2 * q + 1] = dec * cs[2 * q + 1] + sc * bfhi(p4[q]); }
                m = mn; }
        }
    }
    for (int idx = C.bid * NTHR + C.tid; idx < 64 * 128; idx += C.G * NTHR) {
        const int seq = idx >> 7, dd = idx & 127; float n = 0.f, m = 0.f;
        const float* nloc = (const float*)(ws + WS_NLOC); float* nst = (float*)(ws + WS_NST);
        for (int j = 0; j < NCHK; ++j) {
            if (j >= 2) nst[(size_t)(seq * 32 + j - 2) * 128 + dd] = n;
            if (j < NCHK - 1) { const float Bj = BL[(seq * NCHK + j) * 2], Lj = BL[(seq * NCHK + j) * 2 + 1];
                const float mn = fmaxf(Bj + m, Lj); n = __expf(Bj + m - mn) * n + __expf(Lj - mn) * nloc[(size_t)(seq * NCHK + j) * 128 + dd]; m = mn; }
        }
    }
}

__device__ __forceinline__ void mlstm_c_item(const Ctx& C, const Params& P, int item) {
    unsigned char* ws = P.ws;
    const int oc = item & 31, h = (item >> 5) & 3, b = item >> 7;
    LAS unsigned char* KT = C.lds; LAS unsigned char* VT = C.lds + 32768; LAS unsigned char* CT = C.lds + 65536; LAS unsigned char* PS = C.lds + 98304;
    LAS float* colf = (LAS float*)(C.lds + 131072); LAS float* bcs = colf + 128; LAS float* gms = bcs + 128; LAS float* nsl = gms + 128;
    const int lane = C.lane, w = C.wave, fr = lane & 15, fq = lane >> 4;
    const bf16_t* pml = (const bf16_t*)(ws + WS_PML) + (size_t)(b * SEQ + oc * 128) * 1024;
    const float* cw = P.in[17];
    bf16x8 qf[4];
    { const int tau = 16 * w + fr, orig = oc * 128 + tau; const bool hl = (orig & 63) != 0, hr = (orig & 63) != 63;
#pragma unroll
      for (int ks = 0; ks < 4; ++ks) { const int dc = 32 * ks + 8 * fq; const bf16_t* base = pml + (size_t)tau * 1024 + h * 128 + dc;
        const u32x4 vc = *(const u32x4*)base; u32x4 vl = (u32x4){0u, 0u, 0u, 0u}, vr = (u32x4){0u, 0u, 0u, 0u};
        if (hl) vl = *(const u32x4*)(base - 1024); if (hr) vr = *(const u32x4*)(base + 1024);
        const unsigned l4[4] = {vl.x, vl.y, vl.z, vl.w}, c4[4] = {vc.x, vc.y, vc.z, vc.w}, r4[4] = {vr.x, vr.y, vr.z, vr.w}; const int col = h * 128 + dc; unsigned o4[4];
#pragma unroll
        for (int q = 0; q < 4; ++q) {
            const float a0 = cw[col + 2 * q] * bflo(l4[q]) + cw[1024 + col + 2 * q] * bflo(c4[q]) + cw[2048 + col + 2 * q] * bflo(r4[q]);
            const float a1 = cw[col + 2 * q + 1] * bfhi(l4[q]) + cw[1024 + col + 2 * q + 1] * bfhi(c4[q]) + cw[2048 + col + 2 * q + 1] * bfhi(r4[q]);
            o4[q] = pk2(siluf(a0) * 0.08838834764831845f, siluf(a1) * 0.08838834764831845f); }
        qf[ks] = __builtin_bit_cast(bf16x8, (u32x4){o4[0], o4[1], o4[2], o4[3]}); } }
    f32x4 hacc[8];
#pragma unroll
    for (int nt = 0; nt < 8; ++nt) hacc[nt] = (f32x4){0.f, 0.f, 0.f, 0.f};
#pragma unroll 1
    for (int d = 0; d < 2; ++d) {
        ChunkRef r; r.isctx = 0; r.b = b; r.h = h; r.d = d; r.oc = oc;
        const int seq = (d * 8 + b) * 4 + h, jj = d ? 31 - oc : oc, sidx = seq * 32 + jj, aitem = seq * NCHK + 2 + jj;
        __syncthreads();
        if (d == 0) load_kv_tiles(C, P, r, KT, VT, nullptr);
        for (int idx = C.tid; idx < 2048; idx += NTHR) { const int e = idx >> 4, ch = idx & 15;
            *(LAS u32x4*)(CT + off_b(e, ch)) = *(const u32x4*)((const bf16_t*)(ws + WS_CST) + (size_t)sidx * 16384 + e * 128 + 8 * ch); }
        if (C.tid < 384) colf[C.tid] = ((const float*)(ws + WS_GC))[(size_t)aitem * 384 + C.tid];
        else nsl[C.tid - 384] = ((const float*)(ws + WS_NST))[(size_t)sidx * 128 + (C.tid - 384)];
        const float m0 = ((const float*)(ws + WS_MST))[sidx];
        __syncthreads();
        int t = 16 * w + fr, lane = C.lane; asm volatile("" : "+v"(t), "+v"(lane));
        const int fq = lane >> 4;
        const float mx = fmaxf(m0, gms[t]), rowf = -mx, ainter = __expf(m0 - mx), emneg = __expf(-(bcs[t] + mx));
        float qn = 0.f;
#pragma unroll
        for (int ks = 0; ks < 4; ++ks) { const u32x4 qq = __builtin_bit_cast(u32x4, qf[ks]); const LAS float* np_ = nsl + 32 * ks + 8 * fq; const f32x4 na = *(const LAS f32x4*)np_, nb = *(const LAS f32x4*)(np_ + 4);
            qn += bflo(qq.x) * na[0] + bfhi(qq.x) * na[1] + bflo(qq.y) * na[2] + bfhi(qq.y) * na[3] + bflo(qq.z) * nb[0] + bfhi(qq.z) * nb[1] + bflo(qq.w) * nb[2] + bfhi(qq.w) * nb[3]; }
        qn += __shfl_xor(qn, 16); qn += __shfl_xor(qn, 32);
        float rs = 0.f;
#pragma unroll
        for (int nt = 0; nt < 8; ++nt) { f32x4 a = (f32x4){0.f, 0.f, 0.f, 0.f};
#pragma unroll
            for (int ks = 0; ks < 4; ++ks) a = __builtin_amdgcn_mfma_f32_16x16x32_bf16(tile_tr_read(KT, lane, nt, ks), qf[ks], a, 0, 0, 0);
            const int s0 = 16 * nt + 4 * fq; const f32x4 cf = *(const LAS f32x4*)(colf + s0); float pv[4];
#pragma unroll
            for (int q = 0; q < 4; ++q) { const int s = s0 + q; const bool ok = d ? (s >= t) : (s <= t); pv[q] = ok ? __expf(rowf + cf[q]) * a[q] : 0.f; rs += pv[q]; }
            u32x2 pw; pw.x = pk2(pv[0], pv[1]); pw.y = pk2(pv[2], pv[3]);
            *(LAS u32x2*)(PS + off_b(t, 2 * nt + (fq >> 1)) + 8 * (fq & 1)) = pw; }
        rs += __shfl_xor(rs, 16); rs += __shfl_xor(rs, 32);
        const float inv = 1.f / fmaxf(fabsf(rs + ainter * qn), emneg);
        LDS_WAIT();
        bf16x8 pf[4];
#pragma unroll
        for (int ks = 0; ks < 4; ++ks) pf[ks] = tile_row_read(PS, lane, w, ks);
        float ai4[4], iv4[4];
#pragma unroll
        for (int q = 0; q < 4; ++q) { ai4[q] = __shfl(ainter, 4 * fq + q); iv4[q] = __shfl(inv, 4 * fq + q); }
#pragma unroll
        for (int nt = 0; nt < 8; ++nt) { f32x4 a = (f32x4){0.f, 0.f, 0.f, 0.f}, c = (f32x4){0.f, 0.f, 0.f, 0.f};
#pragma unroll
            for (int ks = 0; ks < 4; ++ks) { a = __builtin_amdgcn_mfma_f32_16x16x32_bf16(pf[ks], tile_row_read(VT, lane, nt, ks), a, 0, 0, 0);
                c = __builtin_amdgcn_mfma_f32_16x16x32_bf16(qf[ks], tile_row_read(CT, lane, nt, ks), c, 0, 0, 0); }
#pragma unroll
            for (int q = 0; q < 4; ++q) hacc[nt][q] += (a[q] + ai4[q] * c[q]) * iv4[q]; }
    }
    float ss[4] = {0.f, 0.f, 0.f, 0.f};
#pragma unroll
    for (int nt = 0; nt < 8; ++nt)
#pragma unroll
        for (int q = 0; q < 4; ++q) ss[q] += hacc[nt][q] * hacc[nt][q];
#pragma unroll
    for (int q = 0; q < 4; ++q) { ss[q] += __shfl_xor(ss[q], 1); ss[q] += __shfl_xor(ss[q], 2); ss[q] += __shfl_xor(ss[q], 4); ss[q] += __shfl_xor(ss[q], 8);
        ss[q] = rsqrtf(ss[q] * (1.f / 128.f) + RMS_EPS); }
    const float* ng = P.in[18]; bf16_t* yb = (bf16_t*)(ws + WS_YAB) + 512;
#pragma unroll
    for (int nt = 0; nt < 8; ++nt) { const int e = h * 128 + 16 * nt + fr; const float gn = ng[e];
#pragma unroll
        for (int q = 0; q < 4; ++q) { const int t = 16 * w + 4 * fq + q; const float og = bf2f(pml[(size_t)t * 1024 + 512 + e]);
            yb[(size_t)(b * SEQ + oc * 128 + t) * 1024 + e] = (bf16_t)f2bf(hacc[nt][q] * ss[q] * gn * sigm(og)); } }
}

__device__ __forceinline__ void transpose_z2(const Ctx& C, const Params& P) {
    unsigned char* ws = P.ws;
    const bf16_t* src = (const bf16_t*)(ws + WS_Z2CM); bf16_t* dst = (bf16_t*)(ws + WS_YAB);
    LAS bf16_t* tl = (LAS bf16_t*)(C.lds + 143360 - 20480);
    for (int it = C.bid; it < 8 * 256; it += C.G) {
        const int c0 = (it & 7) * 64, r0 = (it >> 3) * 128;
        __syncthreads();
        for (int idx = C.tid; idx < 64 * 16; idx += NTHR) { const int cc = idx >> 4, rc = (idx & 15) * 8;
            const u32x4 v = *(const u32x4*)(src + (size_t)(c0 + cc) * MX + r0 + rc); const unsigned v4[4] = {v.x, v.y, v.z, v.w};
#pragma unroll
            for (int q = 0; q < 4; ++q) { tl[(rc + 2 * q) * 72 + cc] = (bf16_t)(v4[q] & 0xffffu); tl[(rc + 2 * q + 1) * 72 + cc] = (bf16_t)(v4[q] >> 16); } }
        __syncthreads();
        for (int idx = C.tid; idx < 128 * 8; idx += NTHR) { const int rr = idx >> 3, c8 = (idx & 7) * 8;
            *(u32x4*)(dst + (size_t)(r0 + rr) * 1024 + c0 + c8) = *(const LAS u32x4*)(tl + rr * 72 + c8); }
    }
}

__device__ __forceinline__ void phase6(const Ctx& C, const Params& P) {
    unsigned char* ws = P.ws;
    LAS float* Wr = (LAS float*)C.lds;
    for (int idx = C.tid; idx < 1024 * 16; idx += NTHR) Wr[wl_pos(idx >> 4) * 20 + (idx & 15)] = P.in[22][idx];
    __syncthreads();
    const float* ada = (const float*)(ws + WS_ADA); const float* gffn = P.in[7];
    unsigned char* hx2 = ws + WS_HX2; float* aff = (float*)(ws + WS_AFF); int* slot = (int*)(ws + WS_SLOT);
    const bf16_t* xm = (const bf16_t*)(ws + WS_XMID);
    u32x2 nx[4];
    { const int row0 = C.bid * 8 + C.wave;
      if (row0 < MX) {
#pragma unroll
        for (int j = 0; j < 4; ++j) nx[j] = *(const u32x2*)(xm + (size_t)row0 * DM + 4 * C.lane + 256 * j); } }
    for (int row = C.bid * 8 + C.wave; row < MX; row += C.G * 8) {
        const int b = row >> 12, n = row & 4095;
        f32x4 v[4]; float ss = 0.f;
#pragma unroll
        for (int j = 0; j < 4; ++j) { v[j] = (f32x4){bflo(nx[j].x), bfhi(nx[j].x), bflo(nx[j].y), bfhi(nx[j].y)}; ss += v[j][0] * v[j][0] + v[j][1] * v[j][1] + v[j][2] * v[j][2] + v[j][3] * v[j][3]; }
        if (row + C.G * 8 < MX) {
#pragma unroll
            for (int j = 0; j < 4; ++j) nx[j] = *(const u32x2*)(xm + (size_t)(row + C.G * 8) * DM + 4 * C.lane + 256 * j); }
        const float rstd = rsqrtf(wave_sum(ss) * (1.f / DM) + RMS_EPS);
#pragma unroll
        for (int j = 0; j < 4; ++j) { const int k = 4 * C.lane + 256 * j; const f32x4 g = *(const f32x4*)(gffn + k);
            const f32x4 h4 = *(const f32x4*)(ada + (size_t)b * 6144 + 3072 + k), s4 = *(const f32x4*)(ada + (size_t)b * 6144 + 4096 + k);
#pragma unroll
            for (int q = 0; q < 4; ++q) v[j][q] = (v[j][q] * rstd * g[q]) * (1.f + s4[q]) + h4[q];
            *(unsigned*)(hx2 + (size_t)row * DM + k) = pk4_fp8(v[j][0], v[j][1], v[j][2], v[j][3]); }
        const float lg = row_dot16(v, Wr, C.lane);
        float mx = lg;
        mx = fmaxf(mx, __shfl_xor(mx, 4)); mx = fmaxf(mx, __shfl_xor(mx, 8)); mx = fmaxf(mx, __shfl_xor(mx, 16)); mx = fmaxf(mx, __shfl_xor(mx, 32));
        const float ex = expf(lg - mx);
        float sum = ex;
        sum += __shfl_xor(sum, 4); sum += __shfl_xor(sum, 8); sum += __shfl_xor(sum, 16); sum += __shfl_xor(sum, 32);
        if ((C.lane & 3) == 0) { const int e = C.lane >> 2; aff[((size_t)b * NE + e) * SEQ + n] = ex / sum; slot[(size_t)row * 16 + e] = -1; }
    }
}

__device__ __forceinline__ void topk_item(const Ctx& C, const Params& P, int item) {
    unsigned char* ws = P.ws;
    const int b = item >> 4, e = item & 15;
    const float* aff = (const float*)(ws + WS_AFF) + (size_t)item * SEQ;
    LAS unsigned* red = (LAS unsigned*)C.lds;
    unsigned v[8];
    { const u32x4 a = *(const u32x4*)(aff + 8 * C.tid), c = *(const u32x4*)(aff + 8 * C.tid + 4);
      v[0] = a.x; v[1] = a.y; v[2] = a.z; v[3] = a.w; v[4] = c.x; v[5] = c.y; v[6] = c.z; v[7] = c.w; }
    unsigned prefix = 0u;
    for (int bit = 30; bit >= 0; --bit) {
        const unsigned cand = prefix | (1u << bit); int cnt = 0;
#pragma unroll
        for (int q = 0; q < 8; ++q) cnt += (v[q] >= cand) ? 1 : 0;
        cnt = (int)wave_sum((float)cnt);
        __syncthreads();
        if (C.lane == 0) red[C.wave] = (unsigned)cnt;
        __syncthreads();
        int tot = 0;
#pragma unroll
        for (int q = 0; q < 8; ++q) tot += (int)red[q];
        if (tot >= CAP) prefix = cand;
    }
    int cg_ = 0, ce_ = 0;
#pragma unroll
    for (int q = 0; q < 8; ++q) { cg_ += (v[q] > prefix) ? 1 : 0; ce_ += (v[q] == prefix) ? 1 : 0; }
    int ig = cg_, ie = ce_;
#pragma unroll
    for (int o = 1; o < 64; o <<= 1) { const int tg = __shfl_up(ig, o), te = __shfl_up(ie, o); if (C.lane >= o) { ig += tg; ie += te; } }
    __syncthreads();
    if (C.lane == 63) { red[C.wave] = (unsigned)ig; red[8 + C.wave] = (unsigned)ie; }
    __syncthreads();
    int bg = 0, be = 0, totg = 0;
#pragma unroll
    for (int q = 0; q < 8; ++q) { const int xg = (int)red[q], xe = (int)red[8 + q]; if (q < C.wave) { bg += xg; be += xe; } totg += xg; }
    int pg = bg + ig - cg_, pe = be + ie - ce_;
    const int need = CAP - totg;
    int* sidx = (int*)(ws + WS_SIDX) + (size_t)item * CAP; float* sg = (float*)(ws + WS_SGATE) + (size_t)item * CAP; int* slot = (int*)(ws + WS_SLOT);
#pragma unroll
    for (int q = 0; q < 8; ++q) { const int n = 8 * C.tid + q; int s = -1;
        if (v[q] > prefix) s = pg++;
        else if (v[q] == prefix) { if (pe < need) s = totg + pe; ++pe; }
        if (s >= 0) { sidx[s] = n; sg[s] = __builtin_bit_cast(float, v[q]); slot[((size_t)b * SEQ + n) * 16 + e] = s; } }
}

__device__ __forceinline__ void gather_all(const Ctx& C, const Params& P) {
    unsigned char* ws = P.ws;
    const int* sidx = (const int*)(ws + WS_SIDX); const unsigned char* hx2 = ws + WS_HX2; unsigned char* xg = ws + WS_XG;
    for (int r = C.bid * 8 + C.wave; r < NE * 4096; r += C.G * 8) {
        const int e = r >> 12, rr = r & 4095, b = rr >> 9, s = rr & 511;
        const int n = sidx[((size_t)b * NE + e) * CAP + s];
        const u32x4* src = (const u32x4*)(hx2 + ((size_t)b * SEQ + n) * DM); u32x4* dst = (u32x4*)(xg + (size_t)r * DM);
        dst[C.lane] = src[C.lane];
    }
}

__device__ __forceinline__ void moe_gemm1(const Ctx& C, const Params& P, bool skip_epi) {
    unsigned char* ws = P.ws;
    pg8::SchedMoe S{(const char*)(ws + WS_XG), (const char*)(ws + WS_W13), (size_t)256 * 1024, (size_t)256 * 1024, (size_t)4096 * 1024, (size_t)4096 * 1024, 16, 16, C.G, C.bid};
    pg8::EpiMoe1 E{ws + WS_ACT, skip_epi};
    pg8::gemm_phase<pg8::EpiMoe1, pg8::SchedMoe, false, true>(C.lds, 512, 1024, 1024, S, E);
}
__device__ __forceinline__ void moe_gemm2(const Ctx& C, const Params& P, bool skip_epi) {
    unsigned char* ws = P.ws;
    pg8::SchedMoe S{(const char*)(ws + WS_ACT), (const char*)(ws + WS_W2), (size_t)256 * 2048, (size_t)256 * 2048, (size_t)4096 * 2048, (size_t)1024 * 2048, 16, 4, C.G, C.bid};
    pg8::EpiMoe2 E{(bf16_t*)(ws + WS_YE), (const float*)(ws + WS_SGATE), skip_epi};
    pg8::gemm_phase<pg8::EpiMoe2, pg8::SchedMoe, false, true>(C.lds, 1024, 2048, 2048, S, E);
}

__device__ __forceinline__ void phase_final(const Ctx& C, const Params& P) {
    unsigned char* ws = P.ws;
    const float* ada = (const float*)(ws + WS_ADA); const float* gfin = P.in[26];
    const int* slot = (const int*)(ws + WS_SLOT); const bf16_t* ye = (const bf16_t*)(ws + WS_YE);
    const bf16_t* xm = (const bf16_t*)(ws + WS_XMID);
    u32x2 nx[4]; int nslot = -1;
    { const int row0 = C.bid * 8 + C.wave;
      if (row0 < MX) { if (C.lane < 16) nslot = slot[(size_t)row0 * 16 + C.lane];
#pragma unroll
        for (int j = 0; j < 4; ++j) nx[j] = *(const u32x2*)(xm + (size_t)row0 * DM + 4 * C.lane + 256 * j); } }
    for (int row = C.bid * 8 + C.wave; row < MX; row += C.G * 8) {
        const int b = row >> 12;
        float* xr = P.out + (size_t)row * DM;
        f32x4 xv[4]; const int myslot = nslot;
#pragma unroll
        for (int j = 0; j < 4; ++j) xv[j] = (f32x4){bflo(nx[j].x), bfhi(nx[j].x), bflo(nx[j].y), bfhi(nx[j].y)};
        f32x4 m[4];
#pragma unroll
        for (int j = 0; j < 4; ++j) m[j] = (f32x4){0.f, 0.f, 0.f, 0.f};
        for (int e = 0; e < NE; ++e) { const int s = __shfl(myslot, e);
            if (s >= 0) { const bf16_t* yr = ye + ((size_t)e * 4096 + b * CAP + s) * DM;
#pragma unroll
                for (int j = 0; j < 4; ++j) { const u32x2 w = *(const u32x2*)(yr + 4 * C.lane + 256 * j);
                    m[j][0] += bflo(w.x); m[j][1] += bfhi(w.x); m[j][2] += bflo(w.y); m[j][3] += bfhi(w.y); } } }
        if (row + C.G * 8 < MX) { const int r1 = row + C.G * 8; nslot = (C.lane < 16) ? slot[(size_t)r1 * 16 + C.lane] : -1;
#pragma unroll
            for (int j = 0; j < 4; ++j) nx[j] = *(const u32x2*)(xm + (size_t)r1 * DM + 4 * C.lane + 256 * j); }
        f32x4 v[4]; float ss = 0.f;
#pragma unroll
        for (int j = 0; j < 4; ++j) { const int k = 4 * C.lane + 256 * j; const f32x4 g5 = *(const f32x4*)(ada + (size_t)b * 6144 + 5120 + k);
            v[j] = xv[j] + g5 * m[j]; ss += v[j][0] * v[j][0] + v[j][1] * v[j][1] + v[j][2] * v[j][2] + v[j][3] * v[j][3]; }
        const float rstd = rsqrtf(wave_sum(ss) * (1.f / DM) + RMS_EPS);
#pragma unroll
        for (int j = 0; j < 4; ++j) { const int k = 4 * C.lane + 256 * j; const f32x4 g = *(const f32x4*)(gfin + k);
            *(f32x4*)(xr + k) = v[j] * rstd * g; }
    }
}

constexpr int N_PHASES = 14;
__global__ void __launch_bounds__(NTHR, 2) mega(Params P) {
    extern __shared__ __attribute__((aligned(16))) unsigned char lds_raw[];
    Ctx C; C.lds = (LAS unsigned char*)lds_raw; C.tid = threadIdx.x; C.lane = C.tid & 63; C.wave = __builtin_amdgcn_readfirstlane(C.tid >> 6); C.bid = blockIdx.x; C.G = gridDim.x;
    unsigned char* ws = P.ws;
    if (C.tid < 32) ((LAS unsigned*)(C.lds + LDS_MISC))[C.tid] = 0u;
    __syncthreads();
    XcdBarrier bar = xcd_barrier_post((unsigned*)(ws + WS_CTL), (volatile LAS unsigned*)(C.lds + LDS_MISC));
#define IN(k) (lo <= (k) && (k) < hi)
#define SEAM(k) do { if (IN(k) && IN((k) + 1)) { xcd_barrier(bar); if ((REPEAT >> 23) & 1u) xcd_barrier(bar); } } while (0)
#define RUN(id, ...) do { { constexpr bool rep = false; (void)rep; __VA_ARGS__; } if ((REPEAT >> (id)) & 1u) { __syncthreads(); { constexpr bool rep = true; (void)rep; __VA_ARGS__; } } } while (0)
#define PHASE_PROGRAM(LO, HI) do { const int lo = (LO), hi = (HI); \
    if (IN(0)) RUN(0, phase0(C, P)); \
    SEAM(0); \
    if (IN(1)) RUN(1, phase1(C, P)); \
    SEAM(1); \
    if (IN(2)) { \
        RUN(2, phase2a(C, P)); \
        RUN(3, phase2b(C, P)); \
    } \
    SEAM(2); \
    if (IN(3)) { \
        RUN(4, for (int it = C.bid; it < 512; it += C.G) hyena_item<(rep && ((REPEAT >> 25) & 1u)) ? 1 : 0>(C, P, 0, it)); \
        RUN(5, for (int it = C.bid; it < 64 * NCHK; it += C.G) mlstm_a_item(C, P, it)); \
    } \
    SEAM(3); \
    if (IN(4)) { \
        RUN(6, for (int it = C.bid; it < 512; it += C.G) hyena_item<0>(C, P, 1, it)); \
        RUN(7, mlstm_scan(C, P)); \
    } \
    SEAM(4); \
    if (IN(5)) { \
        RUN(8, for (int it = C.bid; it < 1024; it += C.G) mlstm_c_item(C, P, it)); \
        RUN(9, transpose_z2(C, P)); \
    } \
    SEAM(5); \
    if (IN(6)) RUN(10, phase_merge(C, P)); \
    SEAM(6); \
    if (IN(7)) RUN(11, phase_outproj(C, P)); \
    SEAM(7); \
    if (IN(8)) RUN(12, phase6(C, P)); \
    SEAM(8); \
    if (IN(9)) { \
        RUN(13, for (int it = C.bid; it < BATCH * NE; it += C.G) topk_item(C, P, it)); \
        __syncthreads(); \
        RUN(14, convert_experts(C, P)); \
    } \
    SEAM(9); \
    if (IN(10)) RUN(15, gather_all(C, P)); \
    SEAM(10); \
    if (IN(11)) RUN(16, moe_gemm1(C, P, rep && ((REPEAT >> 25) & 1u))); \
    SEAM(11); \
    if (IN(12)) RUN(17, moe_gemm2(C, P, rep && ((REPEAT >> 25) & 1u))); \
    SEAM(12); \
    if (IN(13)) phase_final(C, P); \
} while (0)
    PHASE_PROGRAM(P.ph_lo, P.ph_hi);
#undef PHASE_PROGRAM
#undef IN
#undef SEAM
#undef RUN
}

extern "C" void kernel_launch(void* const* d_in, const int* in_sizes, int n_in, void* d_out, int out_size, void* d_ws, size_t ws_size, hipStream_t stream) {
    static int grid = 0;
    if (grid == 0) {
        if (n_in != 27 || out_size != MX * DM || ws_size < WS_END) { fprintf(stderr, "kernel_launch: unexpected shapes (n_in %d, out %d, ws %zu < %zu)\n", n_in, out_size, ws_size, (size_t)WS_END); grid = -1; return; }
        int dev = 0, cus = 0, per_cu = 0;
        hipGetDevice(&dev);
        hipDeviceGetAttribute(&cus, hipDeviceAttributeMultiprocessorCount, dev);
        if (hipFuncSetAttribute((const void*)mega, hipFuncAttributeMaxDynamicSharedMemorySize, LDS_BYTES) != hipSuccess) { fprintf(stderr, "kernel_launch: hipFuncSetAttribute failed\n"); grid = -1; return; }
        if (hipOccupancyMaxActiveBlocksPerMultiprocessor(&per_cu, (const void*)mega, NTHR, LDS_BYTES) != hipSuccess || per_cu < 1) { fprintf(stderr, "kernel_launch: occupancy query says %d\n", per_cu); per_cu = 1; }
        (void)hipGetLastError();
        grid = cus * 1;
        if (grid <= 0) grid = 256;
    }
    if (grid < 0) return;
    Params p; memset(&p, 0, sizeof(p));
    for (int i = 0; i < 27; ++i) p.in[i] = (const float*)d_in[i];
    p.out = (float*)d_out; p.ws = (unsigned char*)d_ws;
    (void)hipMemsetAsync((unsigned char*)d_ws + WS_CTL, 0, XCD_BAR_WORDS * 4, stream);
#if N_LAUNCH_MODE == 1
    if (PREFIX > 0) {
        p.ph_lo = 0; p.ph_hi = PREFIX;
        void* pargs[] = {&p};
        (void)hipLaunchCooperativeKernel((const void*)mega, dim3(grid), dim3(NTHR), pargs, LDS_BYTES, stream);
        (void)hipMemsetAsync((unsigned char*)d_ws + WS_CTL, 0, XCD_BAR_WORDS * 4, stream);
    }
    p.ph_lo = 0; p.ph_hi = N_PHASES;
    void* args[] = {&p};
    hipError_t e = hipLaunchCooperativeKernel((const void*)mega, dim3(grid), dim3(NTHR), args, LDS_BYTES, stream);
    if (e != hipSuccess) fprintf(stderr, "kernel_launch: cooperative launch failed: %s (grid %d)\n", hipGetErrorString(e), grid);
#else
    for (int ph = 0; ph < N_PHASES; ++ph) {
        p.ph_lo = ph; p.ph_hi = ph + 1;
        void* args[] = {&p};
        hipError_t e = hipLaunchCooperativeKernel((const void*)mega, dim3(grid), dim3(NTHR), args, LDS_BYTES, stream);
        if (e != hipSuccess) { fprintf(stderr, "kernel_launch: launch %d failed: %s (grid %d)\n", ph, hipGetErrorString(e), grid); break; }
    }
#endif
}
```

```cpp
#include <hip/hip_runtime.h>
#include <hip/hip_cooperative_groups.h>
#include <cstdio>
#include <cstdint>
#include <cstring>
namespace cg = cooperative_groups;

#ifndef N_LAUNCH_MODE
#define N_LAUNCH_MODE 1
#endif

#define LAS __attribute__((address_space(3)))
typedef unsigned short bf16_t;
typedef short bf16x8 __attribute__((ext_vector_type(8)));
typedef float f32x4 __attribute__((ext_vector_type(4)));
typedef float f32x16 __attribute__((ext_vector_type(16)));
typedef unsigned u32x4 __attribute__((ext_vector_type(4)));
typedef unsigned u32x2 __attribute__((ext_vector_type(2)));

constexpr int NTHR = 512;
constexpr int BATCH = 8, SEQ = 4096, DM = 1024, CTXL = 256;
constexpr int MX = BATCH * SEQ;
constexpr int MC = BATCH * CTXL;
constexpr int DIN = 5648, NPROJ = 5632, GATE0 = 3584, MERGE0 = 3600;
constexpr int NE = 16, CAP = 512, DFF = 2048;
constexpr int MT = MX + MC;
constexpr int NCHK = 34;
constexpr float RMS_EPS = 1e-6f;

constexpr size_t MiB = 1u << 20;
constexpr size_t WS_ADAP = 0;
constexpr size_t WS_ADA = 7 * MiB;
constexpr size_t WS_CTL = 7 * MiB + 512 * 1024;
constexpr size_t WS_GATES = 8 * MiB;
constexpr size_t WS_KREV = 11 * MiB;
constexpr size_t WS_BL = 27 * MiB;
constexpr size_t WS_MST = 27 * MiB + 64 * 1024;
constexpr size_t WS_NLOC = 28 * MiB;
constexpr size_t WS_NST = 30 * MiB;
constexpr size_t WS_WIN = 32 * MiB;
constexpr size_t WS_WB = 43 * MiB;
constexpr size_t WS_WOUT = 45 * MiB;
constexpr size_t WS_HX = 48 * MiB;
constexpr size_t WS_PLOC = 48 * MiB;
constexpr size_t WS_PCM = 116 * MiB;
constexpr size_t WS_PML = 212 * MiB;
constexpr size_t WS_KVCM = 276 * MiB;
constexpr size_t WS_GC = 2 * MiB;
constexpr size_t WS_Z1 = 344 * MiB;
constexpr size_t WS_YAB = 376 * MiB;
constexpr size_t WS_CST = 440 * MiB;
constexpr size_t WS_KACT = 48 * MiB;
constexpr size_t WS_QACT = 82 * MiB;
constexpr size_t WS_HDIR = 440 * MiB;
constexpr size_t WS_Z2CM = 504 * MiB;
constexpr size_t WS_Z = 48 * MiB;
constexpr size_t WS_XMID = 496 * MiB;
constexpr size_t WS_AFF = 0;
constexpr size_t WS_SLOT = 2 * MiB;
constexpr size_t WS_SIDX = 4 * MiB;
constexpr size_t WS_SGATE = 4 * MiB + 512 * 1024;
constexpr size_t WS_HX2 = 48 * MiB;
constexpr size_t WS_W13 = 80 * MiB;
constexpr size_t WS_W2 = 144 * MiB;
constexpr size_t WS_XG = 176 * MiB;
constexpr size_t WS_ACT = 240 * MiB;
constexpr size_t WS_YE = 368 * MiB;
constexpr size_t WS_END = 568 * MiB;

constexpr int LDS_BYTES = 147456;
constexpr int LDS_MISC = LDS_BYTES - 128;
constexpr int PREFIX = 0;
constexpr unsigned REPEAT = 0u;

__device__ __forceinline__ unsigned f2bf(float f) { unsigned u = __builtin_bit_cast(unsigned, f); return (u + 0x7fffu + ((u >> 16) & 1u)) >> 16; }
__device__ __forceinline__ unsigned pk2(float lo, float hi) { return f2bf(lo) | (f2bf(hi) << 16); }
__device__ __forceinline__ float bf2f(unsigned short b) { return __builtin_bit_cast(float, ((unsigned)b) << 16); }
__device__ __forceinline__ float bflo(unsigned w) { return __builtin_bit_cast(float, w << 16); }
__device__ __forceinline__ float bfhi(unsigned w) { return __builtin_bit_cast(float, w & 0xffff0000u); }
__device__ __forceinline__ float sigm(float x) { return __builtin_amdgcn_rcpf(1.f + __expf(-x)); }
__device__ __forceinline__ float siluf(float x) { return x * __builtin_amdgcn_rcpf(1.f + __expf(-x)); }
__device__ __forceinline__ float logsig(float x) { return x >= 0.f ? -log1pf(expf(-x)) : x - log1pf(expf(x)); }
__device__ __forceinline__ float wave_sum(float v) {
#pragma unroll
    for (int o = 1; o < 64; o <<= 1) v += __shfl_xor(v, o);
    return v;
}
#define LDS_WAIT() asm volatile("s_waitcnt lgkmcnt(0)" ::: "memory")
__device__ __forceinline__ float clamp8(float x) { return __builtin_amdgcn_fmed3f(x, -448.f, 448.f); }
__device__ __forceinline__ unsigned pk4_fp8(float a, float b, float c, float d) {
    int r = __builtin_amdgcn_cvt_pk_fp8_f32(clamp8(a), clamp8(b), 0, false); r = __builtin_amdgcn_cvt_pk_fp8_f32(clamp8(c), clamp8(d), r, true); return (unsigned)r; }
constexpr float W8_SCALE = 64.f, W8_INV = 1.f / 64.f;

struct Params {
    const float* in[27];
    float* out;
    unsigned char* ws;
    int ph_lo, ph_hi;
};


#define XB_TMO      128
#define XB_XCNT(j)  (256  + 64 * (j))
#define XB_XSUB(j)  (1280 + 64 * (j))
#define XB_XGEN(j)  (2304 + 64 * (j))
#define XB_TOP      3328
#define XB_TOPGEN   3392
#define XCD_BAR_WORDS 3456
#define XB_SPIN_CAP (1u << 18)
__device__ __forceinline__ unsigned xb_ld(unsigned* p)              { return __hip_atomic_load(p, __ATOMIC_RELAXED, __HIP_MEMORY_SCOPE_AGENT); }
__device__ __forceinline__ unsigned xb_add(unsigned* p, unsigned v) { return __hip_atomic_fetch_add(p, v, __ATOMIC_RELAXED, __HIP_MEMORY_SCOPE_AGENT); }
__device__ __forceinline__ unsigned xb_xcc_id() { return (unsigned)__builtin_amdgcn_s_getreg((3 << 11) | 20) & 0xFu; }
#define XB_SPIN(cond, bar) do { unsigned _sp = 0; while (cond) { __builtin_amdgcn_s_sleep(1); \
    if ((++_sp & 255u) == 0u) { if (xb_ld(&(bar)[XB_TMO])) break; if (_sp > XB_SPIN_CAP) { atomicAdd(&(bar)[XB_TMO], 1u); break; } } } } while (0)
struct XcdBarrier { unsigned* bar; unsigned x; volatile LAS unsigned* st; };
__device__ __forceinline__ XcdBarrier xcd_barrier_post(unsigned* bar, volatile LAS unsigned* st) {
    XcdBarrier b; b.bar = bar; b.x = xb_xcc_id(); b.st = st;
    if (threadIdx.x == 0) (void)xb_add(&bar[XB_XCNT(b.x)], 1u);
    return b;
}
__device__ __forceinline__ void xcd_barrier_complete(unsigned* bar, unsigned x, unsigned& nloc, unsigned& nx) {
    const unsigned G = gridDim.x * gridDim.y * gridDim.z;
    unsigned sum, cnt, mine, sp = 0u;
    for (;;) {
        sum = 0u; cnt = 0u; mine = 0u;
#pragma unroll
        for (unsigned j = 0; j < 16; ++j) { const unsigned c = xb_ld(&bar[XB_XCNT(j)]); sum += c; cnt += (c > 0u) ? 1u : 0u; mine = (j == x) ? c : mine; }
        if (sum == G) break;
        __builtin_amdgcn_s_sleep(1);
        if ((++sp & 255u) == 0u) { if (xb_ld(&bar[XB_TMO])) break; if (sp > XB_SPIN_CAP) { atomicAdd(&bar[XB_TMO], 1u); break; } }
    }
    nloc = mine > 0u ? mine : 1u; nx = cnt > 0u ? cnt : 1u;
}
__device__ __forceinline__ void xcd_barrier(const XcdBarrier& b) {
    asm volatile("s_waitcnt vmcnt(0)" ::: "memory");
    __syncthreads();
    if (threadIdx.x == 0) {
        unsigned* bar = b.bar;
        __builtin_amdgcn_s_waitcnt(0);
        unsigned nloc = b.st[0], nx = b.st[1];
        if (nloc == 0u) { xcd_barrier_complete(bar, b.x, nloc, nx); b.st[0] = nloc; b.st[1] = nx; }
        const unsigned old = xb_add(&bar[XB_XSUB(b.x)], 1u);
        const unsigned gen = old / nloc;
        if (old + 1u == (gen + 1u) * nloc) {
            __builtin_amdgcn_fence(__ATOMIC_RELEASE, "agent");
            asm volatile("s_waitcnt vmcnt(0)" ::: "memory");
            const unsigned og = xb_add(&bar[XB_TOP], 1u);
            const unsigned tg = og / nx;
            if (og + 1u == (tg + 1u) * nx) xb_add(&bar[XB_TOPGEN], 1u);
            else XB_SPIN(xb_ld(&bar[XB_TOPGEN]) == tg, bar);
            __builtin_amdgcn_fence(__ATOMIC_ACQUIRE, "agent");
            xb_add(&bar[XB_XGEN(b.x)], 1u);
            asm volatile("s_waitcnt vmcnt(0)" ::: "memory");
        } else {
            XB_SPIN(xb_ld(&bar[XB_XGEN(b.x)]) == gen, bar);
            __builtin_amdgcn_fence(__ATOMIC_ACQUIRE, "agent");
            asm volatile("s_waitcnt vmcnt(0)" ::: "memory");
        }
    }
    __syncthreads();
}

namespace pg8 {
constexpr int BM = 256, BK = 64, HALF = 128, HTB = HALF * BK * 2, STAGE_BYTES = 8 * HTB;
__device__ __forceinline__ int lds_byte(int r, int c) { const int st = (r >> 4) * 2 + (c >> 5), rr = r & 15, cc = c & 31, ob = rr * 64 + cc * 2; return st * 1024 + (ob ^ (((ob >> 9) & 1) << 5)); }
__device__ __forceinline__ void stage_rc(int b, int& R, int& C) { const int st = b / 1024, sb = b % 1024, swz = sb ^ (((sb >> 9) & 1) << 5); R = (st >> 1) * 16 + swz / 64; C = (st & 1) * 32 + (swz % 64) / 2; }
__device__ __forceinline__ int perm32(int rho) { const int n = rho >> 4, i = rho & 15; return 8 * (i >> 2) + 4 * n + (i & 3); }
__device__ __forceinline__ unsigned cvt_pk_bf16(float lo, float hi) { unsigned r; asm volatile("v_cvt_pk_bf16_f32 %0, %1, %2" : "=v"(r) : "v"(lo), "v"(hi)); return r; }

typedef int v4i_t __attribute__((ext_vector_type(4)));
typedef int v8i_t __attribute__((ext_vector_type(8)));
struct Unit { const char* A; const char* B; int pm, pn, aux; };

struct SchedGrid {
    const char* A; const char* B; size_t tstepA, tstepB; int nM, nN, pm0, pn0, G, c;
    int xN, xPm0, xPn0, xCnt;
    int split, gap;
    __device__ bool next(int i, Unit& u) const {
        const long L = (long)i * G + c; const int nwg = nM * nN;
        if (L >= nwg + xCnt) return false;
        if (L >= nwg) { const int q = (int)L - nwg; u.pm = xPm0 + q / xN; u.pn = xPn0 + q % xN; u.aux = 1; }
        else {
            int wgid = (int)L; { const int q = nwg / 8, r = nwg % 8, xcd = wgid % 8, off = wgid / 8; wgid = (xcd < r ? xcd * (q + 1) : r * (q + 1) + (xcd - r) * q) + off; }
            const int nig = 8 * nN, gid = wgid / nig, fm = gid * 8, gsz = (nM - fm) < 8 ? (nM - fm) : 8;
            u.pm = pm0 + fm + ((wgid % nig) % gsz); { const int idx = (wgid % nig) / gsz; u.pn = pn0 + idx + (idx >= split ? gap : 0); } u.aux = 0;
        }
        u.A = A + (size_t)u.pm * tstepA; u.B = B + (size_t)u.pn * tstepB; return true;
    }
};
struct SchedChain {
    SchedGrid G; size_t half;
    __device__ bool next(int i, Unit& u) const {
        if (!G.next(i >> 1, u)) return false;
        u.aux = i & 1; u.A += (size_t)(i & 1) * half; u.B += (size_t)(i & 1) * half; return true;
    }
};

struct SchedMoe {
    const char* A; const char* B; size_t tstepA, tstepB, estepA, estepB; int nM, nN, G, c;
    __device__ bool next(int i, Unit& u) const {
        const long L = (long)i * G + c; const int e8 = (int)(L % 8); const long ta = L / 8; const int per = nM * nN;
        if (ta >= 2L * per) return false;
        const int e = e8 + 8 * (int)(ta / per); const int t = (int)(ta % per);
        if (nN == 16) { const int blk = t >> 5, wi = t & 31; u.pm = 4 * (blk >> 1) + (wi >> 3); u.pn = 8 * (blk & 1) + (wi & 7); }
        else { u.pm = t / nN; u.pn = t % nN; }
        u.aux = e;
        u.A = A + (size_t)e * estepA + (size_t)u.pm * tstepA; u.B = B + (size_t)e * estepB + (size_t)u.pn * tstepB; return true;
    }
};

template <class Epi, class Sched, bool NORMAL, bool F8 = false>
__device__ __forceinline__ void gemm_phase(LAS unsigned char* lds, const int K  , const unsigned lda, const unsigned ldb, const Sched& S, const Epi& E) {
    const int tid = threadIdx.x, wid = __builtin_amdgcn_readfirstlane(tid >> 6), lane = tid & 63, wr = wid >> 2, wc = wid & 3, fr = lane & 15, fq = lane >> 4;
    const int nt = K / BK;
    unsigned voffA[2], voffB[2];
#pragma unroll
    for (int i = 0; i < 2; ++i) { int R, C; stage_rc(tid * 16 + i * 8192, R, C); const int Rb = Epi::PERM ? ((R & ~31) + perm32(R & 31)) : R;
        voffA[i] = (unsigned)R * lda + (unsigned)C * 2u; voffB[i] = (unsigned)Rb * ldb + (unsigned)C * 2u; }
    const size_t kstep = (size_t)(BK * 2);
    const size_t hstepA = (size_t)HALF * lda, hstepB = (size_t)HALF * ldb;
    const unsigned ldsw = (unsigned)wid * 1024u;
    const int aoff = lds_byte(wr * 64 + fr, fq * 8), boff = lds_byte(wc * 32 + fr, fq * 8);
#define PG8_SA(b, h) (((b) * 2 + (h)) * HTB)
#define PG8_SB(b, h) ((4 + (b) * 2 + (h)) * HTB)
#define PG8_STAGE(bufoff, gbase, voff) do { _Pragma("unroll") for (int _i = 0; _i < 2; ++_i) \
        __builtin_amdgcn_global_load_lds((const unsigned*)((const char*)(gbase) + (voff)[_i]), (LAS unsigned*)(lds + (bufoff) + ldsw + _i * 8192), 16, 0, 0); } while (0)
#define PG8_LDA(dst, b, h) do { if constexpr (F8) { _Pragma("unroll") for (int m = 0; m < 4; ++m) dst##8[m] = __builtin_shufflevector(*(const LAS v4i_t*)(lds + PG8_SA(b, h) + aoff + m * 2048), *(const LAS v4i_t*)(lds + PG8_SA(b, h) + aoff + m * 2048 + 1024), 0, 1, 2, 3, 4, 5, 6, 7); } \
        else { _Pragma("unroll") for (int m = 0; m < 4; ++m) _Pragma("unroll") for (int k = 0; k < 2; ++k) dst[m][k] = *(const LAS bf16x8*)(lds + PG8_SA(b, h) + aoff + m * 2048 + k * 1024); } } while (0)
#define PG8_LDB(dst, b, h) do { if constexpr (F8) { _Pragma("unroll") for (int n = 0; n < 2; ++n) dst##8[n] = __builtin_shufflevector(*(const LAS v4i_t*)(lds + PG8_SB(b, h) + boff + n * 2048), *(const LAS v4i_t*)(lds + PG8_SB(b, h) + boff + n * 2048 + 1024), 0, 1, 2, 3, 4, 5, 6, 7); } \
        else { _Pragma("unroll") for (int n = 0; n < 2; ++n) _Pragma("unroll") for (int k = 0; k < 2; ++k) dst[n][k] = *(const LAS bf16x8*)(lds + PG8_SB(b, h) + boff + n * 2048 + k * 1024); } } while (0)
#define PG8_MMA(ai, bj, At, Bt) do { __builtin_amdgcn_s_setprio(1); \
        if constexpr (F8) { _Pragma("unroll") for (int m = 0; m < 4; ++m) _Pragma("unroll") for (int n = 0; n < 2; ++n) \
            asm volatile("v_mfma_scale_f32_16x16x128_f8f6f4 %0, %1, %2, %0, %3, %3 op_sel_hi:[0,0,0]" : "+v"(acc[ai][bj][m][n]) : "v"(Bt##8[n]), "v"(At##8[m]), "v"(sc8)); } \
        else { _Pragma("unroll") for (int m = 0; m < 4; ++m) _Pragma("unroll") for (int n = 0; n < 2; ++n) _Pragma("unroll") for (int k = 0; k < 2; ++k) \
        acc[ai][bj][m][n] = NORMAL ? __builtin_amdgcn_mfma_f32_16x16x32_bf16(At[m][k], Bt[n][k], acc[ai][bj][m][n], 0, 0, 0) \
                                   : __builtin_amdgcn_mfma_f32_16x16x32_bf16(Bt[n][k], At[m][k], acc[ai][bj][m][n], 0, 0, 0); } __builtin_amdgcn_s_setprio(0); } while (0)
#define PG8_WAIT_V(n) asm volatile("s_waitcnt vmcnt(" #n ")" ::: "memory")
#define PG8_WAIT_L(n) asm volatile("s_waitcnt lgkmcnt(" #n ")" ::: "memory")
#define PG8_BAR __builtin_amdgcn_s_barrier()
#define PG8_SCHED __builtin_amdgcn_sched_barrier(0)
    Unit cur, nxt; int ui = 0;
    if (!S.next(0, cur)) return;
    f32x4 acc[2][2][4][2];
#pragma unroll
    for (int a = 0; a < 2; ++a)
#pragma unroll
        for (int b = 0; b < 2; ++b)
#pragma unroll
            for (int m = 0; m < 4; ++m)
#pragma unroll
                for (int n = 0; n < 2; ++n) acc[a][b][m][n] = (f32x4){0.f, 0.f, 0.f, 0.f};
    bf16x8 At[4][2], B0[2][2], B1[2][2];
    v8i_t At8[4], B08[2], B18[2]; const int sc8 = 0x7F7F7F7F;
    const char* cA = cur.A; const char* cB = cur.B;
    PG8_STAGE(PG8_SB(0, 0), cB, voffB); PG8_STAGE(PG8_SB(0, 1), cB + hstepB, voffB); PG8_STAGE(PG8_SA(0, 0), cA, voffA); PG8_STAGE(PG8_SA(0, 1), cA + hstepA, voffA);
    if (wr == 1) PG8_BAR;
    PG8_WAIT_V(2); PG8_BAR;
    PG8_STAGE(PG8_SB(1, 0), cB + kstep, voffB); PG8_STAGE(PG8_SA(1, 0), cA + kstep, voffA); PG8_STAGE(PG8_SB(1, 1), cB + hstepB + kstep, voffB);
    PG8_WAIT_V(6); PG8_BAR;
    for (;;) {
        const bool has_next = S.next(ui + 1, nxt);
        const char* nA = has_next ? nxt.A : cA; const char* nB = has_next ? nxt.B : cB;
#pragma unroll 1
        for (int t = 0; t < nt; t += 2) {
            const bool last = (t == nt - 2);
            const char* a1 = cA + (size_t)(t + 1) * kstep;
            const char* a2 = last ? nA : cA + (size_t)(t + 2) * kstep; const char* b2 = last ? nB : cB + (size_t)(t + 2) * kstep;
            const char* a3 = a2 + kstep; const char* b3 = b2 + kstep;
            PG8_LDB(B0, 0, 0); PG8_LDB(B1, 0, 1); PG8_SCHED; PG8_LDA(At, 0, 0); PG8_STAGE(PG8_SA(1, 1), a1 + hstepA, voffA);
            PG8_WAIT_V(8); PG8_WAIT_L(0); PG8_BAR; PG8_MMA(0, 0, At, B0); PG8_MMA(0, 1, At, B1); PG8_BAR; PG8_SCHED;
            PG8_LDA(At, 0, 1); PG8_STAGE(PG8_SB(0, 0), b2, voffB); PG8_STAGE(PG8_SB(0, 1), b2 + hstepB, voffB); PG8_STAGE(PG8_SA(0, 0), a2, voffA);
            PG8_WAIT_V(8); PG8_WAIT_L(0); PG8_BAR; PG8_MMA(1, 0, At, B0); PG8_MMA(1, 1, At, B1); PG8_BAR; PG8_SCHED;
            PG8_LDB(B0, 1, 0); PG8_LDB(B1, 1, 1); PG8_SCHED; PG8_LDA(At, 1, 0); PG8_STAGE(PG8_SA(0, 1), a2 + hstepA, voffA);
            PG8_WAIT_V(8); PG8_WAIT_L(0); PG8_BAR; PG8_MMA(0, 0, At, B0); PG8_MMA(0, 1, At, B1); PG8_BAR; PG8_SCHED;
            PG8_LDA(At, 1, 1); PG8_STAGE(PG8_SB(1, 0), b3, voffB); PG8_STAGE(PG8_SB(1, 1), b3 + hstepB, voffB); PG8_STAGE(PG8_SA(1, 0), a3, voffA);
            PG8_WAIT_V(8); PG8_WAIT_L(0); PG8_BAR; PG8_MMA(1, 0, At, B0); PG8_MMA(1, 1, At, B1); PG8_BAR; PG8_SCHED;
        }
        if (wr == 0) PG8_BAR;
        if constexpr (F8) asm volatile("s_nop 15\n\ts_nop 15" ::: "memory");
        bool keep = false;
        if constexpr (Epi::HAS_MID) { if (cur.aux == 0) { E.mid(acc, cur, wr, wc, fr, fq); keep = true; } else E(acc, cur, wr, wc, fr, fq); }
        else E(acc, cur, wr, wc, fr, fq);
        if (!has_next) break;
        if (!keep) {
#pragma unroll
        for (int a = 0; a < 2; ++a)
#pragma unroll
            for (int b = 0; b < 2; ++b)
#pragma unroll
                for (int m = 0; m < 4; ++m)
#pragma unroll
                    for (int n = 0; n < 2; ++n) acc[a][b][m][n] = (f32x4){0.f, 0.f, 0.f, 0.f};
        }
        cur = nxt; cA = nA; cB = nB; ++ui;
        if (wr == 1) PG8_BAR;
    }
    PG8_WAIT_V(0);
    PG8_BAR;
#undef PG8_SA
#undef PG8_SB
#undef PG8_STAGE
#undef PG8_LDA
#undef PG8_LDB
#undef PG8_MMA
#undef PG8_WAIT_V
#undef PG8_WAIT_L
#undef PG8_BAR
#undef PG8_SCHED
}


struct EpiCM {
    static constexpr bool PERM = false, HAS_MID = false;
    bf16_t* pcm; bf16_t* kvcm; const float* bias;
    __device__ __forceinline__ void operator()(const f32x4 (&acc)[2][2][4][2], const Unit& u, int wr, int wc, int fr, int fq) const {
        const bool kv = u.pn >= 8;
#pragma unroll
        for (int bj = 0; bj < 2; ++bj)
#pragma unroll
            for (int n = 0; n < 2; ++n) {
                const int c = u.pn * BM + bj * HALF + wc * 32 + n * 16 + fr; const float bv = bias[c];
                bf16_t* base = kv ? (kvcm + (size_t)(c - 2048) * MT) : (pcm + (size_t)c * MX);
#pragma unroll
                for (int ai = 0; ai < 2; ++ai)
#pragma unroll
                    for (int m = 0; m < 4; ++m) {
                        const int r = u.pm * BM + ai * HALF + wr * 64 + m * 16 + 4 * fq; const f32x4 v = acc[ai][bj][m][n] + bv;
                        u32x2 w; w.x = cvt_pk_bf16(v[0], v[1]); w.y = cvt_pk_bf16(v[2], v[3]);
                        *(u32x2*)(base + r) = w; }
                asm volatile("" ::: "memory");
            }
    }
};

struct EpiIn2 {
    static constexpr bool PERM = true, HAS_MID = false;
    bf16_t* pml; bf16_t* pmg; const float* bias;
    __device__ __forceinline__ void operator()(const f32x4 (&acc)[2][2][4][2], const Unit& u, int wr, int wc, int fr, int fq) const {
        const int colt = u.pn * BM; bf16_t* base; int ldc, cbase, bofs = 0; const int row0 = u.pm * BM; bool sg = false;
        if (colt < 2048) { base = pml; ldc = 1024; cbase = colt - 1536; }
        else if (colt < GATE0) { base = pml; ldc = 1024; cbase = colt - 3072 + 512; }
        else { base = pmg; ldc = 2048; cbase = colt - GATE0; bofs = 16; sg = true; }
        const int col0 = cbase + wc * 32 + 8 * fq, bcol0 = colt + bofs + wc * 32 + 8 * fq;
        f32x4 bv[2][2];
#pragma unroll
        for (int bj = 0; bj < 2; ++bj)
#pragma unroll
            for (int n = 0; n < 2; ++n) bv[bj][n] = *(const f32x4*)(bias + bcol0 + bj * HALF + 4 * n);
#pragma unroll
        for (int ai = 0; ai < 2; ++ai)
#pragma unroll
            for (int m = 0; m < 4; ++m) { bf16_t* rowp = base + (size_t)(row0 + wr * 64 + fr + ai * HALF + m * 16) * ldc + col0;
#pragma unroll
                for (int bj = 0; bj < 2; ++bj) { f32x4 v0 = acc[ai][bj][m][0] + bv[bj][0], v1 = acc[ai][bj][m][1] + bv[bj][1];
                    if (sg) {
#pragma unroll
                        for (int j = 0; j < 4; ++j) { v0[j] = sigm(v0[j]); v1[j] = sigm(v1[j]); } }
                    u32x4 w; w.x = cvt_pk_bf16(v0[0], v0[1]); w.y = cvt_pk_bf16(v0[2], v0[3]); w.z = cvt_pk_bf16(v1[0], v1[1]); w.w = cvt_pk_bf16(v1[2], v1[3]);
                    *(u32x4*)(rowp + bj * HALF) = w; }
                asm volatile("" ::: "memory"); }
    }
};

struct EpiMerge {
    static constexpr bool PERM = true, HAS_MID = true;
    bf16_t* Z; const bf16_t* pmg;
    __device__ __forceinline__ void mid(f32x4 (&acc)[2][2][4][2], const Unit& u, int wr, int wc, int fr, int fq) const {
        const int row0 = u.pm * BM + wr * 64 + fr, col0 = u.pn * BM + wc * 32 + 8 * fq;
#pragma unroll
        for (int ai = 0; ai < 2; ++ai)
#pragma unroll
            for (int m = 0; m < 4; ++m) {
                u32x4 ga[2], gb[2];
#pragma unroll
                for (int bj = 0; bj < 2; ++bj) { const bf16_t* gp = pmg + (size_t)(row0 + ai * HALF + m * 16) * 2048 + col0 + bj * HALF;
                    ga[bj] = *(const u32x4*)gp; gb[bj] = *(const u32x4*)(gp + 1024); }
#pragma unroll
                for (int bj = 0; bj < 2; ++bj) { const u32x4 a = ga[bj], b = gb[bj];
                    f32x4& v0 = acc[ai][bj][m][0]; f32x4& v1 = acc[ai][bj][m][1];
                    v0[0] *= bflo(a.x) * __builtin_amdgcn_rcpf(bflo(b.x)); v0[1] *= bfhi(a.x) * __builtin_amdgcn_rcpf(bfhi(b.x));
                    v0[2] *= bflo(a.y) * __builtin_amdgcn_rcpf(bflo(b.y)); v0[3] *= bfhi(a.y) * __builtin_amdgcn_rcpf(bfhi(b.y));
                    v1[0] *= bflo(a.z) * __builtin_amdgcn_rcpf(bflo(b.z)); v1[1] *= bfhi(a.z) * __builtin_amdgcn_rcpf(bfhi(b.z));
                    v1[2] *= bflo(a.w) * __builtin_amdgcn_rcpf(bflo(b.w)); v1[3] *= bfhi(a.w) * __builtin_amdgcn_rcpf(bfhi(b.w)); }
                if (m & 1) asm volatile("" ::: "memory"); }
    }
    __device__ __forceinline__ void operator()(const f32x4 (&acc)[2][2][4][2], const Unit& u, int wr, int wc, int fr, int fq) const {
        const int row0 = u.pm * BM + wr * 64 + fr, col0 = u.pn * BM + wc * 32 + 8 * fq;
#pragma unroll
        for (int ai = 0; ai < 2; ++ai) {
            u32x4 g[4][2];
#pragma unroll
            for (int m = 0; m < 4; ++m)
#pragma unroll
                for (int bj = 0; bj < 2; ++bj) g[m][bj] = *(const u32x4*)(pmg + (size_t)(row0 + ai * HALF + m * 16) * 2048 + 1024 + col0 + bj * HALF);
#pragma unroll
            for (int m = 0; m < 4; ++m)
#pragma unroll
                for (int bj = 0; bj < 2; ++bj) { const size_t row = (size_t)(row0 + ai * HALF + m * 16); const u32x4 gg = g[m][bj];
                    f32x4 v0 = acc[ai][bj][m][0], v1 = acc[ai][bj][m][1];
                    v0[0] *= bflo(gg.x); v0[1] *= bfhi(gg.x); v0[2] *= bflo(gg.y); v0[3] *= bfhi(gg.y);
                    v1[0] *= bflo(gg.z); v1[1] *= bfhi(gg.z); v1[2] *= bflo(gg.w); v1[3] *= bfhi(gg.w);
                    u32x4 w; w.x = cvt_pk_bf16(v0[0], v0[1]); w.y = cvt_pk_bf16(v0[2], v0[3]); w.z = cvt_pk_bf16(v1[0], v1[1]); w.w = cvt_pk_bf16(v1[2], v1[3]);
                    *(u32x4*)(Z + row * 1024 + col0 + bj * HALF) = w; }
            asm volatile("" ::: "memory"); }
    }
};

struct EpiOut {
    static constexpr bool PERM = true, HAS_MID = false;
    const float* x; bf16_t* xmid; const float* ada;
    __device__ __forceinline__ void operator()(const f32x4 (&acc)[2][2][4][2], const Unit& u, int wr, int wc, int fr, int fq) const {
        const int row0 = u.pm * BM + wr * 64 + fr, col0 = u.pn * BM + wc * 32 + 8 * fq;
        const int b = (u.pm * BM) / SEQ;
        f32x4 gv[2][2];
#pragma unroll
        for (int bj = 0; bj < 2; ++bj)
#pragma unroll
            for (int n = 0; n < 2; ++n) gv[bj][n] = *(const f32x4*)(ada + (size_t)b * 6144 + 2048 + col0 + bj * HALF + 4 * n);
#pragma unroll
        for (int ai = 0; ai < 2; ++ai)
#pragma unroll
            for (int m = 0; m < 4; ++m) {
                f32x4 xv[2][2]; const size_t off = (size_t)(row0 + ai * HALF + m * 16) * DM + col0;
#pragma unroll
                for (int bj = 0; bj < 2; ++bj)
#pragma unroll
                    for (int n = 0; n < 2; ++n) xv[bj][n] = *(const f32x4*)(x + off + bj * HALF + 4 * n);
#pragma unroll
                for (int bj = 0; bj < 2; ++bj) { const f32x4 v0 = xv[bj][0] + gv[bj][0] * acc[ai][bj][m][0], v1 = xv[bj][1] + gv[bj][1] * acc[ai][bj][m][1];
                    u32x4 w; w.x = cvt_pk_bf16(v0[0], v0[1]); w.y = cvt_pk_bf16(v0[2], v0[3]); w.z = cvt_pk_bf16(v1[0], v1[1]); w.w = cvt_pk_bf16(v1[2], v1[3]);
                    *(u32x4*)(xmid + off + bj * HALF) = w; }
                if (m & 1) asm volatile("" ::: "memory"); }
    }
};

struct EpiMoe1 {
    static constexpr bool PERM = true, HAS_MID = false;
    unsigned char* act; int skip;
    __device__ __forceinline__ void operator()(const f32x4 (&acc)[2][2][4][2], const Unit& u, int wr, int wc, int fr, int fq) const {
        if (skip == 1) { asm volatile("" :: "v"(acc[0][0][0][0]), "v"(acc[1][1][3][1])); return; }
        const int row0 = u.aux * 4096 + u.pm * BM + wr * 64 + fr, col0 = (u.pn * BM + wc * 32) / 2 + 4 * fq;
#pragma unroll
        for (int ai = 0; ai < 2; ++ai)
#pragma unroll
            for (int m = 0; m < 4; ++m) { unsigned char* rowp = act + (size_t)(row0 + ai * HALF + m * 16) * DFF + col0;
#pragma unroll
                for (int bj = 0; bj < 2; ++bj) { const f32x4 v0 = acc[ai][bj][m][0] * W8_INV, v1 = acc[ai][bj][m][1] * W8_INV;
                    const unsigned pk = pk4_fp8(siluf(v0[0]) * v0[1], siluf(v0[2]) * v0[3], siluf(v1[0]) * v1[1], siluf(v1[2]) * v1[3]);
                    if (skip == 2) asm volatile("" :: "v"(pk)); else *(unsigned*)(rowp + bj * (HALF / 2)) = pk; }
                asm volatile("" ::: "memory"); }
    }
};

struct EpiMoe2 {
    static constexpr bool PERM = true, HAS_MID = false;
    bf16_t* ye; const float* sgate; bool skip;
    __device__ __forceinline__ void operator()(const f32x4 (&acc)[2][2][4][2], const Unit& u, int wr, int wc, int fr, int fq) const {
        if (skip) { asm volatile("" :: "v"(acc[0][0][0][0]), "v"(acc[1][1][3][1])); return; }
        const int e = u.aux, col0 = u.pn * BM + wc * 32 + 8 * fq;
        float gt[2][4];
#pragma unroll
        for (int ai = 0; ai < 2; ++ai)
#pragma unroll
            for (int m = 0; m < 4; ++m) { const int rr = u.pm * BM + wr * 64 + fr + ai * HALF + m * 16; gt[ai][m] = sgate[((rr >> 9) * NE + e) * CAP + (rr & 511)] * W8_INV; }
#pragma unroll
        for (int ai = 0; ai < 2; ++ai)
#pragma unroll
            for (int m = 0; m < 4; ++m) { const int rr = u.pm * BM + wr * 64 + fr + ai * HALF + m * 16;
                const float g = gt[ai][m];
                bf16_t* rowp = ye + ((size_t)e * 4096 + rr) * DM + col0;
#pragma unroll
                for (int bj = 0; bj < 2; ++bj) { const f32x4 v0 = acc[ai][bj][m][0] * g, v1 = acc[ai][bj][m][1] * g;
                    u32x4 w; w.x = cvt_pk_bf16(v0[0], v0[1]); w.y = cvt_pk_bf16(v0[2], v0[3]); w.z = cvt_pk_bf16(v1[0], v1[1]); w.w = cvt_pk_bf16(v1[2], v1[3]);
                    *(u32x4*)(rowp + bj * HALF) = w; }
                asm volatile("" ::: "memory"); }
    }
};
}

struct Ctx {
    LAS unsigned char* lds;
    int tid, lane, wave, bid, G;
};

__device__ __forceinline__ void transpose_item(const float* W, int ldw, int ldt, int ncol0, bf16_t* WT, int dst_row0, int rmul, LAS float* scr, int kb, int nb, int lane) {
    const int k0 = 64 * kb, n0 = 32 * nb;
#pragma unroll 8
    for (int i = 0; i < 32; ++i) { const int kk = 2 * i + (lane >> 5); scr[kk * 33 + (lane & 31)] = W[(size_t)(k0 + kk) * ldw + ncol0 + n0 + (lane & 31)]; }
    LDS_WAIT();
    const int c = lane & 7;
#pragma unroll
    for (int j = 0; j < 4; ++j) { const int n = (lane >> 3) + 8 * j; const LAS float* s = scr + (8 * c) * 33 + n;
        u32x4 o; o.x = pk2(s[0 * 33], s[1 * 33]); o.y = pk2(s[2 * 33], s[3 * 33]); o.z = pk2(s[4 * 33], s[5 * 33]); o.w = pk2(s[6 * 33], s[7 * 33]);
        *(u32x4*)(WT + (size_t)(dst_row0 + (n0 + n) * rmul) * ldt + k0 + 8 * c) = o; }
    LDS_WAIT();
}

__device__ __forceinline__ void transpose_item_f8(const float* W, int ldw, int K, unsigned char* WT, int dst_row0, int rmul, LAS float* scr, int kb, int nb, int lane) {
    const int k0 = 64 * kb, n0 = 32 * nb;
#pragma unroll 8
    for (int i = 0; i < 32; ++i) { const int kk = 2 * i + (lane >> 5); scr[kk * 33 + (lane & 31)] = W[(size_t)(k0 + kk) * ldw + n0 + (lane & 31)]; }
    LDS_WAIT();
    const int c = lane & 3;
#pragma unroll
    for (int j = 0; j < 2; ++j) { const int n = (lane >> 2) + 16 * j; const LAS float* s = scr + (16 * c) * 33 + n;
        u32x4 o;
        o.x = pk4_fp8(s[0 * 33] * W8_SCALE, s[1 * 33] * W8_SCALE, s[2 * 33] * W8_SCALE, s[3 * 33] * W8_SCALE);
        o.y = pk4_fp8(s[4 * 33] * W8_SCALE, s[5 * 33] * W8_SCALE, s[6 * 33] * W8_SCALE, s[7 * 33] * W8_SCALE);
        o.z = pk4_fp8(s[8 * 33] * W8_SCALE, s[9 * 33] * W8_SCALE, s[10 * 33] * W8_SCALE, s[11 * 33] * W8_SCALE);
        o.w = pk4_fp8(s[12 * 33] * W8_SCALE, s[13 * 33] * W8_SCALE, s[14 * 33] * W8_SCALE, s[15 * 33] * W8_SCALE);
        *(u32x4*)(WT + (size_t)(dst_row0 + (n0 + n) * rmul) * K + k0 + 16 * c) = o; }
    LDS_WAIT();
}

__device__ __forceinline__ void convert_experts(const Ctx& C, const Params& P) {
    unsigned char* w13 = P.ws + WS_W13; unsigned char* w2 = P.ws + WS_W2;
    LAS float* scr = (LAS float*)(C.lds + C.wave * 8448);
    const int gw = C.bid * 8 + C.wave, NGW = C.G * 8;
    const int PER_E = 3072;
    for (int it = gw; it < NE * PER_E; it += NGW) {
        const int e = it / PER_E, r = it % PER_E;
        if (r < 1024) transpose_item_f8(P.in[23] + (size_t)e * DM * DFF, DFF, DM, w13 + (size_t)e * 4096 * DM, 0, 2, scr, r / 64, r % 64, C.lane);
        else if (r < 2048) transpose_item_f8(P.in[24] + (size_t)e * DM * DFF, DFF, DM, w13 + (size_t)e * 4096 * DM, 1, 2, scr, (r - 1024) / 64, (r - 1024) % 64, C.lane);
        else transpose_item_f8(P.in[25] + (size_t)e * DFF * DM, DM, DFF, w2 + (size_t)e * DM * DFF, 0, 1, scr, (r - 2048) / 32, (r - 2048) % 32, C.lane);
    }
}

__device__ __forceinline__ void phase0(const Ctx& C, const Params& P) {
    unsigned char* ws = P.ws;
    const int gw = C.bid * 8 + C.wave, NGW = C.G * 8;
    {
        LAS float* scr = (LAS float*)(C.lds + C.wave * 8448);
        const int I_IN1 = 16 * 112, I_IN2 = 16 * 64, I_BH = 8 * 32, I_BM = 8 * 32, I_OUT = 16 * 32;
        const int NIT = I_IN1 + I_IN2 + I_BH + I_BM + I_OUT;
        for (int it = gw; it < NIT; it += NGW) {
            int r = it;
            if (r < I_IN1) { transpose_item(P.in[8], DIN, DM, 0, (bf16_t*)(ws + WS_WIN), 0, 1, scr, r / 112, r % 112, C.lane); continue; } r -= I_IN1;
            if (r < I_IN2) { transpose_item(P.in[8], DIN, DM, MERGE0, (bf16_t*)(ws + WS_WIN), GATE0, 1, scr, r / 64, r % 64, C.lane); continue; } r -= I_IN2;
            if (r < I_BH) { transpose_item(P.in[19], DM, 1024, 0, (bf16_t*)(ws + WS_WB), 0, 1, scr, r / 32, r % 32, C.lane); continue; } r -= I_BH;
            if (r < I_BM) { transpose_item(P.in[20], DM, 1024, 0, (bf16_t*)(ws + WS_WB) + 512, 0, 1, scr, r / 32, r % 32, C.lane); continue; } r -= I_BM;
            transpose_item(P.in[21], DM, DM, 0, (bf16_t*)(ws + WS_WOUT), 0, 1, scr, r / 32, r % 32, C.lane);
        }
    }
    {
        const float* wada = P.in[4]; const float* bada = P.in[5]; float* part = (float*)(ws + WS_ADAP);
        for (int it = gw; it < 96 * 8; it += NGW) {
            const int cgp = it % 96, ks = it / 96, n = cgp * 64 + C.lane;
            float a[9];
#pragma unroll
            for (int r = 0; r < 9; ++r) a[r] = 0.f;
#pragma unroll 1
            for (int k1 = 0; k1 < 4; ++k1) {
                const int k0 = ks * 128 + k1 * 32;
                float sv[9];
                { const int k = k0 + (C.lane & 31);
#pragma unroll
                  for (int r = 0; r < 8; ++r) sv[r] = siluf(P.in[1][r * DM + k]);
                  sv[8] = siluf(P.in[3][k]); }
                float wv[32];
#pragma unroll
                for (int kk = 0; kk < 32; ++kk) wv[kk] = wada[(size_t)(k0 + kk) * 6144 + n];
#pragma unroll
                for (int kk = 0; kk < 32; ++kk) {
#pragma unroll
                    for (int r = 0; r < 9; ++r) a[r] += __shfl(sv[r], kk) * wv[kk]; }
            }
            const float bb = (ks == 0) ? bada[n] : 0.f;
#pragma unroll
            for (int r = 0; r < 9; ++r) part[((size_t)ks * 9 + r) * 6144 + n] = a[r] + bb;
        }
    }
    __syncthreads();
    {
        LAS float* zs = (LAS float*)C.lds;
        LAS float* h1 = zs + 16 * 33;
        LAS float* h2 = h1 + 16 * 64;
        LAS float* w1s = h2 + 16 * 64;
        LAS float* w2s = w1s + 33 * 64;
        bf16_t* krev = (bf16_t*)(ws + WS_KREV);
        const float* w1 = P.in[11]; const float* b1 = P.in[12]; const float* w2 = P.in[13]; const float* b2 = P.in[14]; const float* w3 = P.in[15];
        for (int idx = C.tid; idx < 33 * 64; idx += NTHR) w1s[idx] = w1[idx];
        for (int idx = C.tid; idx < 64 * 64; idx += NTHR) w2s[idx] = w2[idx];
        for (int it = C.bid; it < 256; it += C.G) {
            const int l0 = it * 16;
            __syncthreads();
            for (int idx = C.tid; idx < 16 * 33; idx += NTHR) { const int pos = idx / 33, m = idx % 33, l = l0 + pos; float v;
                if (m == 0) v = (float)l / 4095.0f;
                else { const int bi = (m - 1) & 15; const float band = 1e-4f + (float)bi * ((15.0f - 1e-4f) / 15.0f);
                    const float ang = ((float)(2.0 * 3.14159265358979323846 / 4096.0) * (float)l) * band; v = (m <= 16) ? cosf(ang) : sinf(ang); }
                zs[idx] = v; }
            __syncthreads();
            for (int idx = C.tid; idx < 16 * 64; idx += NTHR) { const int pos = idx >> 6, j = idx & 63; float s = b1[j];
#pragma unroll
                for (int m = 0; m < 33; ++m) s += zs[pos * 33 + m] * w1s[m * 64 + j];
                h1[idx] = sinf(s); }
            __syncthreads();
            for (int idx = C.tid; idx < 16 * 64; idx += NTHR) { const int pos = idx >> 6, j = idx & 63; float s = b2[j];
#pragma unroll 16
                for (int k = 0; k < 64; ++k) s += h1[pos * 64 + k] * w2s[k * 64 + j];
                h2[j * 16 + pos] = sinf(s); }
            __syncthreads();
#pragma unroll 1
            for (int q = 0; q < 4; ++q) {
                const int n = C.tid + NTHR * q;
                float a[16];
#pragma unroll
                for (int p = 0; p < 16; ++p) a[p] = 0.f;
                float wv[16];
#pragma unroll
                for (int k = 0; k < 16; ++k) wv[k] = w3[k * 2048 + n];
#pragma unroll 1
                for (int kb = 0; kb < 4; ++kb) {
                    float wc[16];
#pragma unroll
                    for (int k = 0; k < 16; ++k) wc[k] = wv[k];
                    const int kn = (kb < 3) ? (kb + 1) * 16 : 0;
#pragma unroll
                    for (int k = 0; k < 16; ++k) wv[k] = w3[(kn + k) * 2048 + n];
#pragma unroll
                    for (int kk = 0; kk < 16; ++kk) { const float w = wc[kk]; const LAS float* hp = h2 + (kb * 16 + kk) * 16;
#pragma unroll
                        for (int p4 = 0; p4 < 4; ++p4) { const f32x4 hv = *(const LAS f32x4*)(hp + 4 * p4);
                            a[4 * p4] += hv[0] * w; a[4 * p4 + 1] += hv[1] * w; a[4 * p4 + 2] += hv[2] * w; a[4 * p4 + 3] += hv[3] * w; }
                        if (kk & 1) asm volatile("" ::: "memory"); }
                }
                const int o = n >> 10, side = (n >> 9) & 1, c = n & 511;
                const float delta = fabsf(-3.0701134573253944f + (float)c * ((-15.350567286626972f + 3.0701134573253944f) / 511.0f));
                bf16_t* dst = krev + ((size_t)o * 512 + c) * 8192;
#pragma unroll
                for (int p = 0; p < 16; ++p) { const int l = l0 + p; const float t = (float)l / 4095.0f; const float v = a[p] * expf(-t * delta);
                    if (side == 0) dst[4096 - l] = (bf16_t)f2bf(v);
                    else if (l > 0) dst[4096 + l] = (bf16_t)f2bf(v);
                    else dst[0] = 0; }
            }
        }
    }
}

__device__ __forceinline__ int wl_pos(int k) { return ((k & 3) + 4 * (k >> 8)) * 64 + ((k >> 2) & 63); }
__device__ __forceinline__ float row_dot16(const f32x4 (&y)[4], const LAS float* Wl, int lane) {
    float r[16];
#pragma unroll
    for (int e = 0; e < 16; ++e) r[e] = 0.f;
#pragma unroll
    for (int j = 0; j < 4; ++j) {
#pragma unroll
        for (int q = 0; q < 4; ++q) { const float v = y[j][q]; const LAS float* wp = Wl + ((q + 4 * j) * 64 + lane) * 20;
#pragma unroll
            for (int e4 = 0; e4 < 4; ++e4) { const f32x4 w = *(const LAS f32x4*)(wp + e4 * 4);
                r[e4 * 4 + 0] += v * w[0]; r[e4 * 4 + 1] += v * w[1]; r[e4 * 4 + 2] += v * w[2]; r[e4 * 4 + 3] += v * w[3]; } }
        asm volatile("" ::: "memory"); }
    const bool b5 = (lane & 32) != 0, b4 = (lane & 16) != 0, b3 = (lane & 8) != 0, b2 = (lane & 4) != 0;
    float t[8];
#pragma unroll
    for (int e = 0; e < 8; ++e) { const float snd = b5 ? r[e] : r[e + 8], kp = b5 ? r[e + 8] : r[e]; t[e] = kp + __shfl_xor(snd, 32); }
    float u[4];
#pragma unroll
    for (int e = 0; e < 4; ++e) { const float snd = b4 ? t[e] : t[e + 4], kp = b4 ? t[e + 4] : t[e]; u[e] = kp + __shfl_xor(snd, 16); }
    float v2[2];
#pragma unroll
    for (int e = 0; e < 2; ++e) { const float snd = b3 ? u[e] : u[e + 2], kp = b3 ? u[e + 2] : u[e]; v2[e] = kp + __shfl_xor(snd, 8); }
    float s; { const float snd = b2 ? v2[0] : v2[1], kp = b2 ? v2[1] : v2[0]; s = kp + __shfl_xor(snd, 4); }
    s += __shfl_xor(s, 2); s += __shfl_xor(s, 1);
    return s;
}

__device__ __forceinline__ void phase1(const Ctx& C, const Params& P) {
    unsigned char* ws = P.ws;
    const float* part = (const float*)(ws + WS_ADAP); float* ada = (float*)(ws + WS_ADA);
    for (int o = C.bid * NTHR + C.tid; o < 9 * 6144; o += C.G * NTHR) { float s = 0.f;
#pragma unroll
        for (int ks = 0; ks < 8; ++ks) s += part[(size_t)ks * 9 * 6144 + o];
        ada[o] = s; }
    LAS float* Wg = (LAS float*)C.lds;
    LAS float* mod = Wg + 1024 * 20;
    for (int idx = C.tid; idx < 1024 * 16; idx += NTHR) Wg[wl_pos(idx >> 4) * 20 + (idx & 15)] = P.in[8][(size_t)(idx >> 4) * DIN + GATE0 + (idx & 15)];
    const float* gmix = P.in[6]; const float* bin = P.in[9];
    bf16_t* hx = (bf16_t*)(ws + WS_HX); float* gates = (float*)(ws + WS_GATES);
    for (int rg = C.bid; rg < 256; rg += C.G) {
        const int b = rg >> 5;
        __syncthreads();
        for (int idx = C.tid; idx < 4096; idx += NTHR) { const int which = idx >> 10, k = idx & 1023; const int r = (which < 2) ? b : 8; const int col = (which & 1) * 1024 + k;
            float s = 0.f;
#pragma unroll
            for (int ks = 0; ks < 8; ++ks) s += part[((size_t)ks * 9 + r) * 6144 + col];
            mod[idx] = s; }
        __syncthreads();
        auto rowsrc = [&](int rr) -> const float* { return (rr < 128) ? (P.in[0] + (size_t)(rg * 128 + rr) * DM) : (P.in[2] + (size_t)(rg * 8 + (rr - 128)) * DM); };
        f32x4 nx[4];
        { const float* s0 = rowsrc(C.wave);
#pragma unroll
          for (int j = 0; j < 4; ++j) nx[j] = *(const f32x4*)(s0 + 4 * C.lane + 256 * j); }
        for (int rr = C.wave; rr < 136; rr += 8) {
            const bool isx = rr < 128; const int grow = isx ? (rg * 128 + rr) : (MX + rg * 8 + (rr - 128));
            const LAS float* sh = mod + (isx ? 0 : 2048); const LAS float* sc = sh + 1024;
            f32x4 v[4]; float ss = 0.f;
#pragma unroll
            for (int j = 0; j < 4; ++j) { v[j] = nx[j]; ss += v[j][0] * v[j][0] + v[j][1] * v[j][1] + v[j][2] * v[j][2] + v[j][3] * v[j][3]; }
            if (rr + 8 < 136) { const float* s1 = rowsrc(rr + 8);
#pragma unroll
                for (int j = 0; j < 4; ++j) nx[j] = *(const f32x4*)(s1 + 4 * C.lane + 256 * j); }
            const float rstd = rsqrtf(wave_sum(ss) * (1.f / DM) + RMS_EPS);
#pragma unroll
            for (int j = 0; j < 4; ++j) { const int k = 4 * C.lane + 256 * j; const f32x4 g = *(const f32x4*)(gmix + k);
                const f32x4 s4 = *(const LAS f32x4*)(sc + k), h4 = *(const LAS f32x4*)(sh + k);
#pragma unroll
                for (int q = 0; q < 4; ++q) v[j][q] = (v[j][q] * rstd * g[q]) * (1.f + s4[q]) + h4[q];
                u32x2 w; w.x = pk2(v[j][0], v[j][1]); w.y = pk2(v[j][2], v[j][3]);
                *(u32x2*)(hx + (size_t)grow * DM + k) = w; }
            const float gsum = row_dot16(v, Wg, C.lane);
            if ((C.lane & 3) == 0) gates[(size_t)grow * 16 + (C.lane >> 2)] = gsum + bin[GATE0 + (C.lane >> 2)];
        }
    }
}

__device__ __forceinline__ void phase2a(const Ctx& C, const Params& P) {
    unsigned char* ws = P.ws;
    pg8::SchedGrid S{(const char*)(ws + WS_HX), (const char*)(ws + WS_WIN), (size_t)256 * 2048, (size_t)256 * 2048, 128, 10, 0, 0, C.G, C.bid, 4, 128, 8, 32, 6, 2};
    pg8::EpiCM E{(bf16_t*)(ws + WS_PCM), (bf16_t*)(ws + WS_KVCM), P.in[9]};
    pg8::gemm_phase<pg8::EpiCM, pg8::SchedGrid, true>(C.lds, 1024, 2048, 2048, S, E);
}
__device__ __forceinline__ void phase2b(const Ctx& C, const Params& P) {
    unsigned char* ws = P.ws;
    pg8::SchedGrid S{(const char*)(ws + WS_HX), (const char*)(ws + WS_WIN), (size_t)256 * 2048, (size_t)256 * 2048, 128, 12, 0, 6, C.G, C.bid, 1, 0, 0, 0, 2, 4};
    pg8::EpiIn2 E{(bf16_t*)(ws + WS_PML), (bf16_t*)P.out, P.in[9]};
    pg8::gemm_phase<pg8::EpiIn2, pg8::SchedGrid, false>(C.lds, 1024, 2048, 2048, S, E);
}
__device__ __forceinline__ void phase_merge(const Ctx& C, const Params& P) {
    unsigned char* ws = P.ws;
    pg8::SchedChain S{{(const char*)(ws + WS_YAB), (const char*)(ws + WS_WB), (size_t)256 * 2048, (size_t)256 * 2048, 128, 4, 0, 0, C.G, C.bid, 1, 0, 0, 0, 1 << 30, 0}, 1024};
    pg8::EpiMerge E{(bf16_t*)(ws + WS_Z), (const bf16_t*)P.out};
    pg8::gemm_phase<pg8::EpiMerge, pg8::SchedChain, false>(C.lds, 512, 2048, 2048, S, E);
}
__device__ __forceinline__ void phase_outproj(const Ctx& C, const Params& P) {
    unsigned char* ws = P.ws;
    pg8::SchedGrid S{(const char*)(ws + WS_Z), (const char*)(ws + WS_WOUT), (size_t)256 * 2048, (size_t)256 * 2048, 128, 4, 0, 0, C.G, C.bid, 1, 0, 0, 0, 1 << 30, 0};
    pg8::EpiOut E{P.in[0], (bf16_t*)(ws + WS_XMID), (const float*)(ws + WS_ADA)};
    pg8::gemm_phase<pg8::EpiOut, pg8::SchedGrid, false>(C.lds, 1024, 2048, 2048, S, E);
}

constexpr int HY_KSTR = 16448;
constexpr int HY_UOFF = 4 * HY_KSTR;
constexpr int HY_USTR = 4616;
template <int MODE>
__device__ __forceinline__ void hyena_item(const Ctx& C, const Params& P, int o, int c) {
    unsigned char* ws = P.ws;
    LAS bf16_t* krv = (LAS bf16_t*)C.lds;
    LAS bf16_t* up = (LAS bf16_t*)(C.lds + HY_UOFF);
    const bf16_t* pcm = (const bf16_t*)(ws + WS_PCM);
    const float* hconv = P.in[10];
    __syncthreads();
    {
        const u32x4* src = (const u32x4*)((const bf16_t*)(ws + WS_KREV) + ((size_t)o * 512 + c) * 8192);
        for (int i = C.tid; i < 1024; i += NTHR) *(LAS u32x4*)(krv + 8 * i) = src[i];
        for (int i = C.tid; i < 8 * 65; i += NTHR) { const int b = i / 65, q = i % 65; const int off = (q < 32) ? 8 * q : (4352 + 8 * (q - 32));
            *(LAS u32x4*)(up + b * HY_USTR + off) = (u32x4){0u, 0u, 0u, 0u}; }
        if (o == 0) {
            const bf16_t* src0 = pcm + (size_t)c * MX; const float w0 = hconv[c], w1 = hconv[1536 + c], w2 = hconv[3072 + c];
            u32x4 vv[8]; unsigned vl[8], vr[8];
#pragma unroll
            for (int it = 0; it < 8; ++it) { const int r0 = 8 * (C.tid + NTHR * it); vv[it] = *(const u32x4*)(src0 + r0); vl[it] = *(const unsigned*)(src0 + r0 - 2); vr[it] = *(const unsigned*)(src0 + r0 + 8); }
#pragma unroll
            for (int it = 0; it < 8; ++it) { const int r0 = 8 * (C.tid + NTHR * it); const u32x4 v = vv[it];
                float x[10]; x[1] = bflo(v.x); x[2] = bfhi(v.x); x[3] = bflo(v.y); x[4] = bfhi(v.y); x[5] = bflo(v.z); x[6] = bfhi(v.z); x[7] = bflo(v.w); x[8] = bfhi(v.w);
                x[0] = ((r0 & 63) != 0) ? bfhi(vl[it]) : 0.f; x[9] = ((r0 & 63) != 56) ? bflo(vr[it]) : 0.f;
                float y[8];
#pragma unroll
                for (int j = 0; j < 8; ++j) y[j] = w0 * x[j] + w1 * x[j + 1] + w2 * x[j + 2];
                u32x4 w; w.x = pk2(y[0], y[1]); w.y = pk2(y[2], y[3]); w.z = pk2(y[4], y[5]); w.w = pk2(y[6], y[7]);
                *(LAS u32x4*)(up + (r0 >> 12) * HY_USTR + 256 + (r0 & 4095)) = w; }
        } else {
            const u32x4* src1 = (const u32x4*)((const bf16_t*)(ws + WS_Z1) + (size_t)c * MX);
            u32x4 vv[8];
#pragma unroll
            for (int it = 0; it < 8; ++it) vv[it] = src1[C.tid + NTHR * it];
#pragma unroll
            for (int it = 0; it < 8; ++it) { const int r0 = 8 * (C.tid + NTHR * it); *(LAS u32x4*)(up + (r0 >> 12) * HY_USTR + 256 + (r0 & 4095)) = vv[it]; }
        }
    }
    __syncthreads();
    for (int idx = C.tid; idx < 3 * 1025; idx += NTHR) { const int rho = 1 + idx / 1025, ch = idx % 1025; unsigned short e[8];
#pragma unroll
        for (int j = 0; j < 8; ++j) { const int z = 8 * ch + j - rho; e[j] = (z >= 0 && z < 8192) ? krv[z] : (unsigned short)0; }
        u32x4 w; w.x = e[0] | ((unsigned)e[1] << 16); w.y = e[2] | ((unsigned)e[3] << 16); w.z = e[4] | ((unsigned)e[5] << 16); w.w = e[6] | ((unsigned)e[7] << 16);
        *(LAS u32x4*)(C.lds + rho * HY_KSTR + 16 * ch) = w; }
    if (C.tid == 0) *(LAS u32x4*)(C.lds + 16 * 1024) = (u32x4){0u, 0u, 0u, 0u};
    __syncthreads();
    const int lane = C.lane, w = C.wave, kh = w >> 2, wq = w & 3, i = lane & 31, kq = lane >> 5, nb = (lane >> 2) & 7, np = lane & 3, rho = i & 3;
    f32x16 acc[4][2];
#pragma unroll
    for (int a = 0; a < 4; ++a)
#pragma unroll
        for (int pg = 0; pg < 2; ++pg)
#pragma unroll
            for (int r = 0; r < 16; ++r) acc[a][pg][r] = 0.f;
    const int abase = rho * HY_KSTR + 2 * (4096 - i + 8 * kq + rho) - 2048 * wq - 1536;
    const int bbase = HY_UOFF + 2 * (nb * HY_USTR + 256 + 32 * np + 8 * kq);
    typedef const volatile LAS u32x2* vp2;
#define HY_LOAD(AF, BF, s0) do { const int _a = abase + 2 * (s0), _b = bbase + 2 * (s0); \
        BF[0] = *(const LAS bf16x8*)(C.lds + _b); BF[1] = *(const LAS bf16x8*)(C.lds + _b + 256); \
        _Pragma("unroll") for (int a = 0; a < 4; ++a) { const u32x2 lo = *(vp2)(C.lds + _a + 512 * (3 - a)), hi = *(vp2)(C.lds + _a + 512 * (3 - a) + 8); \
            AF[a] = __builtin_bit_cast(bf16x8, (u32x4){lo.x, lo.y, hi.x, hi.y}); } } while (0)
#define HY_MMA(AF, BF) do { _Pragma("unroll") for (int a = 0; a < 4; ++a) _Pragma("unroll") for (int pg = 0; pg < 2; ++pg) \
        acc[a][pg] = __builtin_amdgcn_mfma_f32_32x32x16_bf16(AF[a], BF[pg], acc[a][pg], 0, 0, 0); } while (0)
    bf16x8 a0[4], a1[4], b0[2], b1[2];
    const int sbeg = -224 + 16 * 135 * kh;
    HY_LOAD(a0, b0, sbeg);
#pragma unroll 1
    for (int j = 0; j < (MODE == 1 ? 0 : 134); j += 2) {
        HY_LOAD(a1, b1, sbeg + 16 * (j + 1));
        __builtin_amdgcn_sched_barrier(0);
        HY_MMA(a0, b0);
        __builtin_amdgcn_sched_barrier(0);
        HY_LOAD(a0, b0, sbeg + 16 * (j + 2));
        __builtin_amdgcn_sched_barrier(0);
        HY_MMA(a1, b1);
        __builtin_amdgcn_sched_barrier(0);
    }
    HY_MMA(a0, b0);
#undef HY_LOAD
#undef HY_MMA
    const float skip = P.in[16][o * 512 + c];
    if (kh == 0) {
#pragma unroll
        for (int a = 0; a < 4; ++a)
#pragma unroll
            for (int pg = 0; pg < 2; ++pg)
#pragma unroll
                for (int g = 0; g < 4; ++g) { const int t0 = 1024 * wq + 256 * a + 128 * pg + 32 * np + 8 * g + 4 * kq;
                    const u32x2 uv = *(const LAS u32x2*)(up + nb * HY_USTR + 256 + t0);
                    acc[a][pg][4 * g + 0] += skip * bflo(uv.x); acc[a][pg][4 * g + 1] += skip * bfhi(uv.x); acc[a][pg][4 * g + 2] += skip * bflo(uv.y); acc[a][pg][4 * g + 3] += skip * bfhi(uv.y); }
    }
    __syncthreads();
    {
        LAS f32x4* slot = (LAS f32x4*)(C.lds + w * 16384);
#pragma unroll
        for (int al = 0; al < 2; ++al)
#pragma unroll
            for (int pg = 0; pg < 2; ++pg)
#pragma unroll
                for (int g = 0; g < 4; ++g) { const int a = kh ? al : 2 + al; const f32x16& v = acc[a][pg];
                    slot[((al * 2 + pg) * 4 + g) * 64 + lane] = (f32x4){v[4 * g], v[4 * g + 1], v[4 * g + 2], v[4 * g + 3]}; }
    }
    __syncthreads();
    const int gch = (o == 0 ? 512 : 1024) + c;
    const float w0 = hconv[gch], w1 = hconv[1536 + gch], w2 = hconv[3072 + gch];
    const bf16_t* gsrc = pcm + (size_t)gch * MX + (size_t)nb * SEQ;
    bf16_t* dst = (bf16_t*)(ws + (o == 0 ? WS_Z1 : WS_Z2CM)) + (size_t)c * MX + (size_t)nb * SEQ;
    const LAS f32x4* pslot = (const LAS f32x4*)(C.lds + (w ^ 4) * 16384);
#pragma unroll
    for (int al = 0; al < 2; ++al) {
        const int a = kh ? 2 + al : al;
        u32x2 gvv[2][4]; unsigned gl[2][4], gr[2][4];
#pragma unroll
        for (int pg = 0; pg < 2; ++pg)
#pragma unroll
            for (int g = 0; g < 4; ++g) { const int t0 = 1024 * wq + 256 * a + 128 * pg + 32 * np + 8 * g + 4 * kq;
                gvv[pg][g] = *(const u32x2*)(gsrc + t0); gl[pg][g] = *(const unsigned*)(gsrc + t0 - 2); gr[pg][g] = *(const unsigned*)(gsrc + t0 + 4); }
#pragma unroll
        for (int pg = 0; pg < 2; ++pg)
#pragma unroll
            for (int g = 0; g < 4; ++g) {
                const int t0 = 1024 * wq + 256 * a + 128 * pg + 32 * np + 8 * g + 4 * kq;
                const f32x4 pv = pslot[((al * 2 + pg) * 4 + g) * 64 + lane];
                const u32x2 gv = gvv[pg][g];
                float x[6]; x[1] = bflo(gv.x); x[2] = bfhi(gv.x); x[3] = bflo(gv.y); x[4] = bfhi(gv.y);
                x[0] = ((t0 & 63) != 0) ? bfhi(gl[pg][g]) : 0.f; x[5] = ((t0 & 63) != 60) ? bflo(gr[pg][g]) : 0.f;
                float z[4];
#pragma unroll
                for (int j = 0; j < 4; ++j) { const float gate = w0 * x[j] + w1 * x[j + 1] + w2 * x[j + 2]; z[j] = gate * (acc[a][pg][4 * g + j] + pv[j]); }
                u32x2 wv; wv.x = pk2(z[0], z[1]); wv.y = pk2(z[2], z[3]);
                if (MODE == 1) { if (z[0] == 12345.678f) *(u32x2*)(dst + t0) = wv; } else *(u32x2*)(dst + t0) = wv;
            }
    }
}

typedef short s16x4 __attribute__((ext_vector_type(4)));
__device__ __forceinline__ unsigned off_b(unsigned row, unsigned ch) { return 256u * row + 16u * (ch ^ (((row & 3) << 2) | ((row >> 2) & 3))); }
__device__ __forceinline__ bf16x8 tile_row_read(const LAS unsigned char* T, int lane, int rb, int s) { return *(const LAS bf16x8*)(T + off_b((lane & 15) + 16 * rb, 4 * s + (lane >> 4))); }
__device__ __forceinline__ bf16x8 tile_tr_read(const LAS unsigned char* T, int lane, int c, int ks) {
    const unsigned g = lane >> 4, q = (lane & 15) >> 2, p = lane & 3;
    const unsigned a0 = off_b(32 * ks + 8 * g + q, 2 * c + (p >> 1)) + 8 * (p & 1), a1 = off_b(32 * ks + 8 * g + 4 + q, 2 * c + (p >> 1)) + 8 * (p & 1);
    const s16x4 lo = __builtin_amdgcn_ds_read_tr16_b64_v4i16((LAS s16x4*)(T + a0)), hi = __builtin_amdgcn_ds_read_tr16_b64_v4i16((LAS s16x4*)(T + a1));
    return __builtin_shufflevector(lo, hi, 0, 1, 2, 3, 4, 5, 6, 7);
}
struct ChunkRef { int isctx, b, h, d, oc; };
__device__ __forceinline__ int chunk_row0(const ChunkRef& r) { return r.isctx ? (MX + r.b * CTXL + r.oc * 128) : (r.b * SEQ + r.oc * 128); }

__device__ __forceinline__ void load_kv_tiles(const Ctx& C, const Params& P, const ChunkRef& r, LAS unsigned char* KT, LAS unsigned char* VT, const LAS float* vscale) {
    const bf16_t* kvcm = (const bf16_t*)(P.ws + WS_KVCM); const float* cw = P.in[17];
    const int col0 = chunk_row0(r), rowlen = r.isctx ? CTXL : 64, orig0 = r.oc * 128;
    for (int idx = C.tid; idx < 2048; idx += NTHR) { const int d = idx >> 4, ch = idx & 15, s0 = 8 * ch;
        const bf16_t* src = kvcm + (size_t)(r.h * 128 + d) * MT + col0 + s0;
        const u32x4 v = *(const u32x4*)src;
        float x[10]; x[1] = bflo(v.x); x[2] = bfhi(v.x); x[3] = bflo(v.y); x[4] = bfhi(v.y); x[5] = bflo(v.z); x[6] = bfhi(v.z); x[7] = bflo(v.w); x[8] = bfhi(v.w);
        x[0] = (((orig0 + s0) % rowlen) != 0) ? bf2f(src[-1]) : 0.f; x[9] = (((orig0 + s0 + 7) % rowlen) != rowlen - 1) ? bf2f(src[8]) : 0.f;
        const int cc = 512 + r.h * 128 + d; const float w0 = cw[cc], w1 = cw[1024 + cc], w2 = cw[2048 + cc];
        float y[8];
#pragma unroll
        for (int j = 0; j < 8; ++j) y[j] = siluf(w0 * x[j] + w1 * x[j + 1] + w2 * x[j + 2]);
        u32x4 o; o.x = pk2(y[0], y[1]); o.y = pk2(y[2], y[3]); o.z = pk2(y[4], y[5]); o.w = pk2(y[6], y[7]);
        *(LAS u32x4*)(KT + off_b(d, ch)) = o;
        const u32x4 vv = *(const u32x4*)(kvcm + (size_t)(512 + r.h * 128 + d) * MT + col0 + s0);
        if (vscale) { const f32x4 sa = *(const LAS f32x4*)(vscale + s0), sb = *(const LAS f32x4*)(vscale + s0 + 4);
            u32x4 ov; ov.x = pk2(bflo(vv.x) * sa[0], bfhi(vv.x) * sa[1]); ov.y = pk2(bflo(vv.y) * sa[2], bfhi(vv.y) * sa[3]);
            ov.z = pk2(bflo(vv.z) * sb[0], bfhi(vv.z) * sb[1]); ov.w = pk2(bflo(vv.w) * sb[2], bfhi(vv.w) * sb[3]);
            *(LAS u32x4*)(VT + off_b(d, ch)) = ov; }
        else *(LAS u32x4*)(VT + off_b(d, ch)) = vv; }
}

__device__ __forceinline__ void mlstm_a_pair(const Ctx& C, const Params& P, int item0) {
    unsigned char* ws = P.ws;
    auto make_ref = [](int it) { ChunkRef q; const int j = it % NCHK, seq = it / NCHK; q.h = seq & 3; q.b = (seq >> 2) & 7; q.d = seq >> 5; q.isctx = j < 2;
        const int jj = q.isctx ? j : j - 2, nch = q.isctx ? 2 : 32; q.oc = q.d ? (nch - 1 - jj) : jj; return q; };
    const bool valid1 = item0 + 1 < 64 * NCHK;
    const ChunkRef r0 = make_ref(item0), r1 = make_ref(valid1 ? item0 + 1 : item0);
    __syncthreads();
    if (C.wave == 0 || (C.wave == 1 && valid1)) {
        const int z = C.wave, item = item0 + z; const ChunkRef rz = make_ref(item); const int d = rz.d, h = rz.h;
        LAS float* wl = (LAS float*)(C.lds + z * 66560 + 65536);
        const float* gates = (const float*)(ws + WS_GATES) + (size_t)chunk_row0(rz) * 16;
        const int p0 = 2 * C.lane, t0 = d ? 127 - p0 : p0, t1 = d ? 126 - p0 : p0 + 1;
        const float li0 = gates[(size_t)t0 * 16 + (d ? 8 : 0) + h], li1 = gates[(size_t)t1 * 16 + (d ? 8 : 0) + h];
        const float lf0 = logsig(gates[(size_t)t0 * 16 + (d ? 12 : 4) + h]), lf1 = logsig(gates[(size_t)t1 * 16 + (d ? 12 : 4) + h]);
        float run = lf0 + lf1;
#pragma unroll
        for (int o = 1; o < 64; o <<= 1) { const float t = __shfl_up(run, o); if (C.lane >= o) run += t; }
        const float b1 = run, b0 = run - lf1;
        const float c0 = li0 - b0, c1 = li1 - b1;
        float gm = fmaxf(c0, c1);
#pragma unroll
        for (int o = 1; o < 64; o <<= 1) { const float t = __shfl_up(gm, o); if (C.lane >= o) gm = fmaxf(gm, t); }
        float gprev = __shfl_up(gm, 1); if (C.lane == 0) gprev = -3.0e38f;
        const float g0 = fmaxf(gprev, c0), g1 = gm;
        const float Bj = __shfl(b1, 63), gfin = __shfl(gm, 63);
        wl[t0] = __expf(c0 - gfin); wl[t1] = __expf(c1 - gfin);
        float* gc = (float*)(ws + WS_GC) + (size_t)item * 384;
        gc[t0] = c0; gc[t1] = c1; gc[128 + t0] = b0; gc[128 + t1] = b1; gc[256 + t0] = g0; gc[256 + t1] = g1;
        if (C.lane == 0) { float* bl = (float*)(ws + WS_BL) + (size_t)item * 2; bl[0] = Bj; bl[1] = Bj + gfin; }
    }
    __syncthreads();
    load_kv_tiles(C, P, r0, C.lds, C.lds + 32768, (const LAS float*)(C.lds + 65536));
    if (valid1) load_kv_tiles(C, P, r1, C.lds + 66560, C.lds + 66560 + 32768, (const LAS float*)(C.lds + 66560 + 65536));
    __syncthreads();
    if (C.tid < 256) { const int z = C.tid >> 7, dd = C.tid & 127;
        if (z == 0 || valid1) { const LAS unsigned char* KT = C.lds + z * 66560; const LAS float* wl = (const LAS float*)(C.lds + z * 66560 + 65536); float s = 0.f;
            for (int ch = 0; ch < 16; ++ch) { const u32x4 kv = *(const LAS u32x4*)(KT + off_b(dd, ch)); const f32x4 wa = *(const LAS f32x4*)(wl + 8 * ch), wb = *(const LAS f32x4*)(wl + 8 * ch + 4);
                s += bflo(kv.x) * wa[0] + bfhi(kv.x) * wa[1] + bflo(kv.y) * wa[2] + bfhi(kv.y) * wa[3] + bflo(kv.z) * wb[0] + bfhi(kv.z) * wb[1] + bflo(kv.w) * wb[2] + bfhi(kv.w) * wb[3]; }
            ((float*)(ws + WS_NLOC))[(size_t)(item0 + z) * 128 + dd] = s; } }
    const int lane = C.lane, w = C.wave, fr = lane & 15, fq = lane >> 4;
#pragma unroll
    for (int z = 0; z < 2; ++z) {
        if (z == 1 && !valid1) continue;
        const LAS unsigned char* KT = C.lds + z * 66560; const LAS unsigned char* VT = KT + 32768;
        bf16x8 af[4];
#pragma unroll
        for (int ks = 0; ks < 4; ++ks) af[ks] = tile_row_read(VT, lane, w, ks);
        bf16_t* dst = (bf16_t*)(ws + WS_PLOC) + (size_t)(item0 + z) * 16384;
#pragma unroll
        for (int nt = 0; nt < 8; ++nt) { f32x4 acc = (f32x4){0.f, 0.f, 0.f, 0.f};
#pragma unroll
            for (int ks = 0; ks < 4; ++ks) acc = __builtin_amdgcn_mfma_f32_16x16x32_bf16(af[ks], tile_row_read(KT, lane, nt, ks), acc, 0, 0, 0);
#pragma unroll
            for (int q = 0; q < 4; ++q) dst[(16 * w + 4 * fq + q) * 128 + 16 * nt + fr] = (bf16_t)f2bf(acc[q]); }
    }
}

__device__ __forceinline__ void mlstm_scan(const Ctx& C, const Params& P) {
    unsigned char* ws = P.ws;
    const float* BL = (const float*)(ws + WS_BL); const bf16_t* ploc = (const bf16_t*)(ws + WS_PLOC); bf16_t* cst = (bf16_t*)(ws + WS_CST);
    for (int slot = C.bid * NTHR + C.tid; slot < 64 * 2048; slot += C.G * NTHR) {
        const int seq = slot >> 11, off = (slot & 2047) * 8;
        float cs[8];
#pragma unroll
        for (int q = 0; q < 8; ++q) cs[q] = 0.f;
        float m = 0.f;
        u32x4 pl[NCHK - 1];
#pragma unroll
        for (int j = 0; j < NCHK - 1; ++j) pl[j] = *(const u32x4*)(ploc + ((size_t)(seq * NCHK + j)) * 16384 + off);
#pragma unroll
        for (int j = 0; j < NCHK; ++j) {
            if (j >= 2) { u32x4 o; o.x = pk2(cs[0], cs[1]); o.y = pk2(cs[2], cs[3]); o.z = pk2(cs[4], cs[5]); o.w = pk2(cs[6], cs[7]);
                *(u32x4*)(cst + ((size_t)(seq * 32 + j - 2)) * 16384 + off) = o;
                if (off == 0) ((float*)(ws + WS_MST))[seq * 32 + j - 2] = m; }
            if (j < NCHK - 1) {
                const float Bj = BL[(seq * NCHK + j) * 2], Lj = BL[(seq * NCHK + j) * 2 + 1];
                const float mn = fmaxf(Bj + m, Lj), dec = __expf(Bj + m - mn), sc = __expf(Lj - mn);
                const unsigned p4[4] = {pl[j].x, pl[j].y, pl[j].z, pl[j].w};
#pragma unroll
                for (int q = 0; q < 4; ++q) { cs[2 * q] = dec * cs[2 * q] + sc * bflo(p4[q]); cs[2 * q + 1] = dec * cs[2 * q + 1] + sc * bfhi(p4[q]); }
                m = mn; }
        }
    }
    for (int idx = C.bid * NTHR + C.tid; idx < 64 * 128; idx += C.G * NTHR) {
        const int seq = idx >> 7, dd = idx & 127; float n = 0.f, m = 0.f;
        const float* nloc = (const float*)(ws + WS_NLOC); float* nst = (float*)(ws + WS_NST);
        for (int j = 0; j < NCHK; ++j) {
            if (j >= 2) nst[(size_t)(seq * 32 + j - 2) * 128 + dd] = n;
            if (j < NCHK - 1) { const float Bj = BL[(seq * NCHK + j) * 2], Lj = BL[(seq * NCHK + j) * 2 + 1];
                const float mn = fmaxf(Bj + m, Lj); n = __expf(Bj + m - mn) * n + __expf(Lj - mn) * nloc[(size_t)(seq * NCHK + j) * 128 + dd]; m = mn; }
        }
    }
}

__device__ __forceinline__ void mlstm_c_item(const Ctx& C, const Params& P, int item) {
    unsigned char* ws = P.ws;
    const int oc = item & 31, h = (item >> 5) & 3, b = item >> 7;
    LAS unsigned char* KT = C.lds; LAS unsigned char* VT = C.lds + 32768; LAS unsigned char* CT = C.lds + 65536; LAS unsigned char* PS = C.lds + 98304;
    LAS float* colf = (LAS float*)(C.lds + 131072); LAS float* bcs = colf + 128; LAS float* gms = bcs + 128; LAS float* nsl = gms + 128;
    const int lane = C.lane, w = C.wave, fr = lane & 15, fq = lane >> 4;
    const bf16_t* pml = (const bf16_t*)(ws + WS_PML) + (size_t)(b * SEQ + oc * 128) * 1024;
    const float* cw = P.in[17];
    bf16x8 qf[4];
    { const int tau = 16 * w + fr, orig = oc * 128 + tau; const bool hl = (orig & 63) != 0, hr = (orig & 63) != 63;
#pragma unroll
      for (int ks = 0; ks < 4; ++ks) { const int dc = 32 * ks + 8 * fq; const bf16_t* base = pml + (size_t)tau * 1024 + h * 128 + dc;
        const u32x4 vc = *(const u32x4*)base; u32x4 vl = (u32x4){0u, 0u, 0u, 0u}, vr = (u32x4){0u, 0u, 0u, 0u};
        if (hl) vl = *(const u32x4*)(base - 1024); if (hr) vr = *(const u32x4*)(base + 1024);
        const unsigned l4[4] = {vl.x, vl.y, vl.z, vl.w}, c4[4] = {vc.x, vc.y, vc.z, vc.w}, r4[4] = {vr.x, vr.y, vr.z, vr.w}; const int col = h * 128 + dc; unsigned o4[4];
#pragma unroll
        for (int q = 0; q < 4; ++q) {
            const float a0 = cw[col + 2 * q] * bflo(l4[q]) + cw[1024 + col + 2 * q] * bflo(c4[q]) + cw[2048 + col + 2 * q] * bflo(r4[q]);
            const float a1 = cw[col + 2 * q + 1] * bfhi(l4[q]) + cw[1024 + col + 2 * q + 1] * bfhi(c4[q]) + cw[2048 + col + 2 * q + 1] * bfhi(r4[q]);
            o4[q] = pk2(siluf(a0) * 0.08838834764831845f, siluf(a1) * 0.08838834764831845f); }
        qf[ks] = __builtin_bit_cast(bf16x8, (u32x4){o4[0], o4[1], o4[2], o4[3]}); } }
    f32x4 hacc[8];
#pragma unroll
    for (int nt = 0; nt < 8; ++nt) hacc[nt] = (f32x4){0.f, 0.f, 0.f, 0.f};
#pragma unroll 1
    for (int d = 0; d < 2; ++d) {
        ChunkRef r; r.isctx = 0; r.b = b; r.h = h; r.d = d; r.oc = oc;
        const int seq = (d * 8 + b) * 4 + h, jj = d ? 31 - oc : oc, sidx = seq * 32 + jj, aitem = seq * NCHK + 2 + jj;
        __syncthreads();
        if (d == 0) load_kv_tiles(C, P, r, KT, VT, nullptr);
        for (int idx = C.tid; idx < 2048; idx += NTHR) { const int e = idx >> 4, ch = idx & 15;
            *(LAS u32x4*)(CT + off_b(e, ch)) = *(const u32x4*)((const bf16_t*)(ws + WS_CST) + (size_t)sidx * 16384 + e * 128 + 8 * ch); }
        if (C.tid < 384) colf[C.tid] = ((const float*)(ws + WS_GC))[(size_t)aitem * 384 + C.tid];
        else nsl[C.tid - 384] = ((const float*)(ws + WS_NST))[(size_t)sidx * 128 + (C.tid - 384)];
        const float m0 = ((const float*)(ws + WS_MST))[sidx];
        __syncthreads();
        int t = 16 * w + fr, lane = C.lane; asm volatile("" : "+v"(t), "+v"(lane));
        const int fq = lane >> 4;
        const float mx = fmaxf(m0, gms[t]), rowf = -mx, ainter = __expf(m0 - mx), emneg = __expf(-(bcs[t] + mx));
        float qn = 0.f;
#pragma unroll
        for (int ks = 0; ks < 4; ++ks) { const u32x4 qq = __builtin_bit_cast(u32x4, qf[ks]); const LAS float* np_ = nsl + 32 * ks + 8 * fq; const f32x4 na = *(const LAS f32x4*)np_, nb = *(const LAS f32x4*)(np_ + 4);
            qn += bflo(qq.x) * na[0] + bfhi(qq.x) * na[1] + bflo(qq.y) * na[2] + bfhi(qq.y) * na[3] + bflo(qq.z) * nb[0] + bfhi(qq.z) * nb[1] + bflo(qq.w) * nb[2] + bfhi(qq.w) * nb[3]; }
        qn += __shfl_xor(qn, 16); qn += __shfl_xor(qn, 32);
        float rs = 0.f;
#pragma unroll
        for (int nt = 0; nt < 8; ++nt) { f32x4 a = (f32x4){0.f, 0.f, 0.f, 0.f};
#pragma unroll
            for (int ks = 0; ks < 4; ++ks) a = __builtin_amdgcn_mfma_f32_16x16x32_bf16(tile_tr_read(KT, lane, nt, ks), qf[ks], a, 0, 0, 0);
            const int s0 = 16 * nt + 4 * fq; const f32x4 cf = *(const LAS f32x4*)(colf + s0); float pv[4];
#pragma unroll
            for (int q = 0; q < 4; ++q) { const int s = s0 + q; const bool ok = d ? (s >= t) : (s <= t); pv[q] = ok ? __expf(rowf + cf[q]) * a[q] : 0.f; rs += pv[q]; }
            u32x2 pw; pw.x = pk2(pv[0], pv[1]); pw.y = pk2(pv[2], pv[3]);
            *(LAS u32x2*)(PS + off_b(t, 2 * nt + (fq >> 1)) + 8 * (fq & 1)) = pw; }
        rs += __shfl_xor(rs, 16); rs += __shfl_xor(rs, 32);
        const float inv = 1.f / fmaxf(fabsf(rs + ainter * qn), emneg);
        LDS_WAIT();
        bf16x8 pf[4];
#pragma unroll
        for (int ks = 0; ks < 4; ++ks) pf[ks] = tile_row_read(PS, lane, w, ks);
        float ai4[4], iv4[4];
#pragma unroll
        for (int q = 0; q < 4; ++q) { ai4[q] = __shfl(ainter, 4 * fq + q); iv4[q] = __shfl(inv, 4 * fq + q); }
#pragma unroll
        for (int nt = 0; nt < 8; ++nt) { f32x4 a = (f32x4){0.f, 0.f, 0.f, 0.f}, c = (f32x4){0.f, 0.f, 0.f, 0.f};
#pragma unroll
            for (int ks = 0; ks < 4; ++ks) { a = __builtin_amdgcn_mfma_f32_16x16x32_bf16(pf[ks], tile_row_read(VT, lane, nt, ks), a, 0, 0, 0);
                c = __builtin_amdgcn_mfma_f32_16x16x32_bf16(qf[ks], tile_row_read(CT, lane, nt, ks), c, 0, 0, 0); }
#pragma unroll
            for (int q = 0; q < 4; ++q) hacc[nt][q] += (a[q] + ai4[q] * c[q]) * iv4[q]; }
    }
    float ss[4] = {0.f, 0.f, 0.f, 0.f};
#pragma unroll
    for (int nt = 0; nt < 8; ++nt)
#pragma unroll
        for (int q = 0; q < 4; ++q) ss[q] += hacc[nt][q] * hacc[nt][q];
#pragma unroll
    for (int q = 0; q < 4; ++q) { ss[q] += __shfl_xor(ss[q], 1); ss[q] += __shfl_xor(ss[q], 2); ss[q] += __shfl_xor(ss[q], 4); ss[q] += __shfl_xor(ss[q], 8);
        ss[q] = rsqrtf(ss[q] * (1.f / 128.f) + RMS_EPS); }
    const float* ng = P.in[18]; bf16_t* yb = (bf16_t*)(ws + WS_YAB) + 512;
#pragma unroll
    for (int nt = 0; nt < 8; ++nt) { const int e = h * 128 + 16 * nt + fr; const float gn = ng[e];
#pragma unroll
        for (int q = 0; q < 4; ++q) { const int t = 16 * w + 4 * fq + q; const float og = bf2f(pml[(size_t)t * 1024 + 512 + e]);
            yb[(size_t)(b * SEQ + oc * 128 + t) * 1024 + e] = (bf16_t)f2bf(hacc[nt][q] * ss[q] * gn * sigm(og)); } }
}

__device__ __forceinline__ void mlstm_prep(const Ctx& C, const Params& P) {
    unsigned char* ws = P.ws;
    const float* cw = P.in[17];
    {
        const bf16_t* kvcm = (const bf16_t*)(ws + WS_KVCM); bf16_t* kact = (bf16_t*)(ws + WS_KACT);
        const int NCH = 512 * (MT / 8);
        for (int i = C.bid * NTHR + C.tid; i < NCH; i += C.G * NTHR) { const int c = i / (MT / 8), col = 8 * (i % (MT / 8));
            const bf16_t* src = kvcm + (size_t)c * MT + col; const u32x4 v = *(const u32x4*)src; const unsigned vl = *(const unsigned*)(src - 2), vr = *(const unsigned*)(src + 8);
            const int t = (col < MX) ? (col & 63) : ((col - MX) & 255), rl = (col < MX) ? 64 : 256;
            float x[10]; x[1] = bflo(v.x); x[2] = bfhi(v.x); x[3] = bflo(v.y); x[4] = bfhi(v.y); x[5] = bflo(v.z); x[6] = bfhi(v.z); x[7] = bflo(v.w); x[8] = bfhi(v.w);
            x[0] = (t != 0) ? bfhi(vl) : 0.f; x[9] = (t + 8 != rl) ? bflo(vr) : 0.f;
            const float w0 = cw[512 + c], w1 = cw[1024 + 512 + c], w2 = cw[2048 + 512 + c]; float y[8];
#pragma unroll
            for (int j = 0; j < 8; ++j) y[j] = siluf(w0 * x[j] + w1 * x[j + 1] + w2 * x[j + 2]);
            u32x4 o; o.x = pk2(y[0], y[1]); o.y = pk2(y[2], y[3]); o.z = pk2(y[4], y[5]); o.w = pk2(y[6], y[7]);
            *(u32x4*)(kact + (size_t)c * MT + col) = o; }
    }
    {
        const bf16_t* pml = (const bf16_t*)(ws + WS_PML); bf16_t* qact = (bf16_t*)(ws + WS_QACT);
        for (int i = C.bid * NTHR + C.tid; i < MX * 64; i += C.G * NTHR) { const int row = i >> 6, c0 = 8 * (i & 63);
            const bf16_t* base = pml + (size_t)row * 1024 + c0; const bool hl = (row & 63) != 0, hr = (row & 63) != 63;
            const u32x4 vc = *(const u32x4*)base; u32x4 vl = (u32x4){0u, 0u, 0u, 0u}, vr = (u32x4){0u, 0u, 0u, 0u};
            if (hl) vl = *(const u32x4*)(base - 1024); if (hr) vr = *(const u32x4*)(base + 1024);
            const unsigned l4[4] = {vl.x, vl.y, vl.z, vl.w}, c4[4] = {vc.x, vc.y, vc.z, vc.w}, r4[4] = {vr.x, vr.y, vr.z, vr.w}; unsigned o4[4];
#pragma unroll
            for (int q = 0; q < 4; ++q) {
                const float a0 = cw[c0 + 2 * q] * bflo(l4[q]) + cw[1024 + c0 + 2 * q] * bflo(c4[q]) + cw[2048 + c0 + 2 * q] * bflo(r4[q]);
                const float a1 = cw[c0 + 2 * q + 1] * bfhi(l4[q]) + cw[1024 + c0 + 2 * q + 1] * bfhi(c4[q]) + cw[2048 + c0 + 2 * q + 1] * bfhi(r4[q]);
                o4[q] = pk2(siluf(a0) * 0.08838834764831845f, siluf(a1) * 0.08838834764831845f); }
            *(u32x4*)(qact + (size_t)row * 512 + c0) = (u32x4){o4[0], o4[1], o4[2], o4[3]}; }
    }
    for (int item = C.bid * 8 + C.wave; item < 64 * NCHK; item += C.G * 8) {
        const int j = item % NCHK, seq = item / NCHK, h = seq & 3, b = (seq >> 2) & 7, d = seq >> 5;
        ChunkRef r; r.isctx = j < 2; r.b = b; r.h = h; r.d = d; { const int jj = r.isctx ? j : j - 2, nch = r.isctx ? 2 : 32; r.oc = d ? (nch - 1 - jj) : jj; }
        const float* gates = (const float*)(ws + WS_GATES) + (size_t)chunk_row0(r) * 16;
        const int p0 = 2 * C.lane, t0 = d ? 127 - p0 : p0, t1 = d ? 126 - p0 : p0 + 1;
        const float li0 = gates[(size_t)t0 * 16 + (d ? 8 : 0) + h], li1 = gates[(size_t)t1 * 16 + (d ? 8 : 0) + h];
        const float lf0 = logsig(gates[(size_t)t0 * 16 + (d ? 12 : 4) + h]), lf1 = logsig(gates[(size_t)t1 * 16 + (d ? 12 : 4) + h]);
        float run = lf0 + lf1;
#pragma unroll
        for (int o = 1; o < 64; o <<= 1) { const float t = __shfl_up(run, o); if (C.lane >= o) run += t; }
        const float b1 = run, b0 = run - lf1;
        const float c0 = li0 - b0, c1 = li1 - b1;
        float gm = fmaxf(c0, c1);
#pragma unroll
        for (int o = 1; o < 64; o <<= 1) { const float t = __shfl_up(gm, o); if (C.lane >= o) gm = fmaxf(gm, t); }
        float gprev = __shfl_up(gm, 1); if (C.lane == 0) gprev = -3.0e38f;
        float* gc = (float*)(ws + WS_GC) + (size_t)item * 384;
        gc[t0] = c0; gc[t1] = c1; gc[128 + t0] = b0; gc[128 + t1] = b1; gc[256 + t0] = fmaxf(gprev, c0); gc[256 + t1] = gm;
        if (C.lane == 63) { float* bl = (float*)(ws + WS_BL) + (size_t)item * 2; bl[0] = b1; bl[1] = gm; }
    }
}

struct SeqPre { u32x4 k[4]; u32x4 v[4]; float g; float bl0, bl1; };
__device__ __forceinline__ ChunkRef seq_chunk(int jc, int b, int h, int d) {
    ChunkRef r; r.isctx = jc < 2; r.b = b; r.h = h; r.d = d; const int jj = r.isctx ? jc : jc - 2, nch = r.isctx ? 2 : 32; r.oc = d ? (nch - 1 - jj) : jj; return r; }
__device__ __forceinline__ void seq_prefetch(const Params& P, const ChunkRef& r, int item, SeqPre& pf, int tid) {
    const bf16_t* kact = (const bf16_t*)(P.ws + WS_KACT); const bf16_t* kvcm = (const bf16_t*)(P.ws + WS_KVCM); const int col0 = chunk_row0(r);
#pragma unroll
    for (int it = 0; it < 4; ++it) { const int idx = tid + NTHR * it, dd = idx >> 4, s0 = 8 * (idx & 15);
        pf.k[it] = *(const u32x4*)(kact + (size_t)(r.h * 128 + dd) * MT + col0 + s0);
        pf.v[it] = *(const u32x4*)(kvcm + (size_t)(512 + r.h * 128 + dd) * MT + col0 + s0); }
    pf.g = (tid < 384) ? ((const float*)(P.ws + WS_GC))[(size_t)item * 384 + tid] : 0.f;
    const float* bl = (const float*)(P.ws + WS_BL) + (size_t)item * 2; pf.bl0 = bl[0]; pf.bl1 = bl[1];
}
#define SEQ_BAR() do { asm volatile("s_waitcnt lgkmcnt(0)" ::: "memory"); __builtin_amdgcn_s_barrier(); asm volatile("" ::: "memory"); } while (0)
__device__ __forceinline__ void mlstm_seq(const Ctx& C, const Params& P, int seq) {
    unsigned char* ws = P.ws;
    const int h = seq & 3, b = (seq >> 2) & 7, d = seq >> 5;
    LAS unsigned char* KT = C.lds; LAS unsigned char* VT = C.lds + 32768; LAS unsigned char* CT = C.lds + 65536; LAS unsigned char* PS = C.lds + 98304;
    LAS float* colf = (LAS float*)(C.lds + 131072); LAS float* bcs = colf + 128; LAS float* gms = bcs + 128; LAS float* wls = gms + 128; LAS float* nbuf = wls + 128  ;
    const int w = C.wave;
    f32x4 Cst[8]; f32x4 nst = (f32x4){0.f, 0.f, 0.f, 0.f};
#pragma unroll
    for (int nt = 0; nt < 8; ++nt) Cst[nt] = (f32x4){0.f, 0.f, 0.f, 0.f};
    float m = 0.f;
    __syncthreads();
    if (C.tid < 256) nbuf[C.tid] = 0.f;
    SeqPre pre;
    seq_prefetch(P, seq_chunk(0, b, h, d), seq * NCHK, pre, C.tid);
    const bf16x8 ones = (bf16x8){0x3f80, 0x3f80, 0x3f80, 0x3f80, 0x3f80, 0x3f80, 0x3f80, 0x3f80};
#pragma unroll 1
    for (int jc = 0; jc < NCHK; ++jc) {
        const ChunkRef r = seq_chunk(jc, b, h, d);
        const LAS float* nsl = nbuf + 128 * (jc & 1); LAS float* nnew = nbuf + 128 * ((jc & 1) ^ 1);
        int tid = C.tid; asm volatile("" : "+v"(tid));
        const int lane = tid & 63, fr = lane & 15, fq = lane >> 4;
        bf16x8 qf[4];
        if (!r.isctx) { const bf16_t* qa = (const bf16_t*)(ws + WS_QACT) + (size_t)(b * SEQ + r.oc * 128 + 16 * w + fr) * 512 + h * 128 + 8 * fq;
#pragma unroll
            for (int ks = 0; ks < 4; ++ks) qf[ks] = *(const bf16x8*)(qa + 32 * ks); }
        else {
#pragma unroll
            for (int ks = 0; ks < 4; ++ks) qf[ks] = (bf16x8){0, 0, 0, 0, 0, 0, 0, 0}; }
        const float Bj = pre.bl0, gfin = pre.bl1, mxs = fmaxf(m, gfin), decay = __expf(m - mxs);
        SEQ_BAR();
        {
#pragma unroll
            for (int it = 0; it < 4; ++it) { const int idx = tid + NTHR * it, dd = idx >> 4, ch = idx & 15;
                *(LAS u32x4*)(KT + off_b(dd, ch)) = pre.k[it]; *(LAS u32x4*)(VT + off_b(dd, ch)) = pre.v[it]; }
            if (tid < 384) colf[tid] = pre.g;
            if (tid < 128) wls[tid] = __expf(pre.g - mxs);
        }
#pragma unroll
        for (int nt = 0; nt < 8; ++nt) { u32x2 pw; pw.x = pk2(Cst[nt][0], Cst[nt][1]); pw.y = pk2(Cst[nt][2], Cst[nt][3]);
            *(LAS u32x2*)(CT + off_b(16 * nt + fr, 2 * w + (fq >> 1)) + 8 * (fq & 1)) = pw; }
        if (fr == 0) *(LAS f32x4*)(nnew + 16 * w + 4 * fq) = nst;
        SEQ_BAR();
        if (!r.isctx) {
            const int t = 16 * w + fr;
            const float mx = fmaxf(m, gms[t]), rowf = -mx, ainter = __expf(m - mx), emneg = __expf(-(bcs[t] + mx));
            float qn = 0.f;
#pragma unroll
            for (int ks = 0; ks < 4; ++ks) { const u32x4 qq = __builtin_bit_cast(u32x4, qf[ks]); const LAS float* np_ = nnew + 32 * ks + 8 * fq; const f32x4 na = *(const LAS f32x4*)np_, nb = *(const LAS f32x4*)(np_ + 4);
                qn += bflo(qq.x) * na[0] + bfhi(qq.x) * na[1] + bflo(qq.y) * na[2] + bfhi(qq.y) * na[3] + bflo(qq.z) * nb[0] + bfhi(qq.z) * nb[1] + bflo(qq.w) * nb[2] + bfhi(qq.w) * nb[3]; }
            qn += __shfl_xor(qn, 16); qn += __shfl_xor(qn, 32);
            float rs = 0.f;
#pragma unroll 2
            for (int nt = 0; nt < 8; ++nt) { f32x4 a = (f32x4){0.f, 0.f, 0.f, 0.f};
#pragma unroll
                for (int ks = 0; ks < 4; ++ks) a = __builtin_amdgcn_mfma_f32_16x16x32_bf16(tile_tr_read(KT, lane, nt, ks), qf[ks], a, 0, 0, 0);
                const int s0 = 16 * nt + 4 * fq; const f32x4 cf = *(const LAS f32x4*)(colf + s0); float pv[4];
#pragma unroll
                for (int q = 0; q < 4; ++q) { const int s = s0 + q; const bool ok = d ? (s >= t) : (s <= t); pv[q] = ok ? __expf(rowf + cf[q]) * a[q] : 0.f; rs += pv[q]; }
                u32x2 pw; pw.x = pk2(pv[0], pv[1]); pw.y = pk2(pv[2], pv[3]);
                *(LAS u32x2*)(PS + off_b(t, 2 * nt + (fq >> 1)) + 8 * (fq & 1)) = pw; }
            rs += __shfl_xor(rs, 16); rs += __shfl_xor(rs, 32);
            const float inv = 1.f / fmaxf(fabsf(rs + ainter * qn), emneg);
            LDS_WAIT();
            bf16x8 pfr[4];
#pragma unroll
            for (int ks = 0; ks < 4; ++ks) pfr[ks] = tile_row_read(PS, lane, w, ks);
            float ai4[4], iv4[4];
#pragma unroll
            for (int q = 0; q < 4; ++q) { ai4[q] = __shfl(ainter, 4 * fq + q); iv4[q] = __shfl(inv, 4 * fq + q); }
            bf16_t* hd = (bf16_t*)(ws + WS_HDIR) + ((size_t)d * MX + (size_t)(b * SEQ + r.oc * 128)) * 512 + h * 128;
#pragma unroll 2
            for (int nt = 0; nt < 8; ++nt) { f32x4 a = (f32x4){0.f, 0.f, 0.f, 0.f}, c = (f32x4){0.f, 0.f, 0.f, 0.f};
#pragma unroll
                for (int ks = 0; ks < 4; ++ks) { a = __builtin_amdgcn_mfma_f32_16x16x32_bf16(pfr[ks], tile_row_read(VT, lane, nt, ks), a, 0, 0, 0);
                    c = __builtin_amdgcn_mfma_f32_16x16x32_bf16(qf[ks], tile_row_read(CT, lane, nt, ks), c, 0, 0, 0); }
#pragma unroll
                for (int q = 0; q < 4; ++q) hd[(size_t)(16 * w + 4 * fq + q) * 512 + 16 * nt + fr] = (bf16_t)f2bf((a[q] + ai4[q] * c[q]) * iv4[q]); }
        }
        if (jc + 1 < NCHK) seq_prefetch(P, seq_chunk(jc + 1, b, h, d), seq * NCHK + jc + 1, pre, tid);
        {
            bf16x8 kfs[4];
#pragma unroll
            for (int ks = 0; ks < 4; ++ks) { const u32x4 kk = __builtin_bit_cast(u32x4, tile_row_read(KT, lane, w, ks)); const LAS float* cp = wls + 32 * ks + 8 * fq;
                const f32x4 ca = *(const LAS f32x4*)cp, cb = *(const LAS f32x4*)(cp + 4);
                u32x4 o; o.x = pk2(bflo(kk.x) * ca[0], bfhi(kk.x) * ca[1]); o.y = pk2(bflo(kk.y) * ca[2], bfhi(kk.y) * ca[3]);
                o.z = pk2(bflo(kk.z) * cb[0], bfhi(kk.z) * cb[1]); o.w = pk2(bflo(kk.w) * cb[2], bfhi(kk.w) * cb[3]);
                kfs[ks] = __builtin_bit_cast(bf16x8, o); }
#pragma unroll
            for (int nt = 0; nt < 8; ++nt) { f32x4 a = (f32x4){0.f, 0.f, 0.f, 0.f};
#pragma unroll
                for (int ks = 0; ks < 4; ++ks) a = __builtin_amdgcn_mfma_f32_16x16x32_bf16(kfs[ks], tile_row_read(VT, lane, nt, ks), a, 0, 0, 0);
                Cst[nt] = Cst[nt] * decay + a; }
            { f32x4 a = (f32x4){0.f, 0.f, 0.f, 0.f};
#pragma unroll
              for (int ks = 0; ks < 4; ++ks) a = __builtin_amdgcn_mfma_f32_16x16x32_bf16(kfs[ks], ones, a, 0, 0, 0);
              nst = nst * decay + a; }
            m = Bj + mxs;
        }
    }
}
#undef SEQ_BAR

__device__ __forceinline__ void mlstm_combine(const Ctx& C, const Params& P) {
    unsigned char* ws = P.ws;
    const bf16_t* hd = (const bf16_t*)(ws + WS_HDIR); const bf16_t* pml = (const bf16_t*)(ws + WS_PML); bf16_t* yab = (bf16_t*)(ws + WS_YAB); const float* ng = P.in[18];
    const f32x4 g0 = *(const f32x4*)(ng + 8 * C.lane), g1 = *(const f32x4*)(ng + 8 * C.lane + 4);
    for (int row = C.bid * 8 + C.wave; row < MX; row += C.G * 8) {
        const u32x4 a = *(const u32x4*)(hd + (size_t)row * 512 + 8 * C.lane), bq = *(const u32x4*)(hd + ((size_t)MX + row) * 512 + 8 * C.lane);
        const u32x4 og = *(const u32x4*)(pml + (size_t)row * 1024 + 512 + 8 * C.lane);
        float v[8] = {bflo(a.x) + bflo(bq.x), bfhi(a.x) + bfhi(bq.x), bflo(a.y) + bflo(bq.y), bfhi(a.y) + bfhi(bq.y), bflo(a.z) + bflo(bq.z), bfhi(a.z) + bfhi(bq.z), bflo(a.w) + bflo(bq.w), bfhi(a.w) + bfhi(bq.w)};
        float ss = 0.f;
#pragma unroll
        for (int j = 0; j < 8; ++j) ss += v[j] * v[j];
        ss += __shfl_xor(ss, 1); ss += __shfl_xor(ss, 2); ss += __shfl_xor(ss, 4); ss += __shfl_xor(ss, 8);
        const float rstd = rsqrtf(ss * (1.f / 128.f) + RMS_EPS);
        const float o8[8] = {bflo(og.x), bfhi(og.x), bflo(og.y), bfhi(og.y), bflo(og.z), bfhi(og.z), bflo(og.w), bfhi(og.w)};
        const float gg[8] = {g0[0], g0[1], g0[2], g0[3], g1[0], g1[1], g1[2], g1[3]};
        float y[8];
#pragma unroll
        for (int j = 0; j < 8; ++j) y[j] = v[j] * rstd * gg[j] * sigm(o8[j]);
        u32x4 wv; wv.x = pk2(y[0], y[1]); wv.y = pk2(y[2], y[3]); wv.z = pk2(y[4], y[5]); wv.w = pk2(y[6], y[7]);
        *(u32x4*)(yab + (size_t)row * 1024 + 512 + 8 * C.lane) = wv;
    }
}

template <int PM>
__device__ __forceinline__ void mixer_phase(const Ctx& C, const Params& P) {
    constexpr int NM = 64;
    const bool small = C.G < 2 * NM;
    const int nh = small ? C.G : C.G - NM, hb = small ? C.bid : C.bid - NM;
    if (PM != 2 && PM != 3) if (small || C.bid < NM) for (int s = C.bid; s < 64; s += (small ? C.G : NM)) mlstm_seq(C, P, s);
    if (PM != 1 && hb >= 0) {
        const int nch = (512 - hb + nh - 1) / nh;
#pragma unroll 1
        for (int j = 0; j < 2 * nch; ++j) { const int c = hb + (j >> 1) * nh, o = j & 1;
            if (o) asm volatile("s_waitcnt vmcnt(0)" ::: "memory");
            hyena_item<0>(C, P, o, c); }
    }
}

__device__ __forceinline__ void transpose_z2(const Ctx& C, const Params& P) {
    unsigned char* ws = P.ws;
    const bf16_t* src = (const bf16_t*)(ws + WS_Z2CM); bf16_t* dst = (bf16_t*)(ws + WS_YAB);
    LAS bf16_t* tl = (LAS bf16_t*)(C.lds + 143360 - 20480);
    for (int it = C.bid; it < 8 * 256; it += C.G) {
        const int c0 = (it & 7) * 64, r0 = (it >> 3) * 128;
        __syncthreads();
        for (int idx = C.tid; idx < 64 * 16; idx += NTHR) { const int cc = idx >> 4, rc = (idx & 15) * 8;
            const u32x4 v = *(const u32x4*)(src + (size_t)(c0 + cc) * MX + r0 + rc); const unsigned v4[4] = {v.x, v.y, v.z, v.w};
#pragma unroll
            for (int q = 0; q < 4; ++q) { tl[(rc + 2 * q) * 72 + cc] = (bf16_t)(v4[q] & 0xffffu); tl[(rc + 2 * q + 1) * 72 + cc] = (bf16_t)(v4[q] >> 16); } }
        __syncthreads();
        for (int idx = C.tid; idx < 128 * 8; idx += NTHR) { const int rr = idx >> 3, c8 = (idx & 7) * 8;
            *(u32x4*)(dst + (size_t)(r0 + rr) * 1024 + c0 + c8) = *(const LAS u32x4*)(tl + rr * 72 + c8); }
    }
}

__device__ __forceinline__ void phase6(const Ctx& C, const Params& P) {
    unsigned char* ws = P.ws;
    LAS float* Wr = (LAS float*)C.lds;
    for (int idx = C.tid; idx < 1024 * 16; idx += NTHR) Wr[wl_pos(idx >> 4) * 20 + (idx & 15)] = P.in[22][idx];
    __syncthreads();
    const float* ada = (const float*)(ws + WS_ADA); const float* gffn = P.in[7];
    unsigned char* hx2 = ws + WS_HX2; float* aff = (float*)(ws + WS_AFF); int* slot = (int*)(ws + WS_SLOT);
    const bf16_t* xm = (const bf16_t*)(ws + WS_XMID);
    u32x2 nx[4];
    { const int row0 = C.bid * 8 + C.wave;
      if (row0 < MX) {
#pragma unroll
        for (int j = 0; j < 4; ++j) nx[j] = *(const u32x2*)(xm + (size_t)row0 * DM + 4 * C.lane + 256 * j); } }
    for (int row = C.bid * 8 + C.wave; row < MX; row += C.G * 8) {
        const int b = row >> 12, n = row & 4095;
        f32x4 v[4]; float ss = 0.f;
#pragma unroll
        for (int j = 0; j < 4; ++j) { v[j] = (f32x4){bflo(nx[j].x), bfhi(nx[j].x), bflo(nx[j].y), bfhi(nx[j].y)}; ss += v[j][0] * v[j][0] + v[j][1] * v[j][1] + v[j][2] * v[j][2] + v[j][3] * v[j][3]; }
        if (row + C.G * 8 < MX) {
#pragma unroll
            for (int j = 0; j < 4; ++j) nx[j] = *(const u32x2*)(xm + (size_t)(row + C.G * 8) * DM + 4 * C.lane + 256 * j); }
        const float rstd = rsqrtf(wave_sum(ss) * (1.f / DM) + RMS_EPS);
#pragma unroll
        for (int j = 0; j < 4; ++j) { const int k = 4 * C.lane + 256 * j; const f32x4 g = *(const f32x4*)(gffn + k);
            const f32x4 h4 = *(const f32x4*)(ada + (size_t)b * 6144 + 3072 + k), s4 = *(const f32x4*)(ada + (size_t)b * 6144 + 4096 + k);
#pragma unroll
            for (int q = 0; q < 4; ++q) v[j][q] = (v[j][q] * rstd * g[q]) * (1.f + s4[q]) + h4[q];
            *(unsigned*)(hx2 + (size_t)row * DM + k) = pk4_fp8(v[j][0], v[j][1], v[j][2], v[j][3]); }
        const float lg = row_dot16(v, Wr, C.lane);
        float mx = lg;
        mx = fmaxf(mx, __shfl_xor(mx, 4)); mx = fmaxf(mx, __shfl_xor(mx, 8)); mx = fmaxf(mx, __shfl_xor(mx, 16)); mx = fmaxf(mx, __shfl_xor(mx, 32));
        const float ex = expf(lg - mx);
        float sum = ex;
        sum += __shfl_xor(sum, 4); sum += __shfl_xor(sum, 8); sum += __shfl_xor(sum, 16); sum += __shfl_xor(sum, 32);
        if ((C.lane & 3) == 0) { const int e = C.lane >> 2; aff[((size_t)b * NE + e) * SEQ + n] = ex / sum; slot[(size_t)row * 16 + e] = -1; }
    }
}

__device__ __forceinline__ void topk_item(const Ctx& C, const Params& P, int item) {
    unsigned char* ws = P.ws;
    const int b = item >> 4, e = item & 15;
    const float* aff = (const float*)(ws + WS_AFF) + (size_t)item * SEQ;
    LAS unsigned* red = (LAS unsigned*)C.lds;
    unsigned v[8];
    { const u32x4 a = *(const u32x4*)(aff + 8 * C.tid), c = *(const u32x4*)(aff + 8 * C.tid + 4);
      v[0] = a.x; v[1] = a.y; v[2] = a.z; v[3] = a.w; v[4] = c.x; v[5] = c.y; v[6] = c.z; v[7] = c.w; }
    unsigned prefix = 0u;
    for (int bit = 30; bit >= 0; --bit) {
        const unsigned cand = prefix | (1u << bit); int cnt = 0;
#pragma unroll
        for (int q = 0; q < 8; ++q) cnt += (v[q] >= cand) ? 1 : 0;
        cnt = (int)wave_sum((float)cnt);
        __syncthreads();
        if (C.lane == 0) red[C.wave] = (unsigned)cnt;
        __syncthreads();
        int tot = 0;
#pragma unroll
        for (int q = 0; q < 8; ++q) tot += (int)red[q];
        if (tot >= CAP) prefix = cand;
    }
    int cg_ = 0, ce_ = 0;
#pragma unroll
    for (int q = 0; q < 8; ++q) { cg_ += (v[q] > prefix) ? 1 : 0; ce_ += (v[q] == prefix) ? 1 : 0; }
    int ig = cg_, ie = ce_;
#pragma unroll
    for (int o = 1; o < 64; o <<= 1) { const int tg = __shfl_up(ig, o), te = __shfl_up(ie, o); if (C.lane >= o) { ig += tg; ie += te; } }
    __syncthreads();
    if (C.lane == 63) { red[C.wave] = (unsigned)ig; red[8 + C.wave] = (unsigned)ie; }
    __syncthreads();
    int bg = 0, be = 0, totg = 0;
#pragma unroll
    for (int q = 0; q < 8; ++q) { const int xg = (int)red[q], xe = (int)red[8 + q]; if (q < C.wave) { bg += xg; be += xe; } totg += xg; }
    int pg = bg + ig - cg_, pe = be + ie - ce_;
    const int need = CAP - totg;
    int* sidx = (int*)(ws + WS_SIDX) + (size_t)item * CAP; float* sg = (float*)(ws + WS_SGATE) + (size_t)item * CAP; int* slot = (int*)(ws + WS_SLOT);
#pragma unroll
    for (int q = 0; q < 8; ++q) { const int n = 8 * C.tid + q; int s = -1;
        if (v[q] > prefix) s = pg++;
        else if (v[q] == prefix) { if (pe < need) s = totg + pe; ++pe; }
        if (s >= 0) { sidx[s] = n; sg[s] = __builtin_bit_cast(float, v[q]); slot[((size_t)b * SEQ + n) * 16 + e] = s; } }
}

__device__ __forceinline__ void gather_all(const Ctx& C, const Params& P) {
    unsigned char* ws = P.ws;
    const int* sidx = (const int*)(ws + WS_SIDX); const unsigned char* hx2 = ws + WS_HX2; unsigned char* xg = ws + WS_XG;
    for (int r = C.bid * 8 + C.wave; r < NE * 4096; r += C.G * 8) {
        const int e = r >> 12, rr = r & 4095, b = rr >> 9, s = rr & 511;
        const int n = sidx[((size_t)b * NE + e) * CAP + s];
        const u32x4* src = (const u32x4*)(hx2 + ((size_t)b * SEQ + n) * DM); u32x4* dst = (u32x4*)(xg + (size_t)r * DM);
        dst[C.lane] = src[C.lane];
    }
}

__device__ __forceinline__ void moe_gemm1(const Ctx& C, const Params& P, int skip_epi) {
    unsigned char* ws = P.ws;
    pg8::SchedMoe S{(const char*)(ws + WS_XG), (const char*)(ws + WS_W13), (size_t)256 * 1024, (size_t)256 * 1024, (size_t)4096 * 1024, (size_t)4096 * 1024, 16, 16, C.G, C.bid};
    pg8::EpiMoe1 E{ws + WS_ACT, skip_epi};
    pg8::gemm_phase<pg8::EpiMoe1, pg8::SchedMoe, false, true>(C.lds, 512, 1024, 1024, S, E);
}
__device__ __forceinline__ void moe_gemm2(const Ctx& C, const Params& P, bool skip_epi) {
    unsigned char* ws = P.ws;
    pg8::SchedMoe S{(const char*)(ws + WS_ACT), (const char*)(ws + WS_W2), (size_t)256 * 2048, (size_t)256 * 2048, (size_t)4096 * 2048, (size_t)1024 * 2048, 16, 4, C.G, C.bid};
    pg8::EpiMoe2 E{(bf16_t*)(ws + WS_YE), (const float*)(ws + WS_SGATE), skip_epi};
    pg8::gemm_phase<pg8::EpiMoe2, pg8::SchedMoe, false, true>(C.lds, 1024, 2048, 2048, S, E);
}

__device__ __forceinline__ void phase_final(const Ctx& C, const Params& P) {
    unsigned char* ws = P.ws;
    const float* ada = (const float*)(ws + WS_ADA); const float* gfin = P.in[26];
    const int* slot = (const int*)(ws + WS_SLOT); const bf16_t* ye = (const bf16_t*)(ws + WS_YE);
    const bf16_t* xm = (const bf16_t*)(ws + WS_XMID);
    u32x2 nx[4]; int nslot = -1;
    { const int row0 = C.bid * 8 + C.wave;
      if (row0 < MX) { if (C.lane < 16) nslot = slot[(size_t)row0 * 16 + C.lane];
#pragma unroll
        for (int j = 0; j < 4; ++j) nx[j] = *(const u32x2*)(xm + (size_t)row0 * DM + 4 * C.lane + 256 * j); } }
    for (int row = C.bid * 8 + C.wave; row < MX; row += C.G * 8) {
        const int b = row >> 12;
        float* xr = P.out + (size_t)row * DM;
        f32x4 xv[4]; const int myslot = nslot;
#pragma unroll
        for (int j = 0; j < 4; ++j) xv[j] = (f32x4){bflo(nx[j].x), bfhi(nx[j].x), bflo(nx[j].y), bfhi(nx[j].y)};
        f32x4 m[4];
#pragma unroll
        for (int j = 0; j < 4; ++j) m[j] = (f32x4){0.f, 0.f, 0.f, 0.f};
        for (int e = 0; e < NE; ++e) { const int s = __shfl(myslot, e);
            if (s >= 0) { const bf16_t* yr = ye + ((size_t)e * 4096 + b * CAP + s) * DM;
#pragma unroll
                for (int j = 0; j < 4; ++j) { const u32x2 w = *(const u32x2*)(yr + 4 * C.lane + 256 * j);
                    m[j][0] += bflo(w.x); m[j][1] += bfhi(w.x); m[j][2] += bflo(w.y); m[j][3] += bfhi(w.y); } } }
        if (row + C.G * 8 < MX) { const int r1 = row + C.G * 8; nslot = (C.lane < 16) ? slot[(size_t)r1 * 16 + C.lane] : -1;
#pragma unroll
            for (int j = 0; j < 4; ++j) nx[j] = *(const u32x2*)(xm + (size_t)r1 * DM + 4 * C.lane + 256 * j); }
        f32x4 v[4]; float ss = 0.f;
#pragma unroll
        for (int j = 0; j < 4; ++j) { const int k = 4 * C.lane + 256 * j; const f32x4 g5 = *(const f32x4*)(ada + (size_t)b * 6144 + 5120 + k);
            v[j] = xv[j] + g5 * m[j]; ss += v[j][0] * v[j][0] + v[j][1] * v[j][1] + v[j][2] * v[j][2] + v[j][3] * v[j][3]; }
        const float rstd = rsqrtf(wave_sum(ss) * (1.f / DM) + RMS_EPS);
#pragma unroll
        for (int j = 0; j < 4; ++j) { const int k = 4 * C.lane + 256 * j; const f32x4 g = *(const f32x4*)(gfin + k);
            *(f32x4*)(xr + k) = v[j] * rstd * g; }
    }
}

constexpr int N_PHASES = 14;
__global__ void __launch_bounds__(NTHR, 2) mega(Params P) {
    extern __shared__ __attribute__((aligned(16))) unsigned char lds_raw[];
    Ctx C; C.lds = (LAS unsigned char*)lds_raw; C.tid = threadIdx.x; C.lane = C.tid & 63; C.wave = __builtin_amdgcn_readfirstlane(C.tid >> 6); C.bid = blockIdx.x; C.G = gridDim.x;
    unsigned char* ws = P.ws;
    if (C.tid < 32) ((LAS unsigned*)(C.lds + LDS_MISC))[C.tid] = 0u;
    __syncthreads();
    XcdBarrier bar = xcd_barrier_post((unsigned*)(ws + WS_CTL), (volatile LAS unsigned*)(C.lds + LDS_MISC));
#define IN(k) (lo <= (k) && (k) < hi)
#define SEAM(k) do { if (IN(k) && IN((k) + 1)) { xcd_barrier(bar); if ((REPEAT >> 23) & 1u) xcd_barrier(bar); } } while (0)
#define RUN(id, ...) do { { constexpr bool rep = false; (void)rep; __VA_ARGS__; } if ((REPEAT >> (id)) & 1u) { xcd_barrier(bar); { constexpr bool rep = true; (void)rep; __VA_ARGS__; } } } while (0)
#define PHASE_PROGRAM(LO, HI) do { const int lo = (LO), hi = (HI); \
    if (IN(0)) RUN(0, phase0(C, P)); \
    SEAM(0); \
    if (IN(1)) RUN(1, phase1(C, P)); \
    SEAM(1); \
    if (IN(2)) { \
        RUN(2, phase2a(C, P)); \
        RUN(3, phase2b(C, P)); \
    } \
    SEAM(2); \
    if (IN(3)) RUN(5, mlstm_prep(C, P)); \
    SEAM(3); \
    if (IN(4)) RUN(4, mixer_phase<rep ? (int)((REPEAT >> 25) & 3u) : 0>(C, P)); \
    SEAM(4); \
    if (IN(5)) { \
        RUN(9, transpose_z2(C, P)); \
        RUN(8, mlstm_combine(C, P)); \
    } \
    SEAM(5); \
    if (IN(6)) RUN(10, phase_merge(C, P)); \
    SEAM(6); \
    if (IN(7)) RUN(11, phase_outproj(C, P)); \
    SEAM(7); \
    if (IN(8)) RUN(12, phase6(C, P)); \
    SEAM(8); \
    if (IN(9)) { \
        RUN(13, for (int it = C.bid; it < BATCH * NE; it += C.G) topk_item(C, P, it)); \
        __syncthreads(); \
        RUN(14, convert_experts(C, P)); \
    } \
    SEAM(9); \
    if (IN(10)) RUN(15, gather_all(C, P)); \
    SEAM(10); \
    if (IN(11)) RUN(16, moe_gemm1(C, P, rep ? (int)((REPEAT >> 25) & 3u) : 0)); \
    SEAM(11); \
    if (IN(12)) RUN(17, moe_gemm2(C, P, rep && ((REPEAT >> 25) & 1u))); \
    SEAM(12); \
    if (IN(13)) phase_final(C, P); \
} while (0)
    PHASE_PROGRAM(P.ph_lo, P.ph_hi);
#undef PHASE_PROGRAM
#undef IN
#undef SEAM
#undef RUN
}

extern "C" void kernel_launch(void* const* d_in, const int* in_sizes, int n_in, void* d_out, int out_size, void* d_ws, size_t ws_size, hipStream_t stream) {
    static int grid = 0;
    if (grid == 0) {
        if (n_in != 27 || out_size != MX * DM || ws_size < WS_END) { fprintf(stderr, "kernel_launch: unexpected shapes (n_in %d, out %d, ws %zu < %zu)\n", n_in, out_size, ws_size, (size_t)WS_END); grid = -1; return; }
        int dev = 0, cus = 0, per_cu = 0;
        hipGetDevice(&dev);
        hipDeviceGetAttribute(&cus, hipDeviceAttributeMultiprocessorCount, dev);
        if (hipFuncSetAttribute((const void*)mega, hipFuncAttributeMaxDynamicSharedMemorySize, LDS_BYTES) != hipSuccess) { fprintf(stderr, "kernel_launch: hipFuncSetAttribute failed\n"); grid = -1; return; }
        if (hipOccupancyMaxActiveBlocksPerMultiprocessor(&per_cu, (const void*)mega, NTHR, LDS_BYTES) != hipSuccess || per_cu < 1) { fprintf(stderr, "kernel_launch: occupancy query says %d\n", per_cu); per_cu = 1; }
        (void)hipGetLastError();
        grid = cus * 1;
        if (grid <= 0) grid = 256;
    }
    if (grid < 0) return;
    Params p; memset(&p, 0, sizeof(p));
    for (int i = 0; i < 27; ++i) p.in[i] = (const float*)d_in[i];
    p.out = (float*)d_out; p.ws = (unsigned char*)d_ws;
    (void)hipMemsetAsync((unsigned char*)d_ws + WS_CTL, 0, XCD_BAR_WORDS * 4, stream);
#if N_LAUNCH_MODE == 1
    if (PREFIX > 0) {
        p.ph_lo = 0; p.ph_hi = PREFIX;
        void* pargs[] = {&p};
        (void)hipLaunchCooperativeKernel((const void*)mega, dim3(grid), dim3(NTHR), pargs, LDS_BYTES, stream);
        (void)hipMemsetAsync((unsigned char*)d_ws + WS_CTL, 0, XCD_BAR_WORDS * 4, stream);
    }
    p.ph_lo = 0; p.ph_hi = N_PHASES;
    void* args[] = {&p};
    hipError_t e = hipLaunchCooperativeKernel((const void*)mega, dim3(grid), dim3(NTHR), args, LDS_BYTES, stream);
    if (e != hipSuccess) fprintf(stderr, "kernel_launch: cooperative launch failed: %s (grid %d)\n", hipGetErrorString(e), grid);
#else
    for (int ph = 0; ph < N_PHASES; ++ph) {
        p.ph_lo = ph; p.ph_hi = ph + 1;
        void* args[] = {&p};
        hipError_t e = hipLaunchCooperativeKernel((const void*)mega, dim3(grid), dim3(NTHR), args, LDS_BYTES, stream);
        if (e != hipSuccess) { fprintf(stderr, "kernel_launch: launch %d failed: %s (grid %d)\n", ph, hipGetErrorString(e), grid); break; }
    }
#endif
}
```

```cpp
#include <hip/hip_runtime.h>
#include <hip/hip_cooperative_groups.h>
#include <cstdio>
#include <cstdint>
#include <cstring>
namespace cg = cooperative_groups;

#ifndef N_LAUNCH_MODE
#define N_LAUNCH_MODE 1
#endif

#define LAS __attribute__((address_space(3)))
typedef unsigned short bf16_t;
typedef short bf16x8 __attribute__((ext_vector_type(8)));
typedef float f32x4 __attribute__((ext_vector_type(4)));
typedef float f32x16 __attribute__((ext_vector_type(16)));
typedef unsigned u32x4 __attribute__((ext_vector_type(4)));
typedef unsigned u32x2 __attribute__((ext_vector_type(2)));

constexpr int NTHR = 512;
constexpr int BATCH = 8, SEQ = 4096, DM = 1024, CTXL = 256;
constexpr int MX = BATCH * SEQ;
constexpr int MC = BATCH * CTXL;
constexpr int DIN = 5648, NPROJ = 5632, GATE0 = 3584, MERGE0 = 3600;
constexpr int NE = 16, CAP = 512, DFF = 2048;
constexpr int MT = MX + MC;
constexpr int NCHK = 34;
constexpr float RMS_EPS = 1e-6f;

constexpr size_t MiB = 1u << 20;
constexpr size_t WS_ADAP = 0;
constexpr size_t WS_ADA = 7 * MiB;
constexpr size_t WS_CTL = 7 * MiB + 512 * 1024;
constexpr size_t WS_GATES = 8 * MiB;
constexpr size_t WS_KREV = 11 * MiB;
constexpr size_t WS_BL = 27 * MiB;
constexpr size_t WS_MST = 27 * MiB + 64 * 1024;
constexpr size_t WS_NLOC = 28 * MiB;
constexpr size_t WS_NST = 30 * MiB;
constexpr size_t WS_WIN = 32 * MiB;
constexpr size_t WS_WB = 43 * MiB;
constexpr size_t WS_WOUT = 45 * MiB;
constexpr size_t WS_HX = 48 * MiB;
constexpr size_t WS_PLOC = 48 * MiB;
constexpr size_t WS_PCM = 116 * MiB;
constexpr size_t WS_PML = 212 * MiB;
constexpr size_t WS_KVCM = 276 * MiB;
constexpr size_t WS_GC = 2 * MiB;
constexpr size_t WS_Z1 = 344 * MiB;
constexpr size_t WS_YAB = 376 * MiB;
constexpr size_t WS_CST = 440 * MiB;
constexpr size_t WS_KACT = 48 * MiB;
constexpr size_t WS_QACT = 82 * MiB;
constexpr size_t WS_HDIR = 440 * MiB;
constexpr size_t WS_Z2CM = 504 * MiB;
constexpr size_t WS_Z = 48 * MiB;
constexpr size_t WS_XMID = 496 * MiB;
constexpr size_t WS_AFF = 0;
constexpr size_t WS_SLOT = 2 * MiB;
constexpr size_t WS_SIDX = 4 * MiB;
constexpr size_t WS_SGATE = 4 * MiB + 512 * 1024;
constexpr size_t WS_HX2 = 48 * MiB;
constexpr size_t WS_W13 = 80 * MiB;
constexpr size_t WS_W2 = 144 * MiB;
constexpr size_t WS_XG = 176 * MiB;
constexpr size_t WS_ACT = 240 * MiB;
constexpr size_t WS_YE = 368 * MiB;
constexpr size_t WS_END = 568 * MiB;

constexpr int LDS_BYTES = 147456;
constexpr int LDS_MISC = LDS_BYTES - 128;
constexpr int PREFIX = 0;
constexpr unsigned REPEAT = 0u;

__device__ __forceinline__ unsigned f2bf(float f) { unsigned u = __builtin_bit_cast(unsigned, f); return (u + 0x7fffu + ((u >> 16) & 1u)) >> 16; }
__device__ __forceinline__ unsigned pk2(float lo, float hi) { return f2bf(lo) | (f2bf(hi) << 16); }
__device__ __forceinline__ float bf2f(unsigned short b) { return __builtin_bit_cast(float, ((unsigned)b) << 16); }
__device__ __forceinline__ float bflo(unsigned w) { return __builtin_bit_cast(float, w << 16); }
__device__ __forceinline__ float bfhi(unsigned w) { return __builtin_bit_cast(float, w & 0xffff0000u); }
__device__ __forceinline__ float sigm(float x) { return __builtin_amdgcn_rcpf(1.f + __expf(-x)); }
__device__ __forceinline__ float siluf(float x) { return x * __builtin_amdgcn_rcpf(1.f + __expf(-x)); }
__device__ __forceinline__ float logsig(float x) { return x >= 0.f ? -log1pf(expf(-x)) : x - log1pf(expf(x)); }
__device__ __forceinline__ float wave_sum(float v) {
#pragma unroll
    for (int o = 1; o < 64; o <<= 1) v += __shfl_xor(v, o);
    return v;
}
#define LDS_WAIT() asm volatile("s_waitcnt lgkmcnt(0)" ::: "memory")
__device__ __forceinline__ float clamp8(float x) { return __builtin_amdgcn_fmed3f(x, -448.f, 448.f); }
__device__ __forceinline__ unsigned pk4_fp8(float a, float b, float c, float d) {
    int r = __builtin_amdgcn_cvt_pk_fp8_f32(clamp8(a), clamp8(b), 0, false); r = __builtin_amdgcn_cvt_pk_fp8_f32(clamp8(c), clamp8(d), r, true); return (unsigned)r; }
constexpr float W8_SCALE = 64.f, W8_INV = 1.f / 64.f;

struct Params {
    const float* in[27];
    float* out;
    unsigned char* ws;
    int ph_lo, ph_hi;
};


#define XB_TMO      128
#define XB_XCNT(j)  (256  + 64 * (j))
#define XB_XSUB(j)  (1280 + 64 * (j))
#define XB_XGEN(j)  (2304 + 64 * (j))
#define XB_TOP      3328
#define XB_TOPGEN   3392
#define XCD_BAR_WORDS 3456
#define XB_SPIN_CAP (1u << 18)
__device__ __forceinline__ unsigned xb_ld(unsigned* p)              { return __hip_atomic_load(p, __ATOMIC_RELAXED, __HIP_MEMORY_SCOPE_AGENT); }
__device__ __forceinline__ unsigned xb_add(unsigned* p, unsigned v) { return __hip_atomic_fetch_add(p, v, __ATOMIC_RELAXED, __HIP_MEMORY_SCOPE_AGENT); }
__device__ __forceinline__ unsigned xb_xcc_id() { return (unsigned)__builtin_amdgcn_s_getreg((3 << 11) | 20) & 0xFu; }
#define XB_SPIN(cond, bar) do { unsigned _sp = 0; while (cond) { __builtin_amdgcn_s_sleep(1); \
    if ((++_sp & 255u) == 0u) { if (xb_ld(&(bar)[XB_TMO])) break; if (_sp > XB_SPIN_CAP) { atomicAdd(&(bar)[XB_TMO], 1u); break; } } } } while (0)
struct XcdBarrier { unsigned* bar; unsigned x; volatile LAS unsigned* st; };
__device__ __forceinline__ XcdBarrier xcd_barrier_post(unsigned* bar, volatile LAS unsigned* st) {
    XcdBarrier b; b.bar = bar; b.x = xb_xcc_id(); b.st = st;
    if (threadIdx.x == 0) (void)xb_add(&bar[XB_XCNT(b.x)], 1u);
    return b;
}
__device__ __forceinline__ void xcd_barrier_complete(unsigned* bar, unsigned x, unsigned& nloc, unsigned& nx) {
    const unsigned G = gridDim.x * gridDim.y * gridDim.z;
    unsigned sum, cnt, mine, sp = 0u;
    for (;;) {
        sum = 0u; cnt = 0u; mine = 0u;
#pragma unroll
        for (unsigned j = 0; j < 16; ++j) { const unsigned c = xb_ld(&bar[XB_XCNT(j)]); sum += c; cnt += (c > 0u) ? 1u : 0u; mine = (j == x) ? c : mine; }
        if (sum == G) break;
        __builtin_amdgcn_s_sleep(1);
        if ((++sp & 255u) == 0u) { if (xb_ld(&bar[XB_TMO])) break; if (sp > XB_SPIN_CAP) { atomicAdd(&bar[XB_TMO], 1u); break; } }
    }
    nloc = mine > 0u ? mine : 1u; nx = cnt > 0u ? cnt : 1u;
}
__device__ __forceinline__ void xcd_barrier(const XcdBarrier& b) {
    asm volatile("s_waitcnt vmcnt(0)" ::: "memory");
    __syncthreads();
    if (threadIdx.x == 0) {
        unsigned* bar = b.bar;
        __builtin_amdgcn_s_waitcnt(0);
        unsigned nloc = b.st[0], nx = b.st[1];
        if (nloc == 0u) { xcd_barrier_complete(bar, b.x, nloc, nx); b.st[0] = nloc; b.st[1] = nx; }
        const unsigned old = xb_add(&bar[XB_XSUB(b.x)], 1u);
        const unsigned gen = old / nloc;
        if (old + 1u == (gen + 1u) * nloc) {
            __builtin_amdgcn_fence(__ATOMIC_RELEASE, "agent");
            asm volatile("s_waitcnt vmcnt(0)" ::: "memory");
            const unsigned og = xb_add(&bar[XB_TOP], 1u);
            const unsigned tg = og / nx;
            if (og + 1u == (tg + 1u) * nx) xb_add(&bar[XB_TOPGEN], 1u);
            else XB_SPIN(xb_ld(&bar[XB_TOPGEN]) == tg, bar);
            __builtin_amdgcn_fence(__ATOMIC_ACQUIRE, "agent");
            xb_add(&bar[XB_XGEN(b.x)], 1u);
            asm volatile("s_waitcnt vmcnt(0)" ::: "memory");
        } else {
            XB_SPIN(xb_ld(&bar[XB_XGEN(b.x)]) == gen, bar);
            __builtin_amdgcn_fence(__ATOMIC_ACQUIRE, "agent");
            asm volatile("s_waitcnt vmcnt(0)" ::: "memory");
        }
    }
    __syncthreads();
}

namespace pg8 {
constexpr int BM = 256, BK = 64, HALF = 128, HTB = HALF * BK * 2, STAGE_BYTES = 8 * HTB;
__device__ __forceinline__ int lds_byte(int r, int c) { const int st = (r >> 4) * 2 + (c >> 5), rr = r & 15, cc = c & 31, ob = rr * 64 + cc * 2; return st * 1024 + (ob ^ (((ob >> 9) & 1) << 5)); }
__device__ __forceinline__ void stage_rc(int b, int& R, int& C) { const int st = b / 1024, sb = b % 1024, swz = sb ^ (((sb >> 9) & 1) << 5); R = (st >> 1) * 16 + swz / 64; C = (st & 1) * 32 + (swz % 64) / 2; }
__device__ __forceinline__ int perm32(int rho) { const int n = rho >> 4, i = rho & 15; return 8 * (i >> 2) + 4 * n + (i & 3); }
__device__ __forceinline__ unsigned cvt_pk_bf16(float lo, float hi) { unsigned r; asm volatile("v_cvt_pk_bf16_f32 %0, %1, %2" : "=v"(r) : "v"(lo), "v"(hi)); return r; }

typedef int v4i_t __attribute__((ext_vector_type(4)));
typedef int v8i_t __attribute__((ext_vector_type(8)));
struct Unit { const char* A; const char* B; int pm, pn, aux; };

struct SchedGrid {
    const char* A; const char* B; size_t tstepA, tstepB; int nM, nN, pm0, pn0, G, c;
    int xN, xPm0, xPn0, xCnt;
    int split, gap;
    __device__ bool next(int i, Unit& u) const {
        const long L = (long)i * G + c; const int nwg = nM * nN;
        if (L >= nwg + xCnt) return false;
        if (L >= nwg) { const int q = (int)L - nwg; u.pm = xPm0 + q / xN; u.pn = xPn0 + q % xN; u.aux = 1; }
        else {
            int wgid = (int)L; { const int q = nwg / 8, r = nwg % 8, xcd = wgid % 8, off = wgid / 8; wgid = (xcd < r ? xcd * (q + 1) : r * (q + 1) + (xcd - r) * q) + off; }
            const int nig = 8 * nN, gid = wgid / nig, fm = gid * 8, gsz = (nM - fm) < 8 ? (nM - fm) : 8;
            u.pm = pm0 + fm + ((wgid % nig) % gsz); { const int idx = (wgid % nig) / gsz; u.pn = pn0 + idx + (idx >= split ? gap : 0); } u.aux = 0;
        }
        u.A = A + (size_t)u.pm * tstepA; u.B = B + (size_t)u.pn * tstepB; return true;
    }
};
struct SchedChain {
    SchedGrid G; size_t half;
    __device__ bool next(int i, Unit& u) const {
        if (!G.next(i >> 1, u)) return false;
        u.aux = i & 1; u.A += (size_t)(i & 1) * half; u.B += (size_t)(i & 1) * half; return true;
    }
};

struct SchedMoe {
    const char* A; const char* B; size_t tstepA, tstepB, estepA, estepB; int nM, nN, G, c;
    __device__ bool next(int i, Unit& u) const {
        const long L = (long)i * G + c; const int e8 = (int)(L % 8); const long ta = L / 8; const int per = nM * nN;
        if (ta >= 2L * per) return false;
        const int e = e8 + 8 * (int)(ta / per); const int t = (int)(ta % per);
        if (nN == 16) { const int blk = t >> 5, wi = t & 31; u.pm = 4 * (blk >> 1) + (wi >> 3); u.pn = 8 * (blk & 1) + (wi & 7); }
        else { u.pm = t / nN; u.pn = t % nN; }
        u.aux = e;
        u.A = A + (size_t)e * estepA + (size_t)u.pm * tstepA; u.B = B + (size_t)e * estepB + (size_t)u.pn * tstepB; return true;
    }
};

template <class Epi, class Sched, bool NORMAL, bool F8 = false>
__device__ __forceinline__ void gemm_phase(LAS unsigned char* lds, const int K  , const unsigned lda, const unsigned ldb, const Sched& S, const Epi& E) {
    const int tid = threadIdx.x, wid = __builtin_amdgcn_readfirstlane(tid >> 6), lane = tid & 63, wr = wid >> 2, wc = wid & 3, fr = lane & 15, fq = lane >> 4;
    const int nt = K / BK;
    unsigned voffA[2], voffB[2];
#pragma unroll
    for (int i = 0; i < 2; ++i) { int R, C; stage_rc(tid * 16 + i * 8192, R, C); const int Rb = Epi::PERM ? ((R & ~31) + perm32(R & 31)) : R;
        voffA[i] = (unsigned)R * lda + (unsigned)C * 2u; voffB[i] = (unsigned)Rb * ldb + (unsigned)C * 2u; }
    const size_t kstep = (size_t)(BK * 2);
    const size_t hstepA = (size_t)HALF * lda, hstepB = (size_t)HALF * ldb;
    const unsigned ldsw = (unsigned)wid * 1024u;
    const int aoff = lds_byte(wr * 64 + fr, fq * 8), boff = lds_byte(wc * 32 + fr, fq * 8);
#define PG8_SA(b, h) (((b) * 2 + (h)) * HTB)
#define PG8_SB(b, h) ((4 + (b) * 2 + (h)) * HTB)
#define PG8_STAGE(bufoff, gbase, voff) do { _Pragma("unroll") for (int _i = 0; _i < 2; ++_i) \
        __builtin_amdgcn_global_load_lds((const unsigned*)((const char*)(gbase) + (voff)[_i]), (LAS unsigned*)(lds + (bufoff) + ldsw + _i * 8192), 16, 0, 0); } while (0)
#define PG8_LDA(dst, b, h) do { if constexpr (F8) { _Pragma("unroll") for (int m = 0; m < 4; ++m) dst##8[m] = __builtin_shufflevector(*(const LAS v4i_t*)(lds + PG8_SA(b, h) + aoff + m * 2048), *(const LAS v4i_t*)(lds + PG8_SA(b, h) + aoff + m * 2048 + 1024), 0, 1, 2, 3, 4, 5, 6, 7); } \
        else { _Pragma("unroll") for (int m = 0; m < 4; ++m) _Pragma("unroll") for (int k = 0; k < 2; ++k) dst[m][k] = *(const LAS bf16x8*)(lds + PG8_SA(b, h) + aoff + m * 2048 + k * 1024); } } while (0)
#define PG8_LDB(dst, b, h) do { if constexpr (F8) { _Pragma("unroll") for (int n = 0; n < 2; ++n) dst##8[n] = __builtin_shufflevector(*(const LAS v4i_t*)(lds + PG8_SB(b, h) + boff + n * 2048), *(const LAS v4i_t*)(lds + PG8_SB(b, h) + boff + n * 2048 + 1024), 0, 1, 2, 3, 4, 5, 6, 7); } \
        else { _Pragma("unroll") for (int n = 0; n < 2; ++n) _Pragma("unroll") for (int k = 0; k < 2; ++k) dst[n][k] = *(const LAS bf16x8*)(lds + PG8_SB(b, h) + boff + n * 2048 + k * 1024); } } while (0)
#define PG8_MMA(ai, bj, At, Bt) do { __builtin_amdgcn_s_setprio(1); \
        if constexpr (F8) { _Pragma("unroll") for (int m = 0; m < 4; ++m) _Pragma("unroll") for (int n = 0; n < 2; ++n) \
            asm volatile("v_mfma_scale_f32_16x16x128_f8f6f4 %0, %1, %2, %0, %3, %3 op_sel_hi:[0,0,0]" : "+v"(acc[ai][bj][m][n]) : "v"(Bt##8[n]), "v"(At##8[m]), "v"(sc8)); } \
        else { _Pragma("unroll") for (int m = 0; m < 4; ++m) _Pragma("unroll") for (int n = 0; n < 2; ++n) _Pragma("unroll") for (int k = 0; k < 2; ++k) \
        acc[ai][bj][m][n] = NORMAL ? __builtin_amdgcn_mfma_f32_16x16x32_bf16(At[m][k], Bt[n][k], acc[ai][bj][m][n], 0, 0, 0) \
                                   : __builtin_amdgcn_mfma_f32_16x16x32_bf16(Bt[n][k], At[m][k], acc[ai][bj][m][n], 0, 0, 0); } __builtin_amdgcn_s_setprio(0); } while (0)
#define PG8_WAIT_V(n) asm volatile("s_waitcnt vmcnt(" #n ")" ::: "memory")
#define PG8_WAIT_L(n) asm volatile("s_waitcnt lgkmcnt(" #n ")" ::: "memory")
#define PG8_BAR __builtin_amdgcn_s_barrier()
#define PG8_SCHED __builtin_amdgcn_sched_barrier(0)
    Unit cur, nxt; int ui = 0;
    if (!S.next(0, cur)) return;
    f32x4 acc[2][2][4][2];
#pragma unroll
    for (int a = 0; a < 2; ++a)
#pragma unroll
        for (int b = 0; b < 2; ++b)
#pragma unroll
            for (int m = 0; m < 4; ++m)
#pragma unroll
                for (int n = 0; n < 2; ++n) acc[a][b][m][n] = (f32x4){0.f, 0.f, 0.f, 0.f};
    bf16x8 At[4][2], B0[2][2], B1[2][2];
    v8i_t At8[4], B08[2], B18[2]; const int sc8 = 0x7F7F7F7F;
    const char* cA = cur.A; const char* cB = cur.B;
    PG8_STAGE(PG8_SB(0, 0), cB, voffB); PG8_STAGE(PG8_SB(0, 1), cB + hstepB, voffB); PG8_STAGE(PG8_SA(0, 0), cA, voffA); PG8_STAGE(PG8_SA(0, 1), cA + hstepA, voffA);
    if (wr == 1) PG8_BAR;
    PG8_WAIT_V(2); PG8_BAR;
    PG8_STAGE(PG8_SB(1, 0), cB + kstep, voffB); PG8_STAGE(PG8_SA(1, 0), cA + kstep, voffA); PG8_STAGE(PG8_SB(1, 1), cB + hstepB + kstep, voffB);
    PG8_WAIT_V(6); PG8_BAR;
    for (;;) {
        const bool has_next = S.next(ui + 1, nxt);
        const char* nA = has_next ? nxt.A : cA; const char* nB = has_next ? nxt.B : cB;
#pragma unroll 1
        for (int t = 0; t < nt; t += 2) {
            const bool last = (t == nt - 2);
            const char* a1 = cA + (size_t)(t + 1) * kstep;
            const char* a2 = last ? nA : cA + (size_t)(t + 2) * kstep; const char* b2 = last ? nB : cB + (size_t)(t + 2) * kstep;
            const char* a3 = a2 + kstep; const char* b3 = b2 + kstep;
            PG8_LDB(B0, 0, 0); PG8_LDB(B1, 0, 1); PG8_SCHED; PG8_LDA(At, 0, 0); PG8_STAGE(PG8_SA(1, 1), a1 + hstepA, voffA);
            PG8_WAIT_V(8); PG8_WAIT_L(0); PG8_BAR; PG8_MMA(0, 0, At, B0); PG8_MMA(0, 1, At, B1); PG8_BAR; PG8_SCHED;
            PG8_LDA(At, 0, 1); PG8_STAGE(PG8_SB(0, 0), b2, voffB); PG8_STAGE(PG8_SB(0, 1), b2 + hstepB, voffB); PG8_STAGE(PG8_SA(0, 0), a2, voffA);
            PG8_WAIT_V(8); PG8_WAIT_L(0); PG8_BAR; PG8_MMA(1, 0, At, B0); PG8_MMA(1, 1, At, B1); PG8_BAR; PG8_SCHED;
            PG8_LDB(B0, 1, 0); PG8_LDB(B1, 1, 1); PG8_SCHED; PG8_LDA(At, 1, 0); PG8_STAGE(PG8_SA(0, 1), a2 + hstepA, voffA);
            PG8_WAIT_V(8); PG8_WAIT_L(0); PG8_BAR; PG8_MMA(0, 0, At, B0); PG8_MMA(0, 1, At, B1); PG8_BAR; PG8_SCHED;
            PG8_LDA(At, 1, 1); PG8_STAGE(PG8_SB(1, 0), b3, voffB); PG8_STAGE(PG8_SB(1, 1), b3 + hstepB, voffB); PG8_STAGE(PG8_SA(1, 0), a3, voffA);
            PG8_WAIT_V(8); PG8_WAIT_L(0); PG8_BAR; PG8_MMA(1, 0, At, B0); PG8_MMA(1, 1, At, B1); PG8_BAR; PG8_SCHED;
        }
        if (wr == 0) PG8_BAR;
        if constexpr (F8) asm volatile("s_nop 15\n\ts_nop 15" ::: "memory");
        bool keep = false;
        if constexpr (Epi::HAS_MID) { if (cur.aux == 0) { E.mid(acc, cur, wr, wc, fr, fq); keep = true; } else E(acc, cur, wr, wc, fr, fq); }
        else E(acc, cur, wr, wc, fr, fq);
        if (!has_next) break;
        if (!keep) {
#pragma unroll
        for (int a = 0; a < 2; ++a)
#pragma unroll
            for (int b = 0; b < 2; ++b)
#pragma unroll
                for (int m = 0; m < 4; ++m)
#pragma unroll
                    for (int n = 0; n < 2; ++n) acc[a][b][m][n] = (f32x4){0.f, 0.f, 0.f, 0.f};
        }
        cur = nxt; cA = nA; cB = nB; ++ui;
        if (wr == 1) PG8_BAR;
    }
    PG8_WAIT_V(0);
    PG8_BAR;
#undef PG8_SA
#undef PG8_SB
#undef PG8_STAGE
#undef PG8_LDA
#undef PG8_LDB
#undef PG8_MMA
#undef PG8_WAIT_V
#undef PG8_WAIT_L
#undef PG8_BAR
#undef PG8_SCHED
}


struct EpiCM {
    static constexpr bool PERM = false, HAS_MID = false;
    bf16_t* pcm; bf16_t* kvcm; const float* bias;
    __device__ __forceinline__ void operator()(const f32x4 (&acc)[2][2][4][2], const Unit& u, int wr, int wc, int fr, int fq) const {
        const bool kv = u.pn >= 8;
#pragma unroll
        for (int bj = 0; bj < 2; ++bj)
#pragma unroll
            for (int n = 0; n < 2; ++n) {
                const int c = u.pn * BM + bj * HALF + wc * 32 + n * 16 + fr; const float bv = bias[c];
                bf16_t* base = kv ? (kvcm + (size_t)(c - 2048) * MT) : (pcm + (size_t)c * MX);
#pragma unroll
                for (int ai = 0; ai < 2; ++ai)
#pragma unroll
                    for (int m = 0; m < 4; ++m) {
                        const int r = u.pm * BM + ai * HALF + wr * 64 + m * 16 + 4 * fq; const f32x4 v = acc[ai][bj][m][n] + bv;
                        u32x2 w; w.x = cvt_pk_bf16(v[0], v[1]); w.y = cvt_pk_bf16(v[2], v[3]);
                        *(u32x2*)(base + r) = w; }
                asm volatile("" ::: "memory");
            }
    }
};

struct EpiIn2 {
    static constexpr bool PERM = true, HAS_MID = false;
    bf16_t* pml; bf16_t* pmg; const float* bias;
    __device__ __forceinline__ void operator()(const f32x4 (&acc)[2][2][4][2], const Unit& u, int wr, int wc, int fr, int fq) const {
        const int colt = u.pn * BM; bf16_t* base; int ldc, cbase, bofs = 0; const int row0 = u.pm * BM; bool sg = false;
        if (colt < 2048) { base = pml; ldc = 1024; cbase = colt - 1536; }
        else if (colt < GATE0) { base = pml; ldc = 1024; cbase = colt - 3072 + 512; }
        else { base = pmg; ldc = 2048; cbase = colt - GATE0; bofs = 16; sg = true; }
        const int col0 = cbase + wc * 32 + 8 * fq, bcol0 = colt + bofs + wc * 32 + 8 * fq;
        f32x4 bv[2][2];
#pragma unroll
        for (int bj = 0; bj < 2; ++bj)
#pragma unroll
            for (int n = 0; n < 2; ++n) bv[bj][n] = *(const f32x4*)(bias + bcol0 + bj * HALF + 4 * n);
#pragma unroll
        for (int ai = 0; ai < 2; ++ai)
#pragma unroll
            for (int m = 0; m < 4; ++m) { bf16_t* rowp = base + (size_t)(row0 + wr * 64 + fr + ai * HALF + m * 16) * ldc + col0;
#pragma unroll
                for (int bj = 0; bj < 2; ++bj) { f32x4 v0 = acc[ai][bj][m][0] + bv[bj][0], v1 = acc[ai][bj][m][1] + bv[bj][1];
                    if (sg) {
#pragma unroll
                        for (int j = 0; j < 4; ++j) { v0[j] = sigm(v0[j]); v1[j] = sigm(v1[j]); } }
                    u32x4 w; w.x = cvt_pk_bf16(v0[0], v0[1]); w.y = cvt_pk_bf16(v0[2], v0[3]); w.z = cvt_pk_bf16(v1[0], v1[1]); w.w = cvt_pk_bf16(v1[2], v1[3]);
                    *(u32x4*)(rowp + bj * HALF) = w; }
                asm volatile("" ::: "memory"); }
    }
};

struct EpiMerge {
    static constexpr bool PERM = true, HAS_MID = true;
    bf16_t* Z; const bf16_t* pmg;
    __device__ __forceinline__ void mid(f32x4 (&acc)[2][2][4][2], const Unit& u, int wr, int wc, int fr, int fq) const {
        const int row0 = u.pm * BM + wr * 64 + fr, col0 = u.pn * BM + wc * 32 + 8 * fq;
#pragma unroll
        for (int ai = 0; ai < 2; ++ai)
#pragma unroll
            for (int m = 0; m < 4; ++m) {
                u32x4 ga[2], gb[2];
#pragma unroll
                for (int bj = 0; bj < 2; ++bj) { const bf16_t* gp = pmg + (size_t)(row0 + ai * HALF + m * 16) * 2048 + col0 + bj * HALF;
                    ga[bj] = *(const u32x4*)gp; gb[bj] = *(const u32x4*)(gp + 1024); }
#pragma unroll
                for (int bj = 0; bj < 2; ++bj) { const u32x4 a = ga[bj], b = gb[bj];
                    f32x4& v0 = acc[ai][bj][m][0]; f32x4& v1 = acc[ai][bj][m][1];
                    v0[0] *= bflo(a.x) * __builtin_amdgcn_rcpf(bflo(b.x)); v0[1] *= bfhi(a.x) * __builtin_amdgcn_rcpf(bfhi(b.x));
                    v0[2] *= bflo(a.y) * __builtin_amdgcn_rcpf(bflo(b.y)); v0[3] *= bfhi(a.y) * __builtin_amdgcn_rcpf(bfhi(b.y));
                    v1[0] *= bflo(a.z) * __builtin_amdgcn_rcpf(bflo(b.z)); v1[1] *= bfhi(a.z) * __builtin_amdgcn_rcpf(bfhi(b.z));
                    v1[2] *= bflo(a.w) * __builtin_amdgcn_rcpf(bflo(b.w)); v1[3] *= bfhi(a.w) * __builtin_amdgcn_rcpf(bfhi(b.w)); }
                if (m & 1) asm volatile("" ::: "memory"); }
    }
    __device__ __forceinline__ void operator()(const f32x4 (&acc)[2][2][4][2], const Unit& u, int wr, int wc, int fr, int fq) const {
        const int row0 = u.pm * BM + wr * 64 + fr, col0 = u.pn * BM + wc * 32 + 8 * fq;
#pragma unroll
        for (int ai = 0; ai < 2; ++ai) {
            u32x4 g[4][2];
#pragma unroll
            for (int m = 0; m < 4; ++m)
#pragma unroll
                for (int bj = 0; bj < 2; ++bj) g[m][bj] = *(const u32x4*)(pmg + (size_t)(row0 + ai * HALF + m * 16) * 2048 + 1024 + col0 + bj * HALF);
#pragma unroll
            for (int m = 0; m < 4; ++m)
#pragma unroll
                for (int bj = 0; bj < 2; ++bj) { const size_t row = (size_t)(row0 + ai * HALF + m * 16); const u32x4 gg = g[m][bj];
                    f32x4 v0 = acc[ai][bj][m][0], v1 = acc[ai][bj][m][1];
                    v0[0] *= bflo(gg.x); v0[1] *= bfhi(gg.x); v0[2] *= bflo(gg.y); v0[3] *= bfhi(gg.y);
                    v1[0] *= bflo(gg.z); v1[1] *= bfhi(gg.z); v1[2] *= bflo(gg.w); v1[3] *= bfhi(gg.w);
                    u32x4 w; w.x = cvt_pk_bf16(v0[0], v0[1]); w.y = cvt_pk_bf16(v0[2], v0[3]); w.z = cvt_pk_bf16(v1[0], v1[1]); w.w = cvt_pk_bf16(v1[2], v1[3]);
                    *(u32x4*)(Z + row * 1024 + col0 + bj * HALF) = w; }
            asm volatile("" ::: "memory"); }
    }
};

struct EpiOut {
    static constexpr bool PERM = true, HAS_MID = false;
    const float* x; bf16_t* xmid; const float* ada;
    __device__ __forceinline__ void operator()(const f32x4 (&acc)[2][2][4][2], const Unit& u, int wr, int wc, int fr, int fq) const {
        const int row0 = u.pm * BM + wr * 64 + fr, col0 = u.pn * BM + wc * 32 + 8 * fq;
        const int b = (u.pm * BM) / SEQ;
        f32x4 gv[2][2];
#pragma unroll
        for (int bj = 0; bj < 2; ++bj)
#pragma unroll
            for (int n = 0; n < 2; ++n) gv[bj][n] = *(const f32x4*)(ada + (size_t)b * 6144 + 2048 + col0 + bj * HALF + 4 * n);
#pragma unroll
        for (int ai = 0; ai < 2; ++ai)
#pragma unroll
            for (int m = 0; m < 4; ++m) {
                f32x4 xv[2][2]; const size_t off = (size_t)(row0 + ai * HALF + m * 16) * DM + col0;
#pragma unroll
                for (int bj = 0; bj < 2; ++bj)
#pragma unroll
                    for (int n = 0; n < 2; ++n) xv[bj][n] = *(const f32x4*)(x + off + bj * HALF + 4 * n);
#pragma unroll
                for (int bj = 0; bj < 2; ++bj) { const f32x4 v0 = xv[bj][0] + gv[bj][0] * acc[ai][bj][m][0], v1 = xv[bj][1] + gv[bj][1] * acc[ai][bj][m][1];
                    u32x4 w; w.x = cvt_pk_bf16(v0[0], v0[1]); w.y = cvt_pk_bf16(v0[2], v0[3]); w.z = cvt_pk_bf16(v1[0], v1[1]); w.w = cvt_pk_bf16(v1[2], v1[3]);
                    *(u32x4*)(xmid + off + bj * HALF) = w; }
                if (m & 1) asm volatile("" ::: "memory"); }
    }
};

struct EpiMoe1 {
    static constexpr bool PERM = true, HAS_MID = false;
    unsigned char* act; int skip;
    __device__ __forceinline__ void operator()(const f32x4 (&acc)[2][2][4][2], const Unit& u, int wr, int wc, int fr, int fq) const {
        if (skip == 1) { asm volatile("" :: "v"(acc[0][0][0][0]), "v"(acc[1][1][3][1])); return; }
        const int row0 = u.aux * 4096 + u.pm * BM + wr * 64 + fr, col0 = (u.pn * BM + wc * 32) / 2 + 4 * fq;
#pragma unroll
        for (int ai = 0; ai < 2; ++ai)
#pragma unroll
            for (int m = 0; m < 4; ++m) { unsigned char* rowp = act + (size_t)(row0 + ai * HALF + m * 16) * DFF + col0;
#pragma unroll
                for (int bj = 0; bj < 2; ++bj) { const f32x4 v0 = acc[ai][bj][m][0] * W8_INV, v1 = acc[ai][bj][m][1] * W8_INV;
                    const unsigned pk = pk4_fp8(siluf(v0[0]) * v0[1], siluf(v0[2]) * v0[3], siluf(v1[0]) * v1[1], siluf(v1[2]) * v1[3]);
                    if (skip == 2) asm volatile("" :: "v"(pk)); else *(unsigned*)(rowp + bj * (HALF / 2)) = pk; }
                asm volatile("" ::: "memory"); }
    }
};

struct EpiMoe2 {
    static constexpr bool PERM = true, HAS_MID = false;
    bf16_t* ye; const float* sgate; bool skip;
    __device__ __forceinline__ void operator()(const f32x4 (&acc)[2][2][4][2], const Unit& u, int wr, int wc, int fr, int fq) const {
        if (skip) { asm volatile("" :: "v"(acc[0][0][0][0]), "v"(acc[1][1][3][1])); return; }
        const int e = u.aux, col0 = u.pn * BM + wc * 32 + 8 * fq;
        float gt[2][4];
#pragma unroll
        for (int ai = 0; ai < 2; ++ai)
#pragma unroll
            for (int m = 0; m < 4; ++m) { const int rr = u.pm * BM + wr * 64 + fr + ai * HALF + m * 16; gt[ai][m] = sgate[((rr >> 9) * NE + e) * CAP + (rr & 511)] * W8_INV; }
#pragma unroll
        for (int ai = 0; ai < 2; ++ai)
#pragma unroll
            for (int m = 0; m < 4; ++m) { const int rr = u.pm * BM + wr * 64 + fr + ai * HALF + m * 16;
                const float g = gt[ai][m];
                bf16_t* rowp = ye + ((size_t)e * 4096 + rr) * DM + col0;
#pragma unroll
                for (int bj = 0; bj < 2; ++bj) { const f32x4 v0 = acc[ai][bj][m][0] * g, v1 = acc[ai][bj][m][1] * g;
                    u32x4 w; w.x = cvt_pk_bf16(v0[0], v0[1]); w.y = cvt_pk_bf16(v0[2], v0[3]); w.z = cvt_pk_bf16(v1[0], v1[1]); w.w = cvt_pk_bf16(v1[2], v1[3]);
                    *(u32x4*)(rowp + bj * HALF) = w; }
                asm volatile("" ::: "memory"); }
    }
};
}

struct Ctx {
    LAS unsigned char* lds;
    int tid, lane, wave, bid, G;
};

__device__ __forceinline__ void transpose_item(const float* W, int ldw, int ldt, int ncol0, bf16_t* WT, int dst_row0, int rmul, LAS float* scr, int kb, int nb, int lane) {
    const int k0 = 64 * kb, n0 = 32 * nb;
#pragma unroll 8
    for (int i = 0; i < 32; ++i) { const int kk = 2 * i + (lane >> 5); scr[kk * 33 + (lane & 31)] = W[(size_t)(k0 + kk) * ldw + ncol0 + n0 + (lane & 31)]; }
    LDS_WAIT();
    const int c = lane & 7;
#pragma unroll
    for (int j = 0; j < 4; ++j) { const int n = (lane >> 3) + 8 * j; const LAS float* s = scr + (8 * c) * 33 + n;
        u32x4 o; o.x = pk2(s[0 * 33], s[1 * 33]); o.y = pk2(s[2 * 33], s[3 * 33]); o.z = pk2(s[4 * 33], s[5 * 33]); o.w = pk2(s[6 * 33], s[7 * 33]);
        *(u32x4*)(WT + (size_t)(dst_row0 + (n0 + n) * rmul) * ldt + k0 + 8 * c) = o; }
    LDS_WAIT();
}

__device__ __forceinline__ void transpose_item_f8(const float* W, int ldw, int K, unsigned char* WT, int dst_row0, int rmul, LAS float* scr, int kb, int nb, int lane) {
    const int k0 = 64 * kb, n0 = 32 * nb;
#pragma unroll 8
    for (int i = 0; i < 32; ++i) { const int kk = 2 * i + (lane >> 5); scr[kk * 33 + (lane & 31)] = W[(size_t)(k0 + kk) * ldw + n0 + (lane & 31)]; }
    LDS_WAIT();
    const int c = lane & 3;
#pragma unroll
    for (int j = 0; j < 2; ++j) { const int n = (lane >> 2) + 16 * j; const LAS float* s = scr + (16 * c) * 33 + n;
        u32x4 o;
        o.x = pk4_fp8(s[0 * 33] * W8_SCALE, s[1 * 33] * W8_SCALE, s[2 * 33] * W8_SCALE, s[3 * 33] * W8_SCALE);
        o.y = pk4_fp8(s[4 * 33] * W8_SCALE, s[5 * 33] * W8_SCALE, s[6 * 33] * W8_SCALE, s[7 * 33] * W8_SCALE);
        o.z = pk4_fp8(s[8 * 33] * W8_SCALE, s[9 * 33] * W8_SCALE, s[10 * 33] * W8_SCALE, s[11 * 33] * W8_SCALE);
        o.w = pk4_fp8(s[12 * 33] * W8_SCALE, s[13 * 33] * W8_SCALE, s[14 * 33] * W8_SCALE, s[15 * 33] * W8_SCALE);
        *(u32x4*)(WT + (size_t)(dst_row0 + (n0 + n) * rmul) * K + k0 + 16 * c) = o; }
    LDS_WAIT();
}

__device__ __forceinline__ void convert_experts(const Ctx& C, const Params& P) {
    unsigned char* w13 = P.ws + WS_W13; unsigned char* w2 = P.ws + WS_W2;
    LAS float* scr = (LAS float*)(C.lds + C.wave * 8448);
    const int gw = C.bid * 8 + C.wave, NGW = C.G * 8;
    const int PER_E = 3072;
    for (int it = gw; it < NE * PER_E; it += NGW) {
        const int e = it / PER_E, r = it % PER_E;
        if (r < 1024) transpose_item_f8(P.in[23] + (size_t)e * DM * DFF, DFF, DM, w13 + (size_t)e * 4096 * DM, 0, 2, scr, r / 64, r % 64, C.lane);
        else if (r < 2048) transpose_item_f8(P.in[24] + (size_t)e * DM * DFF, DFF, DM, w13 + (size_t)e * 4096 * DM, 1, 2, scr, (r - 1024) / 64, (r - 1024) % 64, C.lane);
        else transpose_item_f8(P.in[25] + (size_t)e * DFF * DM, DM, DFF, w2 + (size_t)e * DM * DFF, 0, 1, scr, (r - 2048) / 32, (r - 2048) % 32, C.lane);
    }
}

__device__ __forceinline__ void phase0(const Ctx& C, const Params& P) {
    unsigned char* ws = P.ws;
    const int gw = C.bid * 8 + C.wave, NGW = C.G * 8;
    {
        LAS float* scr = (LAS float*)(C.lds + C.wave * 8448);
        const int I_IN1 = 16 * 112, I_IN2 = 16 * 64, I_BH = 8 * 32, I_BM = 8 * 32, I_OUT = 16 * 32;
        const int NIT = I_IN1 + I_IN2 + I_BH + I_BM + I_OUT;
        for (int it = gw; it < NIT; it += NGW) {
            int r = it;
            if (r < I_IN1) { transpose_item(P.in[8], DIN, DM, 0, (bf16_t*)(ws + WS_WIN), 0, 1, scr, r / 112, r % 112, C.lane); continue; } r -= I_IN1;
            if (r < I_IN2) { transpose_item(P.in[8], DIN, DM, MERGE0, (bf16_t*)(ws + WS_WIN), GATE0, 1, scr, r / 64, r % 64, C.lane); continue; } r -= I_IN2;
            if (r < I_BH) { transpose_item(P.in[19], DM, 1024, 0, (bf16_t*)(ws + WS_WB), 0, 1, scr, r / 32, r % 32, C.lane); continue; } r -= I_BH;
            if (r < I_BM) { transpose_item(P.in[20], DM, 1024, 0, (bf16_t*)(ws + WS_WB) + 512, 0, 1, scr, r / 32, r % 32, C.lane); continue; } r -= I_BM;
            transpose_item(P.in[21], DM, DM, 0, (bf16_t*)(ws + WS_WOUT), 0, 1, scr, r / 32, r % 32, C.lane);
        }
    }
    {
        const float* wada = P.in[4]; const float* bada = P.in[5]; float* part = (float*)(ws + WS_ADAP);
        for (int it = gw; it < 96 * 8; it += NGW) {
            const int cgp = it % 96, ks = it / 96, n = cgp * 64 + C.lane;
            float a[9];
#pragma unroll
            for (int r = 0; r < 9; ++r) a[r] = 0.f;
#pragma unroll 1
            for (int k1 = 0; k1 < 4; ++k1) {
                const int k0 = ks * 128 + k1 * 32;
                float sv[9];
                { const int k = k0 + (C.lane & 31);
#pragma unroll
                  for (int r = 0; r < 8; ++r) sv[r] = siluf(P.in[1][r * DM + k]);
                  sv[8] = siluf(P.in[3][k]); }
                float wv[32];
#pragma unroll
                for (int kk = 0; kk < 32; ++kk) wv[kk] = wada[(size_t)(k0 + kk) * 6144 + n];
#pragma unroll
                for (int kk = 0; kk < 32; ++kk) {
#pragma unroll
                    for (int r = 0; r < 9; ++r) a[r] += __shfl(sv[r], kk) * wv[kk]; }
            }
            const float bb = (ks == 0) ? bada[n] : 0.f;
#pragma unroll
            for (int r = 0; r < 9; ++r) part[((size_t)ks * 9 + r) * 6144 + n] = a[r] + bb;
        }
    }
    __syncthreads();
    {
        LAS float* zs = (LAS float*)C.lds;
        LAS float* h1 = zs + 16 * 33;
        LAS float* h2 = h1 + 16 * 64;
        LAS float* w1s = h2 + 16 * 64;
        LAS float* w2s = w1s + 33 * 64;
        bf16_t* krev = (bf16_t*)(ws + WS_KREV);
        const float* w1 = P.in[11]; const float* b1 = P.in[12]; const float* w2 = P.in[13]; const float* b2 = P.in[14]; const float* w3 = P.in[15];
        for (int idx = C.tid; idx < 33 * 64; idx += NTHR) w1s[idx] = w1[idx];
        for (int idx = C.tid; idx < 64 * 64; idx += NTHR) w2s[idx] = w2[idx];
        for (int it = C.bid; it < 256; it += C.G) {
            const int l0 = it * 16;
            __syncthreads();
            for (int idx = C.tid; idx < 16 * 33; idx += NTHR) { const int pos = idx / 33, m = idx % 33, l = l0 + pos; float v;
                if (m == 0) v = (float)l / 4095.0f;
                else { const int bi = (m - 1) & 15; const float band = 1e-4f + (float)bi * ((15.0f - 1e-4f) / 15.0f);
                    const float ang = ((float)(2.0 * 3.14159265358979323846 / 4096.0) * (float)l) * band; v = (m <= 16) ? cosf(ang) : sinf(ang); }
                zs[idx] = v; }
            __syncthreads();
            for (int idx = C.tid; idx < 16 * 64; idx += NTHR) { const int pos = idx >> 6, j = idx & 63; float s = b1[j];
#pragma unroll
                for (int m = 0; m < 33; ++m) s += zs[pos * 33 + m] * w1s[m * 64 + j];
                h1[idx] = sinf(s); }
            __syncthreads();
            for (int idx = C.tid; idx < 16 * 64; idx += NTHR) { const int pos = idx >> 6, j = idx & 63; float s = b2[j];
#pragma unroll 16
                for (int k = 0; k < 64; ++k) s += h1[pos * 64 + k] * w2s[k * 64 + j];
                h2[j * 16 + pos] = sinf(s); }
            __syncthreads();
#pragma unroll 1
            for (int q = 0; q < 4; ++q) {
                const int n = C.tid + NTHR * q;
                float a[16];
#pragma unroll
                for (int p = 0; p < 16; ++p) a[p] = 0.f;
                float wv[16];
#pragma unroll
                for (int k = 0; k < 16; ++k) wv[k] = w3[k * 2048 + n];
#pragma unroll 1
                for (int kb = 0; kb < 4; ++kb) {
                    float wc[16];
#pragma unroll
                    for (int k = 0; k < 16; ++k) wc[k] = wv[k];
                    const int kn = (kb < 3) ? (kb + 1) * 16 : 0;
#pragma unroll
                    for (int k = 0; k < 16; ++k) wv[k] = w3[(kn + k) * 2048 + n];
#pragma unroll
                    for (int kk = 0; kk < 16; ++kk) { const float w = wc[kk]; const LAS float* hp = h2 + (kb * 16 + kk) * 16;
#pragma unroll
                        for (int p4 = 0; p4 < 4; ++p4) { const f32x4 hv = *(const LAS f32x4*)(hp + 4 * p4);
                            a[4 * p4] += hv[0] * w; a[4 * p4 + 1] += hv[1] * w; a[4 * p4 + 2] += hv[2] * w; a[4 * p4 + 3] += hv[3] * w; }
                        if (kk & 1) asm volatile("" ::: "memory"); }
                }
                const int o = n >> 10, side = (n >> 9) & 1, c = n & 511;
                const float delta = fabsf(-3.0701134573253944f + (float)c * ((-15.350567286626972f + 3.0701134573253944f) / 511.0f));
                bf16_t* dst = krev + ((size_t)o * 512 + c) * 8192;
#pragma unroll
                for (int p = 0; p < 16; ++p) { const int l = l0 + p; const float t = (float)l / 4095.0f; const float v = a[p] * expf(-t * delta);
                    if (side == 0) dst[4096 - l] = (bf16_t)f2bf(v);
                    else if (l > 0) dst[4096 + l] = (bf16_t)f2bf(v);
                    else dst[0] = 0; }
            }
        }
    }
}

__device__ __forceinline__ int wl_pos(int k) { return ((k & 3) + 4 * (k >> 8)) * 64 + ((k >> 2) & 63); }
__device__ __forceinline__ float row_dot16(const f32x4 (&y)[4], const LAS float* Wl, int lane) {
    float r[16];
#pragma unroll
    for (int e = 0; e < 16; ++e) r[e] = 0.f;
#pragma unroll
    for (int j = 0; j < 4; ++j) {
#pragma unroll
        for (int q = 0; q < 4; ++q) { const float v = y[j][q]; const LAS float* wp = Wl + ((q + 4 * j) * 64 + lane) * 20;
#pragma unroll
            for (int e4 = 0; e4 < 4; ++e4) { const f32x4 w = *(const LAS f32x4*)(wp + e4 * 4);
                r[e4 * 4 + 0] += v * w[0]; r[e4 * 4 + 1] += v * w[1]; r[e4 * 4 + 2] += v * w[2]; r[e4 * 4 + 3] += v * w[3]; } }
        asm volatile("" ::: "memory"); }
    const bool b5 = (lane & 32) != 0, b4 = (lane & 16) != 0, b3 = (lane & 8) != 0, b2 = (lane & 4) != 0;
    float t[8];
#pragma unroll
    for (int e = 0; e < 8; ++e) { const float snd = b5 ? r[e] : r[e + 8], kp = b5 ? r[e + 8] : r[e]; t[e] = kp + __shfl_xor(snd, 32); }
    float u[4];
#pragma unroll
    for (int e = 0; e < 4; ++e) { const float snd = b4 ? t[e] : t[e + 4], kp = b4 ? t[e + 4] : t[e]; u[e] = kp + __shfl_xor(snd, 16); }
    float v2[2];
#pragma unroll
    for (int e = 0; e < 2; ++e) { const float snd = b3 ? u[e] : u[e + 2], kp = b3 ? u[e + 2] : u[e]; v2[e] = kp + __shfl_xor(snd, 8); }
    float s; { const float snd = b2 ? v2[0] : v2[1], kp = b2 ? v2[1] : v2[0]; s = kp + __shfl_xor(snd, 4); }
    s += __shfl_xor(s, 2); s += __shfl_xor(s, 1);
    return s;
}

__device__ __forceinline__ void phase1(const Ctx& C, const Params& P) {
    unsigned char* ws = P.ws;
    const float* part = (const float*)(ws + WS_ADAP); float* ada = (float*)(ws + WS_ADA);
    for (int o = C.bid * NTHR + C.tid; o < 9 * 6144; o += C.G * NTHR) { float s = 0.f;
#pragma unroll
        for (int ks = 0; ks < 8; ++ks) s += part[(size_t)ks * 9 * 6144 + o];
        ada[o] = s; }
    LAS float* Wg = (LAS float*)C.lds;
    LAS float* mod = Wg + 1024 * 20;
#pragma unroll 1
    for (int i0 = C.tid; i0 < 1024 * 16; i0 += 8 * NTHR) { float t8[8];
#pragma unroll
        for (int u = 0; u < 8; ++u) { const int idx = i0 + u * NTHR; t8[u] = P.in[8][(size_t)(idx >> 4) * DIN + GATE0 + (idx & 15)]; }
#pragma unroll
        for (int u = 0; u < 8; ++u) { const int idx = i0 + u * NTHR; Wg[wl_pos(idx >> 4) * 20 + (idx & 15)] = t8[u]; } }
    const float* gmix = P.in[6]; const float* bin = P.in[9];
    bf16_t* hx = (bf16_t*)(ws + WS_HX); float* gates = (float*)(ws + WS_GATES);
    for (int rg = C.bid; rg < 256; rg += C.G) {
        const int b = rg >> 5;
        __syncthreads();
#pragma unroll 2
        for (int idx = C.tid; idx < 4096; idx += NTHR) { const int which = idx >> 10, k = idx & 1023; const int r = (which < 2) ? b : 8; const int col = (which & 1) * 1024 + k;
            float s = 0.f;
#pragma unroll
            for (int ks = 0; ks < 8; ++ks) s += part[((size_t)ks * 9 + r) * 6144 + col];
            mod[idx] = s; }
        __syncthreads();
        auto rowsrc = [&](int rr) -> const float* { return (rr < 128) ? (P.in[0] + (size_t)(rg * 128 + rr) * DM) : (P.in[2] + (size_t)(rg * 8 + (rr - 128)) * DM); };
        f32x4 nx[4];
        { const float* s0 = rowsrc(C.wave);
#pragma unroll
          for (int j = 0; j < 4; ++j) nx[j] = *(const f32x4*)(s0 + 4 * C.lane + 256 * j); }
        for (int rr = C.wave; rr < 136; rr += 8) {
            const bool isx = rr < 128; const int grow = isx ? (rg * 128 + rr) : (MX + rg * 8 + (rr - 128));
            const LAS float* sh = mod + (isx ? 0 : 2048); const LAS float* sc = sh + 1024;
            f32x4 v[4]; float ss = 0.f;
#pragma unroll
            for (int j = 0; j < 4; ++j) { v[j] = nx[j]; ss += v[j][0] * v[j][0] + v[j][1] * v[j][1] + v[j][2] * v[j][2] + v[j][3] * v[j][3]; }
            if (rr + 8 < 136) { const float* s1 = rowsrc(rr + 8);
#pragma unroll
                for (int j = 0; j < 4; ++j) nx[j] = *(const f32x4*)(s1 + 4 * C.lane + 256 * j); }
            const float rstd = rsqrtf(wave_sum(ss) * (1.f / DM) + RMS_EPS);
#pragma unroll
            for (int j = 0; j < 4; ++j) { const int k = 4 * C.lane + 256 * j; const f32x4 g = *(const f32x4*)(gmix + k);
                const f32x4 s4 = *(const LAS f32x4*)(sc + k), h4 = *(const LAS f32x4*)(sh + k);
#pragma unroll
                for (int q = 0; q < 4; ++q) v[j][q] = (v[j][q] * rstd * g[q]) * (1.f + s4[q]) + h4[q];
                u32x2 w; w.x = pk2(v[j][0], v[j][1]); w.y = pk2(v[j][2], v[j][3]);
                *(u32x2*)(hx + (size_t)grow * DM + k) = w; }
            const float gsum = row_dot16(v, Wg, C.lane);
            if ((C.lane & 3) == 0) gates[(size_t)grow * 16 + (C.lane >> 2)] = gsum + bin[GATE0 + (C.lane >> 2)];
        }
    }
}

__device__ __forceinline__ void phase2a(const Ctx& C, const Params& P) {
    unsigned char* ws = P.ws;
    pg8::SchedGrid S{(const char*)(ws + WS_HX), (const char*)(ws + WS_WIN), (size_t)256 * 2048, (size_t)256 * 2048, 128, 10, 0, 0, C.G, C.bid, 4, 128, 8, 32, 6, 2};
    pg8::EpiCM E{(bf16_t*)(ws + WS_PCM), (bf16_t*)(ws + WS_KVCM), P.in[9]};
    pg8::gemm_phase<pg8::EpiCM, pg8::SchedGrid, true>(C.lds, 1024, 2048, 2048, S, E);
}
__device__ __forceinline__ void phase2b(const Ctx& C, const Params& P) {
    unsigned char* ws = P.ws;
    pg8::SchedGrid S{(const char*)(ws + WS_HX), (const char*)(ws + WS_WIN), (size_t)256 * 2048, (size_t)256 * 2048, 128, 12, 0, 6, C.G, C.bid, 1, 0, 0, 0, 2, 4};
    pg8::EpiIn2 E{(bf16_t*)(ws + WS_PML), (bf16_t*)P.out, P.in[9]};
    pg8::gemm_phase<pg8::EpiIn2, pg8::SchedGrid, false>(C.lds, 1024, 2048, 2048, S, E);
}
__device__ __forceinline__ void phase_merge(const Ctx& C, const Params& P) {
    unsigned char* ws = P.ws;
    pg8::SchedChain S{{(const char*)(ws + WS_YAB), (const char*)(ws + WS_WB), (size_t)256 * 2048, (size_t)256 * 2048, 128, 4, 0, 0, C.G, C.bid, 1, 0, 0, 0, 1 << 30, 0}, 1024};
    pg8::EpiMerge E{(bf16_t*)(ws + WS_Z), (const bf16_t*)P.out};
    pg8::gemm_phase<pg8::EpiMerge, pg8::SchedChain, false>(C.lds, 512, 2048, 2048, S, E);
}
__device__ __forceinline__ void phase_outproj(const Ctx& C, const Params& P) {
    unsigned char* ws = P.ws;
    pg8::SchedGrid S{(const char*)(ws + WS_Z), (const char*)(ws + WS_WOUT), (size_t)256 * 2048, (size_t)256 * 2048, 128, 4, 0, 0, C.G, C.bid, 1, 0, 0, 0, 1 << 30, 0};
    pg8::EpiOut E{P.in[0], (bf16_t*)(ws + WS_XMID), (const float*)(ws + WS_ADA)};
    pg8::gemm_phase<pg8::EpiOut, pg8::SchedGrid, false>(C.lds, 1024, 2048, 2048, S, E);
}

constexpr int HY_KSTR = 16448;
constexpr int HY_UOFF = 4 * HY_KSTR;
constexpr int HY_USTR = 4616;
template <int MODE>
__device__ __forceinline__ void hyena_item(const Ctx& C, const Params& P, int o, int c) {
    unsigned char* ws = P.ws;
    LAS bf16_t* krv = (LAS bf16_t*)C.lds;
    LAS bf16_t* up = (LAS bf16_t*)(C.lds + HY_UOFF);
    const bf16_t* pcm = (const bf16_t*)(ws + WS_PCM);
    const float* hconv = P.in[10];
    __syncthreads();
    {
        const u32x4* src = (const u32x4*)((const bf16_t*)(ws + WS_KREV) + ((size_t)o * 512 + c) * 8192);
        for (int i = C.tid; i < 1024; i += NTHR) *(LAS u32x4*)(krv + 8 * i) = src[i];
        for (int i = C.tid; i < 8 * 65; i += NTHR) { const int b = i / 65, q = i % 65; const int off = (q < 32) ? 8 * q : (4352 + 8 * (q - 32));
            *(LAS u32x4*)(up + b * HY_USTR + off) = (u32x4){0u, 0u, 0u, 0u}; }
        if (o == 0) {
            const bf16_t* src0 = pcm + (size_t)c * MX; const float w0 = hconv[c], w1 = hconv[1536 + c], w2 = hconv[3072 + c];
            u32x4 vv[8]; unsigned vl[8], vr[8];
#pragma unroll
            for (int it = 0; it < 8; ++it) { const int r0 = 8 * (C.tid + NTHR * it); vv[it] = *(const u32x4*)(src0 + r0); vl[it] = *(const unsigned*)(src0 + r0 - 2); vr[it] = *(const unsigned*)(src0 + r0 + 8); }
#pragma unroll
            for (int it = 0; it < 8; ++it) { const int r0 = 8 * (C.tid + NTHR * it); const u32x4 v = vv[it];
                float x[10]; x[1] = bflo(v.x); x[2] = bfhi(v.x); x[3] = bflo(v.y); x[4] = bfhi(v.y); x[5] = bflo(v.z); x[6] = bfhi(v.z); x[7] = bflo(v.w); x[8] = bfhi(v.w);
                x[0] = ((r0 & 63) != 0) ? bfhi(vl[it]) : 0.f; x[9] = ((r0 & 63) != 56) ? bflo(vr[it]) : 0.f;
                float y[8];
#pragma unroll
                for (int j = 0; j < 8; ++j) y[j] = w0 * x[j] + w1 * x[j + 1] + w2 * x[j + 2];
                u32x4 w; w.x = pk2(y[0], y[1]); w.y = pk2(y[2], y[3]); w.z = pk2(y[4], y[5]); w.w = pk2(y[6], y[7]);
                *(LAS u32x4*)(up + (r0 >> 12) * HY_USTR + 256 + (r0 & 4095)) = w; }
        } else {
            const u32x4* src1 = (const u32x4*)((const bf16_t*)(ws + WS_Z1) + (size_t)c * MX);
            u32x4 vv[8];
#pragma unroll
            for (int it = 0; it < 8; ++it) vv[it] = src1[C.tid + NTHR * it];
#pragma unroll
            for (int it = 0; it < 8; ++it) { const int r0 = 8 * (C.tid + NTHR * it); *(LAS u32x4*)(up + (r0 >> 12) * HY_USTR + 256 + (r0 & 4095)) = vv[it]; }
        }
    }
    __syncthreads();
    for (int idx = C.tid; idx < 3 * 1025; idx += NTHR) { const int rho = 1 + idx / 1025, ch = idx % 1025; unsigned short e[8];
#pragma unroll
        for (int j = 0; j < 8; ++j) { const int z = 8 * ch + j - rho; e[j] = (z >= 0 && z < 8192) ? krv[z] : (unsigned short)0; }
        u32x4 w; w.x = e[0] | ((unsigned)e[1] << 16); w.y = e[2] | ((unsigned)e[3] << 16); w.z = e[4] | ((unsigned)e[5] << 16); w.w = e[6] | ((unsigned)e[7] << 16);
        *(LAS u32x4*)(C.lds + rho * HY_KSTR + 16 * ch) = w; }
    if (C.tid == 0) *(LAS u32x4*)(C.lds + 16 * 1024) = (u32x4){0u, 0u, 0u, 0u};
    __syncthreads();
    const int lane = C.lane, w = C.wave, kh = w >> 2, wq = w & 3, i = lane & 31, kq = lane >> 5, nb = (lane >> 2) & 7, np = lane & 3, rho = i & 3;
    f32x16 acc[4][2];
#pragma unroll
    for (int a = 0; a < 4; ++a)
#pragma unroll
        for (int pg = 0; pg < 2; ++pg)
#pragma unroll
            for (int r = 0; r < 16; ++r) acc[a][pg][r] = 0.f;
    const int abase = rho * HY_KSTR + 2 * (4096 - i + 8 * kq + rho) - 2048 * wq - 1536;
    const int bbase = HY_UOFF + 2 * (nb * HY_USTR + 256 + 32 * np + 8 * kq);
    typedef const volatile LAS u32x2* vp2;
#define HY_LOAD(AF, BF, s0) do { const int _a = abase + 2 * (s0), _b = bbase + 2 * (s0); \
        BF[0] = *(const LAS bf16x8*)(C.lds + _b); BF[1] = *(const LAS bf16x8*)(C.lds + _b + 256); \
        _Pragma("unroll") for (int a = 0; a < 4; ++a) { const u32x2 lo = *(vp2)(C.lds + _a + 512 * (3 - a)), hi = *(vp2)(C.lds + _a + 512 * (3 - a) + 8); \
            AF[a] = __builtin_bit_cast(bf16x8, (u32x4){lo.x, lo.y, hi.x, hi.y}); } } while (0)
#define HY_MMA(AF, BF) do { _Pragma("unroll") for (int a = 0; a < 4; ++a) _Pragma("unroll") for (int pg = 0; pg < 2; ++pg) \
        acc[a][pg] = __builtin_amdgcn_mfma_f32_32x32x16_bf16(AF[a], BF[pg], acc[a][pg], 0, 0, 0); } while (0)
    bf16x8 a0[4], a1[4], b0[2], b1[2];
    const int sbeg = -224 + 16 * 135 * kh;
    HY_LOAD(a0, b0, sbeg);
#pragma unroll 1
    for (int j = 0; j < (MODE == 1 ? 0 : 134); j += 2) {
        HY_LOAD(a1, b1, sbeg + 16 * (j + 1));
        __builtin_amdgcn_sched_barrier(0);
        HY_MMA(a0, b0);
        __builtin_amdgcn_sched_barrier(0);
        HY_LOAD(a0, b0, sbeg + 16 * (j + 2));
        __builtin_amdgcn_sched_barrier(0);
        HY_MMA(a1, b1);
        __builtin_amdgcn_sched_barrier(0);
    }
    HY_MMA(a0, b0);
#undef HY_LOAD
#undef HY_MMA
    const float skip = P.in[16][o * 512 + c];
    if (kh == 0) {
#pragma unroll
        for (int a = 0; a < 4; ++a)
#pragma unroll
            for (int pg = 0; pg < 2; ++pg)
#pragma unroll
                for (int g = 0; g < 4; ++g) { const int t0 = 1024 * wq + 256 * a + 128 * pg + 32 * np + 8 * g + 4 * kq;
                    const u32x2 uv = *(const LAS u32x2*)(up + nb * HY_USTR + 256 + t0);
                    acc[a][pg][4 * g + 0] += skip * bflo(uv.x); acc[a][pg][4 * g + 1] += skip * bfhi(uv.x); acc[a][pg][4 * g + 2] += skip * bflo(uv.y); acc[a][pg][4 * g + 3] += skip * bfhi(uv.y); }
    }
    __syncthreads();
    {
        LAS f32x4* slot = (LAS f32x4*)(C.lds + w * 16384);
#pragma unroll
        for (int al = 0; al < 2; ++al)
#pragma unroll
            for (int pg = 0; pg < 2; ++pg)
#pragma unroll
                for (int g = 0; g < 4; ++g) { const int a = kh ? al : 2 + al; const f32x16& v = acc[a][pg];
                    slot[((al * 2 + pg) * 4 + g) * 64 + lane] = (f32x4){v[4 * g], v[4 * g + 1], v[4 * g + 2], v[4 * g + 3]}; }
    }
    __syncthreads();
    const int gch = (o == 0 ? 512 : 1024) + c;
    const float w0 = hconv[gch], w1 = hconv[1536 + gch], w2 = hconv[3072 + gch];
    const bf16_t* gsrc = pcm + (size_t)gch * MX + (size_t)nb * SEQ;
    bf16_t* dst = (bf16_t*)(ws + (o == 0 ? WS_Z1 : WS_Z2CM)) + (size_t)c * MX + (size_t)nb * SEQ;
    const LAS f32x4* pslot = (const LAS f32x4*)(C.lds + (w ^ 4) * 16384);
#pragma unroll
    for (int al = 0; al < 2; ++al) {
        const int a = kh ? 2 + al : al;
        u32x2 gvv[2][4]; unsigned gl[2][4], gr[2][4];
#pragma unroll
        for (int pg = 0; pg < 2; ++pg)
#pragma unroll
            for (int g = 0; g < 4; ++g) { const int t0 = 1024 * wq + 256 * a + 128 * pg + 32 * np + 8 * g + 4 * kq;
                gvv[pg][g] = *(const u32x2*)(gsrc + t0); gl[pg][g] = *(const unsigned*)(gsrc + t0 - 2); gr[pg][g] = *(const unsigned*)(gsrc + t0 + 4); }
#pragma unroll
        for (int pg = 0; pg < 2; ++pg)
#pragma unroll
            for (int g = 0; g < 4; ++g) {
                const int t0 = 1024 * wq + 256 * a + 128 * pg + 32 * np + 8 * g + 4 * kq;
                const f32x4 pv = pslot[((al * 2 + pg) * 4 + g) * 64 + lane];
                const u32x2 gv = gvv[pg][g];
                float x[6]; x[1] = bflo(gv.x); x[2] = bfhi(gv.x); x[3] = bflo(gv.y); x[4] = bfhi(gv.y);
                x[0] = ((t0 & 63) != 0) ? bfhi(gl[pg][g]) : 0.f; x[5] = ((t0 & 63) != 60) ? bflo(gr[pg][g]) : 0.f;
                float z[4];
#pragma unroll
                for (int j = 0; j < 4; ++j) { const float gate = w0 * x[j] + w1 * x[j + 1] + w2 * x[j + 2]; z[j] = gate * (acc[a][pg][4 * g + j] + pv[j]); }
                u32x2 wv; wv.x = pk2(z[0], z[1]); wv.y = pk2(z[2], z[3]);
                if (MODE == 1) { if (z[0] == 12345.678f) *(u32x2*)(dst + t0) = wv; } else *(u32x2*)(dst + t0) = wv;
            }
    }
}

typedef short s16x4 __attribute__((ext_vector_type(4)));
__device__ __forceinline__ unsigned off_b(unsigned row, unsigned ch) { return 256u * row + 16u * (ch ^ (((row & 3) << 2) | ((row >> 2) & 3))); }
__device__ __forceinline__ bf16x8 tile_row_read(const LAS unsigned char* T, int lane, int rb, int s) { return *(const LAS bf16x8*)(T + off_b((lane & 15) + 16 * rb, 4 * s + (lane >> 4))); }
__device__ __forceinline__ bf16x8 tile_tr_read(const LAS unsigned char* T, int lane, int c, int ks) {
    const unsigned g = lane >> 4, q = (lane & 15) >> 2, p = lane & 3;
    const unsigned a0 = off_b(32 * ks + 8 * g + q, 2 * c + (p >> 1)) + 8 * (p & 1), a1 = off_b(32 * ks + 8 * g + 4 + q, 2 * c + (p >> 1)) + 8 * (p & 1);
    const s16x4 lo = __builtin_amdgcn_ds_read_tr16_b64_v4i16((LAS s16x4*)(T + a0)), hi = __builtin_amdgcn_ds_read_tr16_b64_v4i16((LAS s16x4*)(T + a1));
    return __builtin_shufflevector(lo, hi, 0, 1, 2, 3, 4, 5, 6, 7);
}
struct ChunkRef { int isctx, b, h, d, oc; };
__device__ __forceinline__ int chunk_row0(const ChunkRef& r) { return r.isctx ? (MX + r.b * CTXL + r.oc * 128) : (r.b * SEQ + r.oc * 128); }

__device__ __forceinline__ void load_kv_tiles(const Ctx& C, const Params& P, const ChunkRef& r, LAS unsigned char* KT, LAS unsigned char* VT, const LAS float* vscale) {
    const bf16_t* kvcm = (const bf16_t*)(P.ws + WS_KVCM); const float* cw = P.in[17];
    const int col0 = chunk_row0(r), rowlen = r.isctx ? CTXL : 64, orig0 = r.oc * 128;
    for (int idx = C.tid; idx < 2048; idx += NTHR) { const int d = idx >> 4, ch = idx & 15, s0 = 8 * ch;
        const bf16_t* src = kvcm + (size_t)(r.h * 128 + d) * MT + col0 + s0;
        const u32x4 v = *(const u32x4*)src;
        float x[10]; x[1] = bflo(v.x); x[2] = bfhi(v.x); x[3] = bflo(v.y); x[4] = bfhi(v.y); x[5] = bflo(v.z); x[6] = bfhi(v.z); x[7] = bflo(v.w); x[8] = bfhi(v.w);
        x[0] = (((orig0 + s0) % rowlen) != 0) ? bf2f(src[-1]) : 0.f; x[9] = (((orig0 + s0 + 7) % rowlen) != rowlen - 1) ? bf2f(src[8]) : 0.f;
        const int cc = 512 + r.h * 128 + d; const float w0 = cw[cc], w1 = cw[1024 + cc], w2 = cw[2048 + cc];
        float y[8];
#pragma unroll
        for (int j = 0; j < 8; ++j) y[j] = siluf(w0 * x[j] + w1 * x[j + 1] + w2 * x[j + 2]);
        u32x4 o; o.x = pk2(y[0], y[1]); o.y = pk2(y[2], y[3]); o.z = pk2(y[4], y[5]); o.w = pk2(y[6], y[7]);
        *(LAS u32x4*)(KT + off_b(d, ch)) = o;
        const u32x4 vv = *(const u32x4*)(kvcm + (size_t)(512 + r.h * 128 + d) * MT + col0 + s0);
        if (vscale) { const f32x4 sa = *(const LAS f32x4*)(vscale + s0), sb = *(const LAS f32x4*)(vscale + s0 + 4);
            u32x4 ov; ov.x = pk2(bflo(vv.x) * sa[0], bfhi(vv.x) * sa[1]); ov.y = pk2(bflo(vv.y) * sa[2], bfhi(vv.y) * sa[3]);
            ov.z = pk2(bflo(vv.z) * sb[0], bfhi(vv.z) * sb[1]); ov.w = pk2(bflo(vv.w) * sb[2], bfhi(vv.w) * sb[3]);
            *(LAS u32x4*)(VT + off_b(d, ch)) = ov; }
        else *(LAS u32x4*)(VT + off_b(d, ch)) = vv; }
}

__device__ __forceinline__ void mlstm_a_pair(const Ctx& C, const Params& P, int item0) {
    unsigned char* ws = P.ws;
    auto make_ref = [](int it) { ChunkRef q; const int j = it % NCHK, seq = it / NCHK; q.h = seq & 3; q.b = (seq >> 2) & 7; q.d = seq >> 5; q.isctx = j < 2;
        const int jj = q.isctx ? j : j - 2, nch = q.isctx ? 2 : 32; q.oc = q.d ? (nch - 1 - jj) : jj; return q; };
    const bool valid1 = item0 + 1 < 64 * NCHK;
    const ChunkRef r0 = make_ref(item0), r1 = make_ref(valid1 ? item0 + 1 : item0);
    __syncthreads();
    if (C.wave == 0 || (C.wave == 1 && valid1)) {
        const int z = C.wave, item = item0 + z; const ChunkRef rz = make_ref(item); const int d = rz.d, h = rz.h;
        LAS float* wl = (LAS float*)(C.lds + z * 66560 + 65536);
        const float* gates = (const float*)(ws + WS_GATES) + (size_t)chunk_row0(rz) * 16;
        const int p0 = 2 * C.lane, t0 = d ? 127 - p0 : p0, t1 = d ? 126 - p0 : p0 + 1;
        const float li0 = gates[(size_t)t0 * 16 + (d ? 8 : 0) + h], li1 = gates[(size_t)t1 * 16 + (d ? 8 : 0) + h];
        const float lf0 = logsig(gates[(size_t)t0 * 16 + (d ? 12 : 4) + h]), lf1 = logsig(gates[(size_t)t1 * 16 + (d ? 12 : 4) + h]);
        float run = lf0 + lf1;
#pragma unroll
        for (int o = 1; o < 64; o <<= 1) { const float t = __shfl_up(run, o); if (C.lane >= o) run += t; }
        const float b1 = run, b0 = run - lf1;
        const float c0 = li0 - b0, c1 = li1 - b1;
        float gm = fmaxf(c0, c1);
#pragma unroll
        for (int o = 1; o < 64; o <<= 1) { const float t = __shfl_up(gm, o); if (C.lane >= o) gm = fmaxf(gm, t); }
        float gprev = __shfl_up(gm, 1); if (C.lane == 0) gprev = -3.0e38f;
        const float g0 = fmaxf(gprev, c0), g1 = gm;
        const float Bj = __shfl(b1, 63), gfin = __shfl(gm, 63);
        wl[t0] = __expf(c0 - gfin); wl[t1] = __expf(c1 - gfin);
        float* gc = (float*)(ws + WS_GC) + (size_t)item * 384;
        gc[t0] = c0; gc[t1] = c1; gc[128 + t0] = b0; gc[128 + t1] = b1; gc[256 + t0] = g0; gc[256 + t1] = g1;
        if (C.lane == 0) { float* bl = (float*)(ws + WS_BL) + (size_t)item * 2; bl[0] = Bj; bl[1] = Bj + gfin; }
    }
    __syncthreads();
    load_kv_tiles(C, P, r0, C.lds, C.lds + 32768, (const LAS float*)(C.lds + 65536));
    if (valid1) load_kv_tiles(C, P, r1, C.lds + 66560, C.lds + 66560 + 32768, (const LAS float*)(C.lds + 66560 + 65536));
    __syncthreads();
    if (C.tid < 256) { const int z = C.tid >> 7, dd = C.tid & 127;
        if (z == 0 || valid1) { const LAS unsigned char* KT = C.lds + z * 66560; const LAS float* wl = (const LAS float*)(C.lds + z * 66560 + 65536); float s = 0.f;
            for (int ch = 0; ch < 16; ++ch) { const u32x4 kv = *(const LAS u32x4*)(KT + off_b(dd, ch)); const f32x4 wa = *(const LAS f32x4*)(wl + 8 * ch), wb = *(const LAS f32x4*)(wl + 8 * ch + 4);
                s += bflo(kv.x) * wa[0] + bfhi(kv.x) * wa[1] + bflo(kv.y) * wa[2] + bfhi(kv.y) * wa[3] + bflo(kv.z) * wb[0] + bfhi(kv.z) * wb[1] + bflo(kv.w) * wb[2] + bfhi(kv.w) * wb[3]; }
            ((float*)(ws + WS_NLOC))[(size_t)(item0 + z) * 128 + dd] = s; } }
    const int lane = C.lane, w = C.wave, fr = lane & 15, fq = lane >> 4;
#pragma unroll
    for (int z = 0; z < 2; ++z) {
        if (z == 1 && !valid1) continue;
        const LAS unsigned char* KT = C.lds + z * 66560; const LAS unsigned char* VT = KT + 32768;
        bf16x8 af[4];
#pragma unroll
        for (int ks = 0; ks < 4; ++ks) af[ks] = tile_row_read(VT, lane, w, ks);
        bf16_t* dst = (bf16_t*)(ws + WS_PLOC) + (size_t)(item0 + z) * 16384;
#pragma unroll
        for (int nt = 0; nt < 8; ++nt) { f32x4 acc = (f32x4){0.f, 0.f, 0.f, 0.f};
#pragma unroll
            for (int ks = 0; ks < 4; ++ks) acc = __builtin_amdgcn_mfma_f32_16x16x32_bf16(af[ks], tile_row_read(KT, lane, nt, ks), acc, 0, 0, 0);
#pragma unroll
            for (int q = 0; q < 4; ++q) dst[(16 * w + 4 * fq + q) * 128 + 16 * nt + fr] = (bf16_t)f2bf(acc[q]); }
    }
}

__device__ __forceinline__ void mlstm_scan(const Ctx& C, const Params& P) {
    unsigned char* ws = P.ws;
    const float* BL = (const float*)(ws + WS_BL); const bf16_t* ploc = (const bf16_t*)(ws + WS_PLOC); bf16_t* cst = (bf16_t*)(ws + WS_CST);
    for (int slot = C.bid * NTHR + C.tid; slot < 64 * 2048; slot += C.G * NTHR) {
        const int seq = slot >> 11, off = (slot & 2047) * 8;
        float cs[8];
#pragma unroll
        for (int q = 0; q < 8; ++q) cs[q] = 0.f;
        float m = 0.f;
        u32x4 pl[NCHK - 1];
#pragma unroll
        for (int j = 0; j < NCHK - 1; ++j) pl[j] = *(const u32x4*)(ploc + ((size_t)(seq * NCHK + j)) * 16384 + off);
#pragma unroll
        for (int j = 0; j < NCHK; ++j) {
            if (j >= 2) { u32x4 o; o.x = pk2(cs[0], cs[1]); o.y = pk2(cs[2], cs[3]); o.z = pk2(cs[4], cs[5]); o.w = pk2(cs[6], cs[7]);
                *(u32x4*)(cst + ((size_t)(seq * 32 + j - 2)) * 16384 + off) = o;
                if (off == 0) ((float*)(ws + WS_MST))[seq * 32 + j - 2] = m; }
            if (j < NCHK - 1) {
                const float Bj = BL[(seq * NCHK + j) * 2], Lj = BL[(seq * NCHK + j) * 2 + 1];
                const float mn = fmaxf(Bj + m, Lj), dec = __expf(Bj + m - mn), sc = __expf(Lj - mn);
                const unsigned p4[4] = {pl[j].x, pl[j].y, pl[j].z, pl[j].w};
#pragma unroll
                for (int q = 0; q < 4; ++q) { cs[2 * q] = dec * cs[2 * q] + sc * bflo(p4[q]); cs[2 * q + 1] = dec * cs[2 * q + 1] + sc * bfhi(p4[q]); }
                m = mn; }
        }
    }
    for (int idx = C.bid * NTHR + C.tid; idx < 64 * 128; idx += C.G * NTHR) {
        const int seq = idx >> 7, dd = idx & 127; float n = 0.f, m = 0.f;
        const float* nloc = (const float*)(ws + WS_NLOC); float* nst = (float*)(ws + WS_NST);
        for (int j = 0; j < NCHK; ++j) {
            if (j >= 2) nst[(size_t)(seq * 32 + j - 2) * 128 + dd] = n;
            if (j < NCHK - 1) { const float Bj = BL[(seq * NCHK + j) * 2], Lj = BL[(seq * NCHK + j) * 2 + 1];
                const float mn = fmaxf(Bj + m, Lj); n = __expf(Bj + m - mn) * n + __expf(Lj - mn) * nloc[(size_t)(seq * NCHK + j) * 128 + dd]; m = mn; }
        }
    }
}

__device__ __forceinline__ void mlstm_c_item(const Ctx& C, const Params& P, int item) {
    unsigned char* ws = P.ws;
    const int oc = item & 31, h = (item >> 5) & 3, b = item >> 7;
    LAS unsigned char* KT = C.lds; LAS unsigned char* VT = C.lds + 32768; LAS unsigned char* CT = C.lds + 65536; LAS unsigned char* PS = C.lds + 98304;
    LAS float* colf = (LAS float*)(C.lds + 131072); LAS float* bcs = colf + 128; LAS float* gms = bcs + 128; LAS float* nsl = gms + 128;
    const int lane = C.lane, w = C.wave, fr = lane & 15, fq = lane >> 4;
    const bf16_t* pml = (const bf16_t*)(ws + WS_PML) + (size_t)(b * SEQ + oc * 128) * 1024;
    const float* cw = P.in[17];
    bf16x8 qf[4];
    { const int tau = 16 * w + fr, orig = oc * 128 + tau; const bool hl = (orig & 63) != 0, hr = (orig & 63) != 63;
#pragma unroll
      for (int ks = 0; ks < 4; ++ks) { const int dc = 32 * ks + 8 * fq; const bf16_t* base = pml + (size_t)tau * 1024 + h * 128 + dc;
        const u32x4 vc = *(const u32x4*)base; u32x4 vl = (u32x4){0u, 0u, 0u, 0u}, vr = (u32x4){0u, 0u, 0u, 0u};
        if (hl) vl = *(const u32x4*)(base - 1024); if (hr) vr = *(const u32x4*)(base + 1024);
        const unsigned l4[4] = {vl.x, vl.y, vl.z, vl.w}, c4[4] = {vc.x, vc.y, vc.z, vc.w}, r4[4] = {vr.x, vr.y, vr.z, vr.w}; const int col = h * 128 + dc; unsigned o4[4];
#pragma unroll
        for (int q = 0; q < 4; ++q) {
            const float a0 = cw[col + 2 * q] * bflo(l4[q]) + cw[1024 + col + 2 * q] * bflo(c4[q]) + cw[2048 + col + 2 * q] * bflo(r4[q]);
            const float a1 = cw[col + 2 * q + 1] * bfhi(l4[q]) + cw[1024 + col + 2 * q + 1] * bfhi(c4[q]) + cw[2048 + col + 2 * q + 1] * bfhi(r4[q]);
            o4[q] = pk2(siluf(a0) * 0.08838834764831845f, siluf(a1) * 0.08838834764831845f); }
        qf[ks] = __builtin_bit_cast(bf16x8, (u32x4){o4[0], o4[1], o4[2], o4[3]}); } }
    f32x4 hacc[8];
#pragma unroll
    for (int nt = 0; nt < 8; ++nt) hacc[nt] = (f32x4){0.f, 0.f, 0.f, 0.f};
#pragma unroll 1
    for (int d = 0; d < 2; ++d) {
        ChunkRef r; r.isctx = 0; r.b = b; r.h = h; r.d = d; r.oc = oc;
        const int seq = (d * 8 + b) * 4 + h, jj = d ? 31 - oc : oc, sidx = seq * 32 + jj, aitem = seq * NCHK + 2 + jj;
        __syncthreads();
        if (d == 0) load_kv_tiles(C, P, r, KT, VT, nullptr);
        for (int idx = C.tid; idx < 2048; idx += NTHR) { const int e = idx >> 4, ch = idx & 15;
            *(LAS u32x4*)(CT + off_b(e, ch)) = *(const u32x4*)((const bf16_t*)(ws + WS_CST) + (size_t)sidx * 16384 + e * 128 + 8 * ch); }
        if (C.tid < 384) colf[C.tid] = ((const float*)(ws + WS_GC))[(size_t)aitem * 384 + C.tid];
        else nsl[C.tid - 384] = ((const float*)(ws + WS_NST))[(size_t)sidx * 128 + (C.tid - 384)];
        const float m0 = ((const float*)(ws + WS_MST))[sidx];
        __syncthreads();
        int t = 16 * w + fr, lane = C.lane; asm volatile("" : "+v"(t), "+v"(lane));
        const int fq = lane >> 4;
        const float mx = fmaxf(m0, gms[t]), rowf = -mx, ainter = __expf(m0 - mx), emneg = __expf(-(bcs[t] + mx));
        float qn = 0.f;
#pragma unroll
        for (int ks = 0; ks < 4; ++ks) { const u32x4 qq = __builtin_bit_cast(u32x4, qf[ks]); const LAS float* np_ = nsl + 32 * ks + 8 * fq; const f32x4 na = *(const LAS f32x4*)np_, nb = *(const LAS f32x4*)(np_ + 4);
            qn += bflo(qq.x) * na[0] + bfhi(qq.x) * na[1] + bflo(qq.y) * na[2] + bfhi(qq.y) * na[3] + bflo(qq.z) * nb[0] + bfhi(qq.z) * nb[1] + bflo(qq.w) * nb[2] + bfhi(qq.w) * nb[3]; }
        qn += __shfl_xor(qn, 16); qn += __shfl_xor(qn, 32);
        float rs = 0.f;
#pragma unroll
        for (int nt = 0; nt < 8; ++nt) { f32x4 a = (f32x4){0.f, 0.f, 0.f, 0.f};
#pragma unroll
            for (int ks = 0; ks < 4; ++ks) a = __builtin_amdgcn_mfma_f32_16x16x32_bf16(tile_tr_read(KT, lane, nt, ks), qf[ks], a, 0, 0, 0);
            const int s0 = 16 * nt + 4 * fq; const f32x4 cf = *(const LAS f32x4*)(colf + s0); float pv[4];
#pragma unroll
            for (int q = 0; q < 4; ++q) { const int s = s0 + q; const bool ok = d ? (s >= t) : (s <= t); pv[q] = ok ? __expf(rowf + cf[q]) * a[q] : 0.f; rs += pv[q]; }
            u32x2 pw; pw.x = pk2(pv[0], pv[1]); pw.y = pk2(pv[2], pv[3]);
            *(LAS u32x2*)(PS + off_b(t, 2 * nt + (fq >> 1)) + 8 * (fq & 1)) = pw; }
        rs += __shfl_xor(rs, 16); rs += __shfl_xor(rs, 32);
        const float inv = 1.f / fmaxf(fabsf(rs + ainter * qn), emneg);
        LDS_WAIT();
        bf16x8 pf[4];
#pragma unroll
        for (int ks = 0; ks < 4; ++ks) pf[ks] = tile_row_read(PS, lane, w, ks);
        float ai4[4], iv4[4];
#pragma unroll
        for (int q = 0; q < 4; ++q) { ai4[q] = __shfl(ainter, 4 * fq + q); iv4[q] = __shfl(inv, 4 * fq + q); }
#pragma unroll
        for (int nt = 0; nt < 8; ++nt) { f32x4 a = (f32x4){0.f, 0.f, 0.f, 0.f}, c = (f32x4){0.f, 0.f, 0.f, 0.f};
#pragma unroll
            for (int ks = 0; ks < 4; ++ks) { a = __builtin_amdgcn_mfma_f32_16x16x32_bf16(pf[ks], tile_row_read(VT, lane, nt, ks), a, 0, 0, 0);
                c = __builtin_amdgcn_mfma_f32_16x16x32_bf16(qf[ks], tile_row_read(CT, lane, nt, ks), c, 0, 0, 0); }
#pragma unroll
            for (int q = 0; q < 4; ++q) hacc[nt][q] += (a[q] + ai4[q] * c[q]) * iv4[q]; }
    }
    float ss[4] = {0.f, 0.f, 0.f, 0.f};
#pragma unroll
    for (int nt = 0; nt < 8; ++nt)
#pragma unroll
        for (int q = 0; q < 4; ++q) ss[q] += hacc[nt][q] * hacc[nt][q];
#pragma unroll
    for (int q = 0; q < 4; ++q) { ss[q] += __shfl_xor(ss[q], 1); ss[q] += __shfl_xor(ss[q], 2); ss[q] += __shfl_xor(ss[q], 4); ss[q] += __shfl_xor(ss[q], 8);
        ss[q] = rsqrtf(ss[q] * (1.f / 128.f) + RMS_EPS); }
    const float* ng = P.in[18]; bf16_t* yb = (bf16_t*)(ws + WS_YAB) + 512;
#pragma unroll
    for (int nt = 0; nt < 8; ++nt) { const int e = h * 128 + 16 * nt + fr; const float gn = ng[e];
#pragma unroll
        for (int q = 0; q < 4; ++q) { const int t = 16 * w + 4 * fq + q; const float og = bf2f(pml[(size_t)t * 1024 + 512 + e]);
            yb[(size_t)(b * SEQ + oc * 128 + t) * 1024 + e] = (bf16_t)f2bf(hacc[nt][q] * ss[q] * gn * sigm(og)); } }
}

__device__ __forceinline__ void mlstm_prep(const Ctx& C, const Params& P) {
    unsigned char* ws = P.ws;
    const float* cw = P.in[17];
    {
        const bf16_t* kvcm = (const bf16_t*)(ws + WS_KVCM); bf16_t* kact = (bf16_t*)(ws + WS_KACT);
        const int NCH = 512 * (MT / 8), STR = C.G * NTHR;
        for (int i0 = C.bid * NTHR + C.tid; i0 < NCH; i0 += 4 * STR) {
            u32x4 vv[4]; unsigned vl4[4], vr4[4];
#pragma unroll
            for (int u = 0; u < 4; ++u) { const int i = i0 + u * STR; if (i < NCH) { const int c = i / (MT / 8), col = 8 * (i % (MT / 8)); const bf16_t* src = kvcm + (size_t)c * MT + col;
                vv[u] = *(const u32x4*)src; vl4[u] = *(const unsigned*)(src - 2); vr4[u] = *(const unsigned*)(src + 8); } }
#pragma unroll
            for (int u = 0; u < 4; ++u) { const int i = i0 + u * STR; if (i < NCH) { const int c = i / (MT / 8), col = 8 * (i % (MT / 8)); const u32x4 v = vv[u];
                const int t = (col < MX) ? (col & 63) : ((col - MX) & 255), rl = (col < MX) ? 64 : 256;
                float x[10]; x[1] = bflo(v.x); x[2] = bfhi(v.x); x[3] = bflo(v.y); x[4] = bfhi(v.y); x[5] = bflo(v.z); x[6] = bfhi(v.z); x[7] = bflo(v.w); x[8] = bfhi(v.w);
                x[0] = (t != 0) ? bfhi(vl4[u]) : 0.f; x[9] = (t + 8 != rl) ? bflo(vr4[u]) : 0.f;
                const float w0 = cw[512 + c], w1 = cw[1024 + 512 + c], w2 = cw[2048 + 512 + c]; float y[8];
#pragma unroll
                for (int j = 0; j < 8; ++j) y[j] = siluf(w0 * x[j] + w1 * x[j + 1] + w2 * x[j + 2]);
                u32x4 o; o.x = pk2(y[0], y[1]); o.y = pk2(y[2], y[3]); o.z = pk2(y[4], y[5]); o.w = pk2(y[6], y[7]);
                *(u32x4*)(kact + (size_t)c * MT + col) = o; } }
        }
    }
    {
        const bf16_t* pml = (const bf16_t*)(ws + WS_PML); bf16_t* qact = (bf16_t*)(ws + WS_QACT);
        const int NQ = MX * 64, STR = C.G * NTHR;
        for (int i0 = C.bid * NTHR + C.tid; i0 < NQ; i0 += 4 * STR) {
            u32x4 vc4[4], vl4[4], vr4[4];
#pragma unroll
            for (int u = 0; u < 4; ++u) { const int i = i0 + u * STR; if (i < NQ) { const int row = i >> 6, c0 = 8 * (i & 63); const bf16_t* base = pml + (size_t)row * 1024 + c0;
                const bool hl = (row & 63) != 0, hr = (row & 63) != 63;
                vc4[u] = *(const u32x4*)base; vl4[u] = (u32x4){0u, 0u, 0u, 0u}; vr4[u] = (u32x4){0u, 0u, 0u, 0u};
                if (hl) vl4[u] = *(const u32x4*)(base - 1024); if (hr) vr4[u] = *(const u32x4*)(base + 1024); } }
#pragma unroll
            for (int u = 0; u < 4; ++u) { const int i = i0 + u * STR; if (i < NQ) { const int row = i >> 6, c0 = 8 * (i & 63);
                const u32x4 vc = vc4[u], vl = vl4[u], vr = vr4[u];
                const unsigned l4[4] = {vl.x, vl.y, vl.z, vl.w}, c4[4] = {vc.x, vc.y, vc.z, vc.w}, r4[4] = {vr.x, vr.y, vr.z, vr.w}; unsigned o4[4];
#pragma unroll
                for (int q = 0; q < 4; ++q) {
                    const float a0 = cw[c0 + 2 * q] * bflo(l4[q]) + cw[1024 + c0 + 2 * q] * bflo(c4[q]) + cw[2048 + c0 + 2 * q] * bflo(r4[q]);
                    const float a1 = cw[c0 + 2 * q + 1] * bfhi(l4[q]) + cw[1024 + c0 + 2 * q + 1] * bfhi(c4[q]) + cw[2048 + c0 + 2 * q + 1] * bfhi(r4[q]);
                    o4[q] = pk2(siluf(a0) * 0.08838834764831845f, siluf(a1) * 0.08838834764831845f); }
                *(u32x4*)(qact + (size_t)row * 512 + c0) = (u32x4){o4[0], o4[1], o4[2], o4[3]}; } }
        }
    }
    for (int item = C.bid * 8 + C.wave; item < 64 * NCHK; item += C.G * 8) {
        const int j = item % NCHK, seq = item / NCHK, h = seq & 3, b = (seq >> 2) & 7, d = seq >> 5;
        ChunkRef r; r.isctx = j < 2; r.b = b; r.h = h; r.d = d; { const int jj = r.isctx ? j : j - 2, nch = r.isctx ? 2 : 32; r.oc = d ? (nch - 1 - jj) : jj; }
        const float* gates = (const float*)(ws + WS_GATES) + (size_t)chunk_row0(r) * 16;
        const int p0 = 2 * C.lane, t0 = d ? 127 - p0 : p0, t1 = d ? 126 - p0 : p0 + 1;
        const float li0 = gates[(size_t)t0 * 16 + (d ? 8 : 0) + h], li1 = gates[(size_t)t1 * 16 + (d ? 8 : 0) + h];
        const float lf0 = logsig(gates[(size_t)t0 * 16 + (d ? 12 : 4) + h]), lf1 = logsig(gates[(size_t)t1 * 16 + (d ? 12 : 4) + h]);
        float run = lf0 + lf1;
#pragma unroll
        for (int o = 1; o < 64; o <<= 1) { const float t = __shfl_up(run, o); if (C.lane >= o) run += t; }
        const float b1 = run, b0 = run - lf1;
        const float c0 = li0 - b0, c1 = li1 - b1;
        float gm = fmaxf(c0, c1);
#pragma unroll
        for (int o = 1; o < 64; o <<= 1) { const float t = __shfl_up(gm, o); if (C.lane >= o) gm = fmaxf(gm, t); }
        float gprev = __shfl_up(gm, 1); if (C.lane == 0) gprev = -3.0e38f;
        float* gc = (float*)(ws + WS_GC) + (size_t)item * 384;
        gc[t0] = c0; gc[t1] = c1; gc[128 + t0] = b0; gc[128 + t1] = b1; gc[256 + t0] = fmaxf(gprev, c0); gc[256 + t1] = gm;
        if (C.lane == 63) { float* bl = (float*)(ws + WS_BL) + (size_t)item * 2; bl[0] = b1; bl[1] = gm; }
    }
}

struct SeqPre { u32x4 k[4]; u32x4 v[4]; float g; float bl0, bl1; };
__device__ __forceinline__ ChunkRef seq_chunk(int jc, int b, int h, int d) {
    ChunkRef r; r.isctx = jc < 2; r.b = b; r.h = h; r.d = d; const int jj = r.isctx ? jc : jc - 2, nch = r.isctx ? 2 : 32; r.oc = d ? (nch - 1 - jj) : jj; return r; }
__device__ __forceinline__ void seq_prefetch(const Params& P, const ChunkRef& r, int item, SeqPre& pf, int tid) {
    const bf16_t* kact = (const bf16_t*)(P.ws + WS_KACT); const bf16_t* kvcm = (const bf16_t*)(P.ws + WS_KVCM); const int col0 = chunk_row0(r);
#pragma unroll
    for (int it = 0; it < 4; ++it) { const int idx = tid + NTHR * it, dd = idx >> 4, s0 = 8 * (idx & 15);
        pf.k[it] = *(const u32x4*)(kact + (size_t)(r.h * 128 + dd) * MT + col0 + s0);
        pf.v[it] = *(const u32x4*)(kvcm + (size_t)(512 + r.h * 128 + dd) * MT + col0 + s0); }
    pf.g = (tid < 384) ? ((const float*)(P.ws + WS_GC))[(size_t)item * 384 + tid] : 0.f;
    const float* bl = (const float*)(P.ws + WS_BL) + (size_t)item * 2; pf.bl0 = bl[0]; pf.bl1 = bl[1];
}
#define SEQ_BAR() do { asm volatile("s_waitcnt lgkmcnt(0)" ::: "memory"); __builtin_amdgcn_s_barrier(); asm volatile("" ::: "memory"); } while (0)
__device__ __forceinline__ void mlstm_seq(const Ctx& C, const Params& P, int seq) {
    unsigned char* ws = P.ws;
    const int h = seq & 3, b = (seq >> 2) & 7, d = seq >> 5;
    LAS unsigned char* KT = C.lds; LAS unsigned char* VT = C.lds + 32768; LAS unsigned char* CT = C.lds + 65536; LAS unsigned char* PS = C.lds + 98304;
    LAS float* colf = (LAS float*)(C.lds + 131072); LAS float* bcs = colf + 128; LAS float* gms = bcs + 128; LAS float* wls = gms + 128; LAS float* nbuf = wls + 128  ;
    const int w = C.wave;
    f32x4 Cst[8]; f32x4 nst = (f32x4){0.f, 0.f, 0.f, 0.f};
#pragma unroll
    for (int nt = 0; nt < 8; ++nt) Cst[nt] = (f32x4){0.f, 0.f, 0.f, 0.f};
    float m = 0.f;
    __syncthreads();
    if (C.tid < 256) nbuf[C.tid] = 0.f;
    SeqPre pre;
    seq_prefetch(P, seq_chunk(0, b, h, d), seq * NCHK, pre, C.tid);
    const bf16x8 ones = (bf16x8){0x3f80, 0x3f80, 0x3f80, 0x3f80, 0x3f80, 0x3f80, 0x3f80, 0x3f80};
#pragma unroll 1
    for (int jc = 0; jc < NCHK; ++jc) {
        const ChunkRef r = seq_chunk(jc, b, h, d);
        const LAS float* nsl = nbuf + 128 * (jc & 1); LAS float* nnew = nbuf + 128 * ((jc & 1) ^ 1);
        int tid = C.tid; asm volatile("" : "+v"(tid));
        const int lane = tid & 63, fr = lane & 15, fq = lane >> 4;
        bf16x8 qf[4];
        if (!r.isctx) { const bf16_t* qa = (const bf16_t*)(ws + WS_QACT) + (size_t)(b * SEQ + r.oc * 128 + 16 * w + fr) * 512 + h * 128 + 8 * fq;
#pragma unroll
            for (int ks = 0; ks < 4; ++ks) qf[ks] = *(const bf16x8*)(qa + 32 * ks); }
        else {
#pragma unroll
            for (int ks = 0; ks < 4; ++ks) qf[ks] = (bf16x8){0, 0, 0, 0, 0, 0, 0, 0}; }
        const float Bj = pre.bl0, gfin = pre.bl1, mxs = fmaxf(m, gfin), decay = __expf(m - mxs);
        SEQ_BAR();
        {
#pragma unroll
            for (int it = 0; it < 4; ++it) { const int idx = tid + NTHR * it, dd = idx >> 4, ch = idx & 15;
                *(LAS u32x4*)(KT + off_b(dd, ch)) = pre.k[it]; *(LAS u32x4*)(VT + off_b(dd, ch)) = pre.v[it]; }
            if (tid < 384) colf[tid] = pre.g;
            if (tid < 128) wls[tid] = __expf(pre.g - mxs);
        }
#pragma unroll
        for (int nt = 0; nt < 8; ++nt) { u32x2 pw; pw.x = pk2(Cst[nt][0], Cst[nt][1]); pw.y = pk2(Cst[nt][2], Cst[nt][3]);
            *(LAS u32x2*)(CT + off_b(16 * nt + fr, 2 * w + (fq >> 1)) + 8 * (fq & 1)) = pw; }
        if (fr == 0) *(LAS f32x4*)(nnew + 16 * w + 4 * fq) = nst;
        SEQ_BAR();
        if (!r.isctx) {
            const int t = 16 * w + fr;
            const float mx = fmaxf(m, gms[t]), rowf = -mx, ainter = __expf(m - mx), emneg = __expf(-(bcs[t] + mx));
            float qn = 0.f;
#pragma unroll
            for (int ks = 0; ks < 4; ++ks) { const u32x4 qq = __builtin_bit_cast(u32x4, qf[ks]); const LAS float* np_ = nnew + 32 * ks + 8 * fq; const f32x4 na = *(const LAS f32x4*)np_, nb = *(const LAS f32x4*)(np_ + 4);
                qn += bflo(qq.x) * na[0] + bfhi(qq.x) * na[1] + bflo(qq.y) * na[2] + bfhi(qq.y) * na[3] + bflo(qq.z) * nb[0] + bfhi(qq.z) * nb[1] + bflo(qq.w) * nb[2] + bfhi(qq.w) * nb[3]; }
            qn += __shfl_xor(qn, 16); qn += __shfl_xor(qn, 32);
            float rs = 0.f;
#pragma unroll 2
            for (int nt = 0; nt < 8; ++nt) { f32x4 a = (f32x4){0.f, 0.f, 0.f, 0.f};
#pragma unroll
                for (int ks = 0; ks < 4; ++ks) a = __builtin_amdgcn_mfma_f32_16x16x32_bf16(tile_tr_read(KT, lane, nt, ks), qf[ks], a, 0, 0, 0);
                const int s0 = 16 * nt + 4 * fq; const f32x4 cf = *(const LAS f32x4*)(colf + s0); float pv[4];
#pragma unroll
                for (int q = 0; q < 4; ++q) { const int s = s0 + q; const bool ok = d ? (s >= t) : (s <= t); pv[q] = ok ? __expf(rowf + cf[q]) * a[q] : 0.f; rs += pv[q]; }
                u32x2 pw; pw.x = pk2(pv[0], pv[1]); pw.y = pk2(pv[2], pv[3]);
                *(LAS u32x2*)(PS + off_b(t, 2 * nt + (fq >> 1)) + 8 * (fq & 1)) = pw; }
            rs += __shfl_xor(rs, 16); rs += __shfl_xor(rs, 32);
            const float inv = 1.f / fmaxf(fabsf(rs + ainter * qn), emneg);
            LDS_WAIT();
            bf16x8 pfr[4];
#pragma unroll
            for (int ks = 0; ks < 4; ++ks) pfr[ks] = tile_row_read(PS, lane, w, ks);
            float ai4[4], iv4[4];
#pragma unroll
            for (int q = 0; q < 4; ++q) { ai4[q] = __shfl(ainter, 4 * fq + q); iv4[q] = __shfl(inv, 4 * fq + q); }
            bf16_t* hd = (bf16_t*)(ws + WS_HDIR) + ((size_t)d * MX + (size_t)(b * SEQ + r.oc * 128)) * 512 + h * 128;
#pragma unroll 2
            for (int nt = 0; nt < 8; ++nt) { f32x4 a = (f32x4){0.f, 0.f, 0.f, 0.f}, c = (f32x4){0.f, 0.f, 0.f, 0.f};
#pragma unroll
                for (int ks = 0; ks < 4; ++ks) { a = __builtin_amdgcn_mfma_f32_16x16x32_bf16(pfr[ks], tile_row_read(VT, lane, nt, ks), a, 0, 0, 0);
                    c = __builtin_amdgcn_mfma_f32_16x16x32_bf16(qf[ks], tile_row_read(CT, lane, nt, ks), c, 0, 0, 0); }
#pragma unroll
                for (int q = 0; q < 4; ++q) hd[(size_t)(16 * w + 4 * fq + q) * 512 + 16 * nt + fr] = (bf16_t)f2bf((a[q] + ai4[q] * c[q]) * iv4[q]); }
        }
        if (jc + 1 < NCHK) seq_prefetch(P, seq_chunk(jc + 1, b, h, d), seq * NCHK + jc + 1, pre, tid);
        {
            bf16x8 kfs[4];
#pragma unroll
            for (int ks = 0; ks < 4; ++ks) { const u32x4 kk = __builtin_bit_cast(u32x4, tile_row_read(KT, lane, w, ks)); const LAS float* cp = wls + 32 * ks + 8 * fq;
                const f32x4 ca = *(const LAS f32x4*)cp, cb = *(const LAS f32x4*)(cp + 4);
                u32x4 o; o.x = pk2(bflo(kk.x) * ca[0], bfhi(kk.x) * ca[1]); o.y = pk2(bflo(kk.y) * ca[2], bfhi(kk.y) * ca[3]);
                o.z = pk2(bflo(kk.z) * cb[0], bfhi(kk.z) * cb[1]); o.w = pk2(bflo(kk.w) * cb[2], bfhi(kk.w) * cb[3]);
                kfs[ks] = __builtin_bit_cast(bf16x8, o); }
#pragma unroll
            for (int nt = 0; nt < 8; ++nt) { f32x4 a = (f32x4){0.f, 0.f, 0.f, 0.f};
#pragma unroll
                for (int ks = 0; ks < 4; ++ks) a = __builtin_amdgcn_mfma_f32_16x16x32_bf16(kfs[ks], tile_row_read(VT, lane, nt, ks), a, 0, 0, 0);
                Cst[nt] = Cst[nt] * decay + a; }
            { f32x4 a = (f32x4){0.f, 0.f, 0.f, 0.f};
#pragma unroll
              for (int ks = 0; ks < 4; ++ks) a = __builtin_amdgcn_mfma_f32_16x16x32_bf16(kfs[ks], ones, a, 0, 0, 0);
              nst = nst * decay + a; }
            m = Bj + mxs;
        }
    }
}
#undef SEQ_BAR

__device__ __forceinline__ void mlstm_combine(const Ctx& C, const Params& P) {
    unsigned char* ws = P.ws;
    const bf16_t* hd = (const bf16_t*)(ws + WS_HDIR); const bf16_t* pml = (const bf16_t*)(ws + WS_PML); bf16_t* yab = (bf16_t*)(ws + WS_YAB); const float* ng = P.in[18];
    const f32x4 g0 = *(const f32x4*)(ng + 8 * C.lane), g1 = *(const f32x4*)(ng + 8 * C.lane + 4);
    u32x4 na, nb, no;
    { const int row0 = C.bid * 8 + C.wave;
      if (row0 < MX) { na = *(const u32x4*)(hd + (size_t)row0 * 512 + 8 * C.lane); nb = *(const u32x4*)(hd + ((size_t)MX + row0) * 512 + 8 * C.lane); no = *(const u32x4*)(pml + (size_t)row0 * 1024 + 512 + 8 * C.lane); } }
    for (int row = C.bid * 8 + C.wave; row < MX; row += C.G * 8) {
        const u32x4 a = na, bq = nb, og = no;
        if (row + C.G * 8 < MX) { const int r1 = row + C.G * 8;
            na = *(const u32x4*)(hd + (size_t)r1 * 512 + 8 * C.lane); nb = *(const u32x4*)(hd + ((size_t)MX + r1) * 512 + 8 * C.lane); no = *(const u32x4*)(pml + (size_t)r1 * 1024 + 512 + 8 * C.lane); }
        float v[8] = {bflo(a.x) + bflo(bq.x), bfhi(a.x) + bfhi(bq.x), bflo(a.y) + bflo(bq.y), bfhi(a.y) + bfhi(bq.y), bflo(a.z) + bflo(bq.z), bfhi(a.z) + bfhi(bq.z), bflo(a.w) + bflo(bq.w), bfhi(a.w) + bfhi(bq.w)};
        float ss = 0.f;
#pragma unroll
        for (int j = 0; j < 8; ++j) ss += v[j] * v[j];
        ss += __shfl_xor(ss, 1); ss += __shfl_xor(ss, 2); ss += __shfl_xor(ss, 4); ss += __shfl_xor(ss, 8);
        const float rstd = rsqrtf(ss * (1.f / 128.f) + RMS_EPS);
        const float o8[8] = {bflo(og.x), bfhi(og.x), bflo(og.y), bfhi(og.y), bflo(og.z), bfhi(og.z), bflo(og.w), bfhi(og.w)};
        const float gg[8] = {g0[0], g0[1], g0[2], g0[3], g1[0], g1[1], g1[2], g1[3]};
        float y[8];
#pragma unroll
        for (int j = 0; j < 8; ++j) y[j] = v[j] * rstd * gg[j] * sigm(o8[j]);
        u32x4 wv; wv.x = pk2(y[0], y[1]); wv.y = pk2(y[2], y[3]); wv.z = pk2(y[4], y[5]); wv.w = pk2(y[6], y[7]);
        *(u32x4*)(yab + (size_t)row * 1024 + 512 + 8 * C.lane) = wv;
    }
}

template <int PM>
__device__ __forceinline__ void mixer_phase(const Ctx& C, const Params& P) {
    constexpr int NM = 64;
    const bool small = C.G < 2 * NM;
    const int nh = small ? C.G : C.G - NM, hb = small ? C.bid : C.bid - NM;
    if (PM != 2 && PM != 3) if (small || C.bid < NM) for (int s = C.bid; s < 64; s += (small ? C.G : NM)) mlstm_seq(C, P, s);
    if (PM != 1 && hb >= 0) {
        const int nch = (512 - hb + nh - 1) / nh;
#pragma unroll 1
        for (int j = 0; j < 2 * nch; ++j) { const int c = hb + (j >> 1) * nh, o = j & 1;
            if (o) asm volatile("s_waitcnt vmcnt(0)" ::: "memory");
            hyena_item<0>(C, P, o, c); }
    }
}

__device__ __forceinline__ void transpose_z2(const Ctx& C, const Params& P) {
    unsigned char* ws = P.ws;
    const bf16_t* src = (const bf16_t*)(ws + WS_Z2CM); bf16_t* dst = (bf16_t*)(ws + WS_YAB);
    LAS bf16_t* tl = (LAS bf16_t*)(C.lds + 143360 - 20480);
    for (int it = C.bid; it < 8 * 256; it += C.G) {
        const int c0 = (it & 7) * 64, r0 = (it >> 3) * 128;
        __syncthreads();
        for (int idx = C.tid; idx < 64 * 16; idx += NTHR) { const int cc = idx >> 4, rc = (idx & 15) * 8;
            const u32x4 v = *(const u32x4*)(src + (size_t)(c0 + cc) * MX + r0 + rc); const unsigned v4[4] = {v.x, v.y, v.z, v.w};
#pragma unroll
            for (int q = 0; q < 4; ++q) { tl[(rc + 2 * q) * 72 + cc] = (bf16_t)(v4[q] & 0xffffu); tl[(rc + 2 * q + 1) * 72 + cc] = (bf16_t)(v4[q] >> 16); } }
        __syncthreads();
        for (int idx = C.tid; idx < 128 * 8; idx += NTHR) { const int rr = idx >> 3, c8 = (idx & 7) * 8;
            *(u32x4*)(dst + (size_t)(r0 + rr) * 1024 + c0 + c8) = *(const LAS u32x4*)(tl + rr * 72 + c8); }
    }
}

__device__ __forceinline__ void phase6(const Ctx& C, const Params& P) {
    unsigned char* ws = P.ws;
    LAS float* Wr = (LAS float*)C.lds;
#pragma unroll 1
    for (int i0 = C.tid; i0 < 1024 * 16; i0 += 8 * NTHR) { float t8[8];
#pragma unroll
        for (int u = 0; u < 8; ++u) t8[u] = P.in[22][i0 + u * NTHR];
#pragma unroll
        for (int u = 0; u < 8; ++u) { const int idx = i0 + u * NTHR; Wr[wl_pos(idx >> 4) * 20 + (idx & 15)] = t8[u]; } }
    __syncthreads();
    const float* ada = (const float*)(ws + WS_ADA); const float* gffn = P.in[7];
    unsigned char* hx2 = ws + WS_HX2; float* aff = (float*)(ws + WS_AFF); int* slot = (int*)(ws + WS_SLOT);
    const bf16_t* xm = (const bf16_t*)(ws + WS_XMID);
    u32x2 nx[4];
    { const int row0 = C.bid * 8 + C.wave;
      if (row0 < MX) {
#pragma unroll
        for (int j = 0; j < 4; ++j) nx[j] = *(const u32x2*)(xm + (size_t)row0 * DM + 4 * C.lane + 256 * j); } }
    for (int row = C.bid * 8 + C.wave; row < MX; row += C.G * 8) {
        const int b = row >> 12, n = row & 4095;
        f32x4 v[4]; float ss = 0.f;
#pragma unroll
        for (int j = 0; j < 4; ++j) { v[j] = (f32x4){bflo(nx[j].x), bfhi(nx[j].x), bflo(nx[j].y), bfhi(nx[j].y)}; ss += v[j][0] * v[j][0] + v[j][1] * v[j][1] + v[j][2] * v[j][2] + v[j][3] * v[j][3]; }
        if (row + C.G * 8 < MX) {
#pragma unroll
            for (int j = 0; j < 4; ++j) nx[j] = *(const u32x2*)(xm + (size_t)(row + C.G * 8) * DM + 4 * C.lane + 256 * j); }
        const float rstd = rsqrtf(wave_sum(ss) * (1.f / DM) + RMS_EPS);
#pragma unroll
        for (int j = 0; j < 4; ++j) { const int k = 4 * C.lane + 256 * j; const f32x4 g = *(const f32x4*)(gffn + k);
            const f32x4 h4 = *(const f32x4*)(ada + (size_t)b * 6144 + 3072 + k), s4 = *(const f32x4*)(ada + (size_t)b * 6144 + 4096 + k);
#pragma unroll
            for (int q = 0; q < 4; ++q) v[j][q] = (v[j][q] * rstd * g[q]) * (1.f + s4[q]) + h4[q];
            *(unsigned*)(hx2 + (size_t)row * DM + k) = pk4_fp8(v[j][0], v[j][1], v[j][2], v[j][3]); }
        const float lg = row_dot16(v, Wr, C.lane);
        float mx = lg;
        mx = fmaxf(mx, __shfl_xor(mx, 4)); mx = fmaxf(mx, __shfl_xor(mx, 8)); mx = fmaxf(mx, __shfl_xor(mx, 16)); mx = fmaxf(mx, __shfl_xor(mx, 32));
        const float ex = expf(lg - mx);
        float sum = ex;
        sum += __shfl_xor(sum, 4); sum += __shfl_xor(sum, 8); sum += __shfl_xor(sum, 16); sum += __shfl_xor(sum, 32);
        if ((C.lane & 3) == 0) { const int e = C.lane >> 2; aff[((size_t)b * NE + e) * SEQ + n] = ex / sum; slot[(size_t)row * 16 + e] = -1; }
    }
}

__device__ __forceinline__ void topk_item(const Ctx& C, const Params& P, int item) {
    unsigned char* ws = P.ws;
    const int b = item >> 4, e = item & 15;
    const float* aff = (const float*)(ws + WS_AFF) + (size_t)item * SEQ;
    LAS unsigned* red = (LAS unsigned*)C.lds;
    unsigned v[8];
    { const u32x4 a = *(const u32x4*)(aff + 8 * C.tid), c = *(const u32x4*)(aff + 8 * C.tid + 4);
      v[0] = a.x; v[1] = a.y; v[2] = a.z; v[3] = a.w; v[4] = c.x; v[5] = c.y; v[6] = c.z; v[7] = c.w; }
    unsigned prefix = 0u;
    for (int bit = 30; bit >= 0; --bit) {
        const unsigned cand = prefix | (1u << bit); int cnt = 0;
#pragma unroll
        for (int q = 0; q < 8; ++q) cnt += (v[q] >= cand) ? 1 : 0;
        cnt = (int)wave_sum((float)cnt);
        __syncthreads();
        if (C.lane == 0) red[C.wave] = (unsigned)cnt;
        __syncthreads();
        int tot = 0;
#pragma unroll
        for (int q = 0; q < 8; ++q) tot += (int)red[q];
        if (tot >= CAP) prefix = cand;
    }
    int cg_ = 0, ce_ = 0;
#pragma unroll
    for (int q = 0; q < 8; ++q) { cg_ += (v[q] > prefix) ? 1 : 0; ce_ += (v[q] == prefix) ? 1 : 0; }
    int ig = cg_, ie = ce_;
#pragma unroll
    for (int o = 1; o < 64; o <<= 1) { const int tg = __shfl_up(ig, o), te = __shfl_up(ie, o); if (C.lane >= o) { ig += tg; ie += te; } }
    __syncthreads();
    if (C.lane == 63) { red[C.wave] = (unsigned)ig; red[8 + C.wave] = (unsigned)ie; }
    __syncthreads();
    int bg = 0, be = 0, totg = 0;
#pragma unroll
    for (int q = 0; q < 8; ++q) { const int xg = (int)red[q], xe = (int)red[8 + q]; if (q < C.wave) { bg += xg; be += xe; } totg += xg; }
    int pg = bg + ig - cg_, pe = be + ie - ce_;
    const int need = CAP - totg;
    int* sidx = (int*)(ws + WS_SIDX) + (size_t)item * CAP; float* sg = (float*)(ws + WS_SGATE) + (size_t)item * CAP; int* slot = (int*)(ws + WS_SLOT);
#pragma unroll
    for (int q = 0; q < 8; ++q) { const int n = 8 * C.tid + q; int s = -1;
        if (v[q] > prefix) s = pg++;
        else if (v[q] == prefix) { if (pe < need) s = totg + pe; ++pe; }
        if (s >= 0) { sidx[s] = n; sg[s] = __builtin_bit_cast(float, v[q]); slot[((size_t)b * SEQ + n) * 16 + e] = s; } }
}

__device__ __forceinline__ void gather_all(const Ctx& C, const Params& P) {
    unsigned char* ws = P.ws;
    const int* sidx = (const int*)(ws + WS_SIDX); const unsigned char* hx2 = ws + WS_HX2; unsigned char* xg = ws + WS_XG;
    const int STR = C.G * 8;
    for (int r0 = C.bid * 8 + C.wave; r0 < NE * 4096; r0 += 4 * STR) {
        int n4[4];
#pragma unroll
        for (int u = 0; u < 4; ++u) { const int r = r0 + u * STR; const int e = r >> 12, rr = r & 4095, b = rr >> 9, s = rr & 511; n4[u] = (r < NE * 4096) ? sidx[((size_t)b * NE + e) * CAP + s] : 0; }
        u32x4 v4[4];
#pragma unroll
        for (int u = 0; u < 4; ++u) { const int r = r0 + u * STR; const int b = (r & 4095) >> 9; if (r < NE * 4096) v4[u] = ((const u32x4*)(hx2 + ((size_t)b * SEQ + n4[u]) * DM))[C.lane]; }
#pragma unroll
        for (int u = 0; u < 4; ++u) { const int r = r0 + u * STR; if (r < NE * 4096) ((u32x4*)(xg + (size_t)r * DM))[C.lane] = v4[u]; }
    }
}

__device__ __forceinline__ void moe_gemm1(const Ctx& C, const Params& P, int skip_epi) {
    unsigned char* ws = P.ws;
    pg8::SchedMoe S{(const char*)(ws + WS_XG), (const char*)(ws + WS_W13), (size_t)256 * 1024, (size_t)256 * 1024, (size_t)4096 * 1024, (size_t)4096 * 1024, 16, 16, C.G, C.bid};
    pg8::EpiMoe1 E{ws + WS_ACT, skip_epi};
    pg8::gemm_phase<pg8::EpiMoe1, pg8::SchedMoe, false, true>(C.lds, 512, 1024, 1024, S, E);
}
__device__ __forceinline__ void moe_gemm2(const Ctx& C, const Params& P, bool skip_epi) {
    unsigned char* ws = P.ws;
    pg8::SchedMoe S{(const char*)(ws + WS_ACT), (const char*)(ws + WS_W2), (size_t)256 * 2048, (size_t)256 * 2048, (size_t)4096 * 2048, (size_t)1024 * 2048, 16, 4, C.G, C.bid};
    pg8::EpiMoe2 E{(bf16_t*)(ws + WS_YE), (const float*)(ws + WS_SGATE), skip_epi};
    pg8::gemm_phase<pg8::EpiMoe2, pg8::SchedMoe, false, true>(C.lds, 1024, 2048, 2048, S, E);
}

__device__ __forceinline__ void phase_final(const Ctx& C, const Params& P) {
    unsigned char* ws = P.ws;
    const float* ada = (const float*)(ws + WS_ADA); const float* gfin = P.in[26];
    const int* slot = (const int*)(ws + WS_SLOT); const bf16_t* ye = (const bf16_t*)(ws + WS_YE);
    const bf16_t* xm = (const bf16_t*)(ws + WS_XMID);
    u32x2 nx[4]; int nslot = -1;
    { const int row0 = C.bid * 8 + C.wave;
      if (row0 < MX) { if (C.lane < 16) nslot = slot[(size_t)row0 * 16 + C.lane];
#pragma unroll
        for (int j = 0; j < 4; ++j) nx[j] = *(const u32x2*)(xm + (size_t)row0 * DM + 4 * C.lane + 256 * j); } }
    for (int row = C.bid * 8 + C.wave; row < MX; row += C.G * 8) {
        const int b = row >> 12;
        float* xr = P.out + (size_t)row * DM;
        f32x4 xv[4]; const int myslot = nslot;
#pragma unroll
        for (int j = 0; j < 4; ++j) xv[j] = (f32x4){bflo(nx[j].x), bfhi(nx[j].x), bflo(nx[j].y), bfhi(nx[j].y)};
        f32x4 m[4];
#pragma unroll
        for (int j = 0; j < 4; ++j) m[j] = (f32x4){0.f, 0.f, 0.f, 0.f};
        for (int e = 0; e < NE; ++e) { const int s = __shfl(myslot, e);
            if (s >= 0) { const bf16_t* yr = ye + ((size_t)e * 4096 + b * CAP + s) * DM;
#pragma unroll
                for (int j = 0; j < 4; ++j) { const u32x2 w = *(const u32x2*)(yr + 4 * C.lane + 256 * j);
                    m[j][0] += bflo(w.x); m[j][1] += bfhi(w.x); m[j][2] += bflo(w.y); m[j][3] += bfhi(w.y); } } }
        if (row + C.G * 8 < MX) { const int r1 = row + C.G * 8; nslot = (C.lane < 16) ? slot[(size_t)r1 * 16 + C.lane] : -1;
#pragma unroll
            for (int j = 0; j < 4; ++j) nx[j] = *(const u32x2*)(xm + (size_t)r1 * DM + 4 * C.lane + 256 * j); }
        f32x4 v[4]; float ss = 0.f;
#pragma unroll
        for (int j = 0; j < 4; ++j) { const int k = 4 * C.lane + 256 * j; const f32x4 g5 = *(const f32x4*)(ada + (size_t)b * 6144 + 5120 + k);
            v[j] = xv[j] + g5 * m[j]; ss += v[j][0] * v[j][0] + v[j][1] * v[j][1] + v[j][2] * v[j][2] + v[j][3] * v[j][3]; }
        const float rstd = rsqrtf(wave_sum(ss) * (1.f / DM) + RMS_EPS);
#pragma unroll
        for (int j = 0; j < 4; ++j) { const int k = 4 * C.lane + 256 * j; const f32x4 g = *(const f32x4*)(gfin + k);
            *(f32x4*)(xr + k) = v[j] * rstd * g; }
    }
}

constexpr int N_PHASES = 14;
__global__ void __launch_bounds__(NTHR, 2) mega(Params P) {
    extern __shared__ __attribute__((aligned(16))) unsigned char lds_raw[];
    Ctx C; C.lds = (LAS unsigned char*)lds_raw; C.tid = threadIdx.x; C.lane = C.tid & 63; C.wave = __builtin_amdgcn_readfirstlane(C.tid >> 6); C.bid = blockIdx.x; C.G = gridDim.x;
    unsigned char* ws = P.ws;
    if (C.tid < 32) ((LAS unsigned*)(C.lds + LDS_MISC))[C.tid] = 0u;
    __syncthreads();
    XcdBarrier bar = xcd_barrier_post((unsigned*)(ws + WS_CTL), (volatile LAS unsigned*)(C.lds + LDS_MISC));
#define IN(k) (lo <= (k) && (k) < hi)
#define SEAM(k) do { if (IN(k) && IN((k) + 1)) { xcd_barrier(bar); if ((REPEAT >> 23) & 1u) xcd_barrier(bar); } } while (0)
#define RUN(id, ...) do { { constexpr bool rep = false; (void)rep; __VA_ARGS__; } if ((REPEAT >> (id)) & 1u) { xcd_barrier(bar); { constexpr bool rep = true; (void)rep; __VA_ARGS__; } } } while (0)
#define PHASE_PROGRAM(LO, HI) do { const int lo = (LO), hi = (HI); \
    if (IN(0)) RUN(0, phase0(C, P)); \
    SEAM(0); \
    if (IN(1)) RUN(1, phase1(C, P)); \
    SEAM(1); \
    if (IN(2)) { \
        RUN(2, phase2a(C, P)); \
        RUN(3, phase2b(C, P)); \
    } \
    SEAM(2); \
    if (IN(3)) RUN(5, mlstm_prep(C, P)); \
    SEAM(3); \
    if (IN(4)) RUN(4, mixer_phase<rep ? (int)((REPEAT >> 25) & 3u) : 0>(C, P)); \
    SEAM(4); \
    if (IN(5)) { \
        RUN(9, transpose_z2(C, P)); \
        RUN(8, mlstm_combine(C, P)); \
    } \
    SEAM(5); \
    if (IN(6)) RUN(10, phase_merge(C, P)); \
    SEAM(6); \
    if (IN(7)) RUN(11, phase_outproj(C, P)); \
    SEAM(7); \
    if (IN(8)) RUN(12, phase6(C, P)); \
    SEAM(8); \
    if (IN(9)) { \
        RUN(13, for (int it = C.bid; it < BATCH * NE; it += C.G) topk_item(C, P, it)); \
        __syncthreads(); \
        RUN(14, convert_experts(C, P)); \
    } \
    SEAM(9); \
    if (IN(10)) RUN(15, gather_all(C, P)); \
    SEAM(10); \
    if (IN(11)) RUN(16, moe_gemm1(C, P, rep ? (int)((REPEAT >> 25) & 3u) : 0)); \
    SEAM(11); \
    if (IN(12)) RUN(17, moe_gemm2(C, P, rep && ((REPEAT >> 25) & 1u))); \
    SEAM(12); \
    if (IN(13)) phase_final(C, P); \
} while (0)
    PHASE_PROGRAM(P.ph_lo, P.ph_hi);
#undef PHASE_PROGRAM
#undef IN
#undef SEAM
#undef RUN
}

extern "C" void kernel_launch(void* const* d_in, const int* in_sizes, int n_in, void* d_out, int out_size, void* d_ws, size_t ws_size, hipStream_t stream) {
    static int grid = 0;
    if (grid == 0) {
        if (n_in != 27 || out_size != MX * DM || ws_size < WS_END) { fprintf(stderr, "kernel_launch: unexpected shapes (n_in %d, out %d, ws %zu < %zu)\n", n_in, out_size, ws_size, (size_t)WS_END); grid = -1; return; }
        int dev = 0, cus = 0, per_cu = 0;
        hipGetDevice(&dev);
        hipDeviceGetAttribute(&cus, hipDeviceAttributeMultiprocessorCount, dev);
        if (hipFuncSetAttribute((const void*)mega, hipFuncAttributeMaxDynamicSharedMemorySize, LDS_BYTES) != hipSuccess) { fprintf(stderr, "kernel_launch: hipFuncSetAttribute failed\n"); grid = -1; return; }
        if (hipOccupancyMaxActiveBlocksPerMultiprocessor(&per_cu, (const void*)mega, NTHR, LDS_BYTES) != hipSuccess || per_cu < 1) { fprintf(stderr, "kernel_launch: occupancy query says %d\n", per_cu); per_cu = 1; }
        (void)hipGetLastError();
        grid = cus * 1;
        if (grid <= 0) grid = 256;
    }
    if (grid < 0) return;
    Params p; memset(&p, 0, sizeof(p));
    for (int i = 0; i < 27; ++i) p.in[i] = (const float*)d_in[i];
    p.out = (float*)d_out; p.ws = (unsigned char*)d_ws;
    (void)hipMemsetAsync((unsigned char*)d_ws + WS_CTL, 0, XCD_BAR_WORDS * 4, stream);
#if N_LAUNCH_MODE == 1
    if (PREFIX > 0) {
        p.ph_lo = 0; p.ph_hi = PREFIX;
        void* pargs[] = {&p};
        (void)hipLaunchCooperativeKernel((const void*)mega, dim3(grid), dim3(NTHR), pargs, LDS_BYTES, stream);
        (void)hipMemsetAsync((unsigned char*)d_ws + WS_CTL, 0, XCD_BAR_WORDS * 4, stream);
    }
    p.ph_lo = 0; p.ph_hi = N_PHASES;
    void* args[] = {&p};
    hipError_t e = hipLaunchCooperativeKernel((const void*)mega, dim3(grid), dim3(NTHR), args, LDS_BYTES, stream);
    if (e != hipSuccess) fprintf(stderr, "kernel_launch: cooperative launch failed: %s (grid %d)\n", hipGetErrorString(e), grid);
#else
    for (int ph = 0; ph < N_PHASES; ++ph) {
        p.ph_lo = ph; p.ph_hi = ph + 1;
        void* args[] = {&p};
        hipError_t e = hipLaunchCooperativeKernel((const void*)mega, dim3(grid), dim3(NTHR), args, LDS_BYTES, stream);
        if (e != hipSuccess) { fprintf(stderr, "kernel_launch: launch %d failed: %s (grid %d)\n", ph, hipGetErrorString(e), grid); break; }
    }
#endif
}
```

```cpp
#include <hip/hip_runtime.h>
#include <hip/hip_cooperative_groups.h>
#include <cstdio>
#include <cstdint>
#include <cstring>
namespace cg = cooperative_groups;

#ifndef N_LAUNCH_MODE
#define N_LAUNCH_MODE 1
#endif

#define LAS __attribute__((address_space(3)))
typedef unsigned short bf16_t;
typedef short bf16x8 __attribute__((ext_vector_type(8)));
typedef float f32x4 __attribute__((ext_vector_type(4)));
typedef float f32x16 __attribute__((ext_vector_type(16)));
typedef unsigned u32x4 __attribute__((ext_vector_type(4)));
typedef unsigned u32x2 __attribute__((ext_vector_type(2)));

constexpr int NTHR = 512;
constexpr int BATCH = 8, SEQ = 4096, DM = 1024, CTXL = 256;
constexpr int MX = BATCH * SEQ;
constexpr int MC = BATCH * CTXL;
constexpr int DIN = 5648, NPROJ = 5632, GATE0 = 3584, MERGE0 = 3600;
constexpr int NE = 16, CAP = 512, DFF = 2048;
constexpr int MT = MX + MC;
constexpr int NCHK = 34;
constexpr float RMS_EPS = 1e-6f;

constexpr size_t MiB = 1u << 20;
constexpr size_t WS_ADAP = 0;
constexpr size_t WS_ADA = 7 * MiB;
constexpr size_t WS_CTL = 7 * MiB + 512 * 1024;
constexpr size_t WS_GATES = 8 * MiB;
constexpr size_t WS_KREV = 11 * MiB;
constexpr size_t WS_BL = 27 * MiB;
constexpr size_t WS_MST = 27 * MiB + 64 * 1024;
constexpr size_t WS_NLOC = 28 * MiB;
constexpr size_t WS_NST = 30 * MiB;
constexpr size_t WS_WIN = 32 * MiB;
constexpr size_t WS_WB = 43 * MiB;
constexpr size_t WS_WOUT = 45 * MiB;
constexpr size_t WS_HX = 48 * MiB;
constexpr size_t WS_PLOC = 48 * MiB;
constexpr size_t WS_PCM = 116 * MiB;
constexpr size_t WS_PML = 212 * MiB;
constexpr size_t WS_KVCM = 276 * MiB;
constexpr size_t WS_GC = 2 * MiB;
constexpr size_t WS_Z1 = 344 * MiB;
constexpr size_t WS_YAB = 376 * MiB;
constexpr size_t WS_CST = 440 * MiB;
constexpr size_t WS_KACT = 48 * MiB;
constexpr size_t WS_QACT = 82 * MiB;
constexpr size_t WS_HDIR = 440 * MiB;
constexpr size_t WS_Z2CM = 504 * MiB;
constexpr size_t WS_Z = 48 * MiB;
constexpr size_t WS_XMID = 496 * MiB;
constexpr size_t WS_AFF = 0;
constexpr size_t WS_SLOT = 2 * MiB;
constexpr size_t WS_SIDX = 4 * MiB;
constexpr size_t WS_SGATE = 4 * MiB + 512 * 1024;
constexpr size_t WS_HX2 = 48 * MiB;
constexpr size_t WS_W13 = 80 * MiB;
constexpr size_t WS_W2 = 144 * MiB;
constexpr size_t WS_XG = 176 * MiB;
constexpr size_t WS_ACT = 240 * MiB;
constexpr size_t WS_YE = 368 * MiB;
constexpr size_t WS_END = 568 * MiB;

constexpr int LDS_BYTES = 147456;
constexpr int LDS_MISC = LDS_BYTES - 128;
constexpr int PREFIX = 0;
constexpr unsigned REPEAT = 0u;

__device__ __forceinline__ unsigned f2bf(float f) { unsigned u = __builtin_bit_cast(unsigned, f); return (u + 0x7fffu + ((u >> 16) & 1u)) >> 16; }
__device__ __forceinline__ unsigned pk2(float lo, float hi) { return f2bf(lo) | (f2bf(hi) << 16); }
__device__ __forceinline__ float bf2f(unsigned short b) { return __builtin_bit_cast(float, ((unsigned)b) << 16); }
__device__ __forceinline__ float bflo(unsigned w) { return __builtin_bit_cast(float, w << 16); }
__device__ __forceinline__ float bfhi(unsigned w) { return __builtin_bit_cast(float, w & 0xffff0000u); }
__device__ __forceinline__ float sigm(float x) { return __builtin_amdgcn_rcpf(1.f + __expf(-x)); }
__device__ __forceinline__ float siluf(float x) { return x * __builtin_amdgcn_rcpf(1.f + __expf(-x)); }
__device__ __forceinline__ float logsig(float x) { return x >= 0.f ? -log1pf(expf(-x)) : x - log1pf(expf(x)); }
__device__ __forceinline__ float wave_sum(float v) {
#pragma unroll
    for (int o = 1; o < 64; o <<= 1) v += __shfl_xor(v, o);
    return v;
}
#define LDS_WAIT() asm volatile("s_waitcnt lgkmcnt(0)" ::: "memory")
__device__ __forceinline__ float clamp8(float x) { return __builtin_amdgcn_fmed3f(x, -448.f, 448.f); }
__device__ __forceinline__ unsigned pk4_fp8(float a, float b, float c, float d) {
    int r = __builtin_amdgcn_cvt_pk_fp8_f32(clamp8(a), clamp8(b), 0, false); r = __builtin_amdgcn_cvt_pk_fp8_f32(clamp8(c), clamp8(d), r, true); return (unsigned)r; }
constexpr float W8_SCALE = 64.f, W8_INV = 1.f / 64.f;

struct Params {
    const float* in[27];
    float* out;
    unsigned char* ws;
    int ph_lo, ph_hi;
};


#define XB_TMO      128
#define XB_XCNT(j)  (256  + 64 * (j))
#define XB_XSUB(j)  (1280 + 64 * (j))
#define XB_XGEN(j)  (2304 + 64 * (j))
#define XB_TOP      3328
#define XB_TOPGEN   3392
#define XCD_BAR_WORDS 3456
#define XB_SPIN_CAP (1u << 18)
__device__ __forceinline__ unsigned xb_ld(unsigned* p)              { return __hip_atomic_load(p, __ATOMIC_RELAXED, __HIP_MEMORY_SCOPE_AGENT); }
__device__ __forceinline__ unsigned xb_add(unsigned* p, unsigned v) { return __hip_atomic_fetch_add(p, v, __ATOMIC_RELAXED, __HIP_MEMORY_SCOPE_AGENT); }
__device__ __forceinline__ unsigned xb_xcc_id() { return (unsigned)__builtin_amdgcn_s_getreg((3 << 11) | 20) & 0xFu; }
#define XB_SPIN(cond, bar) do { unsigned _sp = 0; while (cond) { __builtin_amdgcn_s_sleep(1); \
    if ((++_sp & 255u) == 0u) { if (xb_ld(&(bar)[XB_TMO])) break; if (_sp > XB_SPIN_CAP) { atomicAdd(&(bar)[XB_TMO], 1u); break; } } } } while (0)
struct XcdBarrier { unsigned* bar; unsigned x; volatile LAS unsigned* st; };
__device__ __forceinline__ XcdBarrier xcd_barrier_post(unsigned* bar, volatile LAS unsigned* st) {
    XcdBarrier b; b.bar = bar; b.x = xb_xcc_id(); b.st = st;
    if (threadIdx.x == 0) (void)xb_add(&bar[XB_XCNT(b.x)], 1u);
    return b;
}
__device__ __forceinline__ void xcd_barrier_complete(unsigned* bar, unsigned x, unsigned& nloc, unsigned& nx) {
    const unsigned G = gridDim.x * gridDim.y * gridDim.z;
    unsigned sum, cnt, mine, sp = 0u;
    for (;;) {
        sum = 0u; cnt = 0u; mine = 0u;
#pragma unroll
        for (unsigned j = 0; j < 16; ++j) { const unsigned c = xb_ld(&bar[XB_XCNT(j)]); sum += c; cnt += (c > 0u) ? 1u : 0u; mine = (j == x) ? c : mine; }
        if (sum == G) break;
        __builtin_amdgcn_s_sleep(1);
        if ((++sp & 255u) == 0u) { if (xb_ld(&bar[XB_TMO])) break; if (sp > XB_SPIN_CAP) { atomicAdd(&bar[XB_TMO], 1u); break; } }
    }
    nloc = mine > 0u ? mine : 1u; nx = cnt > 0u ? cnt : 1u;
}
__device__ __forceinline__ void xcd_barrier(const XcdBarrier& b) {
    asm volatile("s_waitcnt vmcnt(0)" ::: "memory");
    __syncthreads();
    if (threadIdx.x == 0) {
        unsigned* bar = b.bar;
        __builtin_amdgcn_s_waitcnt(0);
        unsigned nloc = b.st[0], nx = b.st[1];
        if (nloc == 0u) { xcd_barrier_complete(bar, b.x, nloc, nx); b.st[0] = nloc; b.st[1] = nx; }
        const unsigned old = xb_add(&bar[XB_XSUB(b.x)], 1u);
        const unsigned gen = old / nloc;
        if (old + 1u == (gen + 1u) * nloc) {
            __builtin_amdgcn_fence(__ATOMIC_RELEASE, "agent");
            asm volatile("s_waitcnt vmcnt(0)" ::: "memory");
            const unsigned og = xb_add(&bar[XB_TOP], 1u);
            const unsigned tg = og / nx;
            if (og + 1u == (tg + 1u) * nx) xb_add(&bar[XB_TOPGEN], 1u);
            else XB_SPIN(xb_ld(&bar[XB_TOPGEN]) == tg, bar);
            __builtin_amdgcn_fence(__ATOMIC_ACQUIRE, "agent");
            xb_add(&bar[XB_XGEN(b.x)], 1u);
            asm volatile("s_waitcnt vmcnt(0)" ::: "memory");
        } else {
            XB_SPIN(xb_ld(&bar[XB_XGEN(b.x)]) == gen, bar);
            __builtin_amdgcn_fence(__ATOMIC_ACQUIRE, "agent");
            asm volatile("s_waitcnt vmcnt(0)" ::: "memory");
        }
    }
    __syncthreads();
}

namespace pg8 {
constexpr int BM = 256, BK = 64, HALF = 128, HTB = HALF * BK * 2, STAGE_BYTES = 8 * HTB;
__device__ __forceinline__ int lds_byte(int r, int c) { const int st = (r >> 4) * 2 + (c >> 5), rr = r & 15, cc = c & 31, ob = rr * 64 + cc * 2; return st * 1024 + (ob ^ (((ob >> 9) & 1) << 5)); }
__device__ __forceinline__ void stage_rc(int b, int& R, int& C) { const int st = b / 1024, sb = b % 1024, swz = sb ^ (((sb >> 9) & 1) << 5); R = (st >> 1) * 16 + swz / 64; C = (st & 1) * 32 + (swz % 64) / 2; }
__device__ __forceinline__ int perm32(int rho) { const int n = rho >> 4, i = rho & 15; return 8 * (i >> 2) + 4 * n + (i & 3); }
__device__ __forceinline__ unsigned cvt_pk_bf16(float lo, float hi) { unsigned r; asm volatile("v_cvt_pk_bf16_f32 %0, %1, %2" : "=v"(r) : "v"(lo), "v"(hi)); return r; }

typedef int v4i_t __attribute__((ext_vector_type(4)));
typedef int v8i_t __attribute__((ext_vector_type(8)));
struct Unit { const char* A; const char* B; int pm, pn, aux; };

struct SchedGrid {
    const char* A; const char* B; size_t tstepA, tstepB; int nM, nN, pm0, pn0, G, c;
    int xN, xPm0, xPn0, xCnt;
    int split, gap;
    __device__ bool next(int i, Unit& u) const {
        const long L = (long)i * G + c; const int nwg = nM * nN;
        if (L >= nwg + xCnt) return false;
        if (L >= nwg) { const int q = (int)L - nwg; u.pm = xPm0 + q / xN; u.pn = xPn0 + q % xN; u.aux = 1; }
        else {
            int wgid = (int)L; { const int q = nwg / 8, r = nwg % 8, xcd = wgid % 8, off = wgid / 8; wgid = (xcd < r ? xcd * (q + 1) : r * (q + 1) + (xcd - r) * q) + off; }
            const int nig = 8 * nN, gid = wgid / nig, fm = gid * 8, gsz = (nM - fm) < 8 ? (nM - fm) : 8;
            u.pm = pm0 + fm + ((wgid % nig) % gsz); { const int idx = (wgid % nig) / gsz; u.pn = pn0 + idx + (idx >= split ? gap : 0); } u.aux = 0;
        }
        u.A = A + (size_t)u.pm * tstepA; u.B = B + (size_t)u.pn * tstepB; return true;
    }
};
struct SchedChain {
    SchedGrid G; size_t half;
    __device__ bool next(int i, Unit& u) const {
        if (!G.next(i >> 1, u)) return false;
        u.aux = i & 1; u.A += (size_t)(i & 1) * half; u.B += (size_t)(i & 1) * half; return true;
    }
};

struct SchedMoe {
    const char* A; const char* B; size_t tstepA, tstepB, estepA, estepB; int nM, nN, G, c;
    __device__ bool next(int i, Unit& u) const {
        const long L = (long)i * G + c; const int e8 = (int)(L % 8); const long ta = L / 8; const int per = nM * nN;
        if (ta >= 2L * per) return false;
        const int e = e8 + 8 * (int)(ta / per); const int t = (int)(ta % per);
        if (nN == 16) { const int blk = t >> 5, wi = t & 31; u.pm = 4 * (blk >> 1) + (wi >> 3); u.pn = 8 * (blk & 1) + (wi & 7); }
        else { u.pm = t / nN; u.pn = t % nN; }
        u.aux = e;
        u.A = A + (size_t)e * estepA + (size_t)u.pm * tstepA; u.B = B + (size_t)e * estepB + (size_t)u.pn * tstepB; return true;
    }
};

template <class Epi, class Sched, bool NORMAL, bool F8 = false>
__device__ __forceinline__ void gemm_phase(LAS unsigned char* lds, const int K  , const unsigned lda, const unsigned ldb, const Sched& S, const Epi& E) {
    const int tid = threadIdx.x, wid = __builtin_amdgcn_readfirstlane(tid >> 6), lane = tid & 63, wr = wid >> 2, wc = wid & 3, fr = lane & 15, fq = lane >> 4;
    const int nt = K / BK;
    unsigned voffA[2], voffB[2];
#pragma unroll
    for (int i = 0; i < 2; ++i) { int R, C; stage_rc(tid * 16 + i * 8192, R, C); const int Rb = Epi::PERM ? ((R & ~31) + perm32(R & 31)) : R;
        voffA[i] = (unsigned)R * lda + (unsigned)C * 2u; voffB[i] = (unsigned)Rb * ldb + (unsigned)C * 2u; }
    const size_t kstep = (size_t)(BK * 2);
    const size_t hstepA = (size_t)HALF * lda, hstepB = (size_t)HALF * ldb;
    const unsigned ldsw = (unsigned)wid * 1024u;
    const int aoff = lds_byte(wr * 64 + fr, fq * 8), boff = lds_byte(wc * 32 + fr, fq * 8);
#define PG8_SA(b, h) (((b) * 2 + (h)) * HTB)
#define PG8_SB(b, h) ((4 + (b) * 2 + (h)) * HTB)
#define PG8_STAGE(bufoff, gbase, voff) do { _Pragma("unroll") for (int _i = 0; _i < 2; ++_i) \
        __builtin_amdgcn_global_load_lds((const unsigned*)((const char*)(gbase) + (voff)[_i]), (LAS unsigned*)(lds + (bufoff) + ldsw + _i * 8192), 16, 0, 0); } while (0)
#define PG8_LDA(dst, b, h) do { if constexpr (F8) { _Pragma("unroll") for (int m = 0; m < 4; ++m) dst##8[m] = __builtin_shufflevector(*(const LAS v4i_t*)(lds + PG8_SA(b, h) + aoff + m * 2048), *(const LAS v4i_t*)(lds + PG8_SA(b, h) + aoff + m * 2048 + 1024), 0, 1, 2, 3, 4, 5, 6, 7); } \
        else { _Pragma("unroll") for (int m = 0; m < 4; ++m) _Pragma("unroll") for (int k = 0; k < 2; ++k) dst[m][k] = *(const LAS bf16x8*)(lds + PG8_SA(b, h) + aoff + m * 2048 + k * 1024); } } while (0)
#define PG8_LDB(dst, b, h) do { if constexpr (F8) { _Pragma("unroll") for (int n = 0; n < 2; ++n) dst##8[n] = __builtin_shufflevector(*(const LAS v4i_t*)(lds + PG8_SB(b, h) + boff + n * 2048), *(const LAS v4i_t*)(lds + PG8_SB(b, h) + boff + n * 2048 + 1024), 0, 1, 2, 3, 4, 5, 6, 7); } \
        else { _Pragma("unroll") for (int n = 0; n < 2; ++n) _Pragma("unroll") for (int k = 0; k < 2; ++k) dst[n][k] = *(const LAS bf16x8*)(lds + PG8_SB(b, h) + boff + n * 2048 + k * 1024); } } while (0)
#define PG8_MMA(ai, bj, At, Bt) do { __builtin_amdgcn_s_setprio(1); \
        if constexpr (F8) { _Pragma("unroll") for (int m = 0; m < 4; ++m) _Pragma("unroll") for (int n = 0; n < 2; ++n) \
            asm volatile("v_mfma_scale_f32_16x16x128_f8f6f4 %0, %1, %2, %0, %3, %3 op_sel_hi:[0,0,0]" : "+v"(acc[ai][bj][m][n]) : "v"(Bt##8[n]), "v"(At##8[m]), "v"(sc8)); } \
        else { _Pragma("unroll") for (int m = 0; m < 4; ++m) _Pragma("unroll") for (int n = 0; n < 2; ++n) _Pragma("unroll") for (int k = 0; k < 2; ++k) \
        acc[ai][bj][m][n] = NORMAL ? __builtin_amdgcn_mfma_f32_16x16x32_bf16(At[m][k], Bt[n][k], acc[ai][bj][m][n], 0, 0, 0) \
                                   : __builtin_amdgcn_mfma_f32_16x16x32_bf16(Bt[n][k], At[m][k], acc[ai][bj][m][n], 0, 0, 0); } __builtin_amdgcn_s_setprio(0); } while (0)
#define PG8_WAIT_V(n) asm volatile("s_waitcnt vmcnt(" #n ")" ::: "memory")
#define PG8_WAIT_L(n) asm volatile("s_waitcnt lgkmcnt(" #n ")" ::: "memory")
#define PG8_BAR __builtin_amdgcn_s_barrier()
#define PG8_SCHED __builtin_amdgcn_sched_barrier(0)
    Unit cur, nxt; int ui = 0;
    if (!S.next(0, cur)) return;
    f32x4 acc[2][2][4][2];
#pragma unroll
    for (int a = 0; a < 2; ++a)
#pragma unroll
        for (int b = 0; b < 2; ++b)
#pragma unroll
            for (int m = 0; m < 4; ++m)
#pragma unroll
                for (int n = 0; n < 2; ++n) acc[a][b][m][n] = (f32x4){0.f, 0.f, 0.f, 0.f};
    bf16x8 At[4][2], B0[2][2], B1[2][2];
    v8i_t At8[4], B08[2], B18[2]; const int sc8 = 0x7F7F7F7F;
    const char* cA = cur.A; const char* cB = cur.B;
    PG8_STAGE(PG8_SB(0, 0), cB, voffB); PG8_STAGE(PG8_SB(0, 1), cB + hstepB, voffB); PG8_STAGE(PG8_SA(0, 0), cA, voffA); PG8_STAGE(PG8_SA(0, 1), cA + hstepA, voffA);
    if (wr == 1) PG8_BAR;
    PG8_WAIT_V(2); PG8_BAR;
    PG8_STAGE(PG8_SB(1, 0), cB + kstep, voffB); PG8_STAGE(PG8_SA(1, 0), cA + kstep, voffA); PG8_STAGE(PG8_SB(1, 1), cB + hstepB + kstep, voffB);
    PG8_WAIT_V(6); PG8_BAR;
    for (;;) {
        const bool has_next = S.next(ui + 1, nxt);
        const char* nA = has_next ? nxt.A : cA; const char* nB = has_next ? nxt.B : cB;
#pragma unroll 1
        for (int t = 0; t < nt; t += 2) {
            const bool last = (t == nt - 2);
            const char* a1 = cA + (size_t)(t + 1) * kstep;
            const char* a2 = last ? nA : cA + (size_t)(t + 2) * kstep; const char* b2 = last ? nB : cB + (size_t)(t + 2) * kstep;
            const char* a3 = a2 + kstep; const char* b3 = b2 + kstep;
            PG8_LDB(B0, 0, 0); PG8_LDB(B1, 0, 1); PG8_SCHED; PG8_LDA(At, 0, 0); PG8_STAGE(PG8_SA(1, 1), a1 + hstepA, voffA);
            PG8_WAIT_V(8); PG8_WAIT_L(0); PG8_BAR; PG8_MMA(0, 0, At, B0); PG8_MMA(0, 1, At, B1); PG8_BAR; PG8_SCHED;
            PG8_LDA(At, 0, 1); PG8_STAGE(PG8_SB(0, 0), b2, voffB); PG8_STAGE(PG8_SB(0, 1), b2 + hstepB, voffB); PG8_STAGE(PG8_SA(0, 0), a2, voffA);
            PG8_WAIT_V(8); PG8_WAIT_L(0); PG8_BAR; PG8_MMA(1, 0, At, B0); PG8_MMA(1, 1, At, B1); PG8_BAR; PG8_SCHED;
            PG8_LDB(B0, 1, 0); PG8_LDB(B1, 1, 1); PG8_SCHED; PG8_LDA(At, 1, 0); PG8_STAGE(PG8_SA(0, 1), a2 + hstepA, voffA);
            PG8_WAIT_V(8); PG8_WAIT_L(0); PG8_BAR; PG8_MMA(0, 0, At, B0); PG8_MMA(0, 1, At, B1); PG8_BAR; PG8_SCHED;
            PG8_LDA(At, 1, 1); PG8_STAGE(PG8_SB(1, 0), b3, voffB); PG8_STAGE(PG8_SB(1, 1), b3 + hstepB, voffB); PG8_STAGE(PG8_SA(1, 0), a3, voffA);
            PG8_WAIT_V(8); PG8_WAIT_L(0); PG8_BAR; PG8_MMA(1, 0, At, B0); PG8_MMA(1, 1, At, B1); PG8_BAR; PG8_SCHED;
        }
        if (wr == 0) PG8_BAR;
        if constexpr (F8) asm volatile("s_nop 15\n\ts_nop 15" ::: "memory");
        bool keep = false;
        if constexpr (Epi::HAS_MID) { if (cur.aux == 0) { E.mid(acc, cur, wr, wc, fr, fq); keep = true; } else E(acc, cur, wr, wc, fr, fq); }
        else E(acc, cur, wr, wc, fr, fq);
        if (!has_next) break;
        if (!keep) {
#pragma unroll
        for (int a = 0; a < 2; ++a)
#pragma unroll
            for (int b = 0; b < 2; ++b)
#pragma unroll
                for (int m = 0; m < 4; ++m)
#pragma unroll
                    for (int n = 0; n < 2; ++n) acc[a][b][m][n] = (f32x4){0.f, 0.f, 0.f, 0.f};
        }
        cur = nxt; cA = nA; cB = nB; ++ui;
        if (wr == 1) PG8_BAR;
    }
    PG8_WAIT_V(0);
    PG8_BAR;
#undef PG8_SA
#undef PG8_SB
#undef PG8_STAGE
#undef PG8_LDA
#undef PG8_LDB
#undef PG8_MMA
#undef PG8_WAIT_V
#undef PG8_WAIT_L
#undef PG8_BAR
#undef PG8_SCHED
}


struct EpiCM {
    static constexpr bool PERM = false, HAS_MID = false;
    bf16_t* pcm; bf16_t* kvcm; const float* bias;
    __device__ __forceinline__ void operator()(const f32x4 (&acc)[2][2][4][2], const Unit& u, int wr, int wc, int fr, int fq) const {
        const bool kv = u.pn >= 8;
#pragma unroll
        for (int bj = 0; bj < 2; ++bj)
#pragma unroll
            for (int n = 0; n < 2; ++n) {
                const int c = u.pn * BM + bj * HALF + wc * 32 + n * 16 + fr; const float bv = bias[c];
                bf16_t* base = kv ? (kvcm + (size_t)(c - 2048) * MT) : (pcm + (size_t)c * MX);
#pragma unroll
                for (int ai = 0; ai < 2; ++ai)
#pragma unroll
                    for (int m = 0; m < 4; ++m) {
                        const int r = u.pm * BM + ai * HALF + wr * 64 + m * 16 + 4 * fq; const f32x4 v = acc[ai][bj][m][n] + bv;
                        u32x2 w; w.x = cvt_pk_bf16(v[0], v[1]); w.y = cvt_pk_bf16(v[2], v[3]);
                        *(u32x2*)(base + r) = w; }
                asm volatile("" ::: "memory");
            }
    }
};

struct EpiIn2 {
    static constexpr bool PERM = true, HAS_MID = false;
    bf16_t* pml; bf16_t* pmg; const float* bias;
    __device__ __forceinline__ void operator()(const f32x4 (&acc)[2][2][4][2], const Unit& u, int wr, int wc, int fr, int fq) const {
        const int colt = u.pn * BM; bf16_t* base; int ldc, cbase, bofs = 0; const int row0 = u.pm * BM; bool sg = false;
        if (colt < 2048) { base = pml; ldc = 1024; cbase = colt - 1536; }
        else if (colt < GATE0) { base = pml; ldc = 1024; cbase = colt - 3072 + 512; }
        else { base = pmg; ldc = 2048; cbase = colt - GATE0; bofs = 16; sg = true; }
        const int col0 = cbase + wc * 32 + 8 * fq, bcol0 = colt + bofs + wc * 32 + 8 * fq;
        f32x4 bv[2][2];
#pragma unroll
        for (int bj = 0; bj < 2; ++bj)
#pragma unroll
            for (int n = 0; n < 2; ++n) bv[bj][n] = *(const f32x4*)(bias + bcol0 + bj * HALF + 4 * n);
#pragma unroll
        for (int ai = 0; ai < 2; ++ai)
#pragma unroll
            for (int m = 0; m < 4; ++m) { bf16_t* rowp = base + (size_t)(row0 + wr * 64 + fr + ai * HALF + m * 16) * ldc + col0;
#pragma unroll
                for (int bj = 0; bj < 2; ++bj) { f32x4 v0 = acc[ai][bj][m][0] + bv[bj][0], v1 = acc[ai][bj][m][1] + bv[bj][1];
                    if (sg) {
#pragma unroll
                        for (int j = 0; j < 4; ++j) { v0[j] = sigm(v0[j]); v1[j] = sigm(v1[j]); } }
                    u32x4 w; w.x = cvt_pk_bf16(v0[0], v0[1]); w.y = cvt_pk_bf16(v0[2], v0[3]); w.z = cvt_pk_bf16(v1[0], v1[1]); w.w = cvt_pk_bf16(v1[2], v1[3]);
                    *(u32x4*)(rowp + bj * HALF) = w; }
                asm volatile("" ::: "memory"); }
    }
};

struct EpiMerge {
    static constexpr bool PERM = true, HAS_MID = true;
    bf16_t* Z; const bf16_t* pmg;
    __device__ __forceinline__ void mid(f32x4 (&acc)[2][2][4][2], const Unit& u, int wr, int wc, int fr, int fq) const {
        const int row0 = u.pm * BM + wr * 64 + fr, col0 = u.pn * BM + wc * 32 + 8 * fq;
#pragma unroll
        for (int ai = 0; ai < 2; ++ai)
#pragma unroll
            for (int m = 0; m < 4; ++m) {
                u32x4 ga[2], gb[2];
#pragma unroll
                for (int bj = 0; bj < 2; ++bj) { const bf16_t* gp = pmg + (size_t)(row0 + ai * HALF + m * 16) * 2048 + col0 + bj * HALF;
                    ga[bj] = *(const u32x4*)gp; gb[bj] = *(const u32x4*)(gp + 1024); }
#pragma unroll
                for (int bj = 0; bj < 2; ++bj) { const u32x4 a = ga[bj], b = gb[bj];
                    f32x4& v0 = acc[ai][bj][m][0]; f32x4& v1 = acc[ai][bj][m][1];
                    v0[0] *= bflo(a.x) * __builtin_amdgcn_rcpf(bflo(b.x)); v0[1] *= bfhi(a.x) * __builtin_amdgcn_rcpf(bfhi(b.x));
                    v0[2] *= bflo(a.y) * __builtin_amdgcn_rcpf(bflo(b.y)); v0[3] *= bfhi(a.y) * __builtin_amdgcn_rcpf(bfhi(b.y));
                    v1[0] *= bflo(a.z) * __builtin_amdgcn_rcpf(bflo(b.z)); v1[1] *= bfhi(a.z) * __builtin_amdgcn_rcpf(bfhi(b.z));
                    v1[2] *= bflo(a.w) * __builtin_amdgcn_rcpf(bflo(b.w)); v1[3] *= bfhi(a.w) * __builtin_amdgcn_rcpf(bfhi(b.w)); }
                if (m & 1) asm volatile("" ::: "memory"); }
    }
    __device__ __forceinline__ void operator()(const f32x4 (&acc)[2][2][4][2], const Unit& u, int wr, int wc, int fr, int fq) const {
        const int row0 = u.pm * BM + wr * 64 + fr, col0 = u.pn * BM + wc * 32 + 8 * fq;
#pragma unroll
        for (int ai = 0; ai < 2; ++ai) {
            u32x4 g[4][2];
#pragma unroll
            for (int m = 0; m < 4; ++m)
#pragma unroll
                for (int bj = 0; bj < 2; ++bj) g[m][bj] = *(const u32x4*)(pmg + (size_t)(row0 + ai * HALF + m * 16) * 2048 + 1024 + col0 + bj * HALF);
#pragma unroll
            for (int m = 0; m < 4; ++m)
#pragma unroll
                for (int bj = 0; bj < 2; ++bj) { const size_t row = (size_t)(row0 + ai * HALF + m * 16); const u32x4 gg = g[m][bj];
                    f32x4 v0 = acc[ai][bj][m][0], v1 = acc[ai][bj][m][1];
                    v0[0] *= bflo(gg.x); v0[1] *= bfhi(gg.x); v0[2] *= bflo(gg.y); v0[3] *= bfhi(gg.y);
                    v1[0] *= bflo(gg.z); v1[1] *= bfhi(gg.z); v1[2] *= bflo(gg.w); v1[3] *= bfhi(gg.w);
                    u32x4 w; w.x = cvt_pk_bf16(v0[0], v0[1]); w.y = cvt_pk_bf16(v0[2], v0[3]); w.z = cvt_pk_bf16(v1[0], v1[1]); w.w = cvt_pk_bf16(v1[2], v1[3]);
                    *(u32x4*)(Z + row * 1024 + col0 + bj * HALF) = w; }
            asm volatile("" ::: "memory"); }
    }
};

struct EpiOut {
    static constexpr bool PERM = true, HAS_MID = false;
    const float* x; bf16_t* xmid; const float* ada;
    __device__ __forceinline__ void operator()(const f32x4 (&acc)[2][2][4][2], const Unit& u, int wr, int wc, int fr, int fq) const {
        const int row0 = u.pm * BM + wr * 64 + fr, col0 = u.pn * BM + wc * 32 + 8 * fq;
        const int b = (u.pm * BM) / SEQ;
        f32x4 gv[2][2];
#pragma unroll
        for (int bj = 0; bj < 2; ++bj)
#pragma unroll
            for (int n = 0; n < 2; ++n) gv[bj][n] = *(const f32x4*)(ada + (size_t)b * 6144 + 2048 + col0 + bj * HALF + 4 * n);
#pragma unroll
        for (int ai = 0; ai < 2; ++ai)
#pragma unroll
            for (int m = 0; m < 4; ++m) {
                f32x4 xv[2][2]; const size_t off = (size_t)(row0 + ai * HALF + m * 16) * DM + col0;
#pragma unroll
                for (int bj = 0; bj < 2; ++bj)
#pragma unroll
                    for (int n = 0; n < 2; ++n) xv[bj][n] = *(const f32x4*)(x + off + bj * HALF + 4 * n);
#pragma unroll
                for (int bj = 0; bj < 2; ++bj) { const f32x4 v0 = xv[bj][0] + gv[bj][0] * acc[ai][bj][m][0], v1 = xv[bj][1] + gv[bj][1] * acc[ai][bj][m][1];
                    u32x4 w; w.x = cvt_pk_bf16(v0[0], v0[1]); w.y = cvt_pk_bf16(v0[2], v0[3]); w.z = cvt_pk_bf16(v1[0], v1[1]); w.w = cvt_pk_bf16(v1[2], v1[3]);
                    *(u32x4*)(xmid + off + bj * HALF) = w; }
                if (m & 1) asm volatile("" ::: "memory"); }
    }
};

struct EpiMoe1 {
    static constexpr bool PERM = true, HAS_MID = false;
    unsigned char* act; int skip;
    __device__ __forceinline__ void operator()(const f32x4 (&acc)[2][2][4][2], const Unit& u, int wr, int wc, int fr, int fq) const {
        if (skip == 1) { asm volatile("" :: "v"(acc[0][0][0][0]), "v"(acc[1][1][3][1])); return; }
        const int row0 = u.aux * 4096 + u.pm * BM + wr * 64 + fr, col0 = (u.pn * BM + wc * 32) / 2 + 4 * fq;
#pragma unroll
        for (int ai = 0; ai < 2; ++ai)
#pragma unroll
            for (int m = 0; m < 4; ++m) { unsigned char* rowp = act + (size_t)(row0 + ai * HALF + m * 16) * DFF + col0;
#pragma unroll
                for (int bj = 0; bj < 2; ++bj) { const f32x4 v0 = acc[ai][bj][m][0] * W8_INV, v1 = acc[ai][bj][m][1] * W8_INV;
                    const unsigned pk = pk4_fp8(siluf(v0[0]) * v0[1], siluf(v0[2]) * v0[3], siluf(v1[0]) * v1[1], siluf(v1[2]) * v1[3]);
                    if (skip == 2) asm volatile("" :: "v"(pk)); else *(unsigned*)(rowp + bj * (HALF / 2)) = pk; }
                asm volatile("" ::: "memory"); }
    }
};

struct EpiMoe2 {
    static constexpr bool PERM = true, HAS_MID = false;
    bf16_t* ye; const float* sgate; bool skip;
    __device__ __forceinline__ void operator()(const f32x4 (&acc)[2][2][4][2], const Unit& u, int wr, int wc, int fr, int fq) const {
        if (skip) { asm volatile("" :: "v"(acc[0][0][0][0]), "v"(acc[1][1][3][1])); return; }
        const int e = u.aux, col0 = u.pn * BM + wc * 32 + 8 * fq;
        float gt[2][4];
#pragma unroll
        for (int ai = 0; ai < 2; ++ai)
#pragma unroll
            for (int m = 0; m < 4; ++m) { const int rr = u.pm * BM + wr * 64 + fr + ai * HALF + m * 16; gt[ai][m] = sgate[((rr >> 9) * NE + e) * CAP + (rr & 511)] * W8_INV; }
#pragma unroll
        for (int ai = 0; ai < 2; ++ai)
#pragma unroll
            for (int m = 0; m < 4; ++m) { const int rr = u.pm * BM + wr * 64 + fr + ai * HALF + m * 16;
                const float g = gt[ai][m];
                bf16_t* rowp = ye + ((size_t)e * 4096 + rr) * DM + col0;
#pragma unroll
                for (int bj = 0; bj < 2; ++bj) { const f32x4 v0 = acc[ai][bj][m][0] * g, v1 = acc[ai][bj][m][1] * g;
                    u32x4 w; w.x = cvt_pk_bf16(v0[0], v0[1]); w.y = cvt_pk_bf16(v0[2], v0[3]); w.z = cvt_pk_bf16(v1[0], v1[1]); w.w = cvt_pk_bf16(v1[2], v1[3]);
                    *(u32x4*)(rowp + bj * HALF) = w; }
                asm volatile("" ::: "memory"); }
    }
};
}

struct Ctx {
    LAS unsigned char* lds;
    int tid, lane, wave, bid, G;
};

__device__ __forceinline__ void transpose_item(const float* W, int ldw, int ldt, int ncol0, bf16_t* WT, int dst_row0, int rmul, LAS float* scr, int kb, int nb, int lane) {
    const int k0 = 64 * kb, n0 = 32 * nb;
#pragma unroll 8
    for (int i = 0; i < 32; ++i) { const int kk = 2 * i + (lane >> 5); scr[kk * 33 + (lane & 31)] = W[(size_t)(k0 + kk) * ldw + ncol0 + n0 + (lane & 31)]; }
    LDS_WAIT();
    const int c = lane & 7;
#pragma unroll
    for (int j = 0; j < 4; ++j) { const int n = (lane >> 3) + 8 * j; const LAS float* s = scr + (8 * c) * 33 + n;
        u32x4 o; o.x = pk2(s[0 * 33], s[1 * 33]); o.y = pk2(s[2 * 33], s[3 * 33]); o.z = pk2(s[4 * 33], s[5 * 33]); o.w = pk2(s[6 * 33], s[7 * 33]);
        *(u32x4*)(WT + (size_t)(dst_row0 + (n0 + n) * rmul) * ldt + k0 + 8 * c) = o; }
    LDS_WAIT();
}

__device__ __forceinline__ void transpose_item_f8(const float* W, int ldw, int K, unsigned char* WT, int dst_row0, int rmul, LAS float* scr, int kb, int nb, int lane) {
    const int k0 = 64 * kb, n0 = 32 * nb;
#pragma unroll 8
    for (int i = 0; i < 32; ++i) { const int kk = 2 * i + (lane >> 5); scr[kk * 33 + (lane & 31)] = W[(size_t)(k0 + kk) * ldw + n0 + (lane & 31)]; }
    LDS_WAIT();
    const int c = lane & 3;
#pragma unroll
    for (int j = 0; j < 2; ++j) { const int n = (lane >> 2) + 16 * j; const LAS float* s = scr + (16 * c) * 33 + n;
        u32x4 o;
        o.x = pk4_fp8(s[0 * 33] * W8_SCALE, s[1 * 33] * W8_SCALE, s[2 * 33] * W8_SCALE, s[3 * 33] * W8_SCALE);
        o.y = pk4_fp8(s[4 * 33] * W8_SCALE, s[5 * 33] * W8_SCALE, s[6 * 33] * W8_SCALE, s[7 * 33] * W8_SCALE);
        o.z = pk4_fp8(s[8 * 33] * W8_SCALE, s[9 * 33] * W8_SCALE, s[10 * 33] * W8_SCALE, s[11 * 33] * W8_SCALE);
        o.w = pk4_fp8(s[12 * 33] * W8_SCALE, s[13 * 33] * W8_SCALE, s[14 * 33] * W8_SCALE, s[15 * 33] * W8_SCALE);
        *(u32x4*)(WT + (size_t)(dst_row0 + (n0 + n) * rmul) * K + k0 + 16 * c) = o; }
    LDS_WAIT();
}

__device__ __forceinline__ void convert_experts(const Ctx& C, const Params& P) {
    unsigned char* w13 = P.ws + WS_W13; unsigned char* w2 = P.ws + WS_W2;
    LAS float* scr = (LAS float*)(C.lds + C.wave * 8448);
    const int PER_E = 3072;
    const int nbusy = (BATCH * NE < C.G) ? BATCH * NE : C.G, nfree = C.G - nbusy;
    const int NPRE = (nfree > 0) ? 6912 : 0;
    for (int pass = 0; pass < 2; ++pass) {
    const int lo = pass ? NPRE : 0, hi = pass ? NE * PER_E : NPRE;
    const int gw = pass ? (C.bid * 8 + C.wave) : ((C.bid - nbusy) * 8 + C.wave), NGW = pass ? C.G * 8 : nfree * 8;
    if (!pass && C.bid < nbusy) continue;
    for (int it = lo + gw; it < hi; it += NGW) {
        const int e = it / PER_E, r = it % PER_E;
        if (r < 1024) transpose_item_f8(P.in[23] + (size_t)e * DM * DFF, DFF, DM, w13 + (size_t)e * 4096 * DM, 0, 2, scr, r / 64, r % 64, C.lane);
        else if (r < 2048) transpose_item_f8(P.in[24] + (size_t)e * DM * DFF, DFF, DM, w13 + (size_t)e * 4096 * DM, 1, 2, scr, (r - 1024) / 64, (r - 1024) % 64, C.lane);
        else transpose_item_f8(P.in[25] + (size_t)e * DFF * DM, DM, DFF, w2 + (size_t)e * DM * DFF, 0, 1, scr, (r - 2048) / 32, (r - 2048) % 32, C.lane);
    }
    }
}

__device__ __forceinline__ void phase0(const Ctx& C, const Params& P) {
    unsigned char* ws = P.ws;
    const int gw = C.bid * 8 + C.wave, NGW = C.G * 8;
    {
        LAS float* scr = (LAS float*)(C.lds + C.wave * 8448);
        const int I_IN1 = 16 * 112, I_IN2 = 16 * 64, I_BH = 8 * 32, I_BM = 8 * 32, I_OUT = 16 * 32;
        const int NIT = I_IN1 + I_IN2 + I_BH + I_BM + I_OUT;
        for (int it = gw; it < NIT; it += NGW) {
            int r = it;
            if (r < I_IN1) { transpose_item(P.in[8], DIN, DM, 0, (bf16_t*)(ws + WS_WIN), 0, 1, scr, r / 112, r % 112, C.lane); continue; } r -= I_IN1;
            if (r < I_IN2) { transpose_item(P.in[8], DIN, DM, MERGE0, (bf16_t*)(ws + WS_WIN), GATE0, 1, scr, r / 64, r % 64, C.lane); continue; } r -= I_IN2;
            if (r < I_BH) { transpose_item(P.in[19], DM, 1024, 0, (bf16_t*)(ws + WS_WB), 0, 1, scr, r / 32, r % 32, C.lane); continue; } r -= I_BH;
            if (r < I_BM) { transpose_item(P.in[20], DM, 1024, 0, (bf16_t*)(ws + WS_WB) + 512, 0, 1, scr, r / 32, r % 32, C.lane); continue; } r -= I_BM;
            transpose_item(P.in[21], DM, DM, 0, (bf16_t*)(ws + WS_WOUT), 0, 1, scr, r / 32, r % 32, C.lane);
        }
    }
    {
        const float* wada = P.in[4]; const float* bada = P.in[5]; float* part = (float*)(ws + WS_ADAP);
        for (int it = gw; it < 96 * 8; it += NGW) {
            const int cgp = it % 96, ks = it / 96, n = cgp * 64 + C.lane;
            float a[9];
#pragma unroll
            for (int r = 0; r < 9; ++r) a[r] = 0.f;
#pragma unroll 1
            for (int k1 = 0; k1 < 4; ++k1) {
                const int k0 = ks * 128 + k1 * 32;
                float sv[9];
                { const int k = k0 + (C.lane & 31);
#pragma unroll
                  for (int r = 0; r < 8; ++r) sv[r] = siluf(P.in[1][r * DM + k]);
                  sv[8] = siluf(P.in[3][k]); }
                float wv[32];
#pragma unroll
                for (int kk = 0; kk < 32; ++kk) wv[kk] = wada[(size_t)(k0 + kk) * 6144 + n];
#pragma unroll
                for (int kk = 0; kk < 32; ++kk) {
#pragma unroll
                    for (int r = 0; r < 9; ++r) a[r] += __shfl(sv[r], kk) * wv[kk]; }
            }
            const float bb = (ks == 0) ? bada[n] : 0.f;
#pragma unroll
            for (int r = 0; r < 9; ++r) part[((size_t)ks * 9 + r) * 6144 + n] = a[r] + bb;
        }
    }
    __syncthreads();
    {
        LAS float* zs = (LAS float*)C.lds;
        LAS float* h1 = zs + 16 * 33;
        LAS float* h2 = h1 + 16 * 64;
        LAS float* w1s = h2 + 16 * 64;
        LAS float* w2s = w1s + 33 * 64;
        bf16_t* krev = (bf16_t*)(ws + WS_KREV);
        const float* w1 = P.in[11]; const float* b1 = P.in[12]; const float* w2 = P.in[13]; const float* b2 = P.in[14]; const float* w3 = P.in[15];
        for (int idx = C.tid; idx < 33 * 64; idx += NTHR) w1s[idx] = w1[idx];
        for (int idx = C.tid; idx < 64 * 64; idx += NTHR) w2s[idx] = w2[idx];
        for (int it = C.bid; it < 256; it += C.G) {
            const int l0 = it * 16;
            __syncthreads();
            for (int idx = C.tid; idx < 16 * 33; idx += NTHR) { const int pos = idx / 33, m = idx % 33, l = l0 + pos; float v;
                if (m == 0) v = (float)l / 4095.0f;
                else { const int bi = (m - 1) & 15; const float band = 1e-4f + (float)bi * ((15.0f - 1e-4f) / 15.0f);
                    const float ang = ((float)(2.0 * 3.14159265358979323846 / 4096.0) * (float)l) * band; v = (m <= 16) ? cosf(ang) : sinf(ang); }
                zs[idx] = v; }
            __syncthreads();
            for (int idx = C.tid; idx < 16 * 64; idx += NTHR) { const int pos = idx >> 6, j = idx & 63; float s = b1[j];
#pragma unroll
                for (int m = 0; m < 33; ++m) s += zs[pos * 33 + m] * w1s[m * 64 + j];
                h1[idx] = sinf(s); }
            __syncthreads();
            for (int idx = C.tid; idx < 16 * 64; idx += NTHR) { const int pos = idx >> 6, j = idx & 63; float s = b2[j];
#pragma unroll 16
                for (int k = 0; k < 64; ++k) s += h1[pos * 64 + k] * w2s[k * 64 + j];
                h2[j * 16 + pos] = sinf(s); }
            __syncthreads();
#pragma unroll 1
            for (int q = 0; q < 4; ++q) {
                const int n = C.tid + NTHR * q;
                float a[16];
#pragma unroll
                for (int p = 0; p < 16; ++p) a[p] = 0.f;
                float wv[16];
#pragma unroll
                for (int k = 0; k < 16; ++k) wv[k] = w3[k * 2048 + n];
#pragma unroll 1
                for (int kb = 0; kb < 4; ++kb) {
                    float wc[16];
#pragma unroll
                    for (int k = 0; k < 16; ++k) wc[k] = wv[k];
                    const int kn = (kb < 3) ? (kb + 1) * 16 : 0;
#pragma unroll
                    for (int k = 0; k < 16; ++k) wv[k] = w3[(kn + k) * 2048 + n];
#pragma unroll
                    for (int kk = 0; kk < 16; ++kk) { const float w = wc[kk]; const LAS float* hp = h2 + (kb * 16 + kk) * 16;
#pragma unroll
                        for (int p4 = 0; p4 < 4; ++p4) { const f32x4 hv = *(const LAS f32x4*)(hp + 4 * p4);
                            a[4 * p4] += hv[0] * w; a[4 * p4 + 1] += hv[1] * w; a[4 * p4 + 2] += hv[2] * w; a[4 * p4 + 3] += hv[3] * w; }
                        if (kk & 1) asm volatile("" ::: "memory"); }
                }
                const int o = n >> 10, side = (n >> 9) & 1, c = n & 511;
                const float delta = fabsf(-3.0701134573253944f + (float)c * ((-15.350567286626972f + 3.0701134573253944f) / 511.0f));
                bf16_t* dst = krev + ((size_t)o * 512 + c) * 8192;
#pragma unroll
                for (int p = 0; p < 16; ++p) { const int l = l0 + p; const float t = (float)l / 4095.0f; const float v = a[p] * expf(-t * delta);
                    if (side == 0) dst[4096 - l] = (bf16_t)f2bf(v);
                    else if (l > 0) dst[4096 + l] = (bf16_t)f2bf(v);
                    else dst[0] = 0; }
            }
        }
    }
}

__device__ __forceinline__ int wl_pos(int k) { return ((k & 3) + 4 * (k >> 8)) * 64 + ((k >> 2) & 63); }
__device__ __forceinline__ float row_dot16(const f32x4 (&y)[4], const LAS float* Wl, int lane) {
    float r[16];
#pragma unroll
    for (int e = 0; e < 16; ++e) r[e] = 0.f;
#pragma unroll
    for (int j = 0; j < 4; ++j) {
#pragma unroll
        for (int q = 0; q < 4; ++q) { const float v = y[j][q]; const LAS float* wp = Wl + ((q + 4 * j) * 64 + lane) * 20;
#pragma unroll
            for (int e4 = 0; e4 < 4; ++e4) { const f32x4 w = *(const LAS f32x4*)(wp + e4 * 4);
                r[e4 * 4 + 0] += v * w[0]; r[e4 * 4 + 1] += v * w[1]; r[e4 * 4 + 2] += v * w[2]; r[e4 * 4 + 3] += v * w[3]; } }
        asm volatile("" ::: "memory"); }
    const bool b5 = (lane & 32) != 0, b4 = (lane & 16) != 0, b3 = (lane & 8) != 0, b2 = (lane & 4) != 0;
    float t[8];
#pragma unroll
    for (int e = 0; e < 8; ++e) { const float snd = b5 ? r[e] : r[e + 8], kp = b5 ? r[e + 8] : r[e]; t[e] = kp + __shfl_xor(snd, 32); }
    float u[4];
#pragma unroll
    for (int e = 0; e < 4; ++e) { const float snd = b4 ? t[e] : t[e + 4], kp = b4 ? t[e + 4] : t[e]; u[e] = kp + __shfl_xor(snd, 16); }
    float v2[2];
#pragma unroll
    for (int e = 0; e < 2; ++e) { const float snd = b3 ? u[e] : u[e + 2], kp = b3 ? u[e + 2] : u[e]; v2[e] = kp + __shfl_xor(snd, 8); }
    float s; { const float snd = b2 ? v2[0] : v2[1], kp = b2 ? v2[1] : v2[0]; s = kp + __shfl_xor(snd, 4); }
    s += __shfl_xor(s, 2); s += __shfl_xor(s, 1);
    return s;
}

__device__ __forceinline__ void phase1(const Ctx& C, const Params& P) {
    unsigned char* ws = P.ws;
    const float* part = (const float*)(ws + WS_ADAP); float* ada = (float*)(ws + WS_ADA);
    for (int o = C.bid * NTHR + C.tid; o < 9 * 6144; o += C.G * NTHR) { float s = 0.f;
#pragma unroll
        for (int ks = 0; ks < 8; ++ks) s += part[(size_t)ks * 9 * 6144 + o];
        ada[o] = s; }
    LAS float* Wg = (LAS float*)C.lds;
    LAS float* mod = Wg + 1024 * 20;
#pragma unroll 1
    for (int i0 = C.tid; i0 < 1024 * 16; i0 += 8 * NTHR) { float t8[8];
#pragma unroll
        for (int u = 0; u < 8; ++u) { const int idx = i0 + u * NTHR; t8[u] = P.in[8][(size_t)(idx >> 4) * DIN + GATE0 + (idx & 15)]; }
#pragma unroll
        for (int u = 0; u < 8; ++u) { const int idx = i0 + u * NTHR; Wg[wl_pos(idx >> 4) * 20 + (idx & 15)] = t8[u]; } }
    const float* gmix = P.in[6]; const float* bin = P.in[9];
    bf16_t* hx = (bf16_t*)(ws + WS_HX); float* gates = (float*)(ws + WS_GATES);
    for (int rg = C.bid; rg < 256; rg += C.G) {
        const int b = rg >> 5;
        __syncthreads();
#pragma unroll 2
        for (int idx = C.tid; idx < 4096; idx += NTHR) { const int which = idx >> 10, k = idx & 1023; const int r = (which < 2) ? b : 8; const int col = (which & 1) * 1024 + k;
            float s = 0.f;
#pragma unroll
            for (int ks = 0; ks < 8; ++ks) s += part[((size_t)ks * 9 + r) * 6144 + col];
            mod[idx] = s; }
        __syncthreads();
        auto rowsrc = [&](int rr) -> const float* { return (rr < 128) ? (P.in[0] + (size_t)(rg * 128 + rr) * DM) : (P.in[2] + (size_t)(rg * 8 + (rr - 128)) * DM); };
        f32x4 nx[4];
        { const float* s0 = rowsrc(C.wave);
#pragma unroll
          for (int j = 0; j < 4; ++j) nx[j] = *(const f32x4*)(s0 + 4 * C.lane + 256 * j); }
        for (int rr = C.wave; rr < 136; rr += 8) {
            const bool isx = rr < 128; const int grow = isx ? (rg * 128 + rr) : (MX + rg * 8 + (rr - 128));
            const LAS float* sh = mod + (isx ? 0 : 2048); const LAS float* sc = sh + 1024;
            f32x4 v[4]; float ss = 0.f;
#pragma unroll
            for (int j = 0; j < 4; ++j) { v[j] = nx[j]; ss += v[j][0] * v[j][0] + v[j][1] * v[j][1] + v[j][2] * v[j][2] + v[j][3] * v[j][3]; }
            if (rr + 8 < 136) { const float* s1 = rowsrc(rr + 8);
#pragma unroll
                for (int j = 0; j < 4; ++j) nx[j] = *(const f32x4*)(s1 + 4 * C.lane + 256 * j); }
            const float rstd = rsqrtf(wave_sum(ss) * (1.f / DM) + RMS_EPS);
#pragma unroll
            for (int j = 0; j < 4; ++j) { const int k = 4 * C.lane + 256 * j; const f32x4 g = *(const f32x4*)(gmix + k);
                const f32x4 s4 = *(const LAS f32x4*)(sc + k), h4 = *(const LAS f32x4*)(sh + k);
#pragma unroll
                for (int q = 0; q < 4; ++q) v[j][q] = (v[j][q] * rstd * g[q]) * (1.f + s4[q]) + h4[q];
                u32x2 w; w.x = pk2(v[j][0], v[j][1]); w.y = pk2(v[j][2], v[j][3]);
                *(u32x2*)(hx + (size_t)grow * DM + k) = w; }
            const float gsum = row_dot16(v, Wg, C.lane);
            if ((C.lane & 3) == 0) gates[(size_t)grow * 16 + (C.lane >> 2)] = gsum + bin[GATE0 + (C.lane >> 2)];
        }
    }
}

__device__ __forceinline__ void phase2a(const Ctx& C, const Params& P) {
    unsigned char* ws = P.ws;
    pg8::SchedGrid S{(const char*)(ws + WS_HX), (const char*)(ws + WS_WIN), (size_t)256 * 2048, (size_t)256 * 2048, 128, 10, 0, 0, C.G, C.bid, 4, 128, 8, 32, 6, 2};
    pg8::EpiCM E{(bf16_t*)(ws + WS_PCM), (bf16_t*)(ws + WS_KVCM), P.in[9]};
    pg8::gemm_phase<pg8::EpiCM, pg8::SchedGrid, true>(C.lds, 1024, 2048, 2048, S, E);
}
__device__ __forceinline__ void phase2b(const Ctx& C, const Params& P) {
    unsigned char* ws = P.ws;
    pg8::SchedGrid S{(const char*)(ws + WS_HX), (const char*)(ws + WS_WIN), (size_t)256 * 2048, (size_t)256 * 2048, 128, 12, 0, 6, C.G, C.bid, 1, 0, 0, 0, 2, 4};
    pg8::EpiIn2 E{(bf16_t*)(ws + WS_PML), (bf16_t*)P.out, P.in[9]};
    pg8::gemm_phase<pg8::EpiIn2, pg8::SchedGrid, false>(C.lds, 1024, 2048, 2048, S, E);
}
__device__ __forceinline__ void phase_merge(const Ctx& C, const Params& P) {
    unsigned char* ws = P.ws;
    pg8::SchedChain S{{(const char*)(ws + WS_YAB), (const char*)(ws + WS_WB), (size_t)256 * 2048, (size_t)256 * 2048, 128, 4, 0, 0, C.G, C.bid, 1, 0, 0, 0, 1 << 30, 0}, 1024};
    pg8::EpiMerge E{(bf16_t*)(ws + WS_Z), (const bf16_t*)P.out};
    pg8::gemm_phase<pg8::EpiMerge, pg8::SchedChain, false>(C.lds, 512, 2048, 2048, S, E);
}
__device__ __forceinline__ void phase_outproj(const Ctx& C, const Params& P) {
    unsigned char* ws = P.ws;
    pg8::SchedGrid S{(const char*)(ws + WS_Z), (const char*)(ws + WS_WOUT), (size_t)256 * 2048, (size_t)256 * 2048, 128, 4, 0, 0, C.G, C.bid, 1, 0, 0, 0, 1 << 30, 0};
    pg8::EpiOut E{P.in[0], (bf16_t*)(ws + WS_XMID), (const float*)(ws + WS_ADA)};
    pg8::gemm_phase<pg8::EpiOut, pg8::SchedGrid, false>(C.lds, 1024, 2048, 2048, S, E);
}

constexpr int HY_KSTR = 16448;
constexpr int HY_UOFF = 4 * HY_KSTR;
constexpr int HY_USTR = 4616;
template <int MODE>
__device__ __forceinline__ void hyena_item(const Ctx& C, const Params& P, int o, int c) {
    unsigned char* ws = P.ws;
    LAS bf16_t* krv = (LAS bf16_t*)C.lds;
    LAS bf16_t* up = (LAS bf16_t*)(C.lds + HY_UOFF);
    const bf16_t* pcm = (const bf16_t*)(ws + WS_PCM);
    const float* hconv = P.in[10];
    __syncthreads();
    {
        const u32x4* src = (const u32x4*)((const bf16_t*)(ws + WS_KREV) + ((size_t)o * 512 + c) * 8192);
        for (int i = C.tid; i < 1024; i += NTHR) *(LAS u32x4*)(krv + 8 * i) = src[i];
        for (int i = C.tid; i < 8 * 65; i += NTHR) { const int b = i / 65, q = i % 65; const int off = (q < 32) ? 8 * q : (4352 + 8 * (q - 32));
            *(LAS u32x4*)(up + b * HY_USTR + off) = (u32x4){0u, 0u, 0u, 0u}; }
        if (o == 0) {
            const bf16_t* src0 = pcm + (size_t)c * MX; const float w0 = hconv[c], w1 = hconv[1536 + c], w2 = hconv[3072 + c];
            u32x4 vv[8]; unsigned vl[8], vr[8];
#pragma unroll
            for (int it = 0; it < 8; ++it) { const int r0 = 8 * (C.tid + NTHR * it); vv[it] = *(const u32x4*)(src0 + r0); vl[it] = *(const unsigned*)(src0 + r0 - 2); vr[it] = *(const unsigned*)(src0 + r0 + 8); }
#pragma unroll
            for (int it = 0; it < 8; ++it) { const int r0 = 8 * (C.tid + NTHR * it); const u32x4 v = vv[it];
                float x[10]; x[1] = bflo(v.x); x[2] = bfhi(v.x); x[3] = bflo(v.y); x[4] = bfhi(v.y); x[5] = bflo(v.z); x[6] = bfhi(v.z); x[7] = bflo(v.w); x[8] = bfhi(v.w);
                x[0] = ((r0 & 63) != 0) ? bfhi(vl[it]) : 0.f; x[9] = ((r0 & 63) != 56) ? bflo(vr[it]) : 0.f;
                float y[8];
#pragma unroll
                for (int j = 0; j < 8; ++j) y[j] = w0 * x[j] + w1 * x[j + 1] + w2 * x[j + 2];
                u32x4 w; w.x = pk2(y[0], y[1]); w.y = pk2(y[2], y[3]); w.z = pk2(y[4], y[5]); w.w = pk2(y[6], y[7]);
                *(LAS u32x4*)(up + (r0 >> 12) * HY_USTR + 256 + (r0 & 4095)) = w; }
        } else {
            const u32x4* src1 = (const u32x4*)((const bf16_t*)(ws + WS_Z1) + (size_t)c * MX);
            u32x4 vv[8];
#pragma unroll
            for (int it = 0; it < 8; ++it) vv[it] = src1[C.tid + NTHR * it];
#pragma unroll
            for (int it = 0; it < 8; ++it) { const int r0 = 8 * (C.tid + NTHR * it); *(LAS u32x4*)(up + (r0 >> 12) * HY_USTR + 256 + (r0 & 4095)) = vv[it]; }
        }
    }
    __syncthreads();
    for (int idx = C.tid; idx < 3 * 1025; idx += NTHR) { const int rho = 1 + idx / 1025, ch = idx % 1025; unsigned short e[8];
#pragma unroll
        for (int j = 0; j < 8; ++j) { const int z = 8 * ch + j - rho; e[j] = (z >= 0 && z < 8192) ? krv[z] : (unsigned short)0; }
        u32x4 w; w.x = e[0] | ((unsigned)e[1] << 16); w.y = e[2] | ((unsigned)e[3] << 16); w.z = e[4] | ((unsigned)e[5] << 16); w.w = e[6] | ((unsigned)e[7] << 16);
        *(LAS u32x4*)(C.lds + rho * HY_KSTR + 16 * ch) = w; }
    if (C.tid == 0) *(LAS u32x4*)(C.lds + 16 * 1024) = (u32x4){0u, 0u, 0u, 0u};
    __syncthreads();
    const int lane = C.lane, w = C.wave, kh = w >> 2, wq = w & 3, i = lane & 31, kq = lane >> 5, nb = (lane >> 2) & 7, np = lane & 3, rho = i & 3;
    f32x16 acc[4][2];
#pragma unroll
    for (int a = 0; a < 4; ++a)
#pragma unroll
        for (int pg = 0; pg < 2; ++pg)
#pragma unroll
            for (int r = 0; r < 16; ++r) acc[a][pg][r] = 0.f;
    const int abase = rho * HY_KSTR + 2 * (4096 - i + 8 * kq + rho) - 2048 * wq - 1536;
    const int bbase = HY_UOFF + 2 * (nb * HY_USTR + 256 + 32 * np + 8 * kq);
    typedef const volatile LAS u32x2* vp2;
#define HY_LOAD(AF, BF, s0) do { const int _a = abase + 2 * (s0), _b = bbase + 2 * (s0); \
        BF[0] = *(const LAS bf16x8*)(C.lds + _b); BF[1] = *(const LAS bf16x8*)(C.lds + _b + 256); \
        _Pragma("unroll") for (int a = 0; a < 4; ++a) { const u32x2 lo = *(vp2)(C.lds + _a + 512 * (3 - a)), hi = *(vp2)(C.lds + _a + 512 * (3 - a) + 8); \
            AF[a] = __builtin_bit_cast(bf16x8, (u32x4){lo.x, lo.y, hi.x, hi.y}); } } while (0)
#define HY_MMA(AF, BF) do { _Pragma("unroll") for (int a = 0; a < 4; ++a) _Pragma("unroll") for (int pg = 0; pg < 2; ++pg) \
        acc[a][pg] = __builtin_amdgcn_mfma_f32_32x32x16_bf16(AF[a], BF[pg], acc[a][pg], 0, 0, 0); } while (0)
    bf16x8 a0[4], a1[4], b0[2], b1[2];
    const int sbeg = -224 + 16 * 135 * kh;
    HY_LOAD(a0, b0, sbeg);
#pragma unroll 1
    for (int j = 0; j < (MODE == 1 ? 0 : 134); j += 2) {
        HY_LOAD(a1, b1, sbeg + 16 * (j + 1));
        __builtin_amdgcn_sched_barrier(0);
        HY_MMA(a0, b0);
        __builtin_amdgcn_sched_barrier(0);
        HY_LOAD(a0, b0, sbeg + 16 * (j + 2));
        __builtin_amdgcn_sched_barrier(0);
        HY_MMA(a1, b1);
        __builtin_amdgcn_sched_barrier(0);
    }
    HY_MMA(a0, b0);
#undef HY_LOAD
#undef HY_MMA
    const float skip = P.in[16][o * 512 + c];
    if (kh == 0) {
#pragma unroll
        for (int a = 0; a < 4; ++a)
#pragma unroll
            for (int pg = 0; pg < 2; ++pg)
#pragma unroll
                for (int g = 0; g < 4; ++g) { const int t0 = 1024 * wq + 256 * a + 128 * pg + 32 * np + 8 * g + 4 * kq;
                    const u32x2 uv = *(const LAS u32x2*)(up + nb * HY_USTR + 256 + t0);
                    acc[a][pg][4 * g + 0] += skip * bflo(uv.x); acc[a][pg][4 * g + 1] += skip * bfhi(uv.x); acc[a][pg][4 * g + 2] += skip * bflo(uv.y); acc[a][pg][4 * g + 3] += skip * bfhi(uv.y); }
    }
    __syncthreads();
    {
        LAS f32x4* slot = (LAS f32x4*)(C.lds + w * 16384);
#pragma unroll
        for (int al = 0; al < 2; ++al)
#pragma unroll
            for (int pg = 0; pg < 2; ++pg)
#pragma unroll
                for (int g = 0; g < 4; ++g) { const int a = kh ? al : 2 + al; const f32x16& v = acc[a][pg];
                    slot[((al * 2 + pg) * 4 + g) * 64 + lane] = (f32x4){v[4 * g], v[4 * g + 1], v[4 * g + 2], v[4 * g + 3]}; }
    }
    __syncthreads();
    const int gch = (o == 0 ? 512 : 1024) + c;
    const float w0 = hconv[gch], w1 = hconv[1536 + gch], w2 = hconv[3072 + gch];
    const bf16_t* gsrc = pcm + (size_t)gch * MX + (size_t)nb * SEQ;
    bf16_t* dst = (bf16_t*)(ws + (o == 0 ? WS_Z1 : WS_Z2CM)) + (size_t)c * MX + (size_t)nb * SEQ;
    const LAS f32x4* pslot = (const LAS f32x4*)(C.lds + (w ^ 4) * 16384);
#pragma unroll
    for (int al = 0; al < 2; ++al) {
        const int a = kh ? 2 + al : al;
        u32x2 gvv[2][4]; unsigned gl[2][4], gr[2][4];
#pragma unroll
        for (int pg = 0; pg < 2; ++pg)
#pragma unroll
            for (int g = 0; g < 4; ++g) { const int t0 = 1024 * wq + 256 * a + 128 * pg + 32 * np + 8 * g + 4 * kq;
                gvv[pg][g] = *(const u32x2*)(gsrc + t0); gl[pg][g] = *(const unsigned*)(gsrc + t0 - 2); gr[pg][g] = *(const unsigned*)(gsrc + t0 + 4); }
#pragma unroll
        for (int pg = 0; pg < 2; ++pg)
#pragma unroll
            for (int g = 0; g < 4; ++g) {
                const int t0 = 1024 * wq + 256 * a + 128 * pg + 32 * np + 8 * g + 4 * kq;
                const f32x4 pv = pslot[((al * 2 + pg) * 4 + g) * 64 + lane];
                const u32x2 gv = gvv[pg][g];
                float x[6]; x[1] = bflo(gv.x); x[2] = bfhi(gv.x); x[3] = bflo(gv.y); x[4] = bfhi(gv.y);
                x[0] = ((t0 & 63) != 0) ? bfhi(gl[pg][g]) : 0.f; x[5] = ((t0 & 63) != 60) ? bflo(gr[pg][g]) : 0.f;
                float z[4];
#pragma unroll
                for (int j = 0; j < 4; ++j) { const float gate = w0 * x[j] + w1 * x[j + 1] + w2 * x[j + 2]; z[j] = gate * (acc[a][pg][4 * g + j] + pv[j]); }
                u32x2 wv; wv.x = pk2(z[0], z[1]); wv.y = pk2(z[2], z[3]);
                if (MODE == 1) { if (z[0] == 12345.678f) *(u32x2*)(dst + t0) = wv; } else *(u32x2*)(dst + t0) = wv;
            }
    }
}

typedef short s16x4 __attribute__((ext_vector_type(4)));
__device__ __forceinline__ unsigned off_b(unsigned row, unsigned ch) { return 256u * row + 16u * (ch ^ (((row & 3) << 2) | ((row >> 2) & 3))); }
__device__ __forceinline__ bf16x8 tile_row_read(const LAS unsigned char* T, int lane, int rb, int s) { return *(const LAS bf16x8*)(T + off_b((lane & 15) + 16 * rb, 4 * s + (lane >> 4))); }
__device__ __forceinline__ bf16x8 tile_tr_read(const LAS unsigned char* T, int lane, int c, int ks) {
    const unsigned g = lane >> 4, q = (lane & 15) >> 2, p = lane & 3;
    const unsigned a0 = off_b(32 * ks + 8 * g + q, 2 * c + (p >> 1)) + 8 * (p & 1), a1 = off_b(32 * ks + 8 * g + 4 + q, 2 * c + (p >> 1)) + 8 * (p & 1);
    const s16x4 lo = __builtin_amdgcn_ds_read_tr16_b64_v4i16((LAS s16x4*)(T + a0)), hi = __builtin_amdgcn_ds_read_tr16_b64_v4i16((LAS s16x4*)(T + a1));
    return __builtin_shufflevector(lo, hi, 0, 1, 2, 3, 4, 5, 6, 7);
}
struct ChunkRef { int isctx, b, h, d, oc; };
__device__ __forceinline__ int chunk_row0(const ChunkRef& r) { return r.isctx ? (MX + r.b * CTXL + r.oc * 128) : (r.b * SEQ + r.oc * 128); }

__device__ __forceinline__ void mlstm_prep(const Ctx& C, const Params& P) {
    unsigned char* ws = P.ws;
    const float* cw = P.in[17];
    {
        const bf16_t* kvcm = (const bf16_t*)(ws + WS_KVCM); bf16_t* kact = (bf16_t*)(ws + WS_KACT);
        const int NCH = 512 * (MT / 8), STR = C.G * NTHR;
        for (int i0 = C.bid * NTHR + C.tid; i0 < NCH; i0 += 4 * STR) {
            u32x4 vv[4]; unsigned vl4[4], vr4[4];
#pragma unroll
            for (int u = 0; u < 4; ++u) { const int i = i0 + u * STR; if (i < NCH) { const int c = i / (MT / 8), col = 8 * (i % (MT / 8)); const bf16_t* src = kvcm + (size_t)c * MT + col;
                vv[u] = *(const u32x4*)src; vl4[u] = *(const unsigned*)(src - 2); vr4[u] = *(const unsigned*)(src + 8); } }
#pragma unroll
            for (int u = 0; u < 4; ++u) { const int i = i0 + u * STR; if (i < NCH) { const int c = i / (MT / 8), col = 8 * (i % (MT / 8)); const u32x4 v = vv[u];
                const int t = (col < MX) ? (col & 63) : ((col - MX) & 255), rl = (col < MX) ? 64 : 256;
                float x[10]; x[1] = bflo(v.x); x[2] = bfhi(v.x); x[3] = bflo(v.y); x[4] = bfhi(v.y); x[5] = bflo(v.z); x[6] = bfhi(v.z); x[7] = bflo(v.w); x[8] = bfhi(v.w);
                x[0] = (t != 0) ? bfhi(vl4[u]) : 0.f; x[9] = (t + 8 != rl) ? bflo(vr4[u]) : 0.f;
                const float w0 = cw[512 + c], w1 = cw[1024 + 512 + c], w2 = cw[2048 + 512 + c]; float y[8];
#pragma unroll
                for (int j = 0; j < 8; ++j) y[j] = siluf(w0 * x[j] + w1 * x[j + 1] + w2 * x[j + 2]);
                u32x4 o; o.x = pk2(y[0], y[1]); o.y = pk2(y[2], y[3]); o.z = pk2(y[4], y[5]); o.w = pk2(y[6], y[7]);
                *(u32x4*)(kact + (size_t)c * MT + col) = o; } }
        }
    }
    {
        const bf16_t* pml = (const bf16_t*)(ws + WS_PML); bf16_t* qact = (bf16_t*)(ws + WS_QACT);
        const int NQ = MX * 64, STR = C.G * NTHR;
        for (int i0 = C.bid * NTHR + C.tid; i0 < NQ; i0 += 4 * STR) {
            u32x4 vc4[4], vl4[4], vr4[4];
#pragma unroll
            for (int u = 0; u < 4; ++u) { const int i = i0 + u * STR; if (i < NQ) { const int row = i >> 6, c0 = 8 * (i & 63); const bf16_t* base = pml + (size_t)row * 1024 + c0;
                const bool hl = (row & 63) != 0, hr = (row & 63) != 63;
                vc4[u] = *(const u32x4*)base; vl4[u] = (u32x4){0u, 0u, 0u, 0u}; vr4[u] = (u32x4){0u, 0u, 0u, 0u};
                if (hl) vl4[u] = *(const u32x4*)(base - 1024); if (hr) vr4[u] = *(const u32x4*)(base + 1024); } }
#pragma unroll
            for (int u = 0; u < 4; ++u) { const int i = i0 + u * STR; if (i < NQ) { const int row = i >> 6, c0 = 8 * (i & 63);
                const u32x4 vc = vc4[u], vl = vl4[u], vr = vr4[u];
                const unsigned l4[4] = {vl.x, vl.y, vl.z, vl.w}, c4[4] = {vc.x, vc.y, vc.z, vc.w}, r4[4] = {vr.x, vr.y, vr.z, vr.w}; unsigned o4[4];
#pragma unroll
                for (int q = 0; q < 4; ++q) {
                    const float a0 = cw[c0 + 2 * q] * bflo(l4[q]) + cw[1024 + c0 + 2 * q] * bflo(c4[q]) + cw[2048 + c0 + 2 * q] * bflo(r4[q]);
                    const float a1 = cw[c0 + 2 * q + 1] * bfhi(l4[q]) + cw[1024 + c0 + 2 * q + 1] * bfhi(c4[q]) + cw[2048 + c0 + 2 * q + 1] * bfhi(r4[q]);
                    o4[q] = pk2(siluf(a0) * 0.08838834764831845f, siluf(a1) * 0.08838834764831845f); }
                *(u32x4*)(qact + (size_t)row * 512 + c0) = (u32x4){o4[0], o4[1], o4[2], o4[3]}; } }
        }
    }
    for (int item = C.bid * 8 + C.wave; item < 64 * NCHK; item += C.G * 8) {
        const int j = item % NCHK, seq = item / NCHK, h = seq & 3, b = (seq >> 2) & 7, d = seq >> 5;
        ChunkRef r; r.isctx = j < 2; r.b = b; r.h = h; r.d = d; { const int jj = r.isctx ? j : j - 2, nch = r.isctx ? 2 : 32; r.oc = d ? (nch - 1 - jj) : jj; }
        const float* gates = (const float*)(ws + WS_GATES) + (size_t)chunk_row0(r) * 16;
        const int p0 = 2 * C.lane, t0 = d ? 127 - p0 : p0, t1 = d ? 126 - p0 : p0 + 1;
        const float li0 = gates[(size_t)t0 * 16 + (d ? 8 : 0) + h], li1 = gates[(size_t)t1 * 16 + (d ? 8 : 0) + h];
        const float lf0 = logsig(gates[(size_t)t0 * 16 + (d ? 12 : 4) + h]), lf1 = logsig(gates[(size_t)t1 * 16 + (d ? 12 : 4) + h]);
        float run = lf0 + lf1;
#pragma unroll
        for (int o = 1; o < 64; o <<= 1) { const float t = __shfl_up(run, o); if (C.lane >= o) run += t; }
        const float b1 = run, b0 = run - lf1;
        const float c0 = li0 - b0, c1 = li1 - b1;
        float gm = fmaxf(c0, c1);
#pragma unroll
        for (int o = 1; o < 64; o <<= 1) { const float t = __shfl_up(gm, o); if (C.lane >= o) gm = fmaxf(gm, t); }
        float gprev = __shfl_up(gm, 1); if (C.lane == 0) gprev = -3.0e38f;
        float* gc = (float*)(ws + WS_GC) + (size_t)item * 384;
        gc[t0] = c0; gc[t1] = c1; gc[128 + t0] = b0; gc[128 + t1] = b1; gc[256 + t0] = fmaxf(gprev, c0); gc[256 + t1] = gm;
        if (C.lane == 63) { float* bl = (float*)(ws + WS_BL) + (size_t)item * 2; bl[0] = b1; bl[1] = gm; }
    }
}

struct SeqPre { u32x4 k[4]; u32x4 v[4]; float g; float bl0, bl1; };
__device__ __forceinline__ ChunkRef seq_chunk(int jc, int b, int h, int d) {
    ChunkRef r; r.isctx = jc < 2; r.b = b; r.h = h; r.d = d; const int jj = r.isctx ? jc : jc - 2, nch = r.isctx ? 2 : 32; r.oc = d ? (nch - 1 - jj) : jj; return r; }
__device__ __forceinline__ void seq_prefetch(const Params& P, const ChunkRef& r, int item, SeqPre& pf, int tid) {
    const bf16_t* kact = (const bf16_t*)(P.ws + WS_KACT); const bf16_t* kvcm = (const bf16_t*)(P.ws + WS_KVCM); const int col0 = chunk_row0(r);
#pragma unroll
    for (int it = 0; it < 4; ++it) { const int idx = tid + NTHR * it, dd = idx >> 4, s0 = 8 * (idx & 15);
        pf.k[it] = *(const u32x4*)(kact + (size_t)(r.h * 128 + dd) * MT + col0 + s0);
        pf.v[it] = *(const u32x4*)(kvcm + (size_t)(512 + r.h * 128 + dd) * MT + col0 + s0); }
    pf.g = (tid < 384) ? ((const float*)(P.ws + WS_GC))[(size_t)item * 384 + tid] : 0.f;
    const float* bl = (const float*)(P.ws + WS_BL) + (size_t)item * 2; pf.bl0 = bl[0]; pf.bl1 = bl[1];
}
#define SEQ_BAR() do { asm volatile("s_waitcnt lgkmcnt(0)" ::: "memory"); __builtin_amdgcn_s_barrier(); asm volatile("" ::: "memory"); } while (0)
__device__ __forceinline__ void mlstm_seq(const Ctx& C, const Params& P, int seq) {
    unsigned char* ws = P.ws;
    const int h = seq & 3, b = (seq >> 2) & 7, d = seq >> 5;
    LAS unsigned char* KT = C.lds; LAS unsigned char* VT = C.lds + 32768; LAS unsigned char* CT = C.lds + 65536; LAS unsigned char* PS = C.lds + 98304;
    LAS float* colf = (LAS float*)(C.lds + 131072); LAS float* bcs = colf + 128; LAS float* gms = bcs + 128; LAS float* wls = gms + 128; LAS float* nbuf = wls + 128  ;
    const int w = C.wave;
    f32x4 Cst[8]; f32x4 nst = (f32x4){0.f, 0.f, 0.f, 0.f};
#pragma unroll
    for (int nt = 0; nt < 8; ++nt) Cst[nt] = (f32x4){0.f, 0.f, 0.f, 0.f};
    float m = 0.f;
    __syncthreads();
    if (C.tid < 256) nbuf[C.tid] = 0.f;
    SeqPre pre;
    seq_prefetch(P, seq_chunk(0, b, h, d), seq * NCHK, pre, C.tid);
    const bf16x8 ones = (bf16x8){0x3f80, 0x3f80, 0x3f80, 0x3f80, 0x3f80, 0x3f80, 0x3f80, 0x3f80};
#pragma unroll 1
    for (int jc = 0; jc < NCHK; ++jc) {
        const ChunkRef r = seq_chunk(jc, b, h, d);
        const LAS float* nsl = nbuf + 128 * (jc & 1); LAS float* nnew = nbuf + 128 * ((jc & 1) ^ 1);
        int tid = C.tid; asm volatile("" : "+v"(tid));
        const int lane = tid & 63, fr = lane & 15, fq = lane >> 4;
        bf16x8 qf[4];
        if (!r.isctx) { const bf16_t* qa = (const bf16_t*)(ws + WS_QACT) + (size_t)(b * SEQ + r.oc * 128 + 16 * w + fr) * 512 + h * 128 + 8 * fq;
#pragma unroll
            for (int ks = 0; ks < 4; ++ks) qf[ks] = *(const bf16x8*)(qa + 32 * ks); }
        else {
#pragma unroll
            for (int ks = 0; ks < 4; ++ks) qf[ks] = (bf16x8){0, 0, 0, 0, 0, 0, 0, 0}; }
        const float Bj = pre.bl0, gfin = pre.bl1, mxs = fmaxf(m, gfin), decay = __expf(m - mxs);
        SEQ_BAR();
        {
#pragma unroll
            for (int it = 0; it < 4; ++it) { const int idx = tid + NTHR * it, dd = idx >> 4, ch = idx & 15;
                *(LAS u32x4*)(KT + off_b(dd, ch)) = pre.k[it]; *(LAS u32x4*)(VT + off_b(dd, ch)) = pre.v[it]; }
            if (tid < 384) colf[tid] = pre.g;
            if (tid < 128) wls[tid] = __expf(pre.g - mxs);
        }
#pragma unroll
        for (int nt = 0; nt < 8; ++nt) { u32x2 pw; pw.x = pk2(Cst[nt][0], Cst[nt][1]); pw.y = pk2(Cst[nt][2], Cst[nt][3]);
            *(LAS u32x2*)(CT + off_b(16 * nt + fr, 2 * w + (fq >> 1)) + 8 * (fq & 1)) = pw; }
        if (fr == 0) *(LAS f32x4*)(nnew + 16 * w + 4 * fq) = nst;
        SEQ_BAR();
        if (!r.isctx) {
            const int t = 16 * w + fr;
            const float mx = fmaxf(m, gms[t]), rowf = -mx, ainter = __expf(m - mx), emneg = __expf(-(bcs[t] + mx));
            float qn = 0.f;
#pragma unroll
            for (int ks = 0; ks < 4; ++ks) { const u32x4 qq = __builtin_bit_cast(u32x4, qf[ks]); const LAS float* np_ = nnew + 32 * ks + 8 * fq; const f32x4 na = *(const LAS f32x4*)np_, nb = *(const LAS f32x4*)(np_ + 4);
                qn += bflo(qq.x) * na[0] + bfhi(qq.x) * na[1] + bflo(qq.y) * na[2] + bfhi(qq.y) * na[3] + bflo(qq.z) * nb[0] + bfhi(qq.z) * nb[1] + bflo(qq.w) * nb[2] + bfhi(qq.w) * nb[3]; }
            qn += __shfl_xor(qn, 16); qn += __shfl_xor(qn, 32);
            float rs = 0.f;
#pragma unroll 2
            for (int nt = 0; nt < 8; ++nt) { f32x4 a = (f32x4){0.f, 0.f, 0.f, 0.f};
#pragma unroll
                for (int ks = 0; ks < 4; ++ks) a = __builtin_amdgcn_mfma_f32_16x16x32_bf16(tile_tr_read(KT, lane, nt, ks), qf[ks], a, 0, 0, 0);
                const int s0 = 16 * nt + 4 * fq; const f32x4 cf = *(const LAS f32x4*)(colf + s0); float pv[4];
#pragma unroll
                for (int q = 0; q < 4; ++q) { const int s = s0 + q; const bool ok = d ? (s >= t) : (s <= t); pv[q] = ok ? __expf(rowf + cf[q]) * a[q] : 0.f; rs += pv[q]; }
                u32x2 pw; pw.x = pk2(pv[0], pv[1]); pw.y = pk2(pv[2], pv[3]);
                *(LAS u32x2*)(PS + off_b(t, 2 * nt + (fq >> 1)) + 8 * (fq & 1)) = pw; }
            rs += __shfl_xor(rs, 16); rs += __shfl_xor(rs, 32);
            const float inv = 1.f / fmaxf(fabsf(rs + ainter * qn), emneg);
            LDS_WAIT();
            bf16x8 pfr[4];
#pragma unroll
            for (int ks = 0; ks < 4; ++ks) pfr[ks] = tile_row_read(PS, lane, w, ks);
            float ai4[4], iv4[4];
#pragma unroll
            for (int q = 0; q < 4; ++q) { ai4[q] = __shfl(ainter, 4 * fq + q); iv4[q] = __shfl(inv, 4 * fq + q); }
            bf16_t* hd = (bf16_t*)(ws + WS_HDIR) + ((size_t)d * MX + (size_t)(b * SEQ + r.oc * 128)) * 512 + h * 128;
#pragma unroll 2
            for (int nt = 0; nt < 8; ++nt) { f32x4 a = (f32x4){0.f, 0.f, 0.f, 0.f}, c = (f32x4){0.f, 0.f, 0.f, 0.f};
#pragma unroll
                for (int ks = 0; ks < 4; ++ks) { a = __builtin_amdgcn_mfma_f32_16x16x32_bf16(pfr[ks], tile_row_read(VT, lane, nt, ks), a, 0, 0, 0);
                    c = __builtin_amdgcn_mfma_f32_16x16x32_bf16(qf[ks], tile_row_read(CT, lane, nt, ks), c, 0, 0, 0); }
#pragma unroll
                for (int q = 0; q < 4; ++q) hd[(size_t)(16 * w + 4 * fq + q) * 512 + 16 * nt + fr] = (bf16_t)f2bf((a[q] + ai4[q] * c[q]) * iv4[q]); }
        }
        if (jc + 1 < NCHK) seq_prefetch(P, seq_chunk(jc + 1, b, h, d), seq * NCHK + jc + 1, pre, tid);
        {
            bf16x8 kfs[4];
#pragma unroll
            for (int ks = 0; ks < 4; ++ks) { const u32x4 kk = __builtin_bit_cast(u32x4, tile_row_read(KT, lane, w, ks)); const LAS float* cp = wls + 32 * ks + 8 * fq;
                const f32x4 ca = *(const LAS f32x4*)cp, cb = *(const LAS f32x4*)(cp + 4);
                u32x4 o; o.x = pk2(bflo(kk.x) * ca[0], bfhi(kk.x) * ca[1]); o.y = pk2(bflo(kk.y) * ca[2], bfhi(kk.y) * ca[3]);
                o.z = pk2(bflo(kk.z) * cb[0], bfhi(kk.z) * cb[1]); o.w = pk2(bflo(kk.w) * cb[2], bfhi(kk.w) * cb[3]);
                kfs[ks] = __builtin_bit_cast(bf16x8, o); }
#pragma unroll
            for (int nt = 0; nt < 8; ++nt) { f32x4 a = (f32x4){0.f, 0.f, 0.f, 0.f};
#pragma unroll
                for (int ks = 0; ks < 4; ++ks) a = __builtin_amdgcn_mfma_f32_16x16x32_bf16(kfs[ks], tile_row_read(VT, lane, nt, ks), a, 0, 0, 0);
                Cst[nt] = Cst[nt] * decay + a; }
            { f32x4 a = (f32x4){0.f, 0.f, 0.f, 0.f};
#pragma unroll
              for (int ks = 0; ks < 4; ++ks) a = __builtin_amdgcn_mfma_f32_16x16x32_bf16(kfs[ks], ones, a, 0, 0, 0);
              nst = nst * decay + a; }
            m = Bj + mxs;
        }
    }
}
#undef SEQ_BAR

__device__ __forceinline__ void mlstm_combine(const Ctx& C, const Params& P) {
    unsigned char* ws = P.ws;
    const bf16_t* hd = (const bf16_t*)(ws + WS_HDIR); const bf16_t* pml = (const bf16_t*)(ws + WS_PML); bf16_t* yab = (bf16_t*)(ws + WS_YAB); const float* ng = P.in[18];
    const f32x4 g0 = *(const f32x4*)(ng + 8 * C.lane), g1 = *(const f32x4*)(ng + 8 * C.lane + 4);
    u32x4 na, nb, no;
    { const int row0 = C.bid * 8 + C.wave;
      if (row0 < MX) { na = *(const u32x4*)(hd + (size_t)row0 * 512 + 8 * C.lane); nb = *(const u32x4*)(hd + ((size_t)MX + row0) * 512 + 8 * C.lane); no = *(const u32x4*)(pml + (size_t)row0 * 1024 + 512 + 8 * C.lane); } }
    for (int row = C.bid * 8 + C.wave; row < MX; row += C.G * 8) {
        const u32x4 a = na, bq = nb, og = no;
        if (row + C.G * 8 < MX) { const int r1 = row + C.G * 8;
            na = *(const u32x4*)(hd + (size_t)r1 * 512 + 8 * C.lane); nb = *(const u32x4*)(hd + ((size_t)MX + r1) * 512 + 8 * C.lane); no = *(const u32x4*)(pml + (size_t)r1 * 1024 + 512 + 8 * C.lane); }
        float v[8] = {bflo(a.x) + bflo(bq.x), bfhi(a.x) + bfhi(bq.x), bflo(a.y) + bflo(bq.y), bfhi(a.y) + bfhi(bq.y), bflo(a.z) + bflo(bq.z), bfhi(a.z) + bfhi(bq.z), bflo(a.w) + bflo(bq.w), bfhi(a.w) + bfhi(bq.w)};
        float ss = 0.f;
#pragma unroll
        for (int j = 0; j < 8; ++j) ss += v[j] * v[j];
        ss += __shfl_xor(ss, 1); ss += __shfl_xor(ss, 2); ss += __shfl_xor(ss, 4); ss += __shfl_xor(ss, 8);
        const float rstd = rsqrtf(ss * (1.f / 128.f) + RMS_EPS);
        const float o8[8] = {bflo(og.x), bfhi(og.x), bflo(og.y), bfhi(og.y), bflo(og.z), bfhi(og.z), bflo(og.w), bfhi(og.w)};
        const float gg[8] = {g0[0], g0[1], g0[2], g0[3], g1[0], g1[1], g1[2], g1[3]};
        float y[8];
#pragma unroll
        for (int j = 0; j < 8; ++j) y[j] = v[j] * rstd * gg[j] * sigm(o8[j]);
        u32x4 wv; wv.x = pk2(y[0], y[1]); wv.y = pk2(y[2], y[3]); wv.z = pk2(y[4], y[5]); wv.w = pk2(y[6], y[7]);
        *(u32x4*)(yab + (size_t)row * 1024 + 512 + 8 * C.lane) = wv;
    }
}

template <int PM>
__device__ __forceinline__ void mixer_phase(const Ctx& C, const Params& P) {
    constexpr int NM = 64;
    const bool small = C.G < 2 * NM;
    const int nh = small ? C.G : C.G - NM, hb = small ? C.bid : C.bid - NM;
    if (PM != 2 && PM != 3) if (small || C.bid < NM) for (int s = C.bid; s < 64; s += (small ? C.G : NM)) mlstm_seq(C, P, s);
    if (PM != 1 && hb >= 0) {
        const int nch = (512 - hb + nh - 1) / nh;
#pragma unroll 1
        for (int j = 0; j < 2 * nch; ++j) { const int c = hb + (j >> 1) * nh, o = j & 1;
            if (o) asm volatile("s_waitcnt vmcnt(0)" ::: "memory");
            hyena_item<0>(C, P, o, c); }
    }
}

__device__ __forceinline__ void transpose_z2(const Ctx& C, const Params& P) {
    unsigned char* ws = P.ws;
    const bf16_t* src = (const bf16_t*)(ws + WS_Z2CM); bf16_t* dst = (bf16_t*)(ws + WS_YAB);
    LAS bf16_t* tl = (LAS bf16_t*)(C.lds + 143360 - 20480);
    for (int it = C.bid; it < 8 * 256; it += C.G) {
        const int c0 = (it & 7) * 64, r0 = (it >> 3) * 128;
        __syncthreads();
        for (int idx = C.tid; idx < 64 * 16; idx += NTHR) { const int cc = idx >> 4, rc = (idx & 15) * 8;
            const u32x4 v = *(const u32x4*)(src + (size_t)(c0 + cc) * MX + r0 + rc); const unsigned v4[4] = {v.x, v.y, v.z, v.w};
#pragma unroll
            for (int q = 0; q < 4; ++q) { tl[(rc + 2 * q) * 72 + cc] = (bf16_t)(v4[q] & 0xffffu); tl[(rc + 2 * q + 1) * 72 + cc] = (bf16_t)(v4[q] >> 16); } }
        __syncthreads();
        for (int idx = C.tid; idx < 128 * 8; idx += NTHR) { const int rr = idx >> 3, c8 = (idx & 7) * 8;
            *(u32x4*)(dst + (size_t)(r0 + rr) * 1024 + c0 + c8) = *(const LAS u32x4*)(tl + rr * 72 + c8); }
    }
}

__device__ __forceinline__ void phase6(const Ctx& C, const Params& P) {
    unsigned char* ws = P.ws;
    LAS float* Wr = (LAS float*)C.lds;
#pragma unroll 1
    for (int i0 = C.tid; i0 < 1024 * 16; i0 += 8 * NTHR) { float t8[8];
#pragma unroll
        for (int u = 0; u < 8; ++u) t8[u] = P.in[22][i0 + u * NTHR];
#pragma unroll
        for (int u = 0; u < 8; ++u) { const int idx = i0 + u * NTHR; Wr[wl_pos(idx >> 4) * 20 + (idx & 15)] = t8[u]; } }
    __syncthreads();
    const float* ada = (const float*)(ws + WS_ADA); const float* gffn = P.in[7];
    unsigned char* hx2 = ws + WS_HX2; float* aff = (float*)(ws + WS_AFF); int* slot = (int*)(ws + WS_SLOT);
    const bf16_t* xm = (const bf16_t*)(ws + WS_XMID);
    u32x2 nx[4];
    { const int row0 = C.bid * 8 + C.wave;
      if (row0 < MX) {
#pragma unroll
        for (int j = 0; j < 4; ++j) nx[j] = *(const u32x2*)(xm + (size_t)row0 * DM + 4 * C.lane + 256 * j); } }
    for (int row = C.bid * 8 + C.wave; row < MX; row += C.G * 8) {
        const int b = row >> 12, n = row & 4095;
        f32x4 v[4]; float ss = 0.f;
#pragma unroll
        for (int j = 0; j < 4; ++j) { v[j] = (f32x4){bflo(nx[j].x), bfhi(nx[j].x), bflo(nx[j].y), bfhi(nx[j].y)}; ss += v[j][0] * v[j][0] + v[j][1] * v[j][1] + v[j][2] * v[j][2] + v[j][3] * v[j][3]; }
        if (row + C.G * 8 < MX) {
#pragma unroll
            for (int j = 0; j < 4; ++j) nx[j] = *(const u32x2*)(xm + (size_t)(row + C.G * 8) * DM + 4 * C.lane + 256 * j); }
        const float rstd = rsqrtf(wave_sum(ss) * (1.f / DM) + RMS_EPS);
#pragma unroll
        for (int j = 0; j < 4; ++j) { const int k = 4 * C.lane + 256 * j; const f32x4 g = *(const f32x4*)(gffn + k);
            const f32x4 h4 = *(const f32x4*)(ada + (size_t)b * 6144 + 3072 + k), s4 = *(const f32x4*)(ada + (size_t)b * 6144 + 4096 + k);
#pragma unroll
            for (int q = 0; q < 4; ++q) v[j][q] = (v[j][q] * rstd * g[q]) * (1.f + s4[q]) + h4[q];
            *(unsigned*)(hx2 + (size_t)row * DM + k) = pk4_fp8(v[j][0], v[j][1], v[j][2], v[j][3]); }
        const float lg = row_dot16(v, Wr, C.lane);
        float mx = lg;
        mx = fmaxf(mx, __shfl_xor(mx, 4)); mx = fmaxf(mx, __shfl_xor(mx, 8)); mx = fmaxf(mx, __shfl_xor(mx, 16)); mx = fmaxf(mx, __shfl_xor(mx, 32));
        const float ex = expf(lg - mx);
        float sum = ex;
        sum += __shfl_xor(sum, 4); sum += __shfl_xor(sum, 8); sum += __shfl_xor(sum, 16); sum += __shfl_xor(sum, 32);
        if ((C.lane & 3) == 0) { const int e = C.lane >> 2; aff[((size_t)b * NE + e) * SEQ + n] = ex / sum; slot[(size_t)row * 16 + e] = -1; }
    }
}

__device__ __forceinline__ void topk_item(const Ctx& C, const Params& P, int item) {
    unsigned char* ws = P.ws;
    const int b = item >> 4, e = item & 15;
    const float* aff = (const float*)(ws + WS_AFF) + (size_t)item * SEQ;
    LAS unsigned* red = (LAS unsigned*)C.lds;
    unsigned v[8];
    { const u32x4 a = *(const u32x4*)(aff + 8 * C.tid), c = *(const u32x4*)(aff + 8 * C.tid + 4);
      v[0] = a.x; v[1] = a.y; v[2] = a.z; v[3] = a.w; v[4] = c.x; v[5] = c.y; v[6] = c.z; v[7] = c.w; }
    unsigned prefix = 0u;
    for (int bit = 30; bit >= 0; --bit) {
        const unsigned cand = prefix | (1u << bit); int cnt = 0;
#pragma unroll
        for (int q = 0; q < 8; ++q) cnt += (v[q] >= cand) ? 1 : 0;
        cnt = (int)wave_sum((float)cnt);
        __syncthreads();
        if (C.lane == 0) red[C.wave] = (unsigned)cnt;
        __syncthreads();
        int tot = 0;
#pragma unroll
        for (int q = 0; q < 8; ++q) tot += (int)red[q];
        if (tot >= CAP) prefix = cand;
    }
    int cg_ = 0, ce_ = 0;
#pragma unroll
    for (int q = 0; q < 8; ++q) { cg_ += (v[q] > prefix) ? 1 : 0; ce_ += (v[q] == prefix) ? 1 : 0; }
    int ig = cg_, ie = ce_;
#pragma unroll
    for (int o = 1; o < 64; o <<= 1) { const int tg = __shfl_up(ig, o), te = __shfl_up(ie, o); if (C.lane >= o) { ig += tg; ie += te; } }
    __syncthreads();
    if (C.lane == 63) { red[C.wave] = (unsigned)ig; red[8 + C.wave] = (unsigned)ie; }
    __syncthreads();
    int bg = 0, be = 0, totg = 0;
#pragma unroll
    for (int q = 0; q < 8; ++q) { const int xg = (int)red[q], xe = (int)red[8 + q]; if (q < C.wave) { bg += xg; be += xe; } totg += xg; }
    int pg = bg + ig - cg_, pe = be + ie - ce_;
    const int need = CAP - totg;
    float* sg = (float*)(ws + WS_SGATE) + (size_t)item * CAP; int* slot = (int*)(ws + WS_SLOT);
    LAS int* sel = (LAS int*)(C.lds + 256);
#pragma unroll
    for (int q = 0; q < 8; ++q) { const int n = 8 * C.tid + q; int s = -1;
        if (v[q] > prefix) s = pg++;
        else if (v[q] == prefix) { if (pe < need) s = totg + pe; ++pe; }
        if (s >= 0) { sel[s] = n; sg[s] = __builtin_bit_cast(float, v[q]); slot[((size_t)b * SEQ + n) * 16 + e] = s; } }
    __syncthreads();
    const unsigned char* hx2 = ws + WS_HX2; unsigned char* xg = ws + WS_XG + ((size_t)e * 4096 + (size_t)b * CAP) * DM;
    for (int s0 = C.wave; s0 < CAP; s0 += 32) {
        u32x4 v4[4];
#pragma unroll
        for (int u = 0; u < 4; ++u) v4[u] = ((const u32x4*)(hx2 + ((size_t)b * SEQ + sel[s0 + 8 * u]) * DM))[C.lane];
#pragma unroll
        for (int u = 0; u < 4; ++u) ((u32x4*)(xg + (size_t)(s0 + 8 * u) * DM))[C.lane] = v4[u];
    }
    __syncthreads();
}

__device__ __forceinline__ void moe_gemm1(const Ctx& C, const Params& P, int skip_epi) {
    unsigned char* ws = P.ws;
    pg8::SchedMoe S{(const char*)(ws + WS_XG), (const char*)(ws + WS_W13), (size_t)256 * 1024, (size_t)256 * 1024, (size_t)4096 * 1024, (size_t)4096 * 1024, 16, 16, C.G, C.bid};
    pg8::EpiMoe1 E{ws + WS_ACT, skip_epi};
    pg8::gemm_phase<pg8::EpiMoe1, pg8::SchedMoe, false, true>(C.lds, 512, 1024, 1024, S, E);
}
__device__ __forceinline__ void moe_gemm2(const Ctx& C, const Params& P, bool skip_epi) {
    unsigned char* ws = P.ws;
    pg8::SchedMoe S{(const char*)(ws + WS_ACT), (const char*)(ws + WS_W2), (size_t)256 * 2048, (size_t)256 * 2048, (size_t)4096 * 2048, (size_t)1024 * 2048, 16, 4, C.G, C.bid};
    pg8::EpiMoe2 E{(bf16_t*)(ws + WS_YE), (const float*)(ws + WS_SGATE), skip_epi};
    pg8::gemm_phase<pg8::EpiMoe2, pg8::SchedMoe, false, true>(C.lds, 1024, 2048, 2048, S, E);
}

__device__ __forceinline__ void phase_final(const Ctx& C, const Params& P) {
    unsigned char* ws = P.ws;
    const float* ada = (const float*)(ws + WS_ADA); const float* gfin = P.in[26];
    const int* slot = (const int*)(ws + WS_SLOT); const bf16_t* ye = (const bf16_t*)(ws + WS_YE);
    const bf16_t* xm = (const bf16_t*)(ws + WS_XMID);
    u32x2 nx[4]; int nslot = -1;
    { const int row0 = C.bid * 8 + C.wave;
      if (row0 < MX) { if (C.lane < 16) nslot = slot[(size_t)row0 * 16 + C.lane];
#pragma unroll
        for (int j = 0; j < 4; ++j) nx[j] = *(const u32x2*)(xm + (size_t)row0 * DM + 4 * C.lane + 256 * j); } }
    for (int row = C.bid * 8 + C.wave; row < MX; row += C.G * 8) {
        const int b = row >> 12;
        float* xr = P.out + (size_t)row * DM;
        f32x4 xv[4]; const int myslot = nslot;
#pragma unroll
        for (int j = 0; j < 4; ++j) xv[j] = (f32x4){bflo(nx[j].x), bfhi(nx[j].x), bflo(nx[j].y), bfhi(nx[j].y)};
        f32x4 m[4];
#pragma unroll
        for (int j = 0; j < 4; ++j) m[j] = (f32x4){0.f, 0.f, 0.f, 0.f};
        for (int e = 0; e < NE; ++e) { const int s = __shfl(myslot, e);
            if (s >= 0) { const bf16_t* yr = ye + ((size_t)e * 4096 + b * CAP + s) * DM;
#pragma unroll
                for (int j = 0; j < 4; ++j) { const u32x2 w = *(const u32x2*)(yr + 4 * C.lane + 256 * j);
                    m[j][0] += bflo(w.x); m[j][1] += bfhi(w.x); m[j][2] += bflo(w.y); m[j][3] += bfhi(w.y); } } }
        if (row + C.G * 8 < MX) { const int r1 = row + C.G * 8; nslot = (C.lane < 16) ? slot[(size_t)r1 * 16 + C.lane] : -1;
#pragma unroll
            for (int j = 0; j < 4; ++j) nx[j] = *(const u32x2*)(xm + (size_t)r1 * DM + 4 * C.lane + 256 * j); }
        f32x4 v[4]; float ss = 0.f;
#pragma unroll
        for (int j = 0; j < 4; ++j) { const int k = 4 * C.lane + 256 * j; const f32x4 g5 = *(const f32x4*)(ada + (size_t)b * 6144 + 5120 + k);
            v[j] = xv[j] + g5 * m[j]; ss += v[j][0] * v[j][0] + v[j][1] * v[j][1] + v[j][2] * v[j][2] + v[j][3] * v[j][3]; }
        const float rstd = rsqrtf(wave_sum(ss) * (1.f / DM) + RMS_EPS);
#pragma unroll
        for (int j = 0; j < 4; ++j) { const int k = 4 * C.lane + 256 * j; const f32x4 g = *(const f32x4*)(gfin + k);
            *(f32x4*)(xr + k) = v[j] * rstd * g; }
    }
}

constexpr int N_PHASES = 14;
__global__ void __launch_bounds__(NTHR, 2) mega(Params P) {
    extern __shared__ __attribute__((aligned(16))) unsigned char lds_raw[];
    Ctx C; C.lds = (LAS unsigned char*)lds_raw; C.tid = threadIdx.x; C.lane = C.tid & 63; C.wave = __builtin_amdgcn_readfirstlane(C.tid >> 6); C.bid = blockIdx.x; C.G = gridDim.x;
    unsigned char* ws = P.ws;
    if (C.tid < 32) ((LAS unsigned*)(C.lds + LDS_MISC))[C.tid] = 0u;
    __syncthreads();
    XcdBarrier bar = xcd_barrier_post((unsigned*)(ws + WS_CTL), (volatile LAS unsigned*)(C.lds + LDS_MISC));
#define IN(k) (lo <= (k) && (k) < hi)
#define SEAM(k) do { if (IN(k) && IN((k) + 1)) { xcd_barrier(bar); if ((REPEAT >> 23) & 1u) xcd_barrier(bar); } } while (0)
#define RUN(id, ...) do { { constexpr bool rep = false; (void)rep; __VA_ARGS__; } if ((REPEAT >> (id)) & 1u) { xcd_barrier(bar); { constexpr bool rep = true; (void)rep; __VA_ARGS__; } } } while (0)
#define PHASE_PROGRAM(LO, HI) do { const int lo = (LO), hi = (HI); \
    if (IN(0)) RUN(0, phase0(C, P)); \
    SEAM(0); \
    if (IN(1)) RUN(1, phase1(C, P)); \
    SEAM(1); \
    if (IN(2)) { \
        RUN(2, phase2a(C, P)); \
        RUN(3, phase2b(C, P)); \
    } \
    SEAM(2); \
    if (IN(3)) RUN(5, mlstm_prep(C, P)); \
    SEAM(3); \
    if (IN(4)) RUN(4, mixer_phase<rep ? (int)((REPEAT >> 25) & 3u) : 0>(C, P)); \
    SEAM(4); \
    if (IN(5)) { \
        RUN(9, transpose_z2(C, P)); \
        RUN(8, mlstm_combine(C, P)); \
    } \
    SEAM(5); \
    if (IN(6)) RUN(10, phase_merge(C, P)); \
    SEAM(6); \
    if (IN(7)) RUN(11, phase_outproj(C, P)); \
    SEAM(7); \
    if (IN(8)) RUN(12, phase6(C, P)); \
    SEAM(8); \
    if (IN(9)) { \
        RUN(13, for (int it = C.bid; it < BATCH * NE; it += C.G) topk_item(C, P, it)); \
        __syncthreads(); \
        RUN(14, convert_experts(C, P)); \
    } \
    SEAM(9); \
    if (IN(11)) RUN(16, moe_gemm1(C, P, rep ? (int)((REPEAT >> 25) & 3u) : 0)); \
    SEAM(11); \
    if (IN(12)) RUN(17, moe_gemm2(C, P, rep && ((REPEAT >> 25) & 1u))); \
    SEAM(12); \
    if (IN(13)) phase_final(C, P); \
} while (0)
    PHASE_PROGRAM(P.ph_lo, P.ph_hi);
#undef PHASE_PROGRAM
#undef IN
#undef SEAM
#undef RUN
}

extern "C" void kernel_launch(void* const* d_in, const int* in_sizes, int n_in, void* d_out, int out_size, void* d_ws, size_t ws_size, hipStream_t stream) {
    static int grid = 0;
    if (grid == 0) {
        if (n_in != 27 || out_size != MX * DM || ws_size < WS_END) { fprintf(stderr, "kernel_launch: unexpected shapes (n_in %d, out %d, ws %zu < %zu)\n", n_in, out_size, ws_size, (size_t)WS_END); grid = -1; return; }
        int dev = 0, cus = 0, per_cu = 0;
        hipGetDevice(&dev);
        hipDeviceGetAttribute(&cus, hipDeviceAttributeMultiprocessorCount, dev);
        if (hipFuncSetAttribute((const void*)mega, hipFuncAttributeMaxDynamicSharedMemorySize, LDS_BYTES) != hipSuccess) { fprintf(stderr, "kernel_launch: hipFuncSetAttribute failed\n"); grid = -1; return; }
        if (hipOccupancyMaxActiveBlocksPerMultiprocessor(&per_cu, (const void*)mega, NTHR, LDS_BYTES) != hipSuccess || per_cu < 1) { fprintf(stderr, "kernel_launch: occupancy query says %d\n", per_cu); per_cu = 1; }
        (void)hipGetLastError();
        grid = cus * 1;
        if (grid <= 0) grid = 256;
    }
    if (grid < 0) return;
    Params p; memset(&p, 0, sizeof(p));
    for (int i = 0; i < 27; ++i) p.in[i] = (const float*)d_in[i];
    p.out = (float*)d_out; p.ws = (unsigned char*)d_ws;
    (void)hipMemsetAsync((unsigned char*)d_ws + WS_CTL, 0, XCD_BAR_WORDS * 4, stream);
#if N_LAUNCH_MODE == 1
    if (PREFIX > 0) {
        p.ph_lo = 0; p.ph_hi = PREFIX;
        void* pargs[] = {&p};
        (void)hipLaunchCooperativeKernel((const void*)mega, dim3(grid), dim3(NTHR), pargs, LDS_BYTES, stream);
        (void)hipMemsetAsync((unsigned char*)d_ws + WS_CTL, 0, XCD_BAR_WORDS * 4, stream);
    }
    p.ph_lo = 0; p.ph_hi = N_PHASES;
    void* args[] = {&p};
    hipError_t e = hipLaunchCooperativeKernel((const void*)mega, dim3(grid), dim3(NTHR), args, LDS_BYTES, stream);
    if (e != hipSuccess) fprintf(stderr, "kernel_launch: cooperative launch failed: %s (grid %d)\n", hipGetErrorString(e), grid);
#else
    for (int ph = 0; ph < N_PHASES; ++ph) {
        p.ph_lo = ph; p.ph_hi = ph + 1;
        void* args[] = {&p};
        hipError_t e = hipLaunchCooperativeKernel((const void*)mega, dim3(grid), dim3(NTHR), args, LDS_BYTES, stream);
        if (e != hipSuccess) { fprintf(stderr, "kernel_launch: launch %d failed: %s (grid %d)\n", ph, hipGetErrorString(e), grid); break; }
    }
#endif
}
```

```cpp
#include <hip/hip_runtime.h>
#include <hip/hip_cooperative_groups.h>
#include <cstdio>
#include <cstdint>
#include <cstring>
namespace cg = cooperative_groups;

#ifndef N_LAUNCH_MODE
#define N_LAUNCH_MODE 1
#endif

#define LAS __attribute__((address_space(3)))
typedef unsigned short bf16_t;
typedef short bf16x8 __attribute__((ext_vector_type(8)));
typedef float f32x4 __attribute__((ext_vector_type(4)));
typedef float f32x16 __attribute__((ext_vector_type(16)));
typedef unsigned u32x4 __attribute__((ext_vector_type(4)));
typedef unsigned u32x2 __attribute__((ext_vector_type(2)));

constexpr int NTHR = 512;
constexpr int BATCH = 8, SEQ = 4096, DM = 1024, CTXL = 256;
constexpr int MX = BATCH * SEQ;
constexpr int MC = BATCH * CTXL;
constexpr int DIN = 5648, NPROJ = 5632, GATE0 = 3584, MERGE0 = 3600;
constexpr int NE = 16, CAP = 512, DFF = 2048;
constexpr int MT = MX + MC;
constexpr int NCHK = 34;
constexpr float RMS_EPS = 1e-6f;

constexpr size_t MiB = 1u << 20;
constexpr size_t WS_ADAP = 0;
constexpr size_t WS_ADA = 7 * MiB;
constexpr size_t WS_CTL = 7 * MiB + 512 * 1024;
constexpr size_t WS_GATES = 8 * MiB;
constexpr size_t WS_KREV = 11 * MiB;
constexpr size_t WS_BL = 27 * MiB;
constexpr size_t WS_MST = 27 * MiB + 64 * 1024;
constexpr size_t WS_NLOC = 28 * MiB;
constexpr size_t WS_NST = 30 * MiB;
constexpr size_t WS_WIN = 32 * MiB;
constexpr size_t WS_WB = 43 * MiB;
constexpr size_t WS_WOUT = 45 * MiB;
constexpr size_t WS_HX = 48 * MiB;
constexpr size_t WS_PLOC = 48 * MiB;
constexpr size_t WS_PCM = 116 * MiB;
constexpr size_t WS_PML = 212 * MiB;
constexpr size_t WS_KVCM = 276 * MiB;
constexpr size_t WS_GC = 2 * MiB;
constexpr size_t WS_Z1 = 344 * MiB;
constexpr size_t WS_YAB = 376 * MiB;
constexpr size_t WS_CST = 440 * MiB;
constexpr size_t WS_KACT = 48 * MiB;
constexpr size_t WS_QACT = 82 * MiB;
constexpr size_t WS_HDIR = 440 * MiB;
constexpr size_t WS_Z2CM = 504 * MiB;
constexpr size_t WS_Z = 48 * MiB;
constexpr size_t WS_XMID = 496 * MiB;
constexpr size_t WS_AFF = 0;
constexpr size_t WS_SLOT = 2 * MiB;
constexpr size_t WS_SIDX = 4 * MiB;
constexpr size_t WS_SGATE = 4 * MiB + 512 * 1024;
constexpr size_t WS_HX2 = 48 * MiB;
constexpr size_t WS_W13 = 80 * MiB;
constexpr size_t WS_W2 = 144 * MiB;
constexpr size_t WS_XG = 176 * MiB;
constexpr size_t WS_ACT = 240 * MiB;
constexpr size_t WS_YE = 368 * MiB;
constexpr size_t WS_END = 568 * MiB;

constexpr int LDS_BYTES = 147456;
constexpr int LDS_MISC = LDS_BYTES - 128;
constexpr int PREFIX = 0;
constexpr unsigned REPEAT = 0u;

__device__ __forceinline__ unsigned f2bf(float f) { unsigned u = __builtin_bit_cast(unsigned, f); return (u + 0x7fffu + ((u >> 16) & 1u)) >> 16; }
__device__ __forceinline__ unsigned pk2(float lo, float hi) { return f2bf(lo) | (f2bf(hi) << 16); }
__device__ __forceinline__ float bf2f(unsigned short b) { return __builtin_bit_cast(float, ((unsigned)b) << 16); }
__device__ __forceinline__ float bflo(unsigned w) { return __builtin_bit_cast(float, w << 16); }
__device__ __forceinline__ float bfhi(unsigned w) { return __builtin_bit_cast(float, w & 0xffff0000u); }
__device__ __forceinline__ float sigm(float x) { return __builtin_amdgcn_rcpf(1.f + __expf(-x)); }
__device__ __forceinline__ float siluf(float x) { return x * __builtin_amdgcn_rcpf(1.f + __expf(-x)); }
__device__ __forceinline__ float logsig(float x) { return x >= 0.f ? -log1pf(expf(-x)) : x - log1pf(expf(x)); }
__device__ __forceinline__ float wave_sum(float v) {
#pragma unroll
    for (int o = 1; o < 64; o <<= 1) v += __shfl_xor(v, o);
    return v;
}
#define LDS_WAIT() asm volatile("s_waitcnt lgkmcnt(0)" ::: "memory")
__device__ __forceinline__ float clamp8(float x) { return __builtin_amdgcn_fmed3f(x, -448.f, 448.f); }
__device__ __forceinline__ unsigned pk4_fp8(float a, float b, float c, float d) {
    int r = __builtin_amdgcn_cvt_pk_fp8_f32(clamp8(a), clamp8(b), 0, false); r = __builtin_amdgcn_cvt_pk_fp8_f32(clamp8(c), clamp8(d), r, true); return (unsigned)r; }
constexpr float W8_SCALE = 64.f, W8_INV = 1.f / 64.f;
__device__ __forceinline__ unsigned q8(float g) { return (unsigned)__builtin_amdgcn_fmed3f(g * 255.f + 0.5f, 0.f, 255.f); }
__device__ __forceinline__ unsigned pk4_u8(float a, float b, float c, float d) { return q8(a) | (q8(b) << 8) | (q8(c) << 16) | (q8(d) << 24); }
__device__ __forceinline__ float u8f(unsigned w, int i) { return (float)((w >> (8 * i)) & 255u); }

struct Params {
    const float* in[27];
    float* out;
    unsigned char* ws;
    int ph_lo, ph_hi;
};


#define XB_TMO      128
#define XB_XCNT(j)  (256  + 64 * (j))
#define XB_XSUB(j)  (1280 + 64 * (j))
#define XB_XGEN(j)  (2304 + 64 * (j))
#define XB_TOP      3328
#define XB_TOPGEN   3392
#define XCD_BAR_WORDS 3456
#define XB_SPIN_CAP (1u << 18)
__device__ __forceinline__ unsigned xb_ld(unsigned* p)              { return __hip_atomic_load(p, __ATOMIC_RELAXED, __HIP_MEMORY_SCOPE_AGENT); }
__device__ __forceinline__ unsigned xb_add(unsigned* p, unsigned v) { return __hip_atomic_fetch_add(p, v, __ATOMIC_RELAXED, __HIP_MEMORY_SCOPE_AGENT); }
__device__ __forceinline__ unsigned xb_xcc_id() { return (unsigned)__builtin_amdgcn_s_getreg((3 << 11) | 20) & 0xFu; }
#define XB_SPIN(cond, bar) do { unsigned _sp = 0; while (cond) { __builtin_amdgcn_s_sleep(1); \
    if ((++_sp & 255u) == 0u) { if (xb_ld(&(bar)[XB_TMO])) break; if (_sp > XB_SPIN_CAP) { atomicAdd(&(bar)[XB_TMO], 1u); break; } } } } while (0)
struct XcdBarrier { unsigned* bar; unsigned x; volatile LAS unsigned* st; };
__device__ __forceinline__ XcdBarrier xcd_barrier_post(unsigned* bar, volatile LAS unsigned* st) {
    XcdBarrier b; b.bar = bar; b.x = xb_xcc_id(); b.st = st;
    if (threadIdx.x == 0) (void)xb_add(&bar[XB_XCNT(b.x)], 1u);
    return b;
}
__device__ __forceinline__ void xcd_barrier_complete(unsigned* bar, unsigned x, unsigned& nloc, unsigned& nx) {
    const unsigned G = gridDim.x * gridDim.y * gridDim.z;
    unsigned sum, cnt, mine, sp = 0u;
    for (;;) {
        sum = 0u; cnt = 0u; mine = 0u;
#pragma unroll
        for (unsigned j = 0; j < 16; ++j) { const unsigned c = xb_ld(&bar[XB_XCNT(j)]); sum += c; cnt += (c > 0u) ? 1u : 0u; mine = (j == x) ? c : mine; }
        if (sum == G) break;
        __builtin_amdgcn_s_sleep(1);
        if ((++sp & 255u) == 0u) { if (xb_ld(&bar[XB_TMO])) break; if (sp > XB_SPIN_CAP) { atomicAdd(&bar[XB_TMO], 1u); break; } }
    }
    nloc = mine > 0u ? mine : 1u; nx = cnt > 0u ? cnt : 1u;
}
__device__ __forceinline__ void xcd_barrier(const XcdBarrier& b) {
    asm volatile("s_waitcnt vmcnt(0)" ::: "memory");
    __syncthreads();
    if (threadIdx.x == 0) {
        unsigned* bar = b.bar;
        __builtin_amdgcn_s_waitcnt(0);
        unsigned nloc = b.st[0], nx = b.st[1];
        if (nloc == 0u) { xcd_barrier_complete(bar, b.x, nloc, nx); b.st[0] = nloc; b.st[1] = nx; }
        const unsigned old = xb_add(&bar[XB_XSUB(b.x)], 1u);
        const unsigned gen = old / nloc;
        if (old + 1u == (gen + 1u) * nloc) {
            __builtin_amdgcn_fence(__ATOMIC_RELEASE, "agent");
            asm volatile("s_waitcnt vmcnt(0)" ::: "memory");
            const unsigned og = xb_add(&bar[XB_TOP], 1u);
            const unsigned tg = og / nx;
            if (og + 1u == (tg + 1u) * nx) xb_add(&bar[XB_TOPGEN], 1u);
            else XB_SPIN(xb_ld(&bar[XB_TOPGEN]) == tg, bar);
            __builtin_amdgcn_fence(__ATOMIC_ACQUIRE, "agent");
            xb_add(&bar[XB_XGEN(b.x)], 1u);
            asm volatile("s_waitcnt vmcnt(0)" ::: "memory");
        } else {
            XB_SPIN(xb_ld(&bar[XB_XGEN(b.x)]) == gen, bar);
            __builtin_amdgcn_fence(__ATOMIC_ACQUIRE, "agent");
            asm volatile("s_waitcnt vmcnt(0)" ::: "memory");
        }
    }
    __syncthreads();
}

namespace pg8 {
constexpr int BM = 256, BK = 64, HALF = 128, HTB = HALF * BK * 2, STAGE_BYTES = 8 * HTB;
__device__ __forceinline__ int lds_byte(int r, int c) { const int st = (r >> 4) * 2 + (c >> 5), rr = r & 15, cc = c & 31, ob = rr * 64 + cc * 2; return st * 1024 + (ob ^ (((ob >> 9) & 1) << 5)); }
__device__ __forceinline__ void stage_rc(int b, int& R, int& C) { const int st = b / 1024, sb = b % 1024, swz = sb ^ (((sb >> 9) & 1) << 5); R = (st >> 1) * 16 + swz / 64; C = (st & 1) * 32 + (swz % 64) / 2; }
__device__ __forceinline__ int perm32(int rho) { const int n = rho >> 4, i = rho & 15; return 8 * (i >> 2) + 4 * n + (i & 3); }
__device__ __forceinline__ unsigned cvt_pk_bf16(float lo, float hi) { unsigned r; asm volatile("v_cvt_pk_bf16_f32 %0, %1, %2" : "=v"(r) : "v"(lo), "v"(hi)); return r; }

typedef int v4i_t __attribute__((ext_vector_type(4)));
typedef int v8i_t __attribute__((ext_vector_type(8)));
struct Unit { const char* A; const char* B; int pm, pn, aux; };

struct SchedGrid {
    const char* A; const char* B; size_t tstepA, tstepB; int nM, nN, pm0, pn0, G, c;
    int xN, xPm0, xPn0, xCnt;
    int split, gap;
    __device__ bool next(int i, Unit& u) const {
        const long L = (long)i * G + c; const int nwg = nM * nN;
        if (L >= nwg + xCnt) return false;
        if (L >= nwg) { const int q = (int)L - nwg; u.pm = xPm0 + q / xN; u.pn = xPn0 + q % xN; u.aux = 1; }
        else {
            int wgid = (int)L; { const int q = nwg / 8, r = nwg % 8, xcd = wgid % 8, off = wgid / 8; wgid = (xcd < r ? xcd * (q + 1) : r * (q + 1) + (xcd - r) * q) + off; }
            const int nig = 8 * nN, gid = wgid / nig, fm = gid * 8, gsz = (nM - fm) < 8 ? (nM - fm) : 8;
            u.pm = pm0 + fm + ((wgid % nig) % gsz); { const int idx = (wgid % nig) / gsz; u.pn = pn0 + idx + (idx >= split ? gap : 0); } u.aux = 0;
        }
        u.A = A + (size_t)u.pm * tstepA; u.B = B + (size_t)u.pn * tstepB; return true;
    }
};
struct SchedChain {
    SchedGrid G; size_t half;
    __device__ bool next(int i, Unit& u) const {
        if (!G.next(i >> 1, u)) return false;
        u.aux = i & 1; u.A += (size_t)(i & 1) * half; u.B += (size_t)(i & 1) * half; return true;
    }
};

struct SchedMoe {
    const char* A; const char* B; size_t tstepA, tstepB, estepA, estepB; int nM, nN, G, c;
    __device__ bool next(int i, Unit& u) const {
        const long L = (long)i * G + c; const int e8 = (int)(L % 8); const long ta = L / 8; const int per = nM * nN;
        if (ta >= 2L * per) return false;
        const int e = e8 + 8 * (int)(ta / per); const int t = (int)(ta % per);
        if (nN == 16) { const int blk = t >> 5, wi = t & 31; u.pm = 4 * (blk >> 1) + (wi >> 3); u.pn = 8 * (blk & 1) + (wi & 7); }
        else { u.pm = t / nN; u.pn = t % nN; }
        u.aux = e;
        u.A = A + (size_t)e * estepA + (size_t)u.pm * tstepA; u.B = B + (size_t)e * estepB + (size_t)u.pn * tstepB; return true;
    }
};

template <class Epi, class Sched, bool NORMAL, bool F8 = false>
__device__ __forceinline__ void gemm_phase(LAS unsigned char* lds, const int K  , const unsigned lda, const unsigned ldb, const Sched& S, const Epi& E) {
    const int tid = threadIdx.x, wid = __builtin_amdgcn_readfirstlane(tid >> 6), lane = tid & 63, wr = wid >> 2, wc = wid & 3, fr = lane & 15, fq = lane >> 4;
    const int nt = K / BK;
    unsigned voffA[2], voffB[2];
#pragma unroll
    for (int i = 0; i < 2; ++i) { int R, C; stage_rc(tid * 16 + i * 8192, R, C); const int Rb = Epi::PERM ? ((R & ~31) + perm32(R & 31)) : R;
        voffA[i] = (unsigned)R * lda + (unsigned)C * 2u; voffB[i] = (unsigned)Rb * ldb + (unsigned)C * 2u; }
    const size_t kstep = (size_t)(BK * 2);
    const size_t hstepA = (size_t)HALF * lda, hstepB = (size_t)HALF * ldb;
    const unsigned ldsw = (unsigned)wid * 1024u;
    const int aoff = lds_byte(wr * 64 + fr, fq * 8), boff = lds_byte(wc * 32 + fr, fq * 8);
#define PG8_SA(b, h) (((b) * 2 + (h)) * HTB)
#define PG8_SB(b, h) ((4 + (b) * 2 + (h)) * HTB)
#define PG8_STAGE(bufoff, gbase, voff) do { _Pragma("unroll") for (int _i = 0; _i < 2; ++_i) \
        __builtin_amdgcn_global_load_lds((const unsigned*)((const char*)(gbase) + (voff)[_i]), (LAS unsigned*)(lds + (bufoff) + ldsw + _i * 8192), 16, 0, 0); } while (0)
#define PG8_LDA(dst, b, h) do { if constexpr (F8) { _Pragma("unroll") for (int m = 0; m < 4; ++m) dst##8[m] = __builtin_shufflevector(*(const LAS v4i_t*)(lds + PG8_SA(b, h) + aoff + m * 2048), *(const LAS v4i_t*)(lds + PG8_SA(b, h) + aoff + m * 2048 + 1024), 0, 1, 2, 3, 4, 5, 6, 7); } \
        else { _Pragma("unroll") for (int m = 0; m < 4; ++m) _Pragma("unroll") for (int k = 0; k < 2; ++k) dst[m][k] = *(const LAS bf16x8*)(lds + PG8_SA(b, h) + aoff + m * 2048 + k * 1024); } } while (0)
#define PG8_LDB(dst, b, h) do { if constexpr (F8) { _Pragma("unroll") for (int n = 0; n < 2; ++n) dst##8[n] = __builtin_shufflevector(*(const LAS v4i_t*)(lds + PG8_SB(b, h) + boff + n * 2048), *(const LAS v4i_t*)(lds + PG8_SB(b, h) + boff + n * 2048 + 1024), 0, 1, 2, 3, 4, 5, 6, 7); } \
        else { _Pragma("unroll") for (int n = 0; n < 2; ++n) _Pragma("unroll") for (int k = 0; k < 2; ++k) dst[n][k] = *(const LAS bf16x8*)(lds + PG8_SB(b, h) + boff + n * 2048 + k * 1024); } } while (0)
#define PG8_MMA(ai, bj, At, Bt) do { __builtin_amdgcn_s_setprio(1); \
        if constexpr (F8) { _Pragma("unroll") for (int m = 0; m < 4; ++m) _Pragma("unroll") for (int n = 0; n < 2; ++n) \
            asm volatile("v_mfma_scale_f32_16x16x128_f8f6f4 %0, %1, %2, %0, %3, %3 op_sel_hi:[0,0,0]" : "+v"(acc[ai][bj][m][n]) : "v"(Bt##8[n]), "v"(At##8[m]), "v"(sc8)); } \
        else { _Pragma("unroll") for (int m = 0; m < 4; ++m) _Pragma("unroll") for (int n = 0; n < 2; ++n) _Pragma("unroll") for (int k = 0; k < 2; ++k) \
        acc[ai][bj][m][n] = NORMAL ? __builtin_amdgcn_mfma_f32_16x16x32_bf16(At[m][k], Bt[n][k], acc[ai][bj][m][n], 0, 0, 0) \
                                   : __builtin_amdgcn_mfma_f32_16x16x32_bf16(Bt[n][k], At[m][k], acc[ai][bj][m][n], 0, 0, 0); } __builtin_amdgcn_s_setprio(0); } while (0)
#define PG8_WAIT_V(n) asm volatile("s_waitcnt vmcnt(" #n ")" ::: "memory")
#define PG8_WAIT_L(n) asm volatile("s_waitcnt lgkmcnt(" #n ")" ::: "memory")
#define PG8_BAR __builtin_amdgcn_s_barrier()
#define PG8_SCHED __builtin_amdgcn_sched_barrier(0)
    Unit cur, nxt; int ui = 0;
    if (!S.next(0, cur)) return;
    f32x4 acc[2][2][4][2];
#pragma unroll
    for (int a = 0; a < 2; ++a)
#pragma unroll
        for (int b = 0; b < 2; ++b)
#pragma unroll
            for (int m = 0; m < 4; ++m)
#pragma unroll
                for (int n = 0; n < 2; ++n) acc[a][b][m][n] = (f32x4){0.f, 0.f, 0.f, 0.f};
    bf16x8 At[4][2], B0[2][2], B1[2][2];
    v8i_t At8[4], B08[2], B18[2]; const int sc8 = 0x7F7F7F7F;
    const char* cA = cur.A; const char* cB = cur.B;
    PG8_STAGE(PG8_SB(0, 0), cB, voffB); PG8_STAGE(PG8_SB(0, 1), cB + hstepB, voffB); PG8_STAGE(PG8_SA(0, 0), cA, voffA); PG8_STAGE(PG8_SA(0, 1), cA + hstepA, voffA);
    if (wr == 1) PG8_BAR;
    PG8_WAIT_V(2); PG8_BAR;
    PG8_STAGE(PG8_SB(1, 0), cB + kstep, voffB); PG8_STAGE(PG8_SA(1, 0), cA + kstep, voffA); PG8_STAGE(PG8_SB(1, 1), cB + hstepB + kstep, voffB);
    PG8_WAIT_V(6); PG8_BAR;
    for (;;) {
        const bool has_next = S.next(ui + 1, nxt);
        const char* nA = has_next ? nxt.A : cA; const char* nB = has_next ? nxt.B : cB;
#pragma unroll 1
        for (int t = 0; t < nt; t += 2) {
            const bool last = (t == nt - 2);
            const char* a1 = cA + (size_t)(t + 1) * kstep;
            const char* a2 = last ? nA : cA + (size_t)(t + 2) * kstep; const char* b2 = last ? nB : cB + (size_t)(t + 2) * kstep;
            const char* a3 = a2 + kstep; const char* b3 = b2 + kstep;
            PG8_LDB(B0, 0, 0); PG8_LDB(B1, 0, 1); PG8_SCHED; PG8_LDA(At, 0, 0); PG8_STAGE(PG8_SA(1, 1), a1 + hstepA, voffA);
            PG8_WAIT_V(8); PG8_WAIT_L(0); PG8_BAR; PG8_MMA(0, 0, At, B0); PG8_MMA(0, 1, At, B1); PG8_BAR; PG8_SCHED;
            PG8_LDA(At, 0, 1); PG8_STAGE(PG8_SB(0, 0), b2, voffB); PG8_STAGE(PG8_SB(0, 1), b2 + hstepB, voffB); PG8_STAGE(PG8_SA(0, 0), a2, voffA);
            PG8_WAIT_V(8); PG8_WAIT_L(0); PG8_BAR; PG8_MMA(1, 0, At, B0); PG8_MMA(1, 1, At, B1); PG8_BAR; PG8_SCHED;
            PG8_LDB(B0, 1, 0); PG8_LDB(B1, 1, 1); PG8_SCHED; PG8_LDA(At, 1, 0); PG8_STAGE(PG8_SA(0, 1), a2 + hstepA, voffA);
            PG8_WAIT_V(8); PG8_WAIT_L(0); PG8_BAR; PG8_MMA(0, 0, At, B0); PG8_MMA(0, 1, At, B1); PG8_BAR; PG8_SCHED;
            PG8_LDA(At, 1, 1); PG8_STAGE(PG8_SB(1, 0), b3, voffB); PG8_STAGE(PG8_SB(1, 1), b3 + hstepB, voffB); PG8_STAGE(PG8_SA(1, 0), a3, voffA);
            PG8_WAIT_V(8); PG8_WAIT_L(0); PG8_BAR; PG8_MMA(1, 0, At, B0); PG8_MMA(1, 1, At, B1); PG8_BAR; PG8_SCHED;
        }
        if (wr == 0) PG8_BAR;
        if constexpr (F8) asm volatile("s_nop 15\n\ts_nop 15" ::: "memory");
        bool keep = false;
        if constexpr (Epi::HAS_MID) { if (cur.aux == 0) { E.mid(acc, cur, wr, wc, fr, fq); keep = true; } else E(acc, cur, wr, wc, fr, fq); }
        else E(acc, cur, wr, wc, fr, fq);
        if (!has_next) break;
        if (!keep) {
#pragma unroll
        for (int a = 0; a < 2; ++a)
#pragma unroll
            for (int b = 0; b < 2; ++b)
#pragma unroll
                for (int m = 0; m < 4; ++m)
#pragma unroll
                    for (int n = 0; n < 2; ++n) acc[a][b][m][n] = (f32x4){0.f, 0.f, 0.f, 0.f};
        }
        cur = nxt; cA = nA; cB = nB; ++ui;
        if (wr == 1) PG8_BAR;
    }
    PG8_WAIT_V(0);
    PG8_BAR;
#undef PG8_SA
#undef PG8_SB
#undef PG8_STAGE
#undef PG8_LDA
#undef PG8_LDB
#undef PG8_MMA
#undef PG8_WAIT_V
#undef PG8_WAIT_L
#undef PG8_BAR
#undef PG8_SCHED
}


struct EpiCM {
    static constexpr bool PERM = false, HAS_MID = false;
    bf16_t* pcm; bf16_t* kvcm; const float* bias;
    __device__ __forceinline__ void operator()(const f32x4 (&acc)[2][2][4][2], const Unit& u, int wr, int wc, int fr, int fq) const {
        const bool kv = u.pn >= 8;
#pragma unroll
        for (int bj = 0; bj < 2; ++bj)
#pragma unroll
            for (int n = 0; n < 2; ++n) {
                const int c = u.pn * BM + bj * HALF + wc * 32 + n * 16 + fr; const float bv = bias[c];
                bf16_t* base = kv ? (kvcm + (size_t)(c - 2048) * MT) : (pcm + (size_t)c * MX);
#pragma unroll
                for (int ai = 0; ai < 2; ++ai)
#pragma unroll
                    for (int m = 0; m < 4; ++m) {
                        const int r = u.pm * BM + ai * HALF + wr * 64 + m * 16 + 4 * fq; const f32x4 v = acc[ai][bj][m][n] + bv;
                        u32x2 w; w.x = cvt_pk_bf16(v[0], v[1]); w.y = cvt_pk_bf16(v[2], v[3]);
                        *(u32x2*)(base + r) = w; }
                asm volatile("" ::: "memory");
            }
    }
};

struct EpiIn2 {
    static constexpr bool PERM = true, HAS_MID = false;
    bf16_t* pml; unsigned char* pmg; const float* bias;
    __device__ __forceinline__ void operator()(const f32x4 (&acc)[2][2][4][2], const Unit& u, int wr, int wc, int fr, int fq) const {
        const int colt = u.pn * BM; int cbase, bofs = 0; const int row0 = u.pm * BM; bool sg = false;
        if (colt < 2048) cbase = colt - 1536;
        else if (colt < GATE0) cbase = colt - 3072 + 512;
        else { cbase = colt - GATE0; bofs = 16; sg = true; }
        const int col0 = cbase + wc * 32 + 8 * fq, bcol0 = colt + bofs + wc * 32 + 8 * fq;
        f32x4 bv[2][2];
#pragma unroll
        for (int bj = 0; bj < 2; ++bj)
#pragma unroll
            for (int n = 0; n < 2; ++n) bv[bj][n] = *(const f32x4*)(bias + bcol0 + bj * HALF + 4 * n);
#pragma unroll
        for (int ai = 0; ai < 2; ++ai)
#pragma unroll
            for (int m = 0; m < 4; ++m) { const size_t row = (size_t)(row0 + wr * 64 + fr + ai * HALF + m * 16);
#pragma unroll
                for (int bj = 0; bj < 2; ++bj) { f32x4 v0 = acc[ai][bj][m][0] + bv[bj][0], v1 = acc[ai][bj][m][1] + bv[bj][1];
                    if (sg) { u32x2 w; w.x = pk4_u8(sigm(v0[0]), sigm(v0[1]), sigm(v0[2]), sigm(v0[3])); w.y = pk4_u8(sigm(v1[0]), sigm(v1[1]), sigm(v1[2]), sigm(v1[3]));
                        *(u32x2*)(pmg + row * 2048 + col0 + bj * HALF) = w; }
                    else { u32x4 w; w.x = cvt_pk_bf16(v0[0], v0[1]); w.y = cvt_pk_bf16(v0[2], v0[3]); w.z = cvt_pk_bf16(v1[0], v1[1]); w.w = cvt_pk_bf16(v1[2], v1[3]);
                        *(u32x4*)(pml + row * 1024 + col0 + bj * HALF) = w; } }
                asm volatile("" ::: "memory"); }
    }
};

struct EpiMerge {
    static constexpr bool PERM = true, HAS_MID = true;
    bf16_t* Z; const unsigned char* pmg;
    __device__ __forceinline__ void mid(f32x4 (&acc)[2][2][4][2], const Unit& u, int wr, int wc, int fr, int fq) const {
        const int row0 = u.pm * BM + wr * 64 + fr, col0 = u.pn * BM + wc * 32 + 8 * fq;
#pragma unroll
        for (int ai = 0; ai < 2; ++ai) {
            u32x2 ga[4][2], gb[4][2];
#pragma unroll
            for (int m = 0; m < 4; ++m)
#pragma unroll
                for (int bj = 0; bj < 2; ++bj) { const unsigned char* gp = pmg + (size_t)(row0 + ai * HALF + m * 16) * 2048 + col0 + bj * HALF;
                    ga[m][bj] = *(const u32x2*)gp; gb[m][bj] = *(const u32x2*)(gp + 1024); }
#pragma unroll
            for (int m = 0; m < 4; ++m)
#pragma unroll
                for (int bj = 0; bj < 2; ++bj) { const u32x2 a = ga[m][bj], b = gb[m][bj];
                    f32x4& v0 = acc[ai][bj][m][0]; f32x4& v1 = acc[ai][bj][m][1];
#pragma unroll
                    for (int j = 0; j < 4; ++j) { v0[j] *= u8f(a.x, j) * __builtin_amdgcn_rcpf(fmaxf(u8f(b.x, j), 1.f)); v1[j] *= u8f(a.y, j) * __builtin_amdgcn_rcpf(fmaxf(u8f(b.y, j), 1.f)); } }
            asm volatile("" ::: "memory"); }
    }
    __device__ __forceinline__ void operator()(const f32x4 (&acc)[2][2][4][2], const Unit& u, int wr, int wc, int fr, int fq) const {
        const int row0 = u.pm * BM + wr * 64 + fr, col0 = u.pn * BM + wc * 32 + 8 * fq;
#pragma unroll
        for (int ai = 0; ai < 2; ++ai) {
            u32x2 g[4][2];
#pragma unroll
            for (int m = 0; m < 4; ++m)
#pragma unroll
                for (int bj = 0; bj < 2; ++bj) g[m][bj] = *(const u32x2*)(pmg + (size_t)(row0 + ai * HALF + m * 16) * 2048 + 1024 + col0 + bj * HALF);
#pragma unroll
            for (int m = 0; m < 4; ++m)
#pragma unroll
                for (int bj = 0; bj < 2; ++bj) { const size_t row = (size_t)(row0 + ai * HALF + m * 16); const u32x2 gg = g[m][bj];
                    f32x4 v0 = acc[ai][bj][m][0], v1 = acc[ai][bj][m][1];
#pragma unroll
                    for (int j = 0; j < 4; ++j) { v0[j] *= fmaxf(u8f(gg.x, j), 1.f) * (1.f / 255.f); v1[j] *= fmaxf(u8f(gg.y, j), 1.f) * (1.f / 255.f); }
                    u32x4 w; w.x = cvt_pk_bf16(v0[0], v0[1]); w.y = cvt_pk_bf16(v0[2], v0[3]); w.z = cvt_pk_bf16(v1[0], v1[1]); w.w = cvt_pk_bf16(v1[2], v1[3]);
                    *(u32x4*)(Z + row * 1024 + col0 + bj * HALF) = w; }
            asm volatile("" ::: "memory"); }
    }
};

struct EpiOut {
    static constexpr bool PERM = true, HAS_MID = false;
    const float* x; bf16_t* xmid; const float* ada;
    __device__ __forceinline__ void operator()(const f32x4 (&acc)[2][2][4][2], const Unit& u, int wr, int wc, int fr, int fq) const {
        const int row0 = u.pm * BM + wr * 64 + fr, col0 = u.pn * BM + wc * 32 + 8 * fq;
        const int b = (u.pm * BM) / SEQ;
        f32x4 gv[2][2];
#pragma unroll
        for (int bj = 0; bj < 2; ++bj)
#pragma unroll
            for (int n = 0; n < 2; ++n) gv[bj][n] = *(const f32x4*)(ada + (size_t)b * 6144 + 2048 + col0 + bj * HALF + 4 * n);
#pragma unroll
        for (int ai = 0; ai < 2; ++ai)
#pragma unroll
            for (int m = 0; m < 4; ++m) {
                f32x4 xv[2][2]; const size_t off = (size_t)(row0 + ai * HALF + m * 16) * DM + col0;
#pragma unroll
                for (int bj = 0; bj < 2; ++bj)
#pragma unroll
                    for (int n = 0; n < 2; ++n) xv[bj][n] = *(const f32x4*)(x + off + bj * HALF + 4 * n);
#pragma unroll
                for (int bj = 0; bj < 2; ++bj) { const f32x4 v0 = xv[bj][0] + gv[bj][0] * acc[ai][bj][m][0], v1 = xv[bj][1] + gv[bj][1] * acc[ai][bj][m][1];
                    u32x4 w; w.x = cvt_pk_bf16(v0[0], v0[1]); w.y = cvt_pk_bf16(v0[2], v0[3]); w.z = cvt_pk_bf16(v1[0], v1[1]); w.w = cvt_pk_bf16(v1[2], v1[3]);
                    *(u32x4*)(xmid + off + bj * HALF) = w; }
                if (m & 1) asm volatile("" ::: "memory"); }
    }
};

struct EpiMoe1 {
    static constexpr bool PERM = true, HAS_MID = false;
    unsigned char* act; int skip;
    __device__ __forceinline__ void operator()(const f32x4 (&acc)[2][2][4][2], const Unit& u, int wr, int wc, int fr, int fq) const {
        if (skip == 1) { asm volatile("" :: "v"(acc[0][0][0][0]), "v"(acc[1][1][3][1])); return; }
        const int row0 = u.aux * 4096 + u.pm * BM + wr * 64 + fr, col0 = (u.pn * BM + wc * 32) / 2 + 4 * fq;
#pragma unroll
        for (int ai = 0; ai < 2; ++ai)
#pragma unroll
            for (int m = 0; m < 4; ++m) { unsigned char* rowp = act + (size_t)(row0 + ai * HALF + m * 16) * DFF + col0;
#pragma unroll
                for (int bj = 0; bj < 2; ++bj) { const f32x4 v0 = acc[ai][bj][m][0] * W8_INV, v1 = acc[ai][bj][m][1] * W8_INV;
                    const unsigned pk = pk4_fp8(siluf(v0[0]) * v0[1], siluf(v0[2]) * v0[3], siluf(v1[0]) * v1[1], siluf(v1[2]) * v1[3]);
                    if (skip == 2) asm volatile("" :: "v"(pk)); else *(unsigned*)(rowp + bj * (HALF / 2)) = pk; }
                asm volatile("" ::: "memory"); }
    }
};

struct EpiMoe2 {
    static constexpr bool PERM = true, HAS_MID = false;
    bf16_t* ye; const float* sgate; bool skip;
    __device__ __forceinline__ void operator()(const f32x4 (&acc)[2][2][4][2], const Unit& u, int wr, int wc, int fr, int fq) const {
        if (skip) { asm volatile("" :: "v"(acc[0][0][0][0]), "v"(acc[1][1][3][1])); return; }
        const int e = u.aux, col0 = u.pn * BM + wc * 32 + 8 * fq;
        float gt[2][4];
#pragma unroll
        for (int ai = 0; ai < 2; ++ai)
#pragma unroll
            for (int m = 0; m < 4; ++m) { const int rr = u.pm * BM + wr * 64 + fr + ai * HALF + m * 16; gt[ai][m] = sgate[((rr >> 9) * NE + e) * CAP + (rr & 511)] * W8_INV; }
#pragma unroll
        for (int ai = 0; ai < 2; ++ai)
#pragma unroll
            for (int m = 0; m < 4; ++m) { const int rr = u.pm * BM + wr * 64 + fr + ai * HALF + m * 16;
                const float g = gt[ai][m];
                bf16_t* rowp = ye + ((size_t)e * 4096 + rr) * DM + col0;
#pragma unroll
                for (int bj = 0; bj < 2; ++bj) { const f32x4 v0 = acc[ai][bj][m][0] * g, v1 = acc[ai][bj][m][1] * g;
                    u32x4 w; w.x = cvt_pk_bf16(v0[0], v0[1]); w.y = cvt_pk_bf16(v0[2], v0[3]); w.z = cvt_pk_bf16(v1[0], v1[1]); w.w = cvt_pk_bf16(v1[2], v1[3]);
                    *(u32x4*)(rowp + bj * HALF) = w; }
                asm volatile("" ::: "memory"); }
    }
};
}

struct Ctx {
    LAS unsigned char* lds;
    int tid, lane, wave, bid, G;
};

__device__ __forceinline__ void transpose_item(const float* W, int ldw, int ldt, int ncol0, bf16_t* WT, int dst_row0, int rmul, LAS float* scr, int kb, int nb, int lane) {
    const int k0 = 64 * kb, n0 = 32 * nb;
#pragma unroll 8
    for (int i = 0; i < 32; ++i) { const int kk = 2 * i + (lane >> 5); scr[kk * 33 + (lane & 31)] = W[(size_t)(k0 + kk) * ldw + ncol0 + n0 + (lane & 31)]; }
    LDS_WAIT();
    const int c = lane & 7;
#pragma unroll
    for (int j = 0; j < 4; ++j) { const int n = (lane >> 3) + 8 * j; const LAS float* s = scr + (8 * c) * 33 + n;
        u32x4 o; o.x = pk2(s[0 * 33], s[1 * 33]); o.y = pk2(s[2 * 33], s[3 * 33]); o.z = pk2(s[4 * 33], s[5 * 33]); o.w = pk2(s[6 * 33], s[7 * 33]);
        *(u32x4*)(WT + (size_t)(dst_row0 + (n0 + n) * rmul) * ldt + k0 + 8 * c) = o; }
    LDS_WAIT();
}

__device__ __forceinline__ void transpose_item_f8(const float* W, int ldw, int K, unsigned char* WT, int dst_row0, int rmul, LAS float* scr, int kb, int nb, int lane) {
    const int k0 = 64 * kb, n0 = 32 * nb;
#pragma unroll 8
    for (int i = 0; i < 32; ++i) { const int kk = 2 * i + (lane >> 5); scr[kk * 33 + (lane & 31)] = W[(size_t)(k0 + kk) * ldw + n0 + (lane & 31)]; }
    LDS_WAIT();
    const int c = lane & 3;
#pragma unroll
    for (int j = 0; j < 2; ++j) { const int n = (lane >> 2) + 16 * j; const LAS float* s = scr + (16 * c) * 33 + n;
        u32x4 o;
        o.x = pk4_fp8(s[0 * 33] * W8_SCALE, s[1 * 33] * W8_SCALE, s[2 * 33] * W8_SCALE, s[3 * 33] * W8_SCALE);
        o.y = pk4_fp8(s[4 * 33] * W8_SCALE, s[5 * 33] * W8_SCALE, s[6 * 33] * W8_SCALE, s[7 * 33] * W8_SCALE);
        o.z = pk4_fp8(s[8 * 33] * W8_SCALE, s[9 * 33] * W8_SCALE, s[10 * 33] * W8_SCALE, s[11 * 33] * W8_SCALE);
        o.w = pk4_fp8(s[12 * 33] * W8_SCALE, s[13 * 33] * W8_SCALE, s[14 * 33] * W8_SCALE, s[15 * 33] * W8_SCALE);
        *(u32x4*)(WT + (size_t)(dst_row0 + (n0 + n) * rmul) * K + k0 + 16 * c) = o; }
    LDS_WAIT();
}

__device__ __forceinline__ void convert_experts(const Ctx& C, const Params& P) {
    unsigned char* w13 = P.ws + WS_W13; unsigned char* w2 = P.ws + WS_W2;
    LAS float* scr = (LAS float*)(C.lds + C.wave * 8448);
    const int PER_E = 3072;
    const int nbusy = (BATCH * NE < C.G) ? BATCH * NE : C.G, nfree = C.G - nbusy;
    const int NPRE = (nfree > 0) ? 6912 : 0;
    for (int pass = 0; pass < 2; ++pass) {
    const int lo = pass ? NPRE : 0, hi = pass ? NE * PER_E : NPRE;
    const int gw = pass ? (C.bid * 8 + C.wave) : ((C.bid - nbusy) * 8 + C.wave), NGW = pass ? C.G * 8 : nfree * 8;
    if (!pass && C.bid < nbusy) continue;
    for (int it = lo + gw; it < hi; it += NGW) {
        const int e = it / PER_E, r = it % PER_E;
        if (r < 1024) transpose_item_f8(P.in[23] + (size_t)e * DM * DFF, DFF, DM, w13 + (size_t)e * 4096 * DM, 0, 2, scr, r / 64, r % 64, C.lane);
        else if (r < 2048) transpose_item_f8(P.in[24] + (size_t)e * DM * DFF, DFF, DM, w13 + (size_t)e * 4096 * DM, 1, 2, scr, (r - 1024) / 64, (r - 1024) % 64, C.lane);
        else transpose_item_f8(P.in[25] + (size_t)e * DFF * DM, DM, DFF, w2 + (size_t)e * DM * DFF, 0, 1, scr, (r - 2048) / 32, (r - 2048) % 32, C.lane);
    }
    }
}

__device__ __forceinline__ void phase0(const Ctx& C, const Params& P) {
    unsigned char* ws = P.ws;
    const int gw = C.bid * 8 + C.wave, NGW = C.G * 8;
    {
        LAS float* scr = (LAS float*)(C.lds + C.wave * 8448);
        const int I_IN1 = 16 * 112, I_IN2 = 16 * 64, I_BH = 8 * 32, I_BM = 8 * 32, I_OUT = 16 * 32;
        const int NIT = I_IN1 + I_IN2 + I_BH + I_BM + I_OUT;
        for (int it = gw; it < NIT; it += NGW) {
            int r = it;
            if (r < I_IN1) { transpose_item(P.in[8], DIN, DM, 0, (bf16_t*)(ws + WS_WIN), 0, 1, scr, r / 112, r % 112, C.lane); continue; } r -= I_IN1;
            if (r < I_IN2) { transpose_item(P.in[8], DIN, DM, MERGE0, (bf16_t*)(ws + WS_WIN), GATE0, 1, scr, r / 64, r % 64, C.lane); continue; } r -= I_IN2;
            if (r < I_BH) { transpose_item(P.in[19], DM, 1024, 0, (bf16_t*)(ws + WS_WB), 0, 1, scr, r / 32, r % 32, C.lane); continue; } r -= I_BH;
            if (r < I_BM) { transpose_item(P.in[20], DM, 1024, 0, (bf16_t*)(ws + WS_WB) + 512, 0, 1, scr, r / 32, r % 32, C.lane); continue; } r -= I_BM;
            transpose_item(P.in[21], DM, DM, 0, (bf16_t*)(ws + WS_WOUT), 0, 1, scr, r / 32, r % 32, C.lane);
        }
    }
    {
        const float* wada = P.in[4]; const float* bada = P.in[5]; float* part = (float*)(ws + WS_ADAP);
        for (int it = gw; it < 96 * 8; it += NGW) {
            const int cgp = it % 96, ks = it / 96, n = cgp * 64 + C.lane;
            float a[9];
#pragma unroll
            for (int r = 0; r < 9; ++r) a[r] = 0.f;
#pragma unroll 1
            for (int k1 = 0; k1 < 4; ++k1) {
                const int k0 = ks * 128 + k1 * 32;
                float sv[9];
                { const int k = k0 + (C.lane & 31);
#pragma unroll
                  for (int r = 0; r < 8; ++r) sv[r] = siluf(P.in[1][r * DM + k]);
                  sv[8] = siluf(P.in[3][k]); }
                float wv[32];
#pragma unroll
                for (int kk = 0; kk < 32; ++kk) wv[kk] = wada[(size_t)(k0 + kk) * 6144 + n];
#pragma unroll
                for (int kk = 0; kk < 32; ++kk) {
#pragma unroll
                    for (int r = 0; r < 9; ++r) a[r] += __shfl(sv[r], kk) * wv[kk]; }
            }
            const float bb = (ks == 0) ? bada[n] : 0.f;
#pragma unroll
            for (int r = 0; r < 9; ++r) part[((size_t)ks * 9 + r) * 6144 + n] = a[r] + bb;
        }
    }
    __syncthreads();
    {
        LAS float* zs = (LAS float*)C.lds;
        LAS float* h1 = zs + 16 * 33;
        LAS float* h2 = h1 + 16 * 64;
        LAS float* w1s = h2 + 16 * 64;
        LAS float* w2s = w1s + 33 * 64;
        bf16_t* krev = (bf16_t*)(ws + WS_KREV);
        const float* w1 = P.in[11]; const float* b1 = P.in[12]; const float* w2 = P.in[13]; const float* b2 = P.in[14]; const float* w3 = P.in[15];
        for (int idx = C.tid; idx < 33 * 64; idx += NTHR) w1s[idx] = w1[idx];
        for (int idx = C.tid; idx < 64 * 64; idx += NTHR) w2s[idx] = w2[idx];
        for (int it = C.bid; it < 256; it += C.G) {
            const int l0 = it * 16;
            __syncthreads();
            for (int idx = C.tid; idx < 16 * 33; idx += NTHR) { const int pos = idx / 33, m = idx % 33, l = l0 + pos; float v;
                if (m == 0) v = (float)l / 4095.0f;
                else { const int bi = (m - 1) & 15; const float band = 1e-4f + (float)bi * ((15.0f - 1e-4f) / 15.0f);
                    const float ang = ((float)(2.0 * 3.14159265358979323846 / 4096.0) * (float)l) * band; v = (m <= 16) ? cosf(ang) : sinf(ang); }
                zs[idx] = v; }
            __syncthreads();
            for (int idx = C.tid; idx < 16 * 64; idx += NTHR) { const int pos = idx >> 6, j = idx & 63; float s = b1[j];
#pragma unroll
                for (int m = 0; m < 33; ++m) s += zs[pos * 33 + m] * w1s[m * 64 + j];
                h1[idx] = sinf(s); }
            __syncthreads();
            for (int idx = C.tid; idx < 16 * 64; idx += NTHR) { const int pos = idx >> 6, j = idx & 63; float s = b2[j];
#pragma unroll 16
                for (int k = 0; k < 64; ++k) s += h1[pos * 64 + k] * w2s[k * 64 + j];
                h2[j * 16 + pos] = sinf(s); }
            __syncthreads();
#pragma unroll 1
            for (int q = 0; q < 4; ++q) {
                const int n = C.tid + NTHR * q;
                float a[16];
#pragma unroll
                for (int p = 0; p < 16; ++p) a[p] = 0.f;
                float wv[16];
#pragma unroll
                for (int k = 0; k < 16; ++k) wv[k] = w3[k * 2048 + n];
#pragma unroll 1
                for (int kb = 0; kb < 4; ++kb) {
                    float wc[16];
#pragma unroll
                    for (int k = 0; k < 16; ++k) wc[k] = wv[k];
                    const int kn = (kb < 3) ? (kb + 1) * 16 : 0;
#pragma unroll
                    for (int k = 0; k < 16; ++k) wv[k] = w3[(kn + k) * 2048 + n];
#pragma unroll
                    for (int kk = 0; kk < 16; ++kk) { const float w = wc[kk]; const LAS float* hp = h2 + (kb * 16 + kk) * 16;
#pragma unroll
                        for (int p4 = 0; p4 < 4; ++p4) { const f32x4 hv = *(const LAS f32x4*)(hp + 4 * p4);
                            a[4 * p4] += hv[0] * w; a[4 * p4 + 1] += hv[1] * w; a[4 * p4 + 2] += hv[2] * w; a[4 * p4 + 3] += hv[3] * w; }
                        if (kk & 1) asm volatile("" ::: "memory"); }
                }
                const int o = n >> 10, side = (n >> 9) & 1, c = n & 511;
                const float delta = fabsf(-3.0701134573253944f + (float)c * ((-15.350567286626972f + 3.0701134573253944f) / 511.0f));
                bf16_t* dst = krev + ((size_t)o * 512 + c) * 8192;
#pragma unroll
                for (int p = 0; p < 16; ++p) { const int l = l0 + p; const float t = (float)l / 4095.0f; const float v = a[p] * expf(-t * delta);
                    if (side == 0) dst[4096 - l] = (bf16_t)f2bf(v);
                    else if (l > 0) dst[4096 + l] = (bf16_t)f2bf(v);
                    else dst[0] = 0; }
            }
        }
    }
}

__device__ __forceinline__ int wl_pos(int k) { return ((k & 3) + 4 * (k >> 8)) * 64 + ((k >> 2) & 63); }
__device__ __forceinline__ float row_dot16(const f32x4 (&y)[4], const LAS float* Wl, int lane) {
    float r[16];
#pragma unroll
    for (int e = 0; e < 16; ++e) r[e] = 0.f;
#pragma unroll
    for (int j = 0; j < 4; ++j) {
#pragma unroll
        for (int q = 0; q < 4; ++q) { const float v = y[j][q]; const LAS float* wp = Wl + ((q + 4 * j) * 64 + lane) * 20;
#pragma unroll
            for (int e4 = 0; e4 < 4; ++e4) { const f32x4 w = *(const LAS f32x4*)(wp + e4 * 4);
                r[e4 * 4 + 0] += v * w[0]; r[e4 * 4 + 1] += v * w[1]; r[e4 * 4 + 2] += v * w[2]; r[e4 * 4 + 3] += v * w[3]; } }
        asm volatile("" ::: "memory"); }
    const bool b5 = (lane & 32) != 0, b4 = (lane & 16) != 0, b3 = (lane & 8) != 0, b2 = (lane & 4) != 0;
    float t[8];
#pragma unroll
    for (int e = 0; e < 8; ++e) { const float snd = b5 ? r[e] : r[e + 8], kp = b5 ? r[e + 8] : r[e]; t[e] = kp + __shfl_xor(snd, 32); }
    float u[4];
#pragma unroll
    for (int e = 0; e < 4; ++e) { const float snd = b4 ? t[e] : t[e + 4], kp = b4 ? t[e + 4] : t[e]; u[e] = kp + __shfl_xor(snd, 16); }
    float v2[2];
#pragma unroll
    for (int e = 0; e < 2; ++e) { const float snd = b3 ? u[e] : u[e + 2], kp = b3 ? u[e + 2] : u[e]; v2[e] = kp + __shfl_xor(snd, 8); }
    float s; { const float snd = b2 ? v2[0] : v2[1], kp = b2 ? v2[1] : v2[0]; s = kp + __shfl_xor(snd, 4); }
    s += __shfl_xor(s, 2); s += __shfl_xor(s, 1);
    return s;
}

__device__ __forceinline__ void phase1(const Ctx& C, const Params& P) {
    unsigned char* ws = P.ws;
    const float* part = (const float*)(ws + WS_ADAP); float* ada = (float*)(ws + WS_ADA);
    for (int o = C.bid * NTHR + C.tid; o < 9 * 6144; o += C.G * NTHR) { float s = 0.f;
#pragma unroll
        for (int ks = 0; ks < 8; ++ks) s += part[(size_t)ks * 9 * 6144 + o];
        ada[o] = s; }
    LAS float* Wg = (LAS float*)C.lds;
    LAS float* mod = Wg + 1024 * 20;
#pragma unroll 1
    for (int i0 = C.tid; i0 < 1024 * 16; i0 += 8 * NTHR) { float t8[8];
#pragma unroll
        for (int u = 0; u < 8; ++u) { const int idx = i0 + u * NTHR; t8[u] = P.in[8][(size_t)(idx >> 4) * DIN + GATE0 + (idx & 15)]; }
#pragma unroll
        for (int u = 0; u < 8; ++u) { const int idx = i0 + u * NTHR; Wg[wl_pos(idx >> 4) * 20 + (idx & 15)] = t8[u]; } }
    const float* gmix = P.in[6]; const float* bin = P.in[9];
    bf16_t* hx = (bf16_t*)(ws + WS_HX); float* gates = (float*)(ws + WS_GATES);
    for (int rg = C.bid; rg < 256; rg += C.G) {
        const int b = rg >> 5;
        __syncthreads();
#pragma unroll 2
        for (int idx = C.tid; idx < 4096; idx += NTHR) { const int which = idx >> 10, k = idx & 1023; const int r = (which < 2) ? b : 8; const int col = (which & 1) * 1024 + k;
            float s = 0.f;
#pragma unroll
            for (int ks = 0; ks < 8; ++ks) s += part[((size_t)ks * 9 + r) * 6144 + col];
            mod[idx] = s; }
        __syncthreads();
        auto rowsrc = [&](int rr) -> const float* { return (rr < 128) ? (P.in[0] + (size_t)(rg * 128 + rr) * DM) : (P.in[2] + (size_t)(rg * 8 + (rr - 128)) * DM); };
        f32x4 nx[4];
        { const float* s0 = rowsrc(C.wave);
#pragma unroll
          for (int j = 0; j < 4; ++j) nx[j] = *(const f32x4*)(s0 + 4 * C.lane + 256 * j); }
        for (int rr = C.wave; rr < 136; rr += 8) {
            const bool isx = rr < 128; const int grow = isx ? (rg * 128 + rr) : (MX + rg * 8 + (rr - 128));
            const LAS float* sh = mod + (isx ? 0 : 2048); const LAS float* sc = sh + 1024;
            f32x4 v[4]; float ss = 0.f;
#pragma unroll
            for (int j = 0; j < 4; ++j) { v[j] = nx[j]; ss += v[j][0] * v[j][0] + v[j][1] * v[j][1] + v[j][2] * v[j][2] + v[j][3] * v[j][3]; }
            if (rr + 8 < 136) { const float* s1 = rowsrc(rr + 8);
#pragma unroll
                for (int j = 0; j < 4; ++j) nx[j] = *(const f32x4*)(s1 + 4 * C.lane + 256 * j); }
            const float rstd = rsqrtf(wave_sum(ss) * (1.f / DM) + RMS_EPS);
#pragma unroll
            for (int j = 0; j < 4; ++j) { const int k = 4 * C.lane + 256 * j; const f32x4 g = *(const f32x4*)(gmix + k);
                const f32x4 s4 = *(const LAS f32x4*)(sc + k), h4 = *(const LAS f32x4*)(sh + k);
#pragma unroll
                for (int q = 0; q < 4; ++q) v[j][q] = (v[j][q] * rstd * g[q]) * (1.f + s4[q]) + h4[q];
                u32x2 w; w.x = pk2(v[j][0], v[j][1]); w.y = pk2(v[j][2], v[j][3]);
                *(u32x2*)(hx + (size_t)grow * DM + k) = w; }
            const float gsum = row_dot16(v, Wg, C.lane);
            if ((C.lane & 3) == 0) gates[(size_t)grow * 16 + (C.lane >> 2)] = gsum + bin[GATE0 + (C.lane >> 2)];
        }
    }
}

__device__ __forceinline__ void phase2a(const Ctx& C, const Params& P) {
    unsigned char* ws = P.ws;
    pg8::SchedGrid S{(const char*)(ws + WS_HX), (const char*)(ws + WS_WIN), (size_t)256 * 2048, (size_t)256 * 2048, 128, 10, 0, 0, C.G, C.bid, 4, 128, 8, 32, 6, 2};
    pg8::EpiCM E{(bf16_t*)(ws + WS_PCM), (bf16_t*)(ws + WS_KVCM), P.in[9]};
    pg8::gemm_phase<pg8::EpiCM, pg8::SchedGrid, true>(C.lds, 1024, 2048, 2048, S, E);
}
__device__ __forceinline__ void phase2b(const Ctx& C, const Params& P) {
    unsigned char* ws = P.ws;
    pg8::SchedGrid S{(const char*)(ws + WS_HX), (const char*)(ws + WS_WIN), (size_t)256 * 2048, (size_t)256 * 2048, 128, 12, 0, 6, C.G, C.bid, 1, 0, 0, 0, 2, 4};
    pg8::EpiIn2 E{(bf16_t*)(ws + WS_PML), (unsigned char*)P.out, P.in[9]};
    pg8::gemm_phase<pg8::EpiIn2, pg8::SchedGrid, false>(C.lds, 1024, 2048, 2048, S, E);
}
__device__ __forceinline__ void phase_merge(const Ctx& C, const Params& P) {
    unsigned char* ws = P.ws;
    pg8::SchedChain S{{(const char*)(ws + WS_YAB), (const char*)(ws + WS_WB), (size_t)256 * 2048, (size_t)256 * 2048, 128, 4, 0, 0, C.G, C.bid, 1, 0, 0, 0, 1 << 30, 0}, 1024};
    pg8::EpiMerge E{(bf16_t*)(ws + WS_Z), (const unsigned char*)P.out};
    pg8::gemm_phase<pg8::EpiMerge, pg8::SchedChain, false>(C.lds, 512, 2048, 2048, S, E);
}
__device__ __forceinline__ void phase_outproj(const Ctx& C, const Params& P) {
    unsigned char* ws = P.ws;
    pg8::SchedGrid S{(const char*)(ws + WS_Z), (const char*)(ws + WS_WOUT), (size_t)256 * 2048, (size_t)256 * 2048, 128, 4, 0, 0, C.G, C.bid, 1, 0, 0, 0, 1 << 30, 0};
    pg8::EpiOut E{P.in[0], (bf16_t*)(ws + WS_XMID), (const float*)(ws + WS_ADA)};
    pg8::gemm_phase<pg8::EpiOut, pg8::SchedGrid, false>(C.lds, 1024, 2048, 2048, S, E);
}

constexpr int HY_KSTR = 16448;
constexpr int HY_UOFF = 4 * HY_KSTR;
constexpr int HY_USTR = 4616;
template <int MODE>
__device__ __forceinline__ void hyena_item(const Ctx& C, const Params& P, int o, int c) {
    unsigned char* ws = P.ws;
    LAS bf16_t* krv = (LAS bf16_t*)C.lds;
    LAS bf16_t* up = (LAS bf16_t*)(C.lds + HY_UOFF);
    const bf16_t* pcm = (const bf16_t*)(ws + WS_PCM);
    const float* hconv = P.in[10];
    __syncthreads();
    {
        const u32x4* src = (const u32x4*)((const bf16_t*)(ws + WS_KREV) + ((size_t)o * 512 + c) * 8192);
        for (int i = C.tid; i < 1024; i += NTHR) *(LAS u32x4*)(krv + 8 * i) = src[i];
        for (int i = C.tid; i < 8 * 65; i += NTHR) { const int b = i / 65, q = i % 65; const int off = (q < 32) ? 8 * q : (4352 + 8 * (q - 32));
            *(LAS u32x4*)(up + b * HY_USTR + off) = (u32x4){0u, 0u, 0u, 0u}; }
        if (o == 0) {
            const bf16_t* src0 = pcm + (size_t)c * MX; const float w0 = hconv[c], w1 = hconv[1536 + c], w2 = hconv[3072 + c];
            u32x4 vv[8]; unsigned vl[8], vr[8];
#pragma unroll
            for (int it = 0; it < 8; ++it) { const int r0 = 8 * (C.tid + NTHR * it); vv[it] = *(const u32x4*)(src0 + r0); vl[it] = *(const unsigned*)(src0 + r0 - 2); vr[it] = *(const unsigned*)(src0 + r0 + 8); }
#pragma unroll
            for (int it = 0; it < 8; ++it) { const int r0 = 8 * (C.tid + NTHR * it); const u32x4 v = vv[it];
                float x[10]; x[1] = bflo(v.x); x[2] = bfhi(v.x); x[3] = bflo(v.y); x[4] = bfhi(v.y); x[5] = bflo(v.z); x[6] = bfhi(v.z); x[7] = bflo(v.w); x[8] = bfhi(v.w);
                x[0] = ((r0 & 63) != 0) ? bfhi(vl[it]) : 0.f; x[9] = ((r0 & 63) != 56) ? bflo(vr[it]) : 0.f;
                float y[8];
#pragma unroll
                for (int j = 0; j < 8; ++j) y[j] = w0 * x[j] + w1 * x[j + 1] + w2 * x[j + 2];
                u32x4 w; w.x = pk2(y[0], y[1]); w.y = pk2(y[2], y[3]); w.z = pk2(y[4], y[5]); w.w = pk2(y[6], y[7]);
                *(LAS u32x4*)(up + (r0 >> 12) * HY_USTR + 256 + (r0 & 4095)) = w; }
        } else {
            const u32x4* src1 = (const u32x4*)((const bf16_t*)(ws + WS_Z1) + (size_t)c * MX);
            u32x4 vv[8];
#pragma unroll
            for (int it = 0; it < 8; ++it) vv[it] = src1[C.tid + NTHR * it];
#pragma unroll
            for (int it = 0; it < 8; ++it) { const int r0 = 8 * (C.tid + NTHR * it); *(LAS u32x4*)(up + (r0 >> 12) * HY_USTR + 256 + (r0 & 4095)) = vv[it]; }
        }
    }
    __syncthreads();
    for (int idx = C.tid; idx < 3 * 1025; idx += NTHR) { const int rho = 1 + idx / 1025, ch = idx % 1025; unsigned short e[8];
#pragma unroll
        for (int j = 0; j < 8; ++j) { const int z = 8 * ch + j - rho; e[j] = (z >= 0 && z < 8192) ? krv[z] : (unsigned short)0; }
        u32x4 w; w.x = e[0] | ((unsigned)e[1] << 16); w.y = e[2] | ((unsigned)e[3] << 16); w.z = e[4] | ((unsigned)e[5] << 16); w.w = e[6] | ((unsigned)e[7] << 16);
        *(LAS u32x4*)(C.lds + rho * HY_KSTR + 16 * ch) = w; }
    if (C.tid == 0) *(LAS u32x4*)(C.lds + 16 * 1024) = (u32x4){0u, 0u, 0u, 0u};
    __syncthreads();
    const int lane = C.lane, w = C.wave, kh = w >> 2, wq = w & 3, i = lane & 31, kq = lane >> 5, nb = (lane >> 2) & 7, np = lane & 3, rho = i & 3;
    f32x16 acc[4][2];
#pragma unroll
    for (int a = 0; a < 4; ++a)
#pragma unroll
        for (int pg = 0; pg < 2; ++pg)
#pragma unroll
            for (int r = 0; r < 16; ++r) acc[a][pg][r] = 0.f;
    const int abase = rho * HY_KSTR + 2 * (4096 - i + 8 * kq + rho) - 2048 * wq - 1536;
    const int bbase = HY_UOFF + 2 * (nb * HY_USTR + 256 + 32 * np + 8 * kq);
    typedef const volatile LAS u32x2* vp2;
#define HY_LOAD(AF, BF, s0) do { const int _a = abase + 2 * (s0), _b = bbase + 2 * (s0); \
        BF[0] = *(const LAS bf16x8*)(C.lds + _b); BF[1] = *(const LAS bf16x8*)(C.lds + _b + 256); \
        _Pragma("unroll") for (int a = 0; a < 4; ++a) { const u32x2 lo = *(vp2)(C.lds + _a + 512 * (3 - a)), hi = *(vp2)(C.lds + _a + 512 * (3 - a) + 8); \
            AF[a] = __builtin_bit_cast(bf16x8, (u32x4){lo.x, lo.y, hi.x, hi.y}); } } while (0)
#define HY_MMA(AF, BF) do { _Pragma("unroll") for (int a = 0; a < 4; ++a) _Pragma("unroll") for (int pg = 0; pg < 2; ++pg) \
        acc[a][pg] = __builtin_amdgcn_mfma_f32_32x32x16_bf16(AF[a], BF[pg], acc[a][pg], 0, 0, 0); } while (0)
    bf16x8 a0[4], a1[4], b0[2], b1[2];
    const int sbeg = -224 + 16 * 135 * kh;
    HY_LOAD(a0, b0, sbeg);
#pragma unroll 1
    for (int j = 0; j < (MODE == 1 ? 0 : 134); j += 2) {
        HY_LOAD(a1, b1, sbeg + 16 * (j + 1));
        __builtin_amdgcn_sched_barrier(0);
        HY_MMA(a0, b0);
        __builtin_amdgcn_sched_barrier(0);
        HY_LOAD(a0, b0, sbeg + 16 * (j + 2));
        __builtin_amdgcn_sched_barrier(0);
        HY_MMA(a1, b1);
        __builtin_amdgcn_sched_barrier(0);
    }
    HY_MMA(a0, b0);
#undef HY_LOAD
#undef HY_MMA
    const float skip = P.in[16][o * 512 + c];
    if (kh == 0) {
#pragma unroll
        for (int a = 0; a < 4; ++a)
#pragma unroll
            for (int pg = 0; pg < 2; ++pg)
#pragma unroll
                for (int g = 0; g < 4; ++g) { const int t0 = 1024 * wq + 256 * a + 128 * pg + 32 * np + 8 * g + 4 * kq;
                    const u32x2 uv = *(const LAS u32x2*)(up + nb * HY_USTR + 256 + t0);
                    acc[a][pg][4 * g + 0] += skip * bflo(uv.x); acc[a][pg][4 * g + 1] += skip * bfhi(uv.x); acc[a][pg][4 * g + 2] += skip * bflo(uv.y); acc[a][pg][4 * g + 3] += skip * bfhi(uv.y); }
    }
    __syncthreads();
    {
        LAS f32x4* slot = (LAS f32x4*)(C.lds + w * 16384);
#pragma unroll
        for (int al = 0; al < 2; ++al)
#pragma unroll
            for (int pg = 0; pg < 2; ++pg)
#pragma unroll
                for (int g = 0; g < 4; ++g) { const int a = kh ? al : 2 + al; const f32x16& v = acc[a][pg];
                    slot[((al * 2 + pg) * 4 + g) * 64 + lane] = (f32x4){v[4 * g], v[4 * g + 1], v[4 * g + 2], v[4 * g + 3]}; }
    }
    __syncthreads();
    const int gch = (o == 0 ? 512 : 1024) + c;
    const float w0 = hconv[gch], w1 = hconv[1536 + gch], w2 = hconv[3072 + gch];
    const bf16_t* gsrc = pcm + (size_t)gch * MX + (size_t)nb * SEQ;
    bf16_t* dst = (bf16_t*)(ws + (o == 0 ? WS_Z1 : WS_Z2CM)) + (size_t)c * MX + (size_t)nb * SEQ;
    const LAS f32x4* pslot = (const LAS f32x4*)(C.lds + (w ^ 4) * 16384);
#pragma unroll
    for (int al = 0; al < 2; ++al) {
        const int a = kh ? 2 + al : al;
        u32x2 gvv[2][4]; unsigned gl[2][4], gr[2][4];
#pragma unroll
        for (int pg = 0; pg < 2; ++pg)
#pragma unroll
            for (int g = 0; g < 4; ++g) { const int t0 = 1024 * wq + 256 * a + 128 * pg + 32 * np + 8 * g + 4 * kq;
                gvv[pg][g] = *(const u32x2*)(gsrc + t0); gl[pg][g] = *(const unsigned*)(gsrc + t0 - 2); gr[pg][g] = *(const unsigned*)(gsrc + t0 + 4); }
#pragma unroll
        for (int pg = 0; pg < 2; ++pg)
#pragma unroll
            for (int g = 0; g < 4; ++g) {
                const int t0 = 1024 * wq + 256 * a + 128 * pg + 32 * np + 8 * g + 4 * kq;
                const f32x4 pv = pslot[((al * 2 + pg) * 4 + g) * 64 + lane];
                const u32x2 gv = gvv[pg][g];
                float x[6]; x[1] = bflo(gv.x); x[2] = bfhi(gv.x); x[3] = bflo(gv.y); x[4] = bfhi(gv.y);
                x[0] = ((t0 & 63) != 0) ? bfhi(gl[pg][g]) : 0.f; x[5] = ((t0 & 63) != 60) ? bflo(gr[pg][g]) : 0.f;
                float z[4];
#pragma unroll
                for (int j = 0; j < 4; ++j) { const float gate = w0 * x[j] + w1 * x[j + 1] + w2 * x[j + 2]; z[j] = gate * (acc[a][pg][4 * g + j] + pv[j]); }
                u32x2 wv; wv.x = pk2(z[0], z[1]); wv.y = pk2(z[2], z[3]);
                if (MODE == 1) { if (z[0] == 12345.678f) *(u32x2*)(dst + t0) = wv; } else *(u32x2*)(dst + t0) = wv;
            }
    }
}

typedef short s16x4 __attribute__((ext_vector_type(4)));
__device__ __forceinline__ unsigned off_b(unsigned row, unsigned ch) { return 256u * row + 16u * (ch ^ (((row & 3) << 2) | ((row >> 2) & 3))); }
__device__ __forceinline__ bf16x8 tile_row_read(const LAS unsigned char* T, int lane, int rb, int s) { return *(const LAS bf16x8*)(T + off_b((lane & 15) + 16 * rb, 4 * s + (lane >> 4))); }
__device__ __forceinline__ bf16x8 tile_tr_read(const LAS unsigned char* T, int lane, int c, int ks) {
    const unsigned g = lane >> 4, q = (lane & 15) >> 2, p = lane & 3;
    const unsigned a0 = off_b(32 * ks + 8 * g + q, 2 * c + (p >> 1)) + 8 * (p & 1), a1 = off_b(32 * ks + 8 * g + 4 + q, 2 * c + (p >> 1)) + 8 * (p & 1);
    const s16x4 lo = __builtin_amdgcn_ds_read_tr16_b64_v4i16((LAS s16x4*)(T + a0)), hi = __builtin_amdgcn_ds_read_tr16_b64_v4i16((LAS s16x4*)(T + a1));
    return __builtin_shufflevector(lo, hi, 0, 1, 2, 3, 4, 5, 6, 7);
}
struct ChunkRef { int isctx, b, h, d, oc; };
__device__ __forceinline__ int chunk_row0(const ChunkRef& r) { return r.isctx ? (MX + r.b * CTXL + r.oc * 128) : (r.b * SEQ + r.oc * 128); }

__device__ __forceinline__ void mlstm_prep(const Ctx& C, const Params& P) {
    unsigned char* ws = P.ws;
    const float* cw = P.in[17];
    {
        const bf16_t* kvcm = (const bf16_t*)(ws + WS_KVCM); bf16_t* kact = (bf16_t*)(ws + WS_KACT);
        const int NCH = 512 * (MT / 8), STR = C.G * NTHR;
        for (int i0 = C.bid * NTHR + C.tid; i0 < NCH; i0 += 4 * STR) {
            u32x4 vv[4]; unsigned vl4[4], vr4[4];
#pragma unroll
            for (int u = 0; u < 4; ++u) { const int i = i0 + u * STR; if (i < NCH) { const int c = i / (MT / 8), col = 8 * (i % (MT / 8)); const bf16_t* src = kvcm + (size_t)c * MT + col;
                vv[u] = *(const u32x4*)src; vl4[u] = *(const unsigned*)(src - 2); vr4[u] = *(const unsigned*)(src + 8); } }
#pragma unroll
            for (int u = 0; u < 4; ++u) { const int i = i0 + u * STR; if (i < NCH) { const int c = i / (MT / 8), col = 8 * (i % (MT / 8)); const u32x4 v = vv[u];
                const int t = (col < MX) ? (col & 63) : ((col - MX) & 255), rl = (col < MX) ? 64 : 256;
                float x[10]; x[1] = bflo(v.x); x[2] = bfhi(v.x); x[3] = bflo(v.y); x[4] = bfhi(v.y); x[5] = bflo(v.z); x[6] = bfhi(v.z); x[7] = bflo(v.w); x[8] = bfhi(v.w);
                x[0] = (t != 0) ? bfhi(vl4[u]) : 0.f; x[9] = (t + 8 != rl) ? bflo(vr4[u]) : 0.f;
                const float w0 = cw[512 + c], w1 = cw[1024 + 512 + c], w2 = cw[2048 + 512 + c]; float y[8];
#pragma unroll
                for (int j = 0; j < 8; ++j) y[j] = siluf(w0 * x[j] + w1 * x[j + 1] + w2 * x[j + 2]);
                u32x4 o; o.x = pk2(y[0], y[1]); o.y = pk2(y[2], y[3]); o.z = pk2(y[4], y[5]); o.w = pk2(y[6], y[7]);
                *(u32x4*)(kact + (size_t)c * MT + col) = o; } }
        }
    }
    {
        const bf16_t* pml = (const bf16_t*)(ws + WS_PML); bf16_t* qact = (bf16_t*)(ws + WS_QACT);
        const int NQ = MX * 64, STR = C.G * NTHR;
        for (int i0 = C.bid * NTHR + C.tid; i0 < NQ; i0 += 4 * STR) {
            u32x4 vc4[4], vl4[4], vr4[4];
#pragma unroll
            for (int u = 0; u < 4; ++u) { const int i = i0 + u * STR; if (i < NQ) { const int row = i >> 6, c0 = 8 * (i & 63); const bf16_t* base = pml + (size_t)row * 1024 + c0;
                const bool hl = (row & 63) != 0, hr = (row & 63) != 63;
                vc4[u] = *(const u32x4*)base; vl4[u] = (u32x4){0u, 0u, 0u, 0u}; vr4[u] = (u32x4){0u, 0u, 0u, 0u};
                if (hl) vl4[u] = *(const u32x4*)(base - 1024); if (hr) vr4[u] = *(const u32x4*)(base + 1024); } }
#pragma unroll
            for (int u = 0; u < 4; ++u) { const int i = i0 + u * STR; if (i < NQ) { const int row = i >> 6, c0 = 8 * (i & 63);
                const u32x4 vc = vc4[u], vl = vl4[u], vr = vr4[u];
                const unsigned l4[4] = {vl.x, vl.y, vl.z, vl.w}, c4[4] = {vc.x, vc.y, vc.z, vc.w}, r4[4] = {vr.x, vr.y, vr.z, vr.w}; unsigned o4[4];
#pragma unroll
                for (int q = 0; q < 4; ++q) {
                    const float a0 = cw[c0 + 2 * q] * bflo(l4[q]) + cw[1024 + c0 + 2 * q] * bflo(c4[q]) + cw[2048 + c0 + 2 * q] * bflo(r4[q]);
                    const float a1 = cw[c0 + 2 * q + 1] * bfhi(l4[q]) + cw[1024 + c0 + 2 * q + 1] * bfhi(c4[q]) + cw[2048 + c0 + 2 * q + 1] * bfhi(r4[q]);
                    o4[q] = pk2(siluf(a0) * 0.08838834764831845f, siluf(a1) * 0.08838834764831845f); }
                *(u32x4*)(qact + (size_t)row * 512 + c0) = (u32x4){o4[0], o4[1], o4[2], o4[3]}; } }
        }
    }
    for (int item = C.bid * 8 + C.wave; item < 64 * NCHK; item += C.G * 8) {
        const int j = item % NCHK, seq = item / NCHK, h = seq & 3, b = (seq >> 2) & 7, d = seq >> 5;
        ChunkRef r; r.isctx = j < 2; r.b = b; r.h = h; r.d = d; { const int jj = r.isctx ? j : j - 2, nch = r.isctx ? 2 : 32; r.oc = d ? (nch - 1 - jj) : jj; }
        const float* gates = (const float*)(ws + WS_GATES) + (size_t)chunk_row0(r) * 16;
        const int p0 = 2 * C.lane, t0 = d ? 127 - p0 : p0, t1 = d ? 126 - p0 : p0 + 1;
        const float li0 = gates[(size_t)t0 * 16 + (d ? 8 : 0) + h], li1 = gates[(size_t)t1 * 16 + (d ? 8 : 0) + h];
        const float lf0 = logsig(gates[(size_t)t0 * 16 + (d ? 12 : 4) + h]), lf1 = logsig(gates[(size_t)t1 * 16 + (d ? 12 : 4) + h]);
        float run = lf0 + lf1;
#pragma unroll
        for (int o = 1; o < 64; o <<= 1) { const float t = __shfl_up(run, o); if (C.lane >= o) run += t; }
        const float b1 = run, b0 = run - lf1;
        const float c0 = li0 - b0, c1 = li1 - b1;
        float gm = fmaxf(c0, c1);
#pragma unroll
        for (int o = 1; o < 64; o <<= 1) { const float t = __shfl_up(gm, o); if (C.lane >= o) gm = fmaxf(gm, t); }
        float gprev = __shfl_up(gm, 1); if (C.lane == 0) gprev = -3.0e38f;
        float* gc = (float*)(ws + WS_GC) + (size_t)item * 384;
        gc[t0] = c0; gc[t1] = c1; gc[128 + t0] = b0; gc[128 + t1] = b1; gc[256 + t0] = fmaxf(gprev, c0); gc[256 + t1] = gm;
        if (C.lane == 63) { float* bl = (float*)(ws + WS_BL) + (size_t)item * 2; bl[0] = b1; bl[1] = gm; }
    }
}

struct SeqPre { u32x4 k[4]; u32x4 v[4]; float g; float bl0, bl1; };
__device__ __forceinline__ ChunkRef seq_chunk(int jc, int b, int h, int d) {
    ChunkRef r; r.isctx = jc < 2; r.b = b; r.h = h; r.d = d; const int jj = r.isctx ? jc : jc - 2, nch = r.isctx ? 2 : 32; r.oc = d ? (nch - 1 - jj) : jj; return r; }
__device__ __forceinline__ void seq_prefetch(const Params& P, const ChunkRef& r, int item, SeqPre& pf, int tid) {
    const bf16_t* kact = (const bf16_t*)(P.ws + WS_KACT); const bf16_t* kvcm = (const bf16_t*)(P.ws + WS_KVCM); const int col0 = chunk_row0(r);
#pragma unroll
    for (int it = 0; it < 4; ++it) { const int idx = tid + NTHR * it, dd = idx >> 4, s0 = 8 * (idx & 15);
        pf.k[it] = *(const u32x4*)(kact + (size_t)(r.h * 128 + dd) * MT + col0 + s0);
        pf.v[it] = *(const u32x4*)(kvcm + (size_t)(512 + r.h * 128 + dd) * MT + col0 + s0); }
    pf.g = (tid < 384) ? ((const float*)(P.ws + WS_GC))[(size_t)item * 384 + tid] : 0.f;
    const float* bl = (const float*)(P.ws + WS_BL) + (size_t)item * 2; pf.bl0 = bl[0]; pf.bl1 = bl[1];
}
#define SEQ_BAR() do { asm volatile("s_waitcnt lgkmcnt(0)" ::: "memory"); __builtin_amdgcn_s_barrier(); asm volatile("" ::: "memory"); } while (0)
__device__ __forceinline__ void mlstm_seq(const Ctx& C, const Params& P, int seq) {
    unsigned char* ws = P.ws;
    const int h = seq & 3, b = (seq >> 2) & 7, d = seq >> 5;
    LAS unsigned char* KT = C.lds; LAS unsigned char* VT = C.lds + 32768; LAS unsigned char* CT = C.lds + 65536; LAS unsigned char* PS = C.lds + 98304;
    LAS float* colf = (LAS float*)(C.lds + 131072); LAS float* bcs = colf + 128; LAS float* gms = bcs + 128; LAS float* wls = gms + 128; LAS float* nbuf = wls + 128  ;
    const int w = C.wave;
    f32x4 Cst[8]; f32x4 nst = (f32x4){0.f, 0.f, 0.f, 0.f};
#pragma unroll
    for (int nt = 0; nt < 8; ++nt) Cst[nt] = (f32x4){0.f, 0.f, 0.f, 0.f};
    float m = 0.f;
    __syncthreads();
    if (C.tid < 256) nbuf[C.tid] = 0.f;
    SeqPre pre;
    seq_prefetch(P, seq_chunk(0, b, h, d), seq * NCHK, pre, C.tid);
    const bf16x8 ones = (bf16x8){0x3f80, 0x3f80, 0x3f80, 0x3f80, 0x3f80, 0x3f80, 0x3f80, 0x3f80};
#pragma unroll 1
    for (int jc = 0; jc < NCHK; ++jc) {
        const ChunkRef r = seq_chunk(jc, b, h, d);
        const LAS float* nsl = nbuf + 128 * (jc & 1); LAS float* nnew = nbuf + 128 * ((jc & 1) ^ 1);
        int tid = C.tid; asm volatile("" : "+v"(tid));
        const int lane = tid & 63, fr = lane & 15, fq = lane >> 4;
        bf16x8 qf[4];
        if (!r.isctx) { const bf16_t* qa = (const bf16_t*)(ws + WS_QACT) + (size_t)(b * SEQ + r.oc * 128 + 16 * w + fr) * 512 + h * 128 + 8 * fq;
#pragma unroll
            for (int ks = 0; ks < 4; ++ks) qf[ks] = *(const bf16x8*)(qa + 32 * ks); }
        else {
#pragma unroll
            for (int ks = 0; ks < 4; ++ks) qf[ks] = (bf16x8){0, 0, 0, 0, 0, 0, 0, 0}; }
        const float Bj = pre.bl0, gfin = pre.bl1, mxs = fmaxf(m, gfin), decay = __expf(m - mxs);
        SEQ_BAR();
        {
#pragma unroll
            for (int it = 0; it < 4; ++it) { const int idx = tid + NTHR * it, dd = idx >> 4, ch = idx & 15;
                *(LAS u32x4*)(KT + off_b(dd, ch)) = pre.k[it]; *(LAS u32x4*)(VT + off_b(dd, ch)) = pre.v[it]; }
            if (tid < 384) colf[tid] = pre.g;
            if (tid < 128) wls[tid] = __expf(pre.g - mxs);
        }
#pragma unroll
        for (int nt = 0; nt < 8; ++nt) { u32x2 pw; pw.x = pk2(Cst[nt][0], Cst[nt][1]); pw.y = pk2(Cst[nt][2], Cst[nt][3]);
            *(LAS u32x2*)(CT + off_b(16 * nt + fr, 2 * w + (fq >> 1)) + 8 * (fq & 1)) = pw; }
        if (fr == 0) *(LAS f32x4*)(nnew + 16 * w + 4 * fq) = nst;
        SEQ_BAR();
        if (!r.isctx) {
            const int t = 16 * w + fr;
            const float mx = fmaxf(m, gms[t]), rowf = -mx, ainter = __expf(m - mx), emneg = __expf(-(bcs[t] + mx));
            float qn = 0.f;
#pragma unroll
            for (int ks = 0; ks < 4; ++ks) { const u32x4 qq = __builtin_bit_cast(u32x4, qf[ks]); const LAS float* np_ = nnew + 32 * ks + 8 * fq; const f32x4 na = *(const LAS f32x4*)np_, nb = *(const LAS f32x4*)(np_ + 4);
                qn += bflo(qq.x) * na[0] + bfhi(qq.x) * na[1] + bflo(qq.y) * na[2] + bfhi(qq.y) * na[3] + bflo(qq.z) * nb[0] + bfhi(qq.z) * nb[1] + bflo(qq.w) * nb[2] + bfhi(qq.w) * nb[3]; }
            qn += __shfl_xor(qn, 16); qn += __shfl_xor(qn, 32);
            float rs = 0.f;
#pragma unroll 2
            for (int nt = 0; nt < 8; ++nt) { f32x4 a = (f32x4){0.f, 0.f, 0.f, 0.f};
#pragma unroll
                for (int ks = 0; ks < 4; ++ks) a = __builtin_amdgcn_mfma_f32_16x16x32_bf16(tile_tr_read(KT, lane, nt, ks), qf[ks], a, 0, 0, 0);
                const int s0 = 16 * nt + 4 * fq; const f32x4 cf = *(const LAS f32x4*)(colf + s0); float pv[4];
#pragma unroll
                for (int q = 0; q < 4; ++q) { const int s = s0 + q; const bool ok = d ? (s >= t) : (s <= t); pv[q] = ok ? __expf(rowf + cf[q]) * a[q] : 0.f; rs += pv[q]; }
                u32x2 pw; pw.x = pk2(pv[0], pv[1]); pw.y = pk2(pv[2], pv[3]);
                *(LAS u32x2*)(PS + off_b(t, 2 * nt + (fq >> 1)) + 8 * (fq & 1)) = pw; }
            rs += __shfl_xor(rs, 16); rs += __shfl_xor(rs, 32);
            const float inv = 1.f / fmaxf(fabsf(rs + ainter * qn), emneg);
            LDS_WAIT();
            bf16x8 pfr[4];
#pragma unroll
            for (int ks = 0; ks < 4; ++ks) pfr[ks] = tile_row_read(PS, lane, w, ks);
            float ai4[4], iv4[4];
#pragma unroll
            for (int q = 0; q < 4; ++q) { ai4[q] = __shfl(ainter, 4 * fq + q); iv4[q] = __shfl(inv, 4 * fq + q); }
            bf16_t* hd = (bf16_t*)(ws + WS_HDIR) + ((size_t)d * MX + (size_t)(b * SEQ + r.oc * 128)) * 512 + h * 128;
#pragma unroll 2
            for (int nt = 0; nt < 8; ++nt) { f32x4 a = (f32x4){0.f, 0.f, 0.f, 0.f}, c = (f32x4){0.f, 0.f, 0.f, 0.f};
#pragma unroll
                for (int ks = 0; ks < 4; ++ks) { a = __builtin_amdgcn_mfma_f32_16x16x32_bf16(pfr[ks], tile_row_read(VT, lane, nt, ks), a, 0, 0, 0);
                    c = __builtin_amdgcn_mfma_f32_16x16x32_bf16(qf[ks], tile_row_read(CT, lane, nt, ks), c, 0, 0, 0); }
#pragma unroll
                for (int q = 0; q < 4; ++q) hd[(size_t)(16 * w + 4 * fq + q) * 512 + 16 * nt + fr] = (bf16_t)f2bf((a[q] + ai4[q] * c[q]) * iv4[q]); }
        }
        if (jc + 1 < NCHK) seq_prefetch(P, seq_chunk(jc + 1, b, h, d), seq * NCHK + jc + 1, pre, tid);
        {
            bf16x8 kfs[4];
#pragma unroll
            for (int ks = 0; ks < 4; ++ks) { const u32x4 kk = __builtin_bit_cast(u32x4, tile_row_read(KT, lane, w, ks)); const LAS float* cp = wls + 32 * ks + 8 * fq;
                const f32x4 ca = *(const LAS f32x4*)cp, cb = *(const LAS f32x4*)(cp + 4);
                u32x4 o; o.x = pk2(bflo(kk.x) * ca[0], bfhi(kk.x) * ca[1]); o.y = pk2(bflo(kk.y) * ca[2], bfhi(kk.y) * ca[3]);
                o.z = pk2(bflo(kk.z) * cb[0], bfhi(kk.z) * cb[1]); o.w = pk2(bflo(kk.w) * cb[2], bfhi(kk.w) * cb[3]);
                kfs[ks] = __builtin_bit_cast(bf16x8, o); }
#pragma unroll
            for (int nt = 0; nt < 8; ++nt) { f32x4 a = (f32x4){0.f, 0.f, 0.f, 0.f};
#pragma unroll
                for (int ks = 0; ks < 4; ++ks) a = __builtin_amdgcn_mfma_f32_16x16x32_bf16(kfs[ks], tile_row_read(VT, lane, nt, ks), a, 0, 0, 0);
                Cst[nt] = Cst[nt] * decay + a; }
            { f32x4 a = (f32x4){0.f, 0.f, 0.f, 0.f};
#pragma unroll
              for (int ks = 0; ks < 4; ++ks) a = __builtin_amdgcn_mfma_f32_16x16x32_bf16(kfs[ks], ones, a, 0, 0, 0);
              nst = nst * decay + a; }
            m = Bj + mxs;
        }
    }
}
#undef SEQ_BAR

__device__ __forceinline__ void mlstm_combine(const Ctx& C, const Params& P) {
    unsigned char* ws = P.ws;
    const bf16_t* hd = (const bf16_t*)(ws + WS_HDIR); const bf16_t* pml = (const bf16_t*)(ws + WS_PML); bf16_t* yab = (bf16_t*)(ws + WS_YAB); const float* ng = P.in[18];
    const f32x4 g0 = *(const f32x4*)(ng + 8 * C.lane), g1 = *(const f32x4*)(ng + 8 * C.lane + 4);
    u32x4 na, nb, no;
    { const int row0 = C.bid * 8 + C.wave;
      if (row0 < MX) { na = *(const u32x4*)(hd + (size_t)row0 * 512 + 8 * C.lane); nb = *(const u32x4*)(hd + ((size_t)MX + row0) * 512 + 8 * C.lane); no = *(const u32x4*)(pml + (size_t)row0 * 1024 + 512 + 8 * C.lane); } }
    for (int row = C.bid * 8 + C.wave; row < MX; row += C.G * 8) {
        const u32x4 a = na, bq = nb, og = no;
        if (row + C.G * 8 < MX) { const int r1 = row + C.G * 8;
            na = *(const u32x4*)(hd + (size_t)r1 * 512 + 8 * C.lane); nb = *(const u32x4*)(hd + ((size_t)MX + r1) * 512 + 8 * C.lane); no = *(const u32x4*)(pml + (size_t)r1 * 1024 + 512 + 8 * C.lane); }
        float v[8] = {bflo(a.x) + bflo(bq.x), bfhi(a.x) + bfhi(bq.x), bflo(a.y) + bflo(bq.y), bfhi(a.y) + bfhi(bq.y), bflo(a.z) + bflo(bq.z), bfhi(a.z) + bfhi(bq.z), bflo(a.w) + bflo(bq.w), bfhi(a.w) + bfhi(bq.w)};
        float ss = 0.f;
#pragma unroll
        for (int j = 0; j < 8; ++j) ss += v[j] * v[j];
        ss += __shfl_xor(ss, 1); ss += __shfl_xor(ss, 2); ss += __shfl_xor(ss, 4); ss += __shfl_xor(ss, 8);
        const float rstd = rsqrtf(ss * (1.f / 128.f) + RMS_EPS);
        const float o8[8] = {bflo(og.x), bfhi(og.x), bflo(og.y), bfhi(og.y), bflo(og.z), bfhi(og.z), bflo(og.w), bfhi(og.w)};
        const float gg[8] = {g0[0], g0[1], g0[2], g0[3], g1[0], g1[1], g1[2], g1[3]};
        float y[8];
#pragma unroll
        for (int j = 0; j < 8; ++j) y[j] = v[j] * rstd * gg[j] * sigm(o8[j]);
        u32x4 wv; wv.x = pk2(y[0], y[1]); wv.y = pk2(y[2], y[3]); wv.z = pk2(y[4], y[5]); wv.w = pk2(y[6], y[7]);
        *(u32x4*)(yab + (size_t)row * 1024 + 512 + 8 * C.lane) = wv;
    }
}

template <int PM>
__device__ __forceinline__ void mixer_phase(const Ctx& C, const Params& P) {
    constexpr int NM = 64;
    const bool small = C.G < 2 * NM;
    const int nh = small ? C.G : C.G - NM, hb = small ? C.bid : C.bid - NM;
    if (PM != 2 && PM != 3) if (small || C.bid < NM) for (int s = C.bid; s < 64; s += (small ? C.G : NM)) mlstm_seq(C, P, s);
    if (PM != 1 && hb >= 0) {
        const int nch = (512 - hb + nh - 1) / nh;
#pragma unroll 1
        for (int j = 0; j < 2 * nch; ++j) { const int c = hb + (j >> 1) * nh, o = j & 1;
            if (o) asm volatile("s_waitcnt vmcnt(0)" ::: "memory");
            hyena_item<0>(C, P, o, c); }
    }
}

__device__ __forceinline__ void transpose_z2(const Ctx& C, const Params& P) {
    unsigned char* ws = P.ws;
    const bf16_t* src = (const bf16_t*)(ws + WS_Z2CM); bf16_t* dst = (bf16_t*)(ws + WS_YAB);
    LAS bf16_t* tl = (LAS bf16_t*)(C.lds + 143360 - 20480);
    for (int it = C.bid; it < 8 * 256; it += C.G) {
        const int c0 = (it & 7) * 64, r0 = (it >> 3) * 128;
        __syncthreads();
        for (int idx = C.tid; idx < 64 * 16; idx += NTHR) { const int cc = idx >> 4, rc = (idx & 15) * 8;
            const u32x4 v = *(const u32x4*)(src + (size_t)(c0 + cc) * MX + r0 + rc); const unsigned v4[4] = {v.x, v.y, v.z, v.w};
#pragma unroll
            for (int q = 0; q < 4; ++q) { tl[(rc + 2 * q) * 72 + cc] = (bf16_t)(v4[q] & 0xffffu); tl[(rc + 2 * q + 1) * 72 + cc] = (bf16_t)(v4[q] >> 16); } }
        __syncthreads();
        for (int idx = C.tid; idx < 128 * 8; idx += NTHR) { const int rr = idx >> 3, c8 = (idx & 7) * 8;
            *(u32x4*)(dst + (size_t)(r0 + rr) * 1024 + c0 + c8) = *(const LAS u32x4*)(tl + rr * 72 + c8); }
    }
}

__device__ __forceinline__ void phase6(const Ctx& C, const Params& P) {
    unsigned char* ws = P.ws;
    LAS float* Wr = (LAS float*)C.lds;
#pragma unroll 1
    for (int i0 = C.tid; i0 < 1024 * 16; i0 += 8 * NTHR) { float t8[8];
#pragma unroll
        for (int u = 0; u < 8; ++u) t8[u] = P.in[22][i0 + u * NTHR];
#pragma unroll
        for (int u = 0; u < 8; ++u) { const int idx = i0 + u * NTHR; Wr[wl_pos(idx >> 4) * 20 + (idx & 15)] = t8[u]; } }
    __syncthreads();
    const float* ada = (const float*)(ws + WS_ADA); const float* gffn = P.in[7];
    unsigned char* hx2 = ws + WS_HX2; float* aff = (float*)(ws + WS_AFF); int* slot = (int*)(ws + WS_SLOT);
    const bf16_t* xm = (const bf16_t*)(ws + WS_XMID);
    u32x2 nx[4];
    { const int row0 = C.bid * 8 + C.wave;
      if (row0 < MX) {
#pragma unroll
        for (int j = 0; j < 4; ++j) nx[j] = *(const u32x2*)(xm + (size_t)row0 * DM + 4 * C.lane + 256 * j); } }
    for (int row = C.bid * 8 + C.wave; row < MX; row += C.G * 8) {
        const int b = row >> 12, n = row & 4095;
        f32x4 v[4]; float ss = 0.f;
#pragma unroll
        for (int j = 0; j < 4; ++j) { v[j] = (f32x4){bflo(nx[j].x), bfhi(nx[j].x), bflo(nx[j].y), bfhi(nx[j].y)}; ss += v[j][0] * v[j][0] + v[j][1] * v[j][1] + v[j][2] * v[j][2] + v[j][3] * v[j][3]; }
        if (row + C.G * 8 < MX) {
#pragma unroll
            for (int j = 0; j < 4; ++j) nx[j] = *(const u32x2*)(xm + (size_t)(row + C.G * 8) * DM + 4 * C.lane + 256 * j); }
        const float rstd = rsqrtf(wave_sum(ss) * (1.f / DM) + RMS_EPS);
#pragma unroll
        for (int j = 0; j < 4; ++j) { const int k = 4 * C.lane + 256 * j; const f32x4 g = *(const f32x4*)(gffn + k);
            const f32x4 h4 = *(const f32x4*)(ada + (size_t)b * 6144 + 3072 + k), s4 = *(const f32x4*)(ada + (size_t)b * 6144 + 4096 + k);
#pragma unroll
            for (int q = 0; q < 4; ++q) v[j][q] = (v[j][q] * rstd * g[q]) * (1.f + s4[q]) + h4[q];
            *(unsigned*)(hx2 + (size_t)row * DM + k) = pk4_fp8(v[j][0], v[j][1], v[j][2], v[j][3]); }
        const float lg = row_dot16(v, Wr, C.lane);
        float mx = lg;
        mx = fmaxf(mx, __shfl_xor(mx, 4)); mx = fmaxf(mx, __shfl_xor(mx, 8)); mx = fmaxf(mx, __shfl_xor(mx, 16)); mx = fmaxf(mx, __shfl_xor(mx, 32));
        const float ex = expf(lg - mx);
        float sum = ex;
        sum += __shfl_xor(sum, 4); sum += __shfl_xor(sum, 8); sum += __shfl_xor(sum, 16); sum += __shfl_xor(sum, 32);
        if ((C.lane & 3) == 0) { const int e = C.lane >> 2; aff[((size_t)b * NE + e) * SEQ + n] = ex / sum; slot[(size_t)row * 16 + e] = -1; }
    }
}

__device__ __forceinline__ void topk_item(const Ctx& C, const Params& P, int item) {
    unsigned char* ws = P.ws;
    const int b = item >> 4, e = item & 15;
    const float* aff = (const float*)(ws + WS_AFF) + (size_t)item * SEQ;
    LAS unsigned* red = (LAS unsigned*)C.lds;
    unsigned v[8];
    { const u32x4 a = *(const u32x4*)(aff + 8 * C.tid), c = *(const u32x4*)(aff + 8 * C.tid + 4);
      v[0] = a.x; v[1] = a.y; v[2] = a.z; v[3] = a.w; v[4] = c.x; v[5] = c.y; v[6] = c.z; v[7] = c.w; }
    unsigned prefix = 0u;
    for (int bit = 30; bit >= 0; --bit) {
        const unsigned cand = prefix | (1u << bit); int cnt = 0;
#pragma unroll
        for (int q = 0; q < 8; ++q) cnt += (v[q] >= cand) ? 1 : 0;
        cnt = (int)wave_sum((float)cnt);
        __syncthreads();
        if (C.lane == 0) red[C.wave] = (unsigned)cnt;
        __syncthreads();
        int tot = 0;
#pragma unroll
        for (int q = 0; q < 8; ++q) tot += (int)red[q];
        if (tot >= CAP) prefix = cand;
    }
    int cg_ = 0, ce_ = 0;
#pragma unroll
    for (int q = 0; q < 8; ++q) { cg_ += (v[q] > prefix) ? 1 : 0; ce_ += (v[q] == prefix) ? 1 : 0; }
    int ig = cg_, ie = ce_;
#pragma unroll
    for (int o = 1; o < 64; o <<= 1) { const int tg = __shfl_up(ig, o), te = __shfl_up(ie, o); if (C.lane >= o) { ig += tg; ie += te; } }
    __syncthreads();
    if (C.lane == 63) { red[C.wave] = (unsigned)ig; red[8 + C.wave] = (unsigned)ie; }
    __syncthreads();
    int bg = 0, be = 0, totg = 0;
#pragma unroll
    for (int q = 0; q < 8; ++q) { const int xg = (int)red[q], xe = (int)red[8 + q]; if (q < C.wave) { bg += xg; be += xe; } totg += xg; }
    int pg = bg + ig - cg_, pe = be + ie - ce_;
    const int need = CAP - totg;
    float* sg = (float*)(ws + WS_SGATE) + (size_t)item * CAP; int* slot = (int*)(ws + WS_SLOT);
    LAS int* sel = (LAS int*)(C.lds + 256);
#pragma unroll
    for (int q = 0; q < 8; ++q) { const int n = 8 * C.tid + q; int s = -1;
        if (v[q] > prefix) s = pg++;
        else if (v[q] == prefix) { if (pe < need) s = totg + pe; ++pe; }
        if (s >= 0) { sel[s] = n; sg[s] = __builtin_bit_cast(float, v[q]); slot[((size_t)b * SEQ + n) * 16 + e] = s; } }
    __syncthreads();
    const unsigned char* hx2 = ws + WS_HX2; unsigned char* xg = ws + WS_XG + ((size_t)e * 4096 + (size_t)b * CAP) * DM;
    for (int s0 = C.wave; s0 < CAP; s0 += 32) {
        u32x4 v4[4];
#pragma unroll
        for (int u = 0; u < 4; ++u) v4[u] = ((const u32x4*)(hx2 + ((size_t)b * SEQ + sel[s0 + 8 * u]) * DM))[C.lane];
#pragma unroll
        for (int u = 0; u < 4; ++u) ((u32x4*)(xg + (size_t)(s0 + 8 * u) * DM))[C.lane] = v4[u];
    }
    __syncthreads();
}

__device__ __forceinline__ void moe_gemm1(const Ctx& C, const Params& P, int skip_epi) {
    unsigned char* ws = P.ws;
    pg8::SchedMoe S{(const char*)(ws + WS_XG), (const char*)(ws + WS_W13), (size_t)256 * 1024, (size_t)256 * 1024, (size_t)4096 * 1024, (size_t)4096 * 1024, 16, 16, C.G, C.bid};
    pg8::EpiMoe1 E{ws + WS_ACT, skip_epi};
    pg8::gemm_phase<pg8::EpiMoe1, pg8::SchedMoe, false, true>(C.lds, 512, 1024, 1024, S, E);
}
__device__ __forceinline__ void moe_gemm2(const Ctx& C, const Params& P, bool skip_epi) {
    unsigned char* ws = P.ws;
    pg8::SchedMoe S{(const char*)(ws + WS_ACT), (const char*)(ws + WS_W2), (size_t)256 * 2048, (size_t)256 * 2048, (size_t)4096 * 2048, (size_t)1024 * 2048, 16, 4, C.G, C.bid};
    pg8::EpiMoe2 E{(bf16_t*)(ws + WS_YE), (const float*)(ws + WS_SGATE), skip_epi};
    pg8::gemm_phase<pg8::EpiMoe2, pg8::SchedMoe, false, true>(C.lds, 1024, 2048, 2048, S, E);
}

__device__ __forceinline__ void phase_final(const Ctx& C, const Params& P) {
    unsigned char* ws = P.ws;
    const float* ada = (const float*)(ws + WS_ADA); const float* gfin = P.in[26];
    const int* slot = (const int*)(ws + WS_SLOT); const bf16_t* ye = (const bf16_t*)(ws + WS_YE);
    const bf16_t* xm = (const bf16_t*)(ws + WS_XMID);
    u32x2 nx[4]; int nslot = -1;
    { const int row0 = C.bid * 8 + C.wave;
      if (row0 < MX) { if (C.lane < 16) nslot = slot[(size_t)row0 * 16 + C.lane];
#pragma unroll
        for (int j = 0; j < 4; ++j) nx[j] = *(const u32x2*)(xm + (size_t)row0 * DM + 4 * C.lane + 256 * j); } }
    for (int row = C.bid * 8 + C.wave; row < MX; row += C.G * 8) {
        const int b = row >> 12;
        float* xr = P.out + (size_t)row * DM;
        f32x4 xv[4]; const int myslot = nslot;
#pragma unroll
        for (int j = 0; j < 4; ++j) xv[j] = (f32x4){bflo(nx[j].x), bfhi(nx[j].x), bflo(nx[j].y), bfhi(nx[j].y)};
        f32x4 m[4];
#pragma unroll
        for (int j = 0; j < 4; ++j) m[j] = (f32x4){0.f, 0.f, 0.f, 0.f};
        for (int e = 0; e < NE; ++e) { const int s = __shfl(myslot, e);
            if (s >= 0) { const bf16_t* yr = ye + ((size_t)e * 4096 + b * CAP + s) * DM;
#pragma unroll
                for (int j = 0; j < 4; ++j) { const u32x2 w = *(const u32x2*)(yr + 4 * C.lane + 256 * j);
                    m[j][0] += bflo(w.x); m[j][1] += bfhi(w.x); m[j][2] += bflo(w.y); m[j][3] += bfhi(w.y); } } }
        if (row + C.G * 8 < MX) { const int r1 = row + C.G * 8; nslot = (C.lane < 16) ? slot[(size_t)r1 * 16 + C.lane] : -1;
#pragma unroll
            for (int j = 0; j < 4; ++j) nx[j] = *(const u32x2*)(xm + (size_t)r1 * DM + 4 * C.lane + 256 * j); }
        f32x4 v[4]; float ss = 0.f;
#pragma unroll
        for (int j = 0; j < 4; ++j) { const int k = 4 * C.lane + 256 * j; const f32x4 g5 = *(const f32x4*)(ada + (size_t)b * 6144 + 5120 + k);
            v[j] = xv[j] + g5 * m[j]; ss += v[j][0] * v[j][0] + v[j][1] * v[j][1] + v[j][2] * v[j][2] + v[j][3] * v[j][3]; }
        const float rstd = rsqrtf(wave_sum(ss) * (1.f / DM) + RMS_EPS);
#pragma unroll
        for (int j = 0; j < 4; ++j) { const int k = 4 * C.lane + 256 * j; const f32x4 g = *(const f32x4*)(gfin + k);
            *(f32x4*)(xr + k) = v[j] * rstd * g; }
    }
}

constexpr int N_PHASES = 14;
__global__ void __launch_bounds__(NTHR, 2) mega(Params P) {
    extern __shared__ __attribute__((aligned(16))) unsigned char lds_raw[];
    Ctx C; C.lds = (LAS unsigned char*)lds_raw; C.tid = threadIdx.x; C.lane = C.tid & 63; C.wave = __builtin_amdgcn_readfirstlane(C.tid >> 6); C.bid = blockIdx.x; C.G = gridDim.x;
    unsigned char* ws = P.ws;
    if (C.tid < 32) ((LAS unsigned*)(C.lds + LDS_MISC))[C.tid] = 0u;
    __syncthreads();
    XcdBarrier bar = xcd_barrier_post((unsigned*)(ws + WS_CTL), (volatile LAS unsigned*)(C.lds + LDS_MISC));
#define IN(k) (lo <= (k) && (k) < hi)
#define SEAM(k) do { if (IN(k) && IN((k) + 1)) { xcd_barrier(bar); if ((REPEAT >> 23) & 1u) xcd_barrier(bar); } } while (0)
#define RUN(id, ...) do { { constexpr bool rep = false; (void)rep; __VA_ARGS__; } if ((REPEAT >> (id)) & 1u) { xcd_barrier(bar); { constexpr bool rep = true; (void)rep; __VA_ARGS__; } } } while (0)
#define PHASE_PROGRAM(LO, HI) do { const int lo = (LO), hi = (HI); \
    if (IN(0)) RUN(0, phase0(C, P)); \
    SEAM(0); \
    if (IN(1)) RUN(1, phase1(C, P)); \
    SEAM(1); \
    if (IN(2)) { \
        RUN(2, phase2a(C, P)); \
        RUN(3, phase2b(C, P)); \
    } \
    SEAM(2); \
    if (IN(3)) RUN(5, mlstm_prep(C, P)); \
    SEAM(3); \
    if (IN(4)) RUN(4, mixer_phase<rep ? (int)((REPEAT >> 25) & 3u) : 0>(C, P)); \
    SEAM(4); \
    if (IN(5)) { \
        RUN(9, transpose_z2(C, P)); \
        RUN(8, mlstm_combine(C, P)); \
    } \
    SEAM(5); \
    if (IN(6)) RUN(10, phase_merge(C, P)); \
    SEAM(6); \
    if (IN(7)) RUN(11, phase_outproj(C, P)); \
    SEAM(7); \
    if (IN(8)) RUN(12, phase6(C, P)); \
    SEAM(8); \
    if (IN(9)) { \
        RUN(13, for (int it = C.bid; it < BATCH * NE; it += C.G) topk_item(C, P, it)); \
        __syncthreads(); \
        RUN(14, convert_experts(C, P)); \
    } \
    SEAM(9); \
    if (IN(11)) RUN(16, moe_gemm1(C, P, rep ? (int)((REPEAT >> 25) & 3u) : 0)); \
    SEAM(11); \
    if (IN(12)) RUN(17, moe_gemm2(C, P, rep && ((REPEAT >> 25) & 1u))); \
    SEAM(12); \
    if (IN(13)) phase_final(C, P); \
} while (0)
    PHASE_PROGRAM(P.ph_lo, P.ph_hi);
#undef PHASE_PROGRAM
#undef IN
#undef SEAM
#undef RUN
}

extern "C" void kernel_launch(void* const* d_in, const int* in_sizes, int n_in, void* d_out, int out_size, void* d_ws, size_t ws_size, hipStream_t stream) {
    static int grid = 0;
    if (grid == 0) {
        if (n_in != 27 || out_size != MX * DM || ws_size < WS_END) { fprintf(stderr, "kernel_launch: unexpected shapes (n_in %d, out %d, ws %zu < %zu)\n", n_in, out_size, ws_size, (size_t)WS_END); grid = -1; return; }
        int dev = 0, cus = 0, per_cu = 0;
        hipGetDevice(&dev);
        hipDeviceGetAttribute(&cus, hipDeviceAttributeMultiprocessorCount, dev);
        if (hipFuncSetAttribute((const void*)mega, hipFuncAttributeMaxDynamicSharedMemorySize, LDS_BYTES) != hipSuccess) { fprintf(stderr, "kernel_launch: hipFuncSetAttribute failed\n"); grid = -1; return; }
        if (hipOccupancyMaxActiveBlocksPerMultiprocessor(&per_cu, (const void*)mega, NTHR, LDS_BYTES) != hipSuccess || per_cu < 1) { fprintf(stderr, "kernel_launch: occupancy query says %d\n", per_cu); per_cu = 1; }
        (void)hipGetLastError();
        grid = cus * 1;
        if (grid <= 0) grid = 256;
    }
    if (grid < 0) return;
    Params p; memset(&p, 0, sizeof(p));
    for (int i = 0; i < 27; ++i) p.in[i] = (const float*)d_in[i];
    p.out = (float*)d_out; p.ws = (unsigned char*)d_ws;
    (void)hipMemsetAsync((unsigned char*)d_ws + WS_CTL, 0, XCD_BAR_WORDS * 4, stream);
#if N_LAUNCH_MODE == 1
    if (PREFIX > 0) {
        p.ph_lo = 0; p.ph_hi = PREFIX;
        void* pargs[] = {&p};
        (void)hipLaunchCooperativeKernel((const void*)mega, dim3(grid), dim3(NTHR), pargs, LDS_BYTES, stream);
        (void)hipMemsetAsync((unsigned char*)d_ws + WS_CTL, 0, XCD_BAR_WORDS * 4, stream);
    }
    p.ph_lo = 0; p.ph_hi = N_PHASES;
    void* args[] = {&p};
    hipError_t e = hipLaunchCooperativeKernel((const void*)mega, dim3(grid), dim3(NTHR), args, LDS_BYTES, stream);
    if (e != hipSuccess) fprintf(stderr, "kernel_launch: cooperative launch failed: %s (grid %d)\n", hipGetErrorString(e), grid);
#else
    for (int ph = 0; ph < N_PHASES; ++ph) {
        p.ph_lo = ph; p.ph_hi = ph + 1;
        void* args[] = {&p};
        hipError_t e = hipLaunchCooperativeKernel((const void*)mega, dim3(grid), dim3(NTHR), args, LDS_BYTES, stream);
        if (e != hipSuccess) { fprintf(stderr, "kernel_launch: launch %d failed: %s (grid %d)\n", ph, hipGetErrorString(e), grid); break; }
    }
#endif
}
```

```cpp
#include <hip/hip_runtime.h>
#include <hip/hip_cooperative_groups.h>
#include <cstdio>
#include <cstdint>
#include <cstring>
namespace cg = cooperative_groups;

#ifndef N_LAUNCH_MODE
#define N_LAUNCH_MODE 1
#endif

#define LAS __attribute__((address_space(3)))
typedef unsigned short bf16_t;
typedef short bf16x8 __attribute__((ext_vector_type(8)));
typedef float f32x4 __attribute__((ext_vector_type(4)));
typedef float f32x16 __attribute__((ext_vector_type(16)));
typedef unsigned u32x4 __attribute__((ext_vector_type(4)));
typedef unsigned u32x2 __attribute__((ext_vector_type(2)));

constexpr int NTHR = 512;
constexpr int BATCH = 8, SEQ = 4096, DM = 1024, CTXL = 256;
constexpr int MX = BATCH * SEQ;
constexpr int MC = BATCH * CTXL;
constexpr int DIN = 5648, NPROJ = 5632, GATE0 = 3584, MERGE0 = 3600;
constexpr int NE = 16, CAP = 512, DFF = 2048;
constexpr int MT = MX + MC;
constexpr int NCHK = 34;
constexpr float RMS_EPS = 1e-6f;

constexpr size_t MiB = 1u << 20;
constexpr size_t WS_ADAP = 0;
constexpr size_t WS_ADA = 7 * MiB;
constexpr size_t WS_CTL = 7 * MiB + 512 * 1024;
constexpr size_t WS_GATES = 8 * MiB;
constexpr size_t WS_KREV = 11 * MiB;
constexpr size_t WS_BL = 27 * MiB;
constexpr size_t WS_MST = 27 * MiB + 64 * 1024;
constexpr size_t WS_NLOC = 28 * MiB;
constexpr size_t WS_NST = 30 * MiB;
constexpr size_t WS_WIN = 32 * MiB;
constexpr size_t WS_WB = 43 * MiB;
constexpr size_t WS_WOUT = 45 * MiB;
constexpr size_t WS_HX = 48 * MiB;
constexpr size_t WS_PLOC = 48 * MiB;
constexpr size_t WS_PCM = 116 * MiB;
constexpr size_t WS_PML = 212 * MiB;
constexpr size_t WS_KVCM = 276 * MiB;
constexpr size_t WS_GC = 2 * MiB;
constexpr size_t WS_Z1 = 344 * MiB;
constexpr size_t WS_YAB = 376 * MiB;
constexpr size_t WS_CST = 440 * MiB;
constexpr size_t WS_KACT = 48 * MiB;
constexpr size_t WS_QACT = 82 * MiB;
constexpr size_t WS_HDIR = 440 * MiB;
constexpr size_t WS_Z2CM = 504 * MiB;
constexpr size_t WS_Z = 48 * MiB;
constexpr size_t WS_XMID = 496 * MiB;
constexpr size_t WS_AFF = 0;
constexpr size_t WS_SLOT = 2 * MiB;
constexpr size_t WS_SIDX = 4 * MiB;
constexpr size_t WS_SGATE = 4 * MiB + 512 * 1024;
constexpr size_t WS_HX2 = 48 * MiB;
constexpr size_t WS_W13 = 80 * MiB;
constexpr size_t WS_W2 = 144 * MiB;
constexpr size_t WS_XG = 176 * MiB;
constexpr size_t WS_ACT = 240 * MiB;
constexpr size_t WS_YE = 368 * MiB;
constexpr size_t WS_END = 568 * MiB;

constexpr int LDS_BYTES = 147456;
constexpr int LDS_MISC = LDS_BYTES - 128;
constexpr int PREFIX = 0;
constexpr unsigned REPEAT = 0u;

__device__ __forceinline__ unsigned f2bf(float f) { unsigned u = __builtin_bit_cast(unsigned, f); return (u + 0x7fffu + ((u >> 16) & 1u)) >> 16; }
__device__ __forceinline__ unsigned pk2(float lo, float hi) { return f2bf(lo) | (f2bf(hi) << 16); }
__device__ __forceinline__ float bf2f(unsigned short b) { return __builtin_bit_cast(float, ((unsigned)b) << 16); }
__device__ __forceinline__ float bflo(unsigned w) { return __builtin_bit_cast(float, w << 16); }
__device__ __forceinline__ float bfhi(unsigned w) { return __builtin_bit_cast(float, w & 0xffff0000u); }
__device__ __forceinline__ float sigm(float x) { return __builtin_amdgcn_rcpf(1.f + __expf(-x)); }
__device__ __forceinline__ float siluf(float x) { return x * __builtin_amdgcn_rcpf(1.f + __expf(-x)); }
__device__ __forceinline__ float logsig(float x) { return x >= 0.f ? -log1pf(expf(-x)) : x - log1pf(expf(x)); }
__device__ __forceinline__ float wave_sum(float v) {
#pragma unroll
    for (int o = 1; o < 64; o <<= 1) v += __shfl_xor(v, o);
    return v;
}
#define LDS_WAIT() asm volatile("s_waitcnt lgkmcnt(0)" ::: "memory")
__device__ __forceinline__ float clamp8(float x) { return __builtin_amdgcn_fmed3f(x, -448.f, 448.f); }
__device__ __forceinline__ unsigned pk4_fp8(float a, float b, float c, float d) {
    int r = __builtin_amdgcn_cvt_pk_fp8_f32(clamp8(a), clamp8(b), 0, false); r = __builtin_amdgcn_cvt_pk_fp8_f32(clamp8(c), clamp8(d), r, true); return (unsigned)r; }
constexpr float W8_SCALE = 64.f, W8_INV = 1.f / 64.f;
__device__ __forceinline__ unsigned q8(float g) { return (unsigned)__builtin_amdgcn_fmed3f(g * 255.f + 0.5f, 0.f, 255.f); }
__device__ __forceinline__ unsigned pk4_u8(float a, float b, float c, float d) { return q8(a) | (q8(b) << 8) | (q8(c) << 16) | (q8(d) << 24); }
__device__ __forceinline__ float u8f(unsigned w, int i) { return (float)((w >> (8 * i)) & 255u); }

struct Params {
    const float* in[27];
    float* out;
    unsigned char* ws;
    int ph_lo, ph_hi;
};


#define XB_TMO      128
#define XB_XCNT(j)  (256  + 64 * (j))
#define XB_XSUB(j)  (1280 + 64 * (j))
#define XB_XGEN(j)  (2304 + 64 * (j))
#define XB_TOP      3328
#define XB_TOPGEN   3392
#define XCD_BAR_WORDS 3456
#define XB_SPIN_CAP (1u << 18)
__device__ __forceinline__ unsigned xb_ld(unsigned* p)              { return __hip_atomic_load(p, __ATOMIC_RELAXED, __HIP_MEMORY_SCOPE_AGENT); }
__device__ __forceinline__ unsigned xb_add(unsigned* p, unsigned v) { return __hip_atomic_fetch_add(p, v, __ATOMIC_RELAXED, __HIP_MEMORY_SCOPE_AGENT); }
__device__ __forceinline__ unsigned xb_xcc_id() { return (unsigned)__builtin_amdgcn_s_getreg((3 << 11) | 20) & 0xFu; }
#define XB_SPIN(cond, bar) do { unsigned _sp = 0; while (cond) { __builtin_amdgcn_s_sleep(1); \
    if ((++_sp & 255u) == 0u) { if (xb_ld(&(bar)[XB_TMO])) break; if (_sp > XB_SPIN_CAP) { atomicAdd(&(bar)[XB_TMO], 1u); break; } } } } while (0)
struct XcdBarrier { unsigned* bar; unsigned x; volatile LAS unsigned* st; };
__device__ __forceinline__ XcdBarrier xcd_barrier_post(unsigned* bar, volatile LAS unsigned* st) {
    XcdBarrier b; b.bar = bar; b.x = xb_xcc_id(); b.st = st;
    if (threadIdx.x == 0) (void)xb_add(&bar[XB_XCNT(b.x)], 1u);
    return b;
}
__device__ __forceinline__ void xcd_barrier_complete(unsigned* bar, unsigned x, unsigned& nloc, unsigned& nx) {
    const unsigned G = gridDim.x * gridDim.y * gridDim.z;
    unsigned sum, cnt, mine, sp = 0u;
    for (;;) {
        sum = 0u; cnt = 0u; mine = 0u;
#pragma unroll
        for (unsigned j = 0; j < 16; ++j) { const unsigned c = xb_ld(&bar[XB_XCNT(j)]); sum += c; cnt += (c > 0u) ? 1u : 0u; mine = (j == x) ? c : mine; }
        if (sum == G) break;
        __builtin_amdgcn_s_sleep(1);
        if ((++sp & 255u) == 0u) { if (xb_ld(&bar[XB_TMO])) break; if (sp > XB_SPIN_CAP) { atomicAdd(&bar[XB_TMO], 1u); break; } }
    }
    nloc = mine > 0u ? mine : 1u; nx = cnt > 0u ? cnt : 1u;
}
__device__ __forceinline__ void xcd_barrier(const XcdBarrier& b) {
    asm volatile("s_waitcnt vmcnt(0)" ::: "memory");
    __syncthreads();
    if (threadIdx.x == 0) {
        unsigned* bar = b.bar;
        __builtin_amdgcn_s_waitcnt(0);
        unsigned nloc = b.st[0], nx = b.st[1];
        if (nloc == 0u) { xcd_barrier_complete(bar, b.x, nloc, nx); b.st[0] = nloc; b.st[1] = nx; }
        const unsigned old = xb_add(&bar[XB_XSUB(b.x)], 1u);
        const unsigned gen = old / nloc;
        if (old + 1u == (gen + 1u) * nloc) {
            __builtin_amdgcn_fence(__ATOMIC_RELEASE, "agent");
            asm volatile("s_waitcnt vmcnt(0)" ::: "memory");
            const unsigned og = xb_add(&bar[XB_TOP], 1u);
            const unsigned tg = og / nx;
            if (og + 1u == (tg + 1u) * nx) xb_add(&bar[XB_TOPGEN], 1u);
            else XB_SPIN(xb_ld(&bar[XB_TOPGEN]) == tg, bar);
            __builtin_amdgcn_fence(__ATOMIC_ACQUIRE, "agent");
            xb_add(&bar[XB_XGEN(b.x)], 1u);
            asm volatile("s_waitcnt vmcnt(0)" ::: "memory");
        } else {
            XB_SPIN(xb_ld(&bar[XB_XGEN(b.x)]) == gen, bar);
            __builtin_amdgcn_fence(__ATOMIC_ACQUIRE, "agent");
            asm volatile("s_waitcnt vmcnt(0)" ::: "memory");
        }
    }
    __syncthreads();
}

namespace pg8 {
constexpr int BM = 256, BK = 64, HALF = 128, HTB = HALF * BK * 2, STAGE_BYTES = 8 * HTB;
__device__ __forceinline__ int lds_byte(int r, int c) { const int st = (r >> 4) * 2 + (c >> 5), rr = r & 15, cc = c & 31, ob = rr * 64 + cc * 2; return st * 1024 + (ob ^ (((ob >> 9) & 1) << 5)); }
__device__ __forceinline__ void stage_rc(int b, int& R, int& C) { const int st = b / 1024, sb = b % 1024, swz = sb ^ (((sb >> 9) & 1) << 5); R = (st >> 1) * 16 + swz / 64; C = (st & 1) * 32 + (swz % 64) / 2; }
__device__ __forceinline__ int perm32(int rho) { const int n = rho >> 4, i = rho & 15; return 8 * (i >> 2) + 4 * n + (i & 3); }
__device__ __forceinline__ unsigned cvt_pk_bf16(float lo, float hi) { unsigned r; asm volatile("v_cvt_pk_bf16_f32 %0, %1, %2" : "=v"(r) : "v"(lo), "v"(hi)); return r; }

typedef int v4i_t __attribute__((ext_vector_type(4)));
typedef int v8i_t __attribute__((ext_vector_type(8)));
struct Unit { const char* A; const char* B; int pm, pn, aux; };

struct SchedGrid {
    const char* A; const char* B; size_t tstepA, tstepB; int nM, nN, pm0, pn0, G, c;
    int xN, xPm0, xPn0, xCnt;
    int split, gap;
    __device__ bool next(int i, Unit& u) const {
        const long L = (long)i * G + c; const int nwg = nM * nN;
        if (L >= nwg + xCnt) return false;
        if (L >= nwg) { const int q = (int)L - nwg; u.pm = xPm0 + q / xN; u.pn = xPn0 + q % xN; u.aux = 1; }
        else {
            int wgid = (int)L; { const int q = nwg / 8, r = nwg % 8, xcd = wgid % 8, off = wgid / 8; wgid = (xcd < r ? xcd * (q + 1) : r * (q + 1) + (xcd - r) * q) + off; }
            const int nig = 8 * nN, gid = wgid / nig, fm = gid * 8, gsz = (nM - fm) < 8 ? (nM - fm) : 8;
            u.pm = pm0 + fm + ((wgid % nig) % gsz); { const int idx = (wgid % nig) / gsz; u.pn = pn0 + idx + (idx >= split ? gap : 0); } u.aux = 0;
        }
        u.A = A + (size_t)u.pm * tstepA; u.B = B + (size_t)u.pn * tstepB; return true;
    }
};
struct SchedChain {
    SchedGrid G; size_t half;
    __device__ bool next(int i, Unit& u) const {
        if (!G.next(i >> 1, u)) return false;
        u.aux = i & 1; u.A += (size_t)(i & 1) * half; u.B += (size_t)(i & 1) * half; return true;
    }
};

struct SchedMoe {
    const char* A; const char* B; size_t tstepA, tstepB, estepA, estepB; int nM, nN, G, c;
    __device__ bool next(int i, Unit& u) const {
        const long L = (long)i * G + c; const int e8 = (int)(L % 8); const long ta = L / 8; const int per = nM * nN;
        if (ta >= 2L * per) return false;
        const int e = e8 + 8 * (int)(ta / per); const int t = (int)(ta % per);
        if (nN == 16) { const int blk = t >> 5, wi = t & 31; u.pm = 4 * (blk >> 1) + (wi >> 3); u.pn = 8 * (blk & 1) + (wi & 7); }
        else { u.pm = t / nN; u.pn = t % nN; }
        u.aux = e;
        u.A = A + (size_t)e * estepA + (size_t)u.pm * tstepA; u.B = B + (size_t)e * estepB + (size_t)u.pn * tstepB; return true;
    }
};

template <class Epi, class Sched, bool NORMAL, bool F8 = false>
__device__ __forceinline__ void gemm_phase(LAS unsigned char* lds, const int K  , const unsigned lda, const unsigned ldb, const Sched& S, const Epi& E) {
    const int tid = threadIdx.x, wid = __builtin_amdgcn_readfirstlane(tid >> 6), lane = tid & 63, wr = wid >> 2, wc = wid & 3, fr = lane & 15, fq = lane >> 4;
    const int nt = K / BK;
    unsigned voffA[2], voffB[2];
#pragma unroll
    for (int i = 0; i < 2; ++i) { int R, C; stage_rc(tid * 16 + i * 8192, R, C); const int Rb = Epi::PERM ? ((R & ~31) + perm32(R & 31)) : R;
        voffA[i] = (unsigned)R * lda + (unsigned)C * 2u; voffB[i] = (unsigned)Rb * ldb + (unsigned)C * 2u; }
    const size_t kstep = (size_t)(BK * 2);
    const size_t hstepA = (size_t)HALF * lda, hstepB = (size_t)HALF * ldb;
    const unsigned ldsw = (unsigned)wid * 1024u;
    const int aoff = lds_byte(wr * 64 + fr, fq * 8), boff = lds_byte(wc * 32 + fr, fq * 8);
#define PG8_SA(b, h) (((b) * 2 + (h)) * HTB)
#define PG8_SB(b, h) ((4 + (b) * 2 + (h)) * HTB)
#define PG8_STAGE(bufoff, gbase, voff) do { _Pragma("unroll") for (int _i = 0; _i < 2; ++_i) \
        __builtin_amdgcn_global_load_lds((const unsigned*)((const char*)(gbase) + (voff)[_i]), (LAS unsigned*)(lds + (bufoff) + ldsw + _i * 8192), 16, 0, 0); } while (0)
#define PG8_LDA(dst, b, h) do { if constexpr (F8) { _Pragma("unroll") for (int m = 0; m < 4; ++m) dst##8[m] = __builtin_shufflevector(*(const LAS v4i_t*)(lds + PG8_SA(b, h) + aoff + m * 2048), *(const LAS v4i_t*)(lds + PG8_SA(b, h) + aoff + m * 2048 + 1024), 0, 1, 2, 3, 4, 5, 6, 7); } \
        else { _Pragma("unroll") for (int m = 0; m < 4; ++m) _Pragma("unroll") for (int k = 0; k < 2; ++k) dst[m][k] = *(const LAS bf16x8*)(lds + PG8_SA(b, h) + aoff + m * 2048 + k * 1024); } } while (0)
#define PG8_LDB(dst, b, h) do { if constexpr (F8) { _Pragma("unroll") for (int n = 0; n < 2; ++n) dst##8[n] = __builtin_shufflevector(*(const LAS v4i_t*)(lds + PG8_SB(b, h) + boff + n * 2048), *(const LAS v4i_t*)(lds + PG8_SB(b, h) + boff + n * 2048 + 1024), 0, 1, 2, 3, 4, 5, 6, 7); } \
        else { _Pragma("unroll") for (int n = 0; n < 2; ++n) _Pragma("unroll") for (int k = 0; k < 2; ++k) dst[n][k] = *(const LAS bf16x8*)(lds + PG8_SB(b, h) + boff + n * 2048 + k * 1024); } } while (0)
#define PG8_MMA(ai, bj, At, Bt) do { __builtin_amdgcn_s_setprio(1); \
        if constexpr (F8) { _Pragma("unroll") for (int m = 0; m < 4; ++m) _Pragma("unroll") for (int n = 0; n < 2; ++n) \
            asm volatile("v_mfma_scale_f32_16x16x128_f8f6f4 %0, %1, %2, %0, %3, %3 op_sel_hi:[0,0,0]" : "+v"(acc[ai][bj][m][n]) : "v"(Bt##8[n]), "v"(At##8[m]), "v"(sc8)); } \
        else { _Pragma("unroll") for (int m = 0; m < 4; ++m) _Pragma("unroll") for (int n = 0; n < 2; ++n) _Pragma("unroll") for (int k = 0; k < 2; ++k) \
        acc[ai][bj][m][n] = NORMAL ? __builtin_amdgcn_mfma_f32_16x16x32_bf16(At[m][k], Bt[n][k], acc[ai][bj][m][n], 0, 0, 0) \
                                   : __builtin_amdgcn_mfma_f32_16x16x32_bf16(Bt[n][k], At[m][k], acc[ai][bj][m][n], 0, 0, 0); } __builtin_amdgcn_s_setprio(0); } while (0)
#define PG8_WAIT_V(n) asm volatile("s_waitcnt vmcnt(" #n ")" ::: "memory")
#define PG8_WAIT_L(n) asm volatile("s_waitcnt lgkmcnt(" #n ")" ::: "memory")
#define PG8_BAR __builtin_amdgcn_s_barrier()
#define PG8_SCHED __builtin_amdgcn_sched_barrier(0)
    Unit cur, nxt; int ui = 0;
    if (!S.next(0, cur)) return;
    f32x4 acc[2][2][4][2];
#pragma unroll
    for (int a = 0; a < 2; ++a)
#pragma unroll
        for (int b = 0; b < 2; ++b)
#pragma unroll
            for (int m = 0; m < 4; ++m)
#pragma unroll
                for (int n = 0; n < 2; ++n) acc[a][b][m][n] = (f32x4){0.f, 0.f, 0.f, 0.f};
    bf16x8 At[4][2], B0[2][2], B1[2][2];
    v8i_t At8[4], B08[2], B18[2]; const int sc8 = 0x7F7F7F7F;
    const char* cA = cur.A; const char* cB = cur.B;
    PG8_STAGE(PG8_SB(0, 0), cB, voffB); PG8_STAGE(PG8_SB(0, 1), cB + hstepB, voffB); PG8_STAGE(PG8_SA(0, 0), cA, voffA); PG8_STAGE(PG8_SA(0, 1), cA + hstepA, voffA);
    if (wr == 1) PG8_BAR;
    PG8_WAIT_V(2); PG8_BAR;
    PG8_STAGE(PG8_SB(1, 0), cB + kstep, voffB); PG8_STAGE(PG8_SA(1, 0), cA + kstep, voffA); PG8_STAGE(PG8_SB(1, 1), cB + hstepB + kstep, voffB);
    PG8_WAIT_V(6); PG8_BAR;
    for (;;) {
        const bool has_next = S.next(ui + 1, nxt);
        const char* nA = has_next ? nxt.A : cA; const char* nB = has_next ? nxt.B : cB;
#pragma unroll 1
        for (int t = 0; t < nt; t += 2) {
            const bool last = (t == nt - 2);
            const char* a1 = cA + (size_t)(t + 1) * kstep;
            const char* a2 = last ? nA : cA + (size_t)(t + 2) * kstep; const char* b2 = last ? nB : cB + (size_t)(t + 2) * kstep;
            const char* a3 = a2 + kstep; const char* b3 = b2 + kstep;
            PG8_LDB(B0, 0, 0); PG8_LDB(B1, 0, 1); PG8_SCHED; PG8_LDA(At, 0, 0); PG8_STAGE(PG8_SA(1, 1), a1 + hstepA, voffA);
            PG8_WAIT_V(8); PG8_WAIT_L(0); PG8_BAR; PG8_MMA(0, 0, At, B0); PG8_MMA(0, 1, At, B1); PG8_BAR; PG8_SCHED;
            PG8_LDA(At, 0, 1); PG8_STAGE(PG8_SB(0, 0), b2, voffB); PG8_STAGE(PG8_SB(0, 1), b2 + hstepB, voffB); PG8_STAGE(PG8_SA(0, 0), a2, voffA);
            PG8_WAIT_V(8); PG8_WAIT_L(0); PG8_BAR; PG8_MMA(1, 0, At, B0); PG8_MMA(1, 1, At, B1); PG8_BAR; PG8_SCHED;
            PG8_LDB(B0, 1, 0); PG8_LDB(B1, 1, 1); PG8_SCHED; PG8_LDA(At, 1, 0); PG8_STAGE(PG8_SA(0, 1), a2 + hstepA, voffA);
            PG8_WAIT_V(8); PG8_WAIT_L(0); PG8_BAR; PG8_MMA(0, 0, At, B0); PG8_MMA(0, 1, At, B1); PG8_BAR; PG8_SCHED;
            PG8_LDA(At, 1, 1); PG8_STAGE(PG8_SB(1, 0), b3, voffB); PG8_STAGE(PG8_SB(1, 1), b3 + hstepB, voffB); PG8_STAGE(PG8_SA(1, 0), a3, voffA);
            PG8_WAIT_V(8); PG8_WAIT_L(0); PG8_BAR; PG8_MMA(1, 0, At, B0); PG8_MMA(1, 1, At, B1); PG8_BAR; PG8_SCHED;
        }
        if (wr == 0) PG8_BAR;
        if constexpr (F8) asm volatile("s_nop 15\n\ts_nop 15" ::: "memory");
        bool keep = false;
        if constexpr (Epi::HAS_MID) { if (cur.aux == 0) { E.mid(acc, cur, wr, wc, fr, fq); keep = true; } else E(acc, cur, wr, wc, fr, fq); }
        else E(acc, cur, wr, wc, fr, fq);
        if (!has_next) break;
        if (!keep) {
#pragma unroll
        for (int a = 0; a < 2; ++a)
#pragma unroll
            for (int b = 0; b < 2; ++b)
#pragma unroll
                for (int m = 0; m < 4; ++m)
#pragma unroll
                    for (int n = 0; n < 2; ++n) acc[a][b][m][n] = (f32x4){0.f, 0.f, 0.f, 0.f};
        }
        cur = nxt; cA = nA; cB = nB; ++ui;
        if (wr == 1) PG8_BAR;
    }
    PG8_WAIT_V(0);
    PG8_BAR;
#undef PG8_SA
#undef PG8_SB
#undef PG8_STAGE
#undef PG8_LDA
#undef PG8_LDB
#undef PG8_MMA
#undef PG8_WAIT_V
#undef PG8_WAIT_L
#undef PG8_BAR
#undef PG8_SCHED
}


struct EpiCM {
    static constexpr bool PERM = false, HAS_MID = false;
    bf16_t* pcm; bf16_t* kvcm; const float* bias;
    __device__ __forceinline__ void operator()(const f32x4 (&acc)[2][2][4][2], const Unit& u, int wr, int wc, int fr, int fq) const {
        const bool kv = u.pn >= 8;
#pragma unroll
        for (int bj = 0; bj < 2; ++bj)
#pragma unroll
            for (int n = 0; n < 2; ++n) {
                const int c = u.pn * BM + bj * HALF + wc * 32 + n * 16 + fr; const float bv = bias[c];
                bf16_t* base = kv ? (kvcm + (size_t)(c - 2048) * MT) : (pcm + (size_t)c * MX);
#pragma unroll
                for (int ai = 0; ai < 2; ++ai)
#pragma unroll
                    for (int m = 0; m < 4; ++m) {
                        const int r = u.pm * BM + ai * HALF + wr * 64 + m * 16 + 4 * fq; const f32x4 v = acc[ai][bj][m][n] + bv;
                        u32x2 w; w.x = cvt_pk_bf16(v[0], v[1]); w.y = cvt_pk_bf16(v[2], v[3]);
                        *(u32x2*)(base + r) = w; }
                asm volatile("" ::: "memory");
            }
    }
};

struct EpiIn2 {
    static constexpr bool PERM = true, HAS_MID = false;
    bf16_t* pml; unsigned char* pmg; const float* bias;
    __device__ __forceinline__ void operator()(const f32x4 (&acc)[2][2][4][2], const Unit& u, int wr, int wc, int fr, int fq) const {
        const int colt = u.pn * BM; int cbase, bofs = 0; const int row0 = u.pm * BM; bool sg = false;
        if (colt < 2048) cbase = colt - 1536;
        else if (colt < GATE0) cbase = colt - 3072 + 512;
        else { cbase = colt - GATE0; bofs = 16; sg = true; }
        const int col0 = cbase + wc * 32 + 8 * fq, bcol0 = colt + bofs + wc * 32 + 8 * fq;
        f32x4 bv[2][2];
#pragma unroll
        for (int bj = 0; bj < 2; ++bj)
#pragma unroll
            for (int n = 0; n < 2; ++n) bv[bj][n] = *(const f32x4*)(bias + bcol0 + bj * HALF + 4 * n);
#pragma unroll
        for (int ai = 0; ai < 2; ++ai)
#pragma unroll
            for (int m = 0; m < 4; ++m) { const size_t row = (size_t)(row0 + wr * 64 + fr + ai * HALF + m * 16);
#pragma unroll
                for (int bj = 0; bj < 2; ++bj) { f32x4 v0 = acc[ai][bj][m][0] + bv[bj][0], v1 = acc[ai][bj][m][1] + bv[bj][1];
                    if (sg) { u32x2 w; w.x = pk4_u8(sigm(v0[0]), sigm(v0[1]), sigm(v0[2]), sigm(v0[3])); w.y = pk4_u8(sigm(v1[0]), sigm(v1[1]), sigm(v1[2]), sigm(v1[3]));
                        *(u32x2*)(pmg + row * 2048 + col0 + bj * HALF) = w; }
                    else { u32x4 w; w.x = cvt_pk_bf16(v0[0], v0[1]); w.y = cvt_pk_bf16(v0[2], v0[3]); w.z = cvt_pk_bf16(v1[0], v1[1]); w.w = cvt_pk_bf16(v1[2], v1[3]);
                        *(u32x4*)(pml + row * 1024 + col0 + bj * HALF) = w; } }
                asm volatile("" ::: "memory"); }
    }
};

struct EpiMerge {
    static constexpr bool PERM = true, HAS_MID = true;
    bf16_t* Z; const unsigned char* pmg;
    __device__ __forceinline__ void mid(f32x4 (&acc)[2][2][4][2], const Unit& u, int wr, int wc, int fr, int fq) const {
        const int row0 = u.pm * BM + wr * 64 + fr, col0 = u.pn * BM + wc * 32 + 8 * fq;
#pragma unroll
        for (int ai = 0; ai < 2; ++ai) {
            u32x2 ga[4][2], gb[4][2];
#pragma unroll
            for (int m = 0; m < 4; ++m)
#pragma unroll
                for (int bj = 0; bj < 2; ++bj) { const unsigned char* gp = pmg + (size_t)(row0 + ai * HALF + m * 16) * 2048 + col0 + bj * HALF;
                    ga[m][bj] = *(const u32x2*)gp; gb[m][bj] = *(const u32x2*)(gp + 1024); }
#pragma unroll
            for (int m = 0; m < 4; ++m)
#pragma unroll
                for (int bj = 0; bj < 2; ++bj) { const u32x2 a = ga[m][bj], b = gb[m][bj];
                    f32x4& v0 = acc[ai][bj][m][0]; f32x4& v1 = acc[ai][bj][m][1];
#pragma unroll
                    for (int j = 0; j < 4; ++j) { v0[j] *= u8f(a.x, j) * __builtin_amdgcn_rcpf(fmaxf(u8f(b.x, j), 1.f)); v1[j] *= u8f(a.y, j) * __builtin_amdgcn_rcpf(fmaxf(u8f(b.y, j), 1.f)); } }
            asm volatile("" ::: "memory"); }
    }
    __device__ __forceinline__ void operator()(const f32x4 (&acc)[2][2][4][2], const Unit& u, int wr, int wc, int fr, int fq) const {
        const int row0 = u.pm * BM + wr * 64 + fr, col0 = u.pn * BM + wc * 32 + 8 * fq;
#pragma unroll
        for (int ai = 0; ai < 2; ++ai) {
            u32x2 g[4][2];
#pragma unroll
            for (int m = 0; m < 4; ++m)
#pragma unroll
                for (int bj = 0; bj < 2; ++bj) g[m][bj] = *(const u32x2*)(pmg + (size_t)(row0 + ai * HALF + m * 16) * 2048 + 1024 + col0 + bj * HALF);
#pragma unroll
            for (int m = 0; m < 4; ++m)
#pragma unroll
                for (int bj = 0; bj < 2; ++bj) { const size_t row = (size_t)(row0 + ai * HALF + m * 16); const u32x2 gg = g[m][bj];
                    f32x4 v0 = acc[ai][bj][m][0], v1 = acc[ai][bj][m][1];
#pragma unroll
                    for (int j = 0; j < 4; ++j) { v0[j] *= fmaxf(u8f(gg.x, j), 1.f) * (1.f / 255.f); v1[j] *= fmaxf(u8f(gg.y, j), 1.f) * (1.f / 255.f); }
                    u32x4 w; w.x = cvt_pk_bf16(v0[0], v0[1]); w.y = cvt_pk_bf16(v0[2], v0[3]); w.z = cvt_pk_bf16(v1[0], v1[1]); w.w = cvt_pk_bf16(v1[2], v1[3]);
                    *(u32x4*)(Z + row * 1024 + col0 + bj * HALF) = w; }
            asm volatile("" ::: "memory"); }
    }
};

struct EpiOut {
    static constexpr bool PERM = true, HAS_MID = false;
    const float* x; bf16_t* xmid; const float* ada;
    __device__ __forceinline__ void operator()(const f32x4 (&acc)[2][2][4][2], const Unit& u, int wr, int wc, int fr, int fq) const {
        const int row0 = u.pm * BM + wr * 64 + fr, col0 = u.pn * BM + wc * 32 + 8 * fq;
        const int b = (u.pm * BM) / SEQ;
        f32x4 gv[2][2];
#pragma unroll
        for (int bj = 0; bj < 2; ++bj)
#pragma unroll
            for (int n = 0; n < 2; ++n) gv[bj][n] = *(const f32x4*)(ada + (size_t)b * 6144 + 2048 + col0 + bj * HALF + 4 * n);
#pragma unroll
        for (int ai = 0; ai < 2; ++ai)
#pragma unroll
            for (int m = 0; m < 4; ++m) {
                f32x4 xv[2][2]; const size_t off = (size_t)(row0 + ai * HALF + m * 16) * DM + col0;
#pragma unroll
                for (int bj = 0; bj < 2; ++bj)
#pragma unroll
                    for (int n = 0; n < 2; ++n) xv[bj][n] = *(const f32x4*)(x + off + bj * HALF + 4 * n);
#pragma unroll
                for (int bj = 0; bj < 2; ++bj) { const f32x4 v0 = xv[bj][0] + gv[bj][0] * acc[ai][bj][m][0], v1 = xv[bj][1] + gv[bj][1] * acc[ai][bj][m][1];
                    u32x4 w; w.x = cvt_pk_bf16(v0[0], v0[1]); w.y = cvt_pk_bf16(v0[2], v0[3]); w.z = cvt_pk_bf16(v1[0], v1[1]); w.w = cvt_pk_bf16(v1[2], v1[3]);
                    *(u32x4*)(xmid + off + bj * HALF) = w; }
                if (m & 1) asm volatile("" ::: "memory"); }
    }
};

struct EpiMoe1 {
    static constexpr bool PERM = true, HAS_MID = false;
    unsigned char* act; int skip;
    __device__ __forceinline__ void operator()(const f32x4 (&acc)[2][2][4][2], const Unit& u, int wr, int wc, int fr, int fq) const {
        if (skip == 1) { asm volatile("" :: "v"(acc[0][0][0][0]), "v"(acc[1][1][3][1])); return; }
        const int row0 = u.aux * 4096 + u.pm * BM + wr * 64 + fr, col0 = (u.pn * BM + wc * 32) / 2 + 4 * fq;
#pragma unroll
        for (int ai = 0; ai < 2; ++ai)
#pragma unroll
            for (int m = 0; m < 4; ++m) { unsigned char* rowp = act + (size_t)(row0 + ai * HALF + m * 16) * DFF + col0;
#pragma unroll
                for (int bj = 0; bj < 2; ++bj) { const f32x4 v0 = acc[ai][bj][m][0] * W8_INV, v1 = acc[ai][bj][m][1] * W8_INV;
                    const unsigned pk = pk4_fp8(siluf(v0[0]) * v0[1], siluf(v0[2]) * v0[3], siluf(v1[0]) * v1[1], siluf(v1[2]) * v1[3]);
                    if (skip == 2) asm volatile("" :: "v"(pk)); else *(unsigned*)(rowp + bj * (HALF / 2)) = pk; }
                asm volatile("" ::: "memory"); }
    }
};

struct EpiMoe2 {
    static constexpr bool PERM = true, HAS_MID = false;
    unsigned char* ye; const float* sgate; bool skip;
    __device__ __forceinline__ void operator()(const f32x4 (&acc)[2][2][4][2], const Unit& u, int wr, int wc, int fr, int fq) const {
        if (skip) { asm volatile("" :: "v"(acc[0][0][0][0]), "v"(acc[1][1][3][1])); return; }
        const int e = u.aux, col0 = u.pn * BM + wc * 32 + 8 * fq;
        float gt[2][4];
#pragma unroll
        for (int ai = 0; ai < 2; ++ai)
#pragma unroll
            for (int m = 0; m < 4; ++m) { const int rr = u.pm * BM + wr * 64 + fr + ai * HALF + m * 16; gt[ai][m] = sgate[((rr >> 9) * NE + e) * CAP + (rr & 511)] * (W8_INV * 16.f); }
#pragma unroll
        for (int ai = 0; ai < 2; ++ai)
#pragma unroll
            for (int m = 0; m < 4; ++m) { const int rr = u.pm * BM + wr * 64 + fr + ai * HALF + m * 16;
                const float g = gt[ai][m];
                unsigned char* rowp = ye + ((size_t)e * 4096 + rr) * DM + col0;
#pragma unroll
                for (int bj = 0; bj < 2; ++bj) { const f32x4 v0 = acc[ai][bj][m][0] * g, v1 = acc[ai][bj][m][1] * g;
                    u32x2 w; w.x = pk4_fp8(v0[0], v0[1], v0[2], v0[3]); w.y = pk4_fp8(v1[0], v1[1], v1[2], v1[3]);
                    *(u32x2*)(rowp + bj * HALF) = w; }
                asm volatile("" ::: "memory"); }
    }
};
}

struct Ctx {
    LAS unsigned char* lds;
    int tid, lane, wave, bid, G;
};

__device__ __forceinline__ void transpose_item(const float* W, int ldw, int ldt, int ncol0, bf16_t* WT, int dst_row0, int rmul, LAS float* scr, int kb, int nb, int lane) {
    const int k0 = 64 * kb, n0 = 32 * nb;
#pragma unroll 8
    for (int i = 0; i < 32; ++i) { const int kk = 2 * i + (lane >> 5); scr[kk * 33 + (lane & 31)] = W[(size_t)(k0 + kk) * ldw + ncol0 + n0 + (lane & 31)]; }
    LDS_WAIT();
    const int c = lane & 7;
#pragma unroll
    for (int j = 0; j < 4; ++j) { const int n = (lane >> 3) + 8 * j; const LAS float* s = scr + (8 * c) * 33 + n;
        u32x4 o; o.x = pk2(s[0 * 33], s[1 * 33]); o.y = pk2(s[2 * 33], s[3 * 33]); o.z = pk2(s[4 * 33], s[5 * 33]); o.w = pk2(s[6 * 33], s[7 * 33]);
        *(u32x4*)(WT + (size_t)(dst_row0 + (n0 + n) * rmul) * ldt + k0 + 8 * c) = o; }
    LDS_WAIT();
}

__device__ __forceinline__ void transpose_item_f8(const float* W, int ldw, int K, unsigned char* WT, int dst_row0, int rmul, LAS float* scr, int kb, int nb, int lane) {
    const int k0 = 64 * kb, n0 = 32 * nb;
#pragma unroll 8
    for (int i = 0; i < 32; ++i) { const int kk = 2 * i + (lane >> 5); scr[kk * 33 + (lane & 31)] = W[(size_t)(k0 + kk) * ldw + n0 + (lane & 31)]; }
    LDS_WAIT();
    const int c = lane & 3;
#pragma unroll
    for (int j = 0; j < 2; ++j) { const int n = (lane >> 2) + 16 * j; const LAS float* s = scr + (16 * c) * 33 + n;
        u32x4 o;
        o.x = pk4_fp8(s[0 * 33] * W8_SCALE, s[1 * 33] * W8_SCALE, s[2 * 33] * W8_SCALE, s[3 * 33] * W8_SCALE);
        o.y = pk4_fp8(s[4 * 33] * W8_SCALE, s[5 * 33] * W8_SCALE, s[6 * 33] * W8_SCALE, s[7 * 33] * W8_SCALE);
        o.z = pk4_fp8(s[8 * 33] * W8_SCALE, s[9 * 33] * W8_SCALE, s[10 * 33] * W8_SCALE, s[11 * 33] * W8_SCALE);
        o.w = pk4_fp8(s[12 * 33] * W8_SCALE, s[13 * 33] * W8_SCALE, s[14 * 33] * W8_SCALE, s[15 * 33] * W8_SCALE);
        *(u32x4*)(WT + (size_t)(dst_row0 + (n0 + n) * rmul) * K + k0 + 16 * c) = o; }
    LDS_WAIT();
}

__device__ __forceinline__ void convert_experts(const Ctx& C, const Params& P) {
    unsigned char* w13 = P.ws + WS_W13; unsigned char* w2 = P.ws + WS_W2;
    LAS float* scr = (LAS float*)(C.lds + C.wave * 8448);
    const int PER_E = 3072;
    const int nbusy = (BATCH * NE < C.G) ? BATCH * NE : C.G, nfree = C.G - nbusy;
    const int NPRE = (nfree > 0) ? 6912 : 0;
    for (int pass = 0; pass < 2; ++pass) {
    const int lo = pass ? NPRE : 0, hi = pass ? NE * PER_E : NPRE;
    const int gw = pass ? (C.bid * 8 + C.wave) : ((C.bid - nbusy) * 8 + C.wave), NGW = pass ? C.G * 8 : nfree * 8;
    if (!pass && C.bid < nbusy) continue;
    for (int it = lo + gw; it < hi; it += NGW) {
        const int e = it / PER_E, r = it % PER_E;
        if (r < 1024) transpose_item_f8(P.in[23] + (size_t)e * DM * DFF, DFF, DM, w13 + (size_t)e * 4096 * DM, 0, 2, scr, r / 64, r % 64, C.lane);
        else if (r < 2048) transpose_item_f8(P.in[24] + (size_t)e * DM * DFF, DFF, DM, w13 + (size_t)e * 4096 * DM, 1, 2, scr, (r - 1024) / 64, (r - 1024) % 64, C.lane);
        else transpose_item_f8(P.in[25] + (size_t)e * DFF * DM, DM, DFF, w2 + (size_t)e * DM * DFF, 0, 1, scr, (r - 2048) / 32, (r - 2048) % 32, C.lane);
    }
    }
}

__device__ __forceinline__ void phase0(const Ctx& C, const Params& P) {
    unsigned char* ws = P.ws;
    const int gw = C.bid * 8 + C.wave, NGW = C.G * 8;
    {
        LAS float* scr = (LAS float*)(C.lds + C.wave * 8448);
        const int I_IN1 = 16 * 112, I_IN2 = 16 * 64, I_BH = 8 * 32, I_BM = 8 * 32, I_OUT = 16 * 32;
        const int NIT = I_IN1 + I_IN2 + I_BH + I_BM + I_OUT;
        for (int it = gw; it < NIT; it += NGW) {
            int r = it;
            if (r < I_IN1) { transpose_item(P.in[8], DIN, DM, 0, (bf16_t*)(ws + WS_WIN), 0, 1, scr, r / 112, r % 112, C.lane); continue; } r -= I_IN1;
            if (r < I_IN2) { transpose_item(P.in[8], DIN, DM, MERGE0, (bf16_t*)(ws + WS_WIN), GATE0, 1, scr, r / 64, r % 64, C.lane); continue; } r -= I_IN2;
            if (r < I_BH) { transpose_item(P.in[19], DM, 1024, 0, (bf16_t*)(ws + WS_WB), 0, 1, scr, r / 32, r % 32, C.lane); continue; } r -= I_BH;
            if (r < I_BM) { transpose_item(P.in[20], DM, 1024, 0, (bf16_t*)(ws + WS_WB) + 512, 0, 1, scr, r / 32, r % 32, C.lane); continue; } r -= I_BM;
            transpose_item(P.in[21], DM, DM, 0, (bf16_t*)(ws + WS_WOUT), 0, 1, scr, r / 32, r % 32, C.lane);
        }
    }
    {
        const float* wada = P.in[4]; const float* bada = P.in[5]; float* part = (float*)(ws + WS_ADAP);
        for (int it = gw; it < 96 * 8; it += NGW) {
            const int cgp = it % 96, ks = it / 96, n = cgp * 64 + C.lane;
            float a[9];
#pragma unroll
            for (int r = 0; r < 9; ++r) a[r] = 0.f;
#pragma unroll 1
            for (int k1 = 0; k1 < 4; ++k1) {
                const int k0 = ks * 128 + k1 * 32;
                float sv[9];
                { const int k = k0 + (C.lane & 31);
#pragma unroll
                  for (int r = 0; r < 8; ++r) sv[r] = siluf(P.in[1][r * DM + k]);
                  sv[8] = siluf(P.in[3][k]); }
                float wv[32];
#pragma unroll
                for (int kk = 0; kk < 32; ++kk) wv[kk] = wada[(size_t)(k0 + kk) * 6144 + n];
#pragma unroll
                for (int kk = 0; kk < 32; ++kk) {
#pragma unroll
                    for (int r = 0; r < 9; ++r) a[r] += __shfl(sv[r], kk) * wv[kk]; }
            }
            const float bb = (ks == 0) ? bada[n] : 0.f;
#pragma unroll
            for (int r = 0; r < 9; ++r) part[((size_t)ks * 9 + r) * 6144 + n] = a[r] + bb;
        }
    }
    __syncthreads();
    {
        LAS float* zs = (LAS float*)C.lds;
        LAS float* h1 = zs + 16 * 33;
        LAS float* h2 = h1 + 16 * 64;
        LAS float* w1s = h2 + 16 * 64;
        LAS float* w2s = w1s + 33 * 64;
        bf16_t* krev = (bf16_t*)(ws + WS_KREV);
        const float* w1 = P.in[11]; const float* b1 = P.in[12]; const float* w2 = P.in[13]; const float* b2 = P.in[14]; const float* w3 = P.in[15];
        for (int idx = C.tid; idx < 33 * 64; idx += NTHR) w1s[idx] = w1[idx];
        for (int idx = C.tid; idx < 64 * 64; idx += NTHR) w2s[idx] = w2[idx];
        for (int it = C.bid; it < 256; it += C.G) {
            const int l0 = it * 16;
            __syncthreads();
            for (int idx = C.tid; idx < 16 * 33; idx += NTHR) { const int pos = idx / 33, m = idx % 33, l = l0 + pos; float v;
                if (m == 0) v = (float)l / 4095.0f;
                else { const int bi = (m - 1) & 15; const float band = 1e-4f + (float)bi * ((15.0f - 1e-4f) / 15.0f);
                    const float ang = ((float)(2.0 * 3.14159265358979323846 / 4096.0) * (float)l) * band; v = (m <= 16) ? cosf(ang) : sinf(ang); }
                zs[idx] = v; }
            __syncthreads();
            for (int idx = C.tid; idx < 16 * 64; idx += NTHR) { const int pos = idx >> 6, j = idx & 63; float s = b1[j];
#pragma unroll
                for (int m = 0; m < 33; ++m) s += zs[pos * 33 + m] * w1s[m * 64 + j];
                h1[idx] = sinf(s); }
            __syncthreads();
            for (int idx = C.tid; idx < 16 * 64; idx += NTHR) { const int pos = idx >> 6, j = idx & 63; float s = b2[j];
#pragma unroll 16
                for (int k = 0; k < 64; ++k) s += h1[pos * 64 + k] * w2s[k * 64 + j];
                h2[j * 16 + pos] = sinf(s); }
            __syncthreads();
#pragma unroll 1
            for (int q = 0; q < 4; ++q) {
                const int n = C.tid + NTHR * q;
                float a[16];
#pragma unroll
                for (int p = 0; p < 16; ++p) a[p] = 0.f;
                float wv[16];
#pragma unroll
                for (int k = 0; k < 16; ++k) wv[k] = w3[k * 2048 + n];
#pragma unroll 1
                for (int kb = 0; kb < 4; ++kb) {
                    float wc[16];
#pragma unroll
                    for (int k = 0; k < 16; ++k) wc[k] = wv[k];
                    const int kn = (kb < 3) ? (kb + 1) * 16 : 0;
#pragma unroll
                    for (int k = 0; k < 16; ++k) wv[k] = w3[(kn + k) * 2048 + n];
#pragma unroll
                    for (int kk = 0; kk < 16; ++kk) { const float w = wc[kk]; const LAS float* hp = h2 + (kb * 16 + kk) * 16;
#pragma unroll
                        for (int p4 = 0; p4 < 4; ++p4) { const f32x4 hv = *(const LAS f32x4*)(hp + 4 * p4);
                            a[4 * p4] += hv[0] * w; a[4 * p4 + 1] += hv[1] * w; a[4 * p4 + 2] += hv[2] * w; a[4 * p4 + 3] += hv[3] * w; }
                        if (kk & 1) asm volatile("" ::: "memory"); }
                }
                const int o = n >> 10, side = (n >> 9) & 1, c = n & 511;
                const float delta = fabsf(-3.0701134573253944f + (float)c * ((-15.350567286626972f + 3.0701134573253944f) / 511.0f));
                bf16_t* dst = krev + ((size_t)o * 512 + c) * 8192;
#pragma unroll
                for (int p = 0; p < 16; ++p) { const int l = l0 + p; const float t = (float)l / 4095.0f; const float v = a[p] * expf(-t * delta);
                    if (side == 0) dst[4096 - l] = (bf16_t)f2bf(v);
                    else if (l > 0) dst[4096 + l] = (bf16_t)f2bf(v);
                    else dst[0] = 0; }
            }
        }
    }
}

__device__ __forceinline__ int wl_pos(int k) { return ((k & 3) + 4 * (k >> 8)) * 64 + ((k >> 2) & 63); }
__device__ __forceinline__ float row_dot16(const f32x4 (&y)[4], const LAS float* Wl, int lane) {
    float r[16];
#pragma unroll
    for (int e = 0; e < 16; ++e) r[e] = 0.f;
#pragma unroll
    for (int j = 0; j < 4; ++j) {
#pragma unroll
        for (int q = 0; q < 4; ++q) { const float v = y[j][q]; const LAS float* wp = Wl + ((q + 4 * j) * 64 + lane) * 20;
#pragma unroll
            for (int e4 = 0; e4 < 4; ++e4) { const f32x4 w = *(const LAS f32x4*)(wp + e4 * 4);
                r[e4 * 4 + 0] += v * w[0]; r[e4 * 4 + 1] += v * w[1]; r[e4 * 4 + 2] += v * w[2]; r[e4 * 4 + 3] += v * w[3]; } }
        asm volatile("" ::: "memory"); }
    const bool b5 = (lane & 32) != 0, b4 = (lane & 16) != 0, b3 = (lane & 8) != 0, b2 = (lane & 4) != 0;
    float t[8];
#pragma unroll
    for (int e = 0; e < 8; ++e) { const float snd = b5 ? r[e] : r[e + 8], kp = b5 ? r[e + 8] : r[e]; t[e] = kp + __shfl_xor(snd, 32); }
    float u[4];
#pragma unroll
    for (int e = 0; e < 4; ++e) { const float snd = b4 ? t[e] : t[e + 4], kp = b4 ? t[e + 4] : t[e]; u[e] = kp + __shfl_xor(snd, 16); }
    float v2[2];
#pragma unroll
    for (int e = 0; e < 2; ++e) { const float snd = b3 ? u[e] : u[e + 2], kp = b3 ? u[e + 2] : u[e]; v2[e] = kp + __shfl_xor(snd, 8); }
    float s; { const float snd = b2 ? v2[0] : v2[1], kp = b2 ? v2[1] : v2[0]; s = kp + __shfl_xor(snd, 4); }
    s += __shfl_xor(s, 2); s += __shfl_xor(s, 1);
    return s;
}

__device__ __forceinline__ void phase1(const Ctx& C, const Params& P) {
    unsigned char* ws = P.ws;
    const float* part = (const float*)(ws + WS_ADAP); float* ada = (float*)(ws + WS_ADA);
    for (int o = C.bid * NTHR + C.tid; o < 9 * 6144; o += C.G * NTHR) { float s = 0.f;
#pragma unroll
        for (int ks = 0; ks < 8; ++ks) s += part[(size_t)ks * 9 * 6144 + o];
        ada[o] = s; }
    LAS float* Wg = (LAS float*)C.lds;
    LAS float* mod = Wg + 1024 * 20;
#pragma unroll 1
    for (int i0 = C.tid; i0 < 1024 * 16; i0 += 8 * NTHR) { float t8[8];
#pragma unroll
        for (int u = 0; u < 8; ++u) { const int idx = i0 + u * NTHR; t8[u] = P.in[8][(size_t)(idx >> 4) * DIN + GATE0 + (idx & 15)]; }
#pragma unroll
        for (int u = 0; u < 8; ++u) { const int idx = i0 + u * NTHR; Wg[wl_pos(idx >> 4) * 20 + (idx & 15)] = t8[u]; } }
    const float* gmix = P.in[6]; const float* bin = P.in[9];
    bf16_t* hx = (bf16_t*)(ws + WS_HX); float* gates = (float*)(ws + WS_GATES);
    for (int rg = C.bid; rg < 256; rg += C.G) {
        const int b = rg >> 5;
        __syncthreads();
#pragma unroll 2
        for (int idx = C.tid; idx < 4096; idx += NTHR) { const int which = idx >> 10, k = idx & 1023; const int r = (which < 2) ? b : 8; const int col = (which & 1) * 1024 + k;
            float s = 0.f;
#pragma unroll
            for (int ks = 0; ks < 8; ++ks) s += part[((size_t)ks * 9 + r) * 6144 + col];
            mod[idx] = s; }
        __syncthreads();
        auto rowsrc = [&](int rr) -> const float* { return (rr < 128) ? (P.in[0] + (size_t)(rg * 128 + rr) * DM) : (P.in[2] + (size_t)(rg * 8 + (rr - 128)) * DM); };
        f32x4 nx[4];
        { const float* s0 = rowsrc(C.wave);
#pragma unroll
          for (int j = 0; j < 4; ++j) nx[j] = *(const f32x4*)(s0 + 4 * C.lane + 256 * j); }
        for (int rr = C.wave; rr < 136; rr += 8) {
            const bool isx = rr < 128; const int grow = isx ? (rg * 128 + rr) : (MX + rg * 8 + (rr - 128));
            const LAS float* sh = mod + (isx ? 0 : 2048); const LAS float* sc = sh + 1024;
            f32x4 v[4]; float ss = 0.f;
#pragma unroll
            for (int j = 0; j < 4; ++j) { v[j] = nx[j]; ss += v[j][0] * v[j][0] + v[j][1] * v[j][1] + v[j][2] * v[j][2] + v[j][3] * v[j][3]; }
            if (rr + 8 < 136) { const float* s1 = rowsrc(rr + 8);
#pragma unroll
                for (int j = 0; j < 4; ++j) nx[j] = *(const f32x4*)(s1 + 4 * C.lane + 256 * j); }
            const float rstd = rsqrtf(wave_sum(ss) * (1.f / DM) + RMS_EPS);
#pragma unroll
            for (int j = 0; j < 4; ++j) { const int k = 4 * C.lane + 256 * j; const f32x4 g = *(const f32x4*)(gmix + k);
                const f32x4 s4 = *(const LAS f32x4*)(sc + k), h4 = *(const LAS f32x4*)(sh + k);
#pragma unroll
                for (int q = 0; q < 4; ++q) v[j][q] = (v[j][q] * rstd * g[q]) * (1.f + s4[q]) + h4[q];
                u32x2 w; w.x = pk2(v[j][0], v[j][1]); w.y = pk2(v[j][2], v[j][3]);
                *(u32x2*)(hx + (size_t)grow * DM + k) = w; }
            const float gsum = row_dot16(v, Wg, C.lane);
            if ((C.lane & 3) == 0) gates[(size_t)grow * 16 + (C.lane >> 2)] = gsum + bin[GATE0 + (C.lane >> 2)];
        }
    }
}

__device__ __forceinline__ void phase2a(const Ctx& C, const Params& P) {
    unsigned char* ws = P.ws;
    pg8::SchedGrid S{(const char*)(ws + WS_HX), (const char*)(ws + WS_WIN), (size_t)256 * 2048, (size_t)256 * 2048, 128, 10, 0, 0, C.G, C.bid, 4, 128, 8, 32, 6, 2};
    pg8::EpiCM E{(bf16_t*)(ws + WS_PCM), (bf16_t*)(ws + WS_KVCM), P.in[9]};
    pg8::gemm_phase<pg8::EpiCM, pg8::SchedGrid, true>(C.lds, 1024, 2048, 2048, S, E);
}
__device__ __forceinline__ void phase2b(const Ctx& C, const Params& P) {
    unsigned char* ws = P.ws;
    pg8::SchedGrid S{(const char*)(ws + WS_HX), (const char*)(ws + WS_WIN), (size_t)256 * 2048, (size_t)256 * 2048, 128, 12, 0, 6, C.G, C.bid, 1, 0, 0, 0, 2, 4};
    pg8::EpiIn2 E{(bf16_t*)(ws + WS_PML), (unsigned char*)P.out, P.in[9]};
    pg8::gemm_phase<pg8::EpiIn2, pg8::SchedGrid, false>(C.lds, 1024, 2048, 2048, S, E);
}
__device__ __forceinline__ void phase_merge(const Ctx& C, const Params& P) {
    unsigned char* ws = P.ws;
    pg8::SchedChain S{{(const char*)(ws + WS_YAB), (const char*)(ws + WS_WB), (size_t)256 * 2048, (size_t)256 * 2048, 128, 4, 0, 0, C.G, C.bid, 1, 0, 0, 0, 1 << 30, 0}, 1024};
    pg8::EpiMerge E{(bf16_t*)(ws + WS_Z), (const unsigned char*)P.out};
    pg8::gemm_phase<pg8::EpiMerge, pg8::SchedChain, false>(C.lds, 512, 2048, 2048, S, E);
}
__device__ __forceinline__ void phase_outproj(const Ctx& C, const Params& P) {
    unsigned char* ws = P.ws;
    pg8::SchedGrid S{(const char*)(ws + WS_Z), (const char*)(ws + WS_WOUT), (size_t)256 * 2048, (size_t)256 * 2048, 128, 4, 0, 0, C.G, C.bid, 1, 0, 0, 0, 1 << 30, 0};
    pg8::EpiOut E{P.in[0], (bf16_t*)(ws + WS_XMID), (const float*)(ws + WS_ADA)};
    pg8::gemm_phase<pg8::EpiOut, pg8::SchedGrid, false>(C.lds, 1024, 2048, 2048, S, E);
}

constexpr int HY_KSTR = 16448;
constexpr int HY_UOFF = 4 * HY_KSTR;
constexpr int HY_USTR = 4616;
template <int MODE>
__device__ __forceinline__ void hyena_item(const Ctx& C, const Params& P, int o, int c) {
    unsigned char* ws = P.ws;
    LAS bf16_t* krv = (LAS bf16_t*)C.lds;
    LAS bf16_t* up = (LAS bf16_t*)(C.lds + HY_UOFF);
    const bf16_t* pcm = (const bf16_t*)(ws + WS_PCM);
    const float* hconv = P.in[10];
    __syncthreads();
    {
        const u32x4* src = (const u32x4*)((const bf16_t*)(ws + WS_KREV) + ((size_t)o * 512 + c) * 8192);
        for (int i = C.tid; i < 1024; i += NTHR) *(LAS u32x4*)(krv + 8 * i) = src[i];
        for (int i = C.tid; i < 8 * 65; i += NTHR) { const int b = i / 65, q = i % 65; const int off = (q < 32) ? 8 * q : (4352 + 8 * (q - 32));
            *(LAS u32x4*)(up + b * HY_USTR + off) = (u32x4){0u, 0u, 0u, 0u}; }
        if (o == 0) {
            const bf16_t* src0 = pcm + (size_t)c * MX; const float w0 = hconv[c], w1 = hconv[1536 + c], w2 = hconv[3072 + c];
            u32x4 vv[8]; unsigned vl[8], vr[8];
#pragma unroll
            for (int it = 0; it < 8; ++it) { const int r0 = 8 * (C.tid + NTHR * it); vv[it] = *(const u32x4*)(src0 + r0); vl[it] = *(const unsigned*)(src0 + r0 - 2); vr[it] = *(const unsigned*)(src0 + r0 + 8); }
#pragma unroll
            for (int it = 0; it < 8; ++it) { const int r0 = 8 * (C.tid + NTHR * it); const u32x4 v = vv[it];
                float x[10]; x[1] = bflo(v.x); x[2] = bfhi(v.x); x[3] = bflo(v.y); x[4] = bfhi(v.y); x[5] = bflo(v.z); x[6] = bfhi(v.z); x[7] = bflo(v.w); x[8] = bfhi(v.w);
                x[0] = ((r0 & 63) != 0) ? bfhi(vl[it]) : 0.f; x[9] = ((r0 & 63) != 56) ? bflo(vr[it]) : 0.f;
                float y[8];
#pragma unroll
                for (int j = 0; j < 8; ++j) y[j] = w0 * x[j] + w1 * x[j + 1] + w2 * x[j + 2];
                u32x4 w; w.x = pk2(y[0], y[1]); w.y = pk2(y[2], y[3]); w.z = pk2(y[4], y[5]); w.w = pk2(y[6], y[7]);
                *(LAS u32x4*)(up + (r0 >> 12) * HY_USTR + 256 + (r0 & 4095)) = w; }
        } else {
            const u32x4* src1 = (const u32x4*)((const bf16_t*)(ws + WS_Z1) + (size_t)c * MX);
            u32x4 vv[8];
#pragma unroll
            for (int it = 0; it < 8; ++it) vv[it] = src1[C.tid + NTHR * it];
#pragma unroll
            for (int it = 0; it < 8; ++it) { const int r0 = 8 * (C.tid + NTHR * it); *(LAS u32x4*)(up + (r0 >> 12) * HY_USTR + 256 + (r0 & 4095)) = vv[it]; }
        }
    }
    __syncthreads();
    for (int idx = C.tid; idx < 3 * 1025; idx += NTHR) { const int rho = 1 + idx / 1025, ch = idx % 1025; unsigned short e[8];
#pragma unroll
        for (int j = 0; j < 8; ++j) { const int z = 8 * ch + j - rho; e[j] = (z >= 0 && z < 8192) ? krv[z] : (unsigned short)0; }
        u32x4 w; w.x = e[0] | ((unsigned)e[1] << 16); w.y = e[2] | ((unsigned)e[3] << 16); w.z = e[4] | ((unsigned)e[5] << 16); w.w = e[6] | ((unsigned)e[7] << 16);
        *(LAS u32x4*)(C.lds + rho * HY_KSTR + 16 * ch) = w; }
    if (C.tid == 0) *(LAS u32x4*)(C.lds + 16 * 1024) = (u32x4){0u, 0u, 0u, 0u};
    __syncthreads();
    const int lane = C.lane, w = C.wave, kh = w >> 2, wq = w & 3, i = lane & 31, kq = lane >> 5, nb = (lane >> 2) & 7, np = lane & 3, rho = i & 3;
    f32x16 acc[4][2];
#pragma unroll
    for (int a = 0; a < 4; ++a)
#pragma unroll
        for (int pg = 0; pg < 2; ++pg)
#pragma unroll
            for (int r = 0; r < 16; ++r) acc[a][pg][r] = 0.f;
    const int abase = rho * HY_KSTR + 2 * (4096 - i + 8 * kq + rho) - 2048 * wq - 1536;
    const int bbase = HY_UOFF + 2 * (nb * HY_USTR + 256 + 32 * np + 8 * kq);
    typedef const volatile LAS u32x2* vp2;
#define HY_LOAD(AF, BF, s0) do { const int _a = abase + 2 * (s0), _b = bbase + 2 * (s0); \
        BF[0] = *(const LAS bf16x8*)(C.lds + _b); BF[1] = *(const LAS bf16x8*)(C.lds + _b + 256); \
        _Pragma("unroll") for (int a = 0; a < 4; ++a) { const u32x2 lo = *(vp2)(C.lds + _a + 512 * (3 - a)), hi = *(vp2)(C.lds + _a + 512 * (3 - a) + 8); \
            AF[a] = __builtin_bit_cast(bf16x8, (u32x4){lo.x, lo.y, hi.x, hi.y}); } } while (0)
#define HY_MMA(AF, BF) do { _Pragma("unroll") for (int a = 0; a < 4; ++a) _Pragma("unroll") for (int pg = 0; pg < 2; ++pg) \
        acc[a][pg] = __builtin_amdgcn_mfma_f32_32x32x16_bf16(AF[a], BF[pg], acc[a][pg], 0, 0, 0); } while (0)
    bf16x8 a0[4], a1[4], b0[2], b1[2];
    const int sbeg = -224 + 16 * 135 * kh;
    HY_LOAD(a0, b0, sbeg);
#pragma unroll 1
    for (int j = 0; j < (MODE == 1 ? 0 : 134); j += 2) {
        HY_LOAD(a1, b1, sbeg + 16 * (j + 1));
        __builtin_amdgcn_sched_barrier(0);
        HY_MMA(a0, b0);
        __builtin_amdgcn_sched_barrier(0);
        HY_LOAD(a0, b0, sbeg + 16 * (j + 2));
        __builtin_amdgcn_sched_barrier(0);
        HY_MMA(a1, b1);
        __builtin_amdgcn_sched_barrier(0);
    }
    HY_MMA(a0, b0);
#undef HY_LOAD
#undef HY_MMA
    const float skip = P.in[16][o * 512 + c];
    if (kh == 0) {
#pragma unroll
        for (int a = 0; a < 4; ++a)
#pragma unroll
            for (int pg = 0; pg < 2; ++pg)
#pragma unroll
                for (int g = 0; g < 4; ++g) { const int t0 = 1024 * wq + 256 * a + 128 * pg + 32 * np + 8 * g + 4 * kq;
                    const u32x2 uv = *(const LAS u32x2*)(up + nb * HY_USTR + 256 + t0);
                    acc[a][pg][4 * g + 0] += skip * bflo(uv.x); acc[a][pg][4 * g + 1] += skip * bfhi(uv.x); acc[a][pg][4 * g + 2] += skip * bflo(uv.y); acc[a][pg][4 * g + 3] += skip * bfhi(uv.y); }
    }
    __syncthreads();
    {
        LAS f32x4* slot = (LAS f32x4*)(C.lds + w * 16384);
#pragma unroll
        for (int al = 0; al < 2; ++al)
#pragma unroll
            for (int pg = 0; pg < 2; ++pg)
#pragma unroll
                for (int g = 0; g < 4; ++g) { const int a = kh ? al : 2 + al; const f32x16& v = acc[a][pg];
                    slot[((al * 2 + pg) * 4 + g) * 64 + lane] = (f32x4){v[4 * g], v[4 * g + 1], v[4 * g + 2], v[4 * g + 3]}; }
    }
    __syncthreads();
    const int gch = (o == 0 ? 512 : 1024) + c;
    const float w0 = hconv[gch], w1 = hconv[1536 + gch], w2 = hconv[3072 + gch];
    const bf16_t* gsrc = pcm + (size_t)gch * MX + (size_t)nb * SEQ;
    bf16_t* dst = (bf16_t*)(ws + (o == 0 ? WS_Z1 : WS_Z2CM)) + (size_t)c * MX + (size_t)nb * SEQ;
    const LAS f32x4* pslot = (const LAS f32x4*)(C.lds + (w ^ 4) * 16384);
#pragma unroll
    for (int al = 0; al < 2; ++al) {
        const int a = kh ? 2 + al : al;
        u32x2 gvv[2][4]; unsigned gl[2][4], gr[2][4];
#pragma unroll
        for (int pg = 0; pg < 2; ++pg)
#pragma unroll
            for (int g = 0; g < 4; ++g) { const int t0 = 1024 * wq + 256 * a + 128 * pg + 32 * np + 8 * g + 4 * kq;
                gvv[pg][g] = *(const u32x2*)(gsrc + t0); gl[pg][g] = *(const unsigned*)(gsrc + t0 - 2); gr[pg][g] = *(const unsigned*)(gsrc + t0 + 4); }
#pragma unroll
        for (int pg = 0; pg < 2; ++pg)
#pragma unroll
            for (int g = 0; g < 4; ++g) {
                const int t0 = 1024 * wq + 256 * a + 128 * pg + 32 * np + 8 * g + 4 * kq;
                const f32x4 pv = pslot[((al * 2 + pg) * 4 + g) * 64 + lane];
                const u32x2 gv = gvv[pg][g];
                float x[6]; x[1] = bflo(gv.x); x[2] = bfhi(gv.x); x[3] = bflo(gv.y); x[4] = bfhi(gv.y);
                x[0] = ((t0 & 63) != 0) ? bfhi(gl[pg][g]) : 0.f; x[5] = ((t0 & 63) != 60) ? bflo(gr[pg][g]) : 0.f;
                float z[4];
#pragma unroll
                for (int j = 0; j < 4; ++j) { const float gate = w0 * x[j] + w1 * x[j + 1] + w2 * x[j + 2]; z[j] = gate * (acc[a][pg][4 * g + j] + pv[j]); }
                u32x2 wv; wv.x = pk2(z[0], z[1]); wv.y = pk2(z[2], z[3]);
                if (MODE == 1) { if (z[0] == 12345.678f) *(u32x2*)(dst + t0) = wv; } else *(u32x2*)(dst + t0) = wv;
            }
    }
}

typedef short s16x4 __attribute__((ext_vector_type(4)));
__device__ __forceinline__ unsigned off_b(unsigned row, unsigned ch) { return 256u * row + 16u * (ch ^ (((row & 3) << 2) | ((row >> 2) & 3))); }
__device__ __forceinline__ bf16x8 tile_row_read(const LAS unsigned char* T, int lane, int rb, int s) { return *(const LAS bf16x8*)(T + off_b((lane & 15) + 16 * rb, 4 * s + (lane >> 4))); }
__device__ __forceinline__ bf16x8 tile_tr_read(const LAS unsigned char* T, int lane, int c, int ks) {
    const unsigned g = lane >> 4, q = (lane & 15) >> 2, p = lane & 3;
    const unsigned a0 = off_b(32 * ks + 8 * g + q, 2 * c + (p >> 1)) + 8 * (p & 1), a1 = off_b(32 * ks + 8 * g + 4 + q, 2 * c + (p >> 1)) + 8 * (p & 1);
    const s16x4 lo = __builtin_amdgcn_ds_read_tr16_b64_v4i16((LAS s16x4*)(T + a0)), hi = __builtin_amdgcn_ds_read_tr16_b64_v4i16((LAS s16x4*)(T + a1));
    return __builtin_shufflevector(lo, hi, 0, 1, 2, 3, 4, 5, 6, 7);
}
struct ChunkRef { int isctx, b, h, d, oc; };
__device__ __forceinline__ int chunk_row0(const ChunkRef& r) { return r.isctx ? (MX + r.b * CTXL + r.oc * 128) : (r.b * SEQ + r.oc * 128); }

__device__ __forceinline__ void mlstm_prep(const Ctx& C, const Params& P) {
    unsigned char* ws = P.ws;
    const float* cw = P.in[17];
    {
        const bf16_t* kvcm = (const bf16_t*)(ws + WS_KVCM); bf16_t* kact = (bf16_t*)(ws + WS_KACT);
        const int NCH = 512 * (MT / 8), STR = C.G * NTHR;
        for (int i0 = C.bid * NTHR + C.tid; i0 < NCH; i0 += 4 * STR) {
            u32x4 vv[4]; unsigned vl4[4], vr4[4];
#pragma unroll
            for (int u = 0; u < 4; ++u) { const int i = i0 + u * STR; if (i < NCH) { const int c = i / (MT / 8), col = 8 * (i % (MT / 8)); const bf16_t* src = kvcm + (size_t)c * MT + col;
                vv[u] = *(const u32x4*)src; vl4[u] = *(const unsigned*)(src - 2); vr4[u] = *(const unsigned*)(src + 8); } }
#pragma unroll
            for (int u = 0; u < 4; ++u) { const int i = i0 + u * STR; if (i < NCH) { const int c = i / (MT / 8), col = 8 * (i % (MT / 8)); const u32x4 v = vv[u];
                const int t = (col < MX) ? (col & 63) : ((col - MX) & 255), rl = (col < MX) ? 64 : 256;
                float x[10]; x[1] = bflo(v.x); x[2] = bfhi(v.x); x[3] = bflo(v.y); x[4] = bfhi(v.y); x[5] = bflo(v.z); x[6] = bfhi(v.z); x[7] = bflo(v.w); x[8] = bfhi(v.w);
                x[0] = (t != 0) ? bfhi(vl4[u]) : 0.f; x[9] = (t + 8 != rl) ? bflo(vr4[u]) : 0.f;
                const float w0 = cw[512 + c], w1 = cw[1024 + 512 + c], w2 = cw[2048 + 512 + c]; float y[8];
#pragma unroll
                for (int j = 0; j < 8; ++j) y[j] = siluf(w0 * x[j] + w1 * x[j + 1] + w2 * x[j + 2]);
                u32x4 o; o.x = pk2(y[0], y[1]); o.y = pk2(y[2], y[3]); o.z = pk2(y[4], y[5]); o.w = pk2(y[6], y[7]);
                *(u32x4*)(kact + (size_t)c * MT + col) = o; } }
        }
    }
    {
        const bf16_t* pml = (const bf16_t*)(ws + WS_PML); bf16_t* qact = (bf16_t*)(ws + WS_QACT);
        const int NQ = MX * 64, STR = C.G * NTHR;
        for (int i0 = C.bid * NTHR + C.tid; i0 < NQ; i0 += 4 * STR) {
            u32x4 vc4[4], vl4[4], vr4[4];
#pragma unroll
            for (int u = 0; u < 4; ++u) { const int i = i0 + u * STR; if (i < NQ) { const int row = i >> 6, c0 = 8 * (i & 63); const bf16_t* base = pml + (size_t)row * 1024 + c0;
                const bool hl = (row & 63) != 0, hr = (row & 63) != 63;
                vc4[u] = *(const u32x4*)base; vl4[u] = (u32x4){0u, 0u, 0u, 0u}; vr4[u] = (u32x4){0u, 0u, 0u, 0u};
                if (hl) vl4[u] = *(const u32x4*)(base - 1024); if (hr) vr4[u] = *(const u32x4*)(base + 1024); } }
#pragma unroll
            for (int u = 0; u < 4; ++u) { const int i = i0 + u * STR; if (i < NQ) { const int row = i >> 6, c0 = 8 * (i & 63);
                const u32x4 vc = vc4[u], vl = vl4[u], vr = vr4[u];
                const unsigned l4[4] = {vl.x, vl.y, vl.z, vl.w}, c4[4] = {vc.x, vc.y, vc.z, vc.w}, r4[4] = {vr.x, vr.y, vr.z, vr.w}; unsigned o4[4];
#pragma unroll
                for (int q = 0; q < 4; ++q) {
                    const float a0 = cw[c0 + 2 * q] * bflo(l4[q]) + cw[1024 + c0 + 2 * q] * bflo(c4[q]) + cw[2048 + c0 + 2 * q] * bflo(r4[q]);
                    const float a1 = cw[c0 + 2 * q + 1] * bfhi(l4[q]) + cw[1024 + c0 + 2 * q + 1] * bfhi(c4[q]) + cw[2048 + c0 + 2 * q + 1] * bfhi(r4[q]);
                    o4[q] = pk2(siluf(a0) * 0.08838834764831845f, siluf(a1) * 0.08838834764831845f); }
                *(u32x4*)(qact + (size_t)row * 512 + c0) = (u32x4){o4[0], o4[1], o4[2], o4[3]}; } }
        }
    }
    for (int item = C.bid * 8 + C.wave; item < 64 * NCHK; item += C.G * 8) {
        const int j = item % NCHK, seq = item / NCHK, h = seq & 3, b = (seq >> 2) & 7, d = seq >> 5;
        ChunkRef r; r.isctx = j < 2; r.b = b; r.h = h; r.d = d; { const int jj = r.isctx ? j : j - 2, nch = r.isctx ? 2 : 32; r.oc = d ? (nch - 1 - jj) : jj; }
        const float* gates = (const float*)(ws + WS_GATES) + (size_t)chunk_row0(r) * 16;
        const int p0 = 2 * C.lane, t0 = d ? 127 - p0 : p0, t1 = d ? 126 - p0 : p0 + 1;
        const float li0 = gates[(size_t)t0 * 16 + (d ? 8 : 0) + h], li1 = gates[(size_t)t1 * 16 + (d ? 8 : 0) + h];
        const float lf0 = logsig(gates[(size_t)t0 * 16 + (d ? 12 : 4) + h]), lf1 = logsig(gates[(size_t)t1 * 16 + (d ? 12 : 4) + h]);
        float run = lf0 + lf1;
#pragma unroll
        for (int o = 1; o < 64; o <<= 1) { const float t = __shfl_up(run, o); if (C.lane >= o) run += t; }
        const float b1 = run, b0 = run - lf1;
        const float c0 = li0 - b0, c1 = li1 - b1;
        float gm = fmaxf(c0, c1);
#pragma unroll
        for (int o = 1; o < 64; o <<= 1) { const float t = __shfl_up(gm, o); if (C.lane >= o) gm = fmaxf(gm, t); }
        float gprev = __shfl_up(gm, 1); if (C.lane == 0) gprev = -3.0e38f;
        float* gc = (float*)(ws + WS_GC) + (size_t)item * 384;
        gc[t0] = c0; gc[t1] = c1; gc[128 + t0] = b0; gc[128 + t1] = b1; gc[256 + t0] = fmaxf(gprev, c0); gc[256 + t1] = gm;
        if (C.lane == 63) { float* bl = (float*)(ws + WS_BL) + (size_t)item * 2; bl[0] = b1; bl[1] = gm; }
    }
}

struct SeqPre { u32x4 k[4]; u32x4 v[4]; float g; float bl0, bl1; };
__device__ __forceinline__ ChunkRef seq_chunk(int jc, int b, int h, int d) {
    ChunkRef r; r.isctx = jc < 2; r.b = b; r.h = h; r.d = d; const int jj = r.isctx ? jc : jc - 2, nch = r.isctx ? 2 : 32; r.oc = d ? (nch - 1 - jj) : jj; return r; }
__device__ __forceinline__ void seq_prefetch(const Params& P, const ChunkRef& r, int item, SeqPre& pf, int tid) {
    const bf16_t* kact = (const bf16_t*)(P.ws + WS_KACT); const bf16_t* kvcm = (const bf16_t*)(P.ws + WS_KVCM); const int col0 = chunk_row0(r);
#pragma unroll
    for (int it = 0; it < 4; ++it) { const int idx = tid + NTHR * it, dd = idx >> 4, s0 = 8 * (idx & 15);
        pf.k[it] = *(const u32x4*)(kact + (size_t)(r.h * 128 + dd) * MT + col0 + s0);
        pf.v[it] = *(const u32x4*)(kvcm + (size_t)(512 + r.h * 128 + dd) * MT + col0 + s0); }
    pf.g = (tid < 384) ? ((const float*)(P.ws + WS_GC))[(size_t)item * 384 + tid] : 0.f;
    const float* bl = (const float*)(P.ws + WS_BL) + (size_t)item * 2; pf.bl0 = bl[0]; pf.bl1 = bl[1];
}
#define SEQ_BAR() do { asm volatile("s_waitcnt lgkmcnt(0)" ::: "memory"); __builtin_amdgcn_s_barrier(); asm volatile("" ::: "memory"); } while (0)
__device__ __forceinline__ void mlstm_seq(const Ctx& C, const Params& P, int seq) {
    unsigned char* ws = P.ws;
    const int h = seq & 3, b = (seq >> 2) & 7, d = seq >> 5;
    LAS unsigned char* KT = C.lds; LAS unsigned char* VT = C.lds + 32768; LAS unsigned char* CT = C.lds + 65536; LAS unsigned char* PS = C.lds + 98304;
    LAS float* colf = (LAS float*)(C.lds + 131072); LAS float* bcs = colf + 128; LAS float* gms = bcs + 128; LAS float* wls = gms + 128; LAS float* nbuf = wls + 128  ;
    const int w = C.wave;
    f32x4 Cst[8]; f32x4 nst = (f32x4){0.f, 0.f, 0.f, 0.f};
#pragma unroll
    for (int nt = 0; nt < 8; ++nt) Cst[nt] = (f32x4){0.f, 0.f, 0.f, 0.f};
    float m = 0.f;
    __syncthreads();
    if (C.tid < 256) nbuf[C.tid] = 0.f;
    SeqPre pre;
    seq_prefetch(P, seq_chunk(0, b, h, d), seq * NCHK, pre, C.tid);
    const bf16x8 ones = (bf16x8){0x3f80, 0x3f80, 0x3f80, 0x3f80, 0x3f80, 0x3f80, 0x3f80, 0x3f80};
#pragma unroll 1
    for (int jc = 0; jc < NCHK; ++jc) {
        const ChunkRef r = seq_chunk(jc, b, h, d);
        const LAS float* nsl = nbuf + 128 * (jc & 1); LAS float* nnew = nbuf + 128 * ((jc & 1) ^ 1);
        int tid = C.tid; asm volatile("" : "+v"(tid));
        const int lane = tid & 63, fr = lane & 15, fq = lane >> 4;
        bf16x8 qf[4];
        if (!r.isctx) { const bf16_t* qa = (const bf16_t*)(ws + WS_QACT) + (size_t)(b * SEQ + r.oc * 128 + 16 * w + fr) * 512 + h * 128 + 8 * fq;
#pragma unroll
            for (int ks = 0; ks < 4; ++ks) qf[ks] = *(const bf16x8*)(qa + 32 * ks); }
        else {
#pragma unroll
            for (int ks = 0; ks < 4; ++ks) qf[ks] = (bf16x8){0, 0, 0, 0, 0, 0, 0, 0}; }
        const float Bj = pre.bl0, gfin = pre.bl1, mxs = fmaxf(m, gfin), decay = __expf(m - mxs);
        SEQ_BAR();
        {
#pragma unroll
            for (int it = 0; it < 4; ++it) { const int idx = tid + NTHR * it, dd = idx >> 4, ch = idx & 15;
                *(LAS u32x4*)(KT + off_b(dd, ch)) = pre.k[it]; *(LAS u32x4*)(VT + off_b(dd, ch)) = pre.v[it]; }
            if (tid < 384) colf[tid] = pre.g;
            if (tid < 128) wls[tid] = __expf(pre.g - mxs);
        }
#pragma unroll
        for (int nt = 0; nt < 8; ++nt) { u32x2 pw; pw.x = pk2(Cst[nt][0], Cst[nt][1]); pw.y = pk2(Cst[nt][2], Cst[nt][3]);
            *(LAS u32x2*)(CT + off_b(16 * nt + fr, 2 * w + (fq >> 1)) + 8 * (fq & 1)) = pw; }
        if (fr == 0) *(LAS f32x4*)(nnew + 16 * w + 4 * fq) = nst;
        SEQ_BAR();
        if (!r.isctx) {
            const int t = 16 * w + fr;
            const float mx = fmaxf(m, gms[t]), rowf = -mx, ainter = __expf(m - mx), emneg = __expf(-(bcs[t] + mx));
            float qn = 0.f;
#pragma unroll
            for (int ks = 0; ks < 4; ++ks) { const u32x4 qq = __builtin_bit_cast(u32x4, qf[ks]); const LAS float* np_ = nnew + 32 * ks + 8 * fq; const f32x4 na = *(const LAS f32x4*)np_, nb = *(const LAS f32x4*)(np_ + 4);
                qn += bflo(qq.x) * na[0] + bfhi(qq.x) * na[1] + bflo(qq.y) * na[2] + bfhi(qq.y) * na[3] + bflo(qq.z) * nb[0] + bfhi(qq.z) * nb[1] + bflo(qq.w) * nb[2] + bfhi(qq.w) * nb[3]; }
            qn += __shfl_xor(qn, 16); qn += __shfl_xor(qn, 32);
            float rs = 0.f;
#pragma unroll 2
            for (int nt = 0; nt < 8; ++nt) { f32x4 a = (f32x4){0.f, 0.f, 0.f, 0.f};
#pragma unroll
                for (int ks = 0; ks < 4; ++ks) a = __builtin_amdgcn_mfma_f32_16x16x32_bf16(tile_tr_read(KT, lane, nt, ks), qf[ks], a, 0, 0, 0);
                const int s0 = 16 * nt + 4 * fq; const f32x4 cf = *(const LAS f32x4*)(colf + s0); float pv[4];
#pragma unroll
                for (int q = 0; q < 4; ++q) { const int s = s0 + q; const bool ok = d ? (s >= t) : (s <= t); pv[q] = ok ? __expf(rowf + cf[q]) * a[q] : 0.f; rs += pv[q]; }
                u32x2 pw; pw.x = pk2(pv[0], pv[1]); pw.y = pk2(pv[2], pv[3]);
                *(LAS u32x2*)(PS + off_b(t, 2 * nt + (fq >> 1)) + 8 * (fq & 1)) = pw; }
            rs += __shfl_xor(rs, 16); rs += __shfl_xor(rs, 32);
            const float inv = 1.f / fmaxf(fabsf(rs + ainter * qn), emneg);
            LDS_WAIT();
            bf16x8 pfr[4];
#pragma unroll
            for (int ks = 0; ks < 4; ++ks) pfr[ks] = tile_row_read(PS, lane, w, ks);
            float ai4[4], iv4[4];
#pragma unroll
            for (int q = 0; q < 4; ++q) { ai4[q] = __shfl(ainter, 4 * fq + q); iv4[q] = __shfl(inv, 4 * fq + q); }
            bf16_t* hd = (bf16_t*)(ws + WS_HDIR) + ((size_t)d * MX + (size_t)(b * SEQ + r.oc * 128)) * 512 + h * 128;
#pragma unroll 2
            for (int nt = 0; nt < 8; ++nt) { f32x4 a = (f32x4){0.f, 0.f, 0.f, 0.f}, c = (f32x4){0.f, 0.f, 0.f, 0.f};
#pragma unroll
                for (int ks = 0; ks < 4; ++ks) { a = __builtin_amdgcn_mfma_f32_16x16x32_bf16(pfr[ks], tile_row_read(VT, lane, nt, ks), a, 0, 0, 0);
                    c = __builtin_amdgcn_mfma_f32_16x16x32_bf16(qf[ks], tile_row_read(CT, lane, nt, ks), c, 0, 0, 0); }
#pragma unroll
                for (int q = 0; q < 4; ++q) hd[(size_t)(16 * w + 4 * fq + q) * 512 + 16 * nt + fr] = (bf16_t)f2bf((a[q] + ai4[q] * c[q]) * iv4[q]); }
        }
        if (jc + 1 < NCHK) seq_prefetch(P, seq_chunk(jc + 1, b, h, d), seq * NCHK + jc + 1, pre, tid);
        {
            bf16x8 kfs[4];
#pragma unroll
            for (int ks = 0; ks < 4; ++ks) { const u32x4 kk = __builtin_bit_cast(u32x4, tile_row_read(KT, lane, w, ks)); const LAS float* cp = wls + 32 * ks + 8 * fq;
                const f32x4 ca = *(const LAS f32x4*)cp, cb = *(const LAS f32x4*)(cp + 4);
                u32x4 o; o.x = pk2(bflo(kk.x) * ca[0], bfhi(kk.x) * ca[1]); o.y = pk2(bflo(kk.y) * ca[2], bfhi(kk.y) * ca[3]);
                o.z = pk2(bflo(kk.z) * cb[0], bfhi(kk.z) * cb[1]); o.w = pk2(bflo(kk.w) * cb[2], bfhi(kk.w) * cb[3]);
                kfs[ks] = __builtin_bit_cast(bf16x8, o); }
#pragma unroll
            for (int nt = 0; nt < 8; ++nt) { f32x4 a = (f32x4){0.f, 0.f, 0.f, 0.f};
#pragma unroll
                for (int ks = 0; ks < 4; ++ks) a = __builtin_amdgcn_mfma_f32_16x16x32_bf16(kfs[ks], tile_row_read(VT, lane, nt, ks), a, 0, 0, 0);
                Cst[nt] = Cst[nt] * decay + a; }
            { f32x4 a = (f32x4){0.f, 0.f, 0.f, 0.f};
#pragma unroll
              for (int ks = 0; ks < 4; ++ks) a = __builtin_amdgcn_mfma_f32_16x16x32_bf16(kfs[ks], ones, a, 0, 0, 0);
              nst = nst * decay + a; }
            m = Bj + mxs;
        }
    }
}
#undef SEQ_BAR

__device__ __forceinline__ void mlstm_combine(const Ctx& C, const Params& P) {
    unsigned char* ws = P.ws;
    const bf16_t* hd = (const bf16_t*)(ws + WS_HDIR); const bf16_t* pml = (const bf16_t*)(ws + WS_PML); bf16_t* yab = (bf16_t*)(ws + WS_YAB); const float* ng = P.in[18];
    const f32x4 g0 = *(const f32x4*)(ng + 8 * C.lane), g1 = *(const f32x4*)(ng + 8 * C.lane + 4);
    u32x4 na, nb, no;
    { const int row0 = C.bid * 8 + C.wave;
      if (row0 < MX) { na = *(const u32x4*)(hd + (size_t)row0 * 512 + 8 * C.lane); nb = *(const u32x4*)(hd + ((size_t)MX + row0) * 512 + 8 * C.lane); no = *(const u32x4*)(pml + (size_t)row0 * 1024 + 512 + 8 * C.lane); } }
    for (int row = C.bid * 8 + C.wave; row < MX; row += C.G * 8) {
        const u32x4 a = na, bq = nb, og = no;
        if (row + C.G * 8 < MX) { const int r1 = row + C.G * 8;
            na = *(const u32x4*)(hd + (size_t)r1 * 512 + 8 * C.lane); nb = *(const u32x4*)(hd + ((size_t)MX + r1) * 512 + 8 * C.lane); no = *(const u32x4*)(pml + (size_t)r1 * 1024 + 512 + 8 * C.lane); }
        float v[8] = {bflo(a.x) + bflo(bq.x), bfhi(a.x) + bfhi(bq.x), bflo(a.y) + bflo(bq.y), bfhi(a.y) + bfhi(bq.y), bflo(a.z) + bflo(bq.z), bfhi(a.z) + bfhi(bq.z), bflo(a.w) + bflo(bq.w), bfhi(a.w) + bfhi(bq.w)};
        float ss = 0.f;
#pragma unroll
        for (int j = 0; j < 8; ++j) ss += v[j] * v[j];
        ss += __shfl_xor(ss, 1); ss += __shfl_xor(ss, 2); ss += __shfl_xor(ss, 4); ss += __shfl_xor(ss, 8);
        const float rstd = rsqrtf(ss * (1.f / 128.f) + RMS_EPS);
        const float o8[8] = {bflo(og.x), bfhi(og.x), bflo(og.y), bfhi(og.y), bflo(og.z), bfhi(og.z), bflo(og.w), bfhi(og.w)};
        const float gg[8] = {g0[0], g0[1], g0[2], g0[3], g1[0], g1[1], g1[2], g1[3]};
        float y[8];
#pragma unroll
        for (int j = 0; j < 8; ++j) y[j] = v[j] * rstd * gg[j] * sigm(o8[j]);
        u32x4 wv; wv.x = pk2(y[0], y[1]); wv.y = pk2(y[2], y[3]); wv.z = pk2(y[4], y[5]); wv.w = pk2(y[6], y[7]);
        *(u32x4*)(yab + (size_t)row * 1024 + 512 + 8 * C.lane) = wv;
    }
}

template <int PM>
__device__ __forceinline__ void mixer_phase(const Ctx& C, const Params& P) {
    constexpr int NM = 64;
    const bool small = C.G < 2 * NM;
    const int nh = small ? C.G : C.G - NM, hb = small ? C.bid : C.bid - NM;
    if (PM != 2 && PM != 3) if (small || C.bid < NM) for (int s = C.bid; s < 64; s += (small ? C.G : NM)) mlstm_seq(C, P, s);
    if (PM != 1 && hb >= 0) {
        const int nch = (512 - hb + nh - 1) / nh;
#pragma unroll 1
        for (int j = 0; j < 2 * nch; ++j) { const int c = hb + (j >> 1) * nh, o = j & 1;
            if (o) asm volatile("s_waitcnt vmcnt(0)" ::: "memory");
            hyena_item<0>(C, P, o, c); }
    }
}

__device__ __forceinline__ void transpose_z2(const Ctx& C, const Params& P) {
    unsigned char* ws = P.ws;
    const bf16_t* src = (const bf16_t*)(ws + WS_Z2CM); bf16_t* dst = (bf16_t*)(ws + WS_YAB);
    LAS bf16_t* tl = (LAS bf16_t*)(C.lds + 143360 - 20480);
    for (int it = C.bid; it < 8 * 256; it += C.G) {
        const int c0 = (it & 7) * 64, r0 = (it >> 3) * 128;
        __syncthreads();
        for (int idx = C.tid; idx < 64 * 16; idx += NTHR) { const int cc = idx >> 4, rc = (idx & 15) * 8;
            const u32x4 v = *(const u32x4*)(src + (size_t)(c0 + cc) * MX + r0 + rc); const unsigned v4[4] = {v.x, v.y, v.z, v.w};
#pragma unroll
            for (int q = 0; q < 4; ++q) { tl[(rc + 2 * q) * 72 + cc] = (bf16_t)(v4[q] & 0xffffu); tl[(rc + 2 * q + 1) * 72 + cc] = (bf16_t)(v4[q] >> 16); } }
        __syncthreads();
        for (int idx = C.tid; idx < 128 * 8; idx += NTHR) { const int rr = idx >> 3, c8 = (idx & 7) * 8;
            *(u32x4*)(dst + (size_t)(r0 + rr) * 1024 + c0 + c8) = *(const LAS u32x4*)(tl + rr * 72 + c8); }
    }
}

__device__ __forceinline__ void phase6(const Ctx& C, const Params& P) {
    unsigned char* ws = P.ws;
    LAS float* Wr = (LAS float*)C.lds;
#pragma unroll 1
    for (int i0 = C.tid; i0 < 1024 * 16; i0 += 8 * NTHR) { float t8[8];
#pragma unroll
        for (int u = 0; u < 8; ++u) t8[u] = P.in[22][i0 + u * NTHR];
#pragma unroll
        for (int u = 0; u < 8; ++u) { const int idx = i0 + u * NTHR; Wr[wl_pos(idx >> 4) * 20 + (idx & 15)] = t8[u]; } }
    __syncthreads();
    const float* ada = (const float*)(ws + WS_ADA); const float* gffn = P.in[7];
    unsigned char* hx2 = ws + WS_HX2; float* aff = (float*)(ws + WS_AFF); int* slot = (int*)(ws + WS_SLOT);
    const bf16_t* xm = (const bf16_t*)(ws + WS_XMID);
    u32x2 nx[4];
    { const int row0 = C.bid * 8 + C.wave;
      if (row0 < MX) {
#pragma unroll
        for (int j = 0; j < 4; ++j) nx[j] = *(const u32x2*)(xm + (size_t)row0 * DM + 4 * C.lane + 256 * j); } }
    for (int row = C.bid * 8 + C.wave; row < MX; row += C.G * 8) {
        const int b = row >> 12, n = row & 4095;
        f32x4 v[4]; float ss = 0.f;
#pragma unroll
        for (int j = 0; j < 4; ++j) { v[j] = (f32x4){bflo(nx[j].x), bfhi(nx[j].x), bflo(nx[j].y), bfhi(nx[j].y)}; ss += v[j][0] * v[j][0] + v[j][1] * v[j][1] + v[j][2] * v[j][2] + v[j][3] * v[j][3]; }
        if (row + C.G * 8 < MX) {
#pragma unroll
            for (int j = 0; j < 4; ++j) nx[j] = *(const u32x2*)(xm + (size_t)(row + C.G * 8) * DM + 4 * C.lane + 256 * j); }
        const float rstd = rsqrtf(wave_sum(ss) * (1.f / DM) + RMS_EPS);
#pragma unroll
        for (int j = 0; j < 4; ++j) { const int k = 4 * C.lane + 256 * j; const f32x4 g = *(const f32x4*)(gffn + k);
            const f32x4 h4 = *(const f32x4*)(ada + (size_t)b * 6144 + 3072 + k), s4 = *(const f32x4*)(ada + (size_t)b * 6144 + 4096 + k);
#pragma unroll
            for (int q = 0; q < 4; ++q) v[j][q] = (v[j][q] * rstd * g[q]) * (1.f + s4[q]) + h4[q];
            *(unsigned*)(hx2 + (size_t)row * DM + k) = pk4_fp8(v[j][0], v[j][1], v[j][2], v[j][3]); }
        const float lg = row_dot16(v, Wr, C.lane);
        float mx = lg;
        mx = fmaxf(mx, __shfl_xor(mx, 4)); mx = fmaxf(mx, __shfl_xor(mx, 8)); mx = fmaxf(mx, __shfl_xor(mx, 16)); mx = fmaxf(mx, __shfl_xor(mx, 32));
        const float ex = expf(lg - mx);
        float sum = ex;
        sum += __shfl_xor(sum, 4); sum += __shfl_xor(sum, 8); sum += __shfl_xor(sum, 16); sum += __shfl_xor(sum, 32);
        if ((C.lane & 3) == 0) { const int e = C.lane >> 2; aff[((size_t)b * NE + e) * SEQ + n] = ex / sum; slot[(size_t)row * 16 + e] = -1; }
    }
}

__device__ __forceinline__ void topk_item(const Ctx& C, const Params& P, int item) {
    unsigned char* ws = P.ws;
    const int b = item >> 4, e = item & 15;
    const float* aff = (const float*)(ws + WS_AFF) + (size_t)item * SEQ;
    LAS unsigned* red = (LAS unsigned*)C.lds;
    unsigned v[8];
    { const u32x4 a = *(const u32x4*)(aff + 8 * C.tid), c = *(const u32x4*)(aff + 8 * C.tid + 4);
      v[0] = a.x; v[1] = a.y; v[2] = a.z; v[3] = a.w; v[4] = c.x; v[5] = c.y; v[6] = c.z; v[7] = c.w; }
    unsigned prefix = 0u;
    for (int bit = 30; bit >= 0; --bit) {
        const unsigned cand = prefix | (1u << bit); int cnt = 0;
#pragma unroll
        for (int q = 0; q < 8; ++q) cnt += (v[q] >= cand) ? 1 : 0;
        cnt = (int)wave_sum((float)cnt);
        __syncthreads();
        if (C.lane == 0) red[C.wave] = (unsigned)cnt;
        __syncthreads();
        int tot = 0;
#pragma unroll
        for (int q = 0; q < 8; ++q) tot += (int)red[q];
        if (tot >= CAP) prefix = cand;
    }
    int cg_ = 0, ce_ = 0;
#pragma unroll
    for (int q = 0; q < 8; ++q) { cg_ += (v[q] > prefix) ? 1 : 0; ce_ += (v[q] == prefix) ? 1 : 0; }
    int ig = cg_, ie = ce_;
#pragma unroll
    for (int o = 1; o < 64; o <<= 1) { const int tg = __shfl_up(ig, o), te = __shfl_up(ie, o); if (C.lane >= o) { ig += tg; ie += te; } }
    __syncthreads();
    if (C.lane == 63) { red[C.wave] = (unsigned)ig; red[8 + C.wave] = (unsigned)ie; }
    __syncthreads();
    int bg = 0, be = 0, totg = 0;
#pragma unroll
    for (int q = 0; q < 8; ++q) { const int xg = (int)red[q], xe = (int)red[8 + q]; if (q < C.wave) { bg += xg; be += xe; } totg += xg; }
    int pg = bg + ig - cg_, pe = be + ie - ce_;
    const int need = CAP - totg;
    float* sg = (float*)(ws + WS_SGATE) + (size_t)item * CAP; int* slot = (int*)(ws + WS_SLOT);
    LAS int* sel = (LAS int*)(C.lds + 256);
#pragma unroll
    for (int q = 0; q < 8; ++q) { const int n = 8 * C.tid + q; int s = -1;
        if (v[q] > prefix) s = pg++;
        else if (v[q] == prefix) { if (pe < need) s = totg + pe; ++pe; }
        if (s >= 0) { sel[s] = n; sg[s] = __builtin_bit_cast(float, v[q]); slot[((size_t)b * SEQ + n) * 16 + e] = s; } }
    __syncthreads();
    const unsigned char* hx2 = ws + WS_HX2; unsigned char* xg = ws + WS_XG + ((size_t)e * 4096 + (size_t)b * CAP) * DM;
    for (int s0 = C.wave; s0 < CAP; s0 += 32) {
        u32x4 v4[4];
#pragma unroll
        for (int u = 0; u < 4; ++u) v4[u] = ((const u32x4*)(hx2 + ((size_t)b * SEQ + sel[s0 + 8 * u]) * DM))[C.lane];
#pragma unroll
        for (int u = 0; u < 4; ++u) ((u32x4*)(xg + (size_t)(s0 + 8 * u) * DM))[C.lane] = v4[u];
    }
    __syncthreads();
}

__device__ __forceinline__ void moe_gemm1(const Ctx& C, const Params& P, int skip_epi) {
    unsigned char* ws = P.ws;
    pg8::SchedMoe S{(const char*)(ws + WS_XG), (const char*)(ws + WS_W13), (size_t)256 * 1024, (size_t)256 * 1024, (size_t)4096 * 1024, (size_t)4096 * 1024, 16, 16, C.G, C.bid};
    pg8::EpiMoe1 E{ws + WS_ACT, skip_epi};
    pg8::gemm_phase<pg8::EpiMoe1, pg8::SchedMoe, false, true>(C.lds, 512, 1024, 1024, S, E);
}
__device__ __forceinline__ void moe_gemm2(const Ctx& C, const Params& P, bool skip_epi) {
    unsigned char* ws = P.ws;
    pg8::SchedMoe S{(const char*)(ws + WS_ACT), (const char*)(ws + WS_W2), (size_t)256 * 2048, (size_t)256 * 2048, (size_t)4096 * 2048, (size_t)1024 * 2048, 16, 4, C.G, C.bid};
    pg8::EpiMoe2 E{ws + WS_YE, (const float*)(ws + WS_SGATE), skip_epi};
    pg8::gemm_phase<pg8::EpiMoe2, pg8::SchedMoe, false, true>(C.lds, 1024, 2048, 2048, S, E);
}

__device__ __forceinline__ void phase_final(const Ctx& C, const Params& P) {
    unsigned char* ws = P.ws;
    const float* ada = (const float*)(ws + WS_ADA); const float* gfin = P.in[26];
    const int* slot = (const int*)(ws + WS_SLOT); const unsigned char* ye = ws + WS_YE;
    const bf16_t* xm = (const bf16_t*)(ws + WS_XMID);
    u32x2 nx[4]; int nslot = -1;
    { const int row0 = C.bid * 8 + C.wave;
      if (row0 < MX) { if (C.lane < 16) nslot = slot[(size_t)row0 * 16 + C.lane];
#pragma unroll
        for (int j = 0; j < 4; ++j) nx[j] = *(const u32x2*)(xm + (size_t)row0 * DM + 4 * C.lane + 256 * j); } }
    for (int row = C.bid * 8 + C.wave; row < MX; row += C.G * 8) {
        const int b = row >> 12;
        float* xr = P.out + (size_t)row * DM;
        f32x4 xv[4]; const int myslot = nslot;
#pragma unroll
        for (int j = 0; j < 4; ++j) xv[j] = (f32x4){bflo(nx[j].x), bfhi(nx[j].x), bflo(nx[j].y), bfhi(nx[j].y)};
        f32x4 m[4];
#pragma unroll
        for (int j = 0; j < 4; ++j) m[j] = (f32x4){0.f, 0.f, 0.f, 0.f};
        for (int e = 0; e < NE; ++e) { const int s = __shfl(myslot, e);
            if (s >= 0) { const unsigned char* yr = ye + ((size_t)e * 4096 + b * CAP + s) * DM;
#pragma unroll
                for (int j = 0; j < 4; ++j) { const int w = *(const int*)(yr + 4 * C.lane + 256 * j);
                    m[j][0] += __builtin_amdgcn_cvt_f32_fp8(w, 0); m[j][1] += __builtin_amdgcn_cvt_f32_fp8(w, 1); m[j][2] += __builtin_amdgcn_cvt_f32_fp8(w, 2); m[j][3] += __builtin_amdgcn_cvt_f32_fp8(w, 3); } } }
        if (row + C.G * 8 < MX) { const int r1 = row + C.G * 8; nslot = (C.lane < 16) ? slot[(size_t)r1 * 16 + C.lane] : -1;
#pragma unroll
            for (int j = 0; j < 4; ++j) nx[j] = *(const u32x2*)(xm + (size_t)r1 * DM + 4 * C.lane + 256 * j); }
        f32x4 v[4]; float ss = 0.f;
#pragma unroll
        for (int j = 0; j < 4; ++j) { const int k = 4 * C.lane + 256 * j; const f32x4 g5 = *(const f32x4*)(ada + (size_t)b * 6144 + 5120 + k);
            v[j] = xv[j] + g5 * m[j] * (1.f / 16.f); ss += v[j][0] * v[j][0] + v[j][1] * v[j][1] + v[j][2] * v[j][2] + v[j][3] * v[j][3]; }
        const float rstd = rsqrtf(wave_sum(ss) * (1.f / DM) + RMS_EPS);
#pragma unroll
        for (int j = 0; j < 4; ++j) { const int k = 4 * C.lane + 256 * j; const f32x4 g = *(const f32x4*)(gfin + k);
            *(f32x4*)(xr + k) = v[j] * rstd * g; }
    }
}

constexpr int N_PHASES = 14;
__global__ void __launch_bounds__(NTHR, 2) mega(Params P) {
    extern __shared__ __attribute__((aligned(16))) unsigned char lds_raw[];
    Ctx C; C.lds = (LAS unsigned char*)lds_raw; C.tid = threadIdx.x; C.lane = C.tid & 63; C.wave = __builtin_amdgcn_readfirstlane(C.tid >> 6); C.bid = blockIdx.x; C.G = gridDim.x;
    unsigned char* ws = P.ws;
    if (C.tid < 32) ((LAS unsigned*)(C.lds + LDS_MISC))[C.tid] = 0u;
    __syncthreads();
    XcdBarrier bar = xcd_barrier_post((unsigned*)(ws + WS_CTL), (volatile LAS unsigned*)(C.lds + LDS_MISC));
#define IN(k) (lo <= (k) && (k) < hi)
#define SEAM(k) do { if (IN(k) && IN((k) + 1)) { xcd_barrier(bar); if ((REPEAT >> 23) & 1u) xcd_barrier(bar); } } while (0)
#define RUN(id, ...) do { { constexpr bool rep = false; (void)rep; __VA_ARGS__; } if ((REPEAT >> (id)) & 1u) { xcd_barrier(bar); { constexpr bool rep = true; (void)rep; __VA_ARGS__; } } } while (0)
#define PHASE_PROGRAM(LO, HI) do { const int lo = (LO), hi = (HI); \
    if (IN(0)) RUN(0, phase0(C, P)); \
    SEAM(0); \
    if (IN(1)) RUN(1, phase1(C, P)); \
    SEAM(1); \
    if (IN(2)) { \
        RUN(2, phase2a(C, P)); \
        RUN(3, phase2b(C, P)); \
    } \
    SEAM(2); \
    if (IN(3)) RUN(5, mlstm_prep(C, P)); \
    SEAM(3); \
    if (IN(4)) RUN(4, mixer_phase<rep ? (int)((REPEAT >> 25) & 3u) : 0>(C, P)); \
    SEAM(4); \
    if (IN(5)) { \
        RUN(9, transpose_z2(C, P)); \
        RUN(8, mlstm_combine(C, P)); \
    } \
    SEAM(5); \
    if (IN(6)) RUN(10, phase_merge(C, P)); \
    SEAM(6); \
    if (IN(7)) RUN(11, phase_outproj(C, P)); \
    SEAM(7); \
    if (IN(8)) RUN(12, phase6(C, P)); \
    SEAM(8); \
    if (IN(9)) { \
        RUN(13, for (int it = C.bid; it < BATCH * NE; it += C.G) topk_item(C, P, it)); \
        __syncthreads(); \
        RUN(14, convert_experts(C, P)); \
    } \
    SEAM(9); \
    if (IN(11)) RUN(16, moe_gemm1(C, P, rep ? (int)((REPEAT >> 25) & 3u) : 0)); \
    SEAM(11); \
    if (IN(12)) RUN(17, moe_gemm2(C, P, rep && ((REPEAT >> 25) & 1u))); \
    SEAM(12); \
    if (IN(13)) phase_final(C, P); \
} while (0)
    PHASE_PROGRAM(P.ph_lo, P.ph_hi);
#undef PHASE_PROGRAM
#undef IN
#undef SEAM
#undef RUN
}

extern "C" void kernel_launch(void* const* d_in, const int* in_sizes, int n_in, void* d_out, int out_size, void* d_ws, size_t ws_size, hipStream_t stream) {
    static int grid = 0;
    if (grid == 0) {
        if (n_in != 27 || out_size != MX * DM || ws_size < WS_END) { fprintf(stderr, "kernel_launch: unexpected shapes (n_in %d, out %d, ws %zu < %zu)\n", n_in, out_size, ws_size, (size_t)WS_END); grid = -1; return; }
        int dev = 0, cus = 0, per_cu = 0;
        hipGetDevice(&dev);
        hipDeviceGetAttribute(&cus, hipDeviceAttributeMultiprocessorCount, dev);
        if (hipFuncSetAttribute((const void*)mega, hipFuncAttributeMaxDynamicSharedMemorySize, LDS_BYTES) != hipSuccess) { fprintf(stderr, "kernel_launch: hipFuncSetAttribute failed\n"); grid = -1; return; }
        if (hipOccupancyMaxActiveBlocksPerMultiprocessor(&per_cu, (const void*)mega, NTHR, LDS_BYTES) != hipSuccess || per_cu < 1) { fprintf(stderr, "kernel_launch: occupancy query says %d\n", per_cu); per_cu = 1; }
        (void)hipGetLastError();
        grid = cus * 1;
        if (grid <= 0) grid = 256;
    }
    if (grid < 0) return;
    Params p; memset(&p, 0, sizeof(p));
    for (int i = 0; i < 27; ++i) p.in[i] = (const float*)d_in[i];
    p.out = (float*)d_out; p.ws = (unsigned char*)d_ws;
    (void)hipMemsetAsync((unsigned char*)d_ws + WS_CTL, 0, XCD_BAR_WORDS * 4, stream);
#if N_LAUNCH_MODE == 1
    if (PREFIX > 0) {
        p.ph_lo = 0; p.ph_hi = PREFIX;
        void* pargs[] = {&p};
        (void)hipLaunchCooperativeKernel((const void*)mega, dim3(grid), dim3(NTHR), pargs, LDS_BYTES, stream);
        (void)hipMemsetAsync((unsigned char*)d_ws + WS_CTL, 0, XCD_BAR_WORDS * 4, stream);
    }
    p.ph_lo = 0; p.ph_hi = N_PHASES;
    void* args[] = {&p};
    hipError_t e = hipLaunchCooperativeKernel((const void*)mega, dim3(grid), dim3(NTHR), args, LDS_BYTES, stream);
    if (e != hipSuccess) fprintf(stderr, "kernel_launch: cooperative launch failed: %s (grid %d)\n", hipGetErrorString(e), grid);
#else
    for (int ph = 0; ph < N_PHASES; ++ph) {
        p.ph_lo = ph; p.ph_hi = ph + 1;
        void* args[] = {&p};
        hipError_t e = hipLaunchCooperativeKernel((const void*)mega, dim3(grid), dim3(NTHR), args, LDS_BYTES, stream);
        if (e != hipSuccess) { fprintf(stderr, "kernel_launch: launch %d failed: %s (grid %d)\n", ph, hipGetErrorString(e), grid); break; }
    }
#endif
}
```

```cpp
#include <hip/hip_runtime.h>
#include <hip/hip_cooperative_groups.h>
#include <cstdio>
#include <cstdint>
#include <cstring>
namespace cg = cooperative_groups;

#ifndef N_LAUNCH_MODE
#define N_LAUNCH_MODE 1
#endif

#define LAS __attribute__((address_space(3)))
typedef unsigned short bf16_t;
typedef short bf16x8 __attribute__((ext_vector_type(8)));
typedef float f32x4 __attribute__((ext_vector_type(4)));
typedef float f32x16 __attribute__((ext_vector_type(16)));
typedef unsigned u32x4 __attribute__((ext_vector_type(4)));
typedef unsigned u32x2 __attribute__((ext_vector_type(2)));

constexpr int NTHR = 512;
constexpr int BATCH = 8, SEQ = 4096, DM = 1024, CTXL = 256;
constexpr int MX = BATCH * SEQ;
constexpr int MC = BATCH * CTXL;
constexpr int DIN = 5648, NPROJ = 5632, GATE0 = 3584, MERGE0 = 3600;
constexpr int NE = 16, CAP = 512, DFF = 2048;
constexpr int MT = MX + MC;
constexpr int NCHK = 34;
constexpr float RMS_EPS = 1e-6f;

constexpr size_t MiB = 1u << 20;
constexpr size_t WS_ADAP = 0;
constexpr size_t WS_ADA = 7 * MiB;
constexpr size_t WS_CTL = 7 * MiB + 512 * 1024;
constexpr size_t WS_GATES = 8 * MiB;
constexpr size_t WS_KREV = 11 * MiB;
constexpr size_t WS_BL = 27 * MiB;
constexpr size_t WS_MST = 27 * MiB + 64 * 1024;
constexpr size_t WS_WG8 = 28 * MiB;
constexpr size_t WS_HX8 = 440 * MiB;
constexpr size_t WS_NLOC = 28 * MiB;
constexpr size_t WS_NST = 30 * MiB;
constexpr size_t WS_WIN = 32 * MiB;
constexpr size_t WS_WB = 43 * MiB;
constexpr size_t WS_WOUT = 45 * MiB;
constexpr size_t WS_HX = 48 * MiB;
constexpr size_t WS_PLOC = 48 * MiB;
constexpr size_t WS_PCM = 116 * MiB;
constexpr size_t WS_PML = 212 * MiB;
constexpr size_t WS_KVCM = 276 * MiB;
constexpr size_t WS_GC = 2 * MiB;
constexpr size_t WS_Z1 = 344 * MiB;
constexpr size_t WS_YAB = 116 * MiB;
constexpr size_t WS_CST = 440 * MiB;
constexpr size_t WS_KACT = 48 * MiB;
constexpr size_t WS_QACT = 82 * MiB;
constexpr size_t WS_HDIR = 440 * MiB;
constexpr size_t WS_Z2CM = 504 * MiB;
constexpr size_t WS_Z = 48 * MiB;
constexpr size_t WS_XMID = 464 * MiB;
constexpr size_t WS_AFF = 0;
constexpr size_t WS_SLOT = 2 * MiB;
constexpr size_t WS_SIDX = 4 * MiB;
constexpr size_t WS_SGATE = 4 * MiB + 512 * 1024;
constexpr size_t WS_HX2 = 48 * MiB;
constexpr size_t WS_W13 = 376 * MiB;
constexpr size_t WS_XG = 144 * MiB;
constexpr size_t WS_ACT = 208 * MiB;
constexpr size_t WS_YE = 48 * MiB;
constexpr size_t WS_W2 = 536 * MiB;
constexpr size_t WS_END = 568 * MiB;

constexpr int LDS_BYTES = 147456;
constexpr int LDS_MISC = LDS_BYTES - 128;
constexpr int PREFIX = 0;
constexpr unsigned REPEAT = 0u;

__device__ __forceinline__ unsigned f2bf(float f) { unsigned u = __builtin_bit_cast(unsigned, f); return (u + 0x7fffu + ((u >> 16) & 1u)) >> 16; }
__device__ __forceinline__ unsigned pk2(float lo, float hi) { unsigned r; asm("v_cvt_pk_bf16_f32 %0, %1, %2" : "=v"(r) : "v"(lo), "v"(hi)); return r; }
__device__ __forceinline__ unsigned pk2_swap(float lo, float hi) { unsigned r; asm("v_cvt_pk_bf16_f32 %0, %1, %2\n\ts_nop 1" : "=v"(r) : "v"(lo), "v"(hi)); return r; }
__device__ __forceinline__ float bf2f(unsigned short b) { return __builtin_bit_cast(float, ((unsigned)b) << 16); }
__device__ __forceinline__ float bflo(unsigned w) { return __builtin_bit_cast(float, w << 16); }
__device__ __forceinline__ float bfhi(unsigned w) { return __builtin_bit_cast(float, w & 0xffff0000u); }
__device__ __forceinline__ float sigm(float x) { return __builtin_amdgcn_rcpf(1.f + __expf(-x)); }
__device__ __forceinline__ float siluf(float x) { return x * __builtin_amdgcn_rcpf(1.f + __expf(-x)); }
__device__ __forceinline__ float logsig(float x) { return x >= 0.f ? -log1pf(expf(-x)) : x - log1pf(expf(x)); }
template <int CTRL> __device__ __forceinline__ float dppf(float x) { return __builtin_bit_cast(float, __builtin_amdgcn_mov_dpp(__builtin_bit_cast(int, x), CTRL, 0xf, 0xf, true)); }
constexpr int DPP_XOR1 = 0xB1, DPP_XOR2 = 0x4E, DPP_XOR7 = 0x141, DPP_XOR8 = 0x128;
__device__ __forceinline__ void swap16(float x, float& own, float& oth) { unsigned a = __builtin_bit_cast(unsigned, x), b = a; asm volatile("" : "+v"(b));
    const auto s = __builtin_amdgcn_permlane16_swap(a, b, false, false); unsigned r0 = s[0], r1 = s[1]; asm volatile("" : "+v"(r0), "+v"(r1)); own = __builtin_bit_cast(float, r0); oth = __builtin_bit_cast(float, r1); }
__device__ __forceinline__ void swap32(float x, float& own, float& oth) { unsigned a = __builtin_bit_cast(unsigned, x), b = a; asm volatile("" : "+v"(b));
    const auto s = __builtin_amdgcn_permlane32_swap(a, b, false, false); unsigned r0 = s[0], r1 = s[1]; asm volatile("" : "+v"(r0), "+v"(r1)); own = __builtin_bit_cast(float, r0); oth = __builtin_bit_cast(float, r1); }
__device__ __forceinline__ float xrow_sum(float x) {
    float p, q; swap16(x, p, q); x = p + q; swap32(x, p, q); return p + q; }
__device__ __forceinline__ float xrow_max(float x) {
    float p, q; swap16(x, p, q); x = fmaxf(p, q); swap32(x, p, q); return fmaxf(p, q); }
__device__ __forceinline__ float row16_sum(float v) { v += dppf<DPP_XOR1>(v); v += dppf<DPP_XOR2>(v); v += dppf<DPP_XOR7>(v); v += dppf<DPP_XOR8>(v); return v; }
__device__ __forceinline__ float wave_sum(float v) { return xrow_sum(row16_sum(v)); }
#define LDS_WAIT() asm volatile("s_waitcnt lgkmcnt(0)" ::: "memory")
__device__ __forceinline__ float clamp8(float x) { return __builtin_amdgcn_fmed3f(x, -448.f, 448.f); }
__device__ __forceinline__ unsigned pk4_fp8(float a, float b, float c, float d) {
    int r = __builtin_amdgcn_cvt_pk_fp8_f32(clamp8(a), clamp8(b), 0, false); r = __builtin_amdgcn_cvt_pk_fp8_f32(clamp8(c), clamp8(d), r, true); return (unsigned)r; }
constexpr float W8_SCALE = 64.f, W8_INV = 1.f / 64.f;
__device__ __forceinline__ unsigned q8(float g) { return (unsigned)__builtin_amdgcn_fmed3f(g * 255.f + 0.5f, 0.f, 255.f); }
__device__ __forceinline__ unsigned pk4_u8(float a, float b, float c, float d) { return q8(a) | (q8(b) << 8) | (q8(c) << 16) | (q8(d) << 24); }
__device__ __forceinline__ float u8f(unsigned w, int i) { return (float)((w >> (8 * i)) & 255u); }

struct Params {
    const float* in[27];
    float* out;
    unsigned char* ws;
    int ph_lo, ph_hi;
};


#define XB_TMO      128
#define XB_XCNT(j)  (256  + 64 * (j))
#define XB_XSUB(j)  (1280 + 64 * (j))
#define XB_XGEN(j)  (2304 + 64 * (j))
#define XB_TOP      3328
#define XB_TOPGEN   3392
#define XCD_BAR_WORDS 3456
#define XB_SPIN_CAP (1u << 18)
#define HY_FLAG0 XCD_BAR_WORDS
#define CTL_WORDS (XCD_BAR_WORDS + 128 * 16)
__device__ __forceinline__ unsigned xb_ld(unsigned* p)              { return __hip_atomic_load(p, __ATOMIC_RELAXED, __HIP_MEMORY_SCOPE_AGENT); }
__device__ __forceinline__ unsigned xb_add(unsigned* p, unsigned v) { return __hip_atomic_fetch_add(p, v, __ATOMIC_RELAXED, __HIP_MEMORY_SCOPE_AGENT); }
__device__ __forceinline__ unsigned xb_xcc_id() { return (unsigned)__builtin_amdgcn_s_getreg((3 << 11) | 20) & 0xFu; }
#define XB_SPIN(cond, bar) do { unsigned _sp = 0; while (cond) { __builtin_amdgcn_s_sleep(1); \
    if ((++_sp & 255u) == 0u) { if (xb_ld(&(bar)[XB_TMO])) break; if (_sp > XB_SPIN_CAP) { atomicAdd(&(bar)[XB_TMO], 1u); break; } } } } while (0)
struct XcdBarrier { unsigned* bar; unsigned x; volatile LAS unsigned* st; };
__device__ __forceinline__ XcdBarrier xcd_barrier_post(unsigned* bar, volatile LAS unsigned* st) {
    XcdBarrier b; b.bar = bar; b.x = xb_xcc_id(); b.st = st;
    if (threadIdx.x == 0) (void)xb_add(&bar[XB_XCNT(b.x)], 1u);
    return b;
}
__device__ __forceinline__ void xcd_barrier_complete(unsigned* bar, unsigned x, unsigned& nloc, unsigned& nx) {
    const unsigned G = gridDim.x * gridDim.y * gridDim.z;
    unsigned sum, cnt, mine, sp = 0u;
    for (;;) {
        sum = 0u; cnt = 0u; mine = 0u;
#pragma unroll
        for (unsigned j = 0; j < 16; ++j) { const unsigned c = xb_ld(&bar[XB_XCNT(j)]); sum += c; cnt += (c > 0u) ? 1u : 0u; mine = (j == x) ? c : mine; }
        if (sum == G) break;
        __builtin_amdgcn_s_sleep(1);
        if ((++sp & 255u) == 0u) { if (xb_ld(&bar[XB_TMO])) break; if (sp > XB_SPIN_CAP) { atomicAdd(&bar[XB_TMO], 1u); break; } }
    }
    nloc = mine > 0u ? mine : 1u; nx = cnt > 0u ? cnt : 1u;
}
__device__ __forceinline__ void xcd_barrier(const XcdBarrier& b) {
    asm volatile("s_waitcnt vmcnt(0)" ::: "memory");
    __syncthreads();
    if (threadIdx.x == 0) {
        unsigned* bar = b.bar;
        __builtin_amdgcn_s_waitcnt(0);
        unsigned nloc = b.st[0], nx = b.st[1];
        if (nloc == 0u) { xcd_barrier_complete(bar, b.x, nloc, nx); b.st[0] = nloc; b.st[1] = nx; }
        const unsigned old = xb_add(&bar[XB_XSUB(b.x)], 1u);
        const unsigned gen = old / nloc;
        if (old + 1u == (gen + 1u) * nloc) {
            __builtin_amdgcn_fence(__ATOMIC_RELEASE, "agent");
            asm volatile("s_waitcnt vmcnt(0)" ::: "memory");
            const unsigned og = xb_add(&bar[XB_TOP], 1u);
            const unsigned tg = og / nx;
            if (og + 1u == (tg + 1u) * nx) xb_add(&bar[XB_TOPGEN], 1u);
            else XB_SPIN(xb_ld(&bar[XB_TOPGEN]) == tg, bar);
            __builtin_amdgcn_fence(__ATOMIC_ACQUIRE, "agent");
            xb_add(&bar[XB_XGEN(b.x)], 1u);
            asm volatile("s_waitcnt vmcnt(0)" ::: "memory");
        } else {
            XB_SPIN(xb_ld(&bar[XB_XGEN(b.x)]) == gen, bar);
            __builtin_amdgcn_fence(__ATOMIC_ACQUIRE, "agent");
            asm volatile("s_waitcnt vmcnt(0)" ::: "memory");
        }
    }
    __syncthreads();
}

namespace pg8 {
constexpr int BM = 256, BK = 64, HALF = 128, HTB = HALF * BK * 2, STAGE_BYTES = 8 * HTB;
__device__ __forceinline__ int lds_byte(int r, int c) { const int st = (r >> 4) * 2 + (c >> 5), rr = r & 15, cc = c & 31, ob = rr * 64 + cc * 2; return st * 1024 + (ob ^ (((ob >> 9) & 1) << 5)); }
__device__ __forceinline__ void stage_rc(int b, int& R, int& C) { const int st = b / 1024, sb = b % 1024, swz = sb ^ (((sb >> 9) & 1) << 5); R = (st >> 1) * 16 + swz / 64; C = (st & 1) * 32 + (swz % 64) / 2; }
__device__ __forceinline__ int perm32(int rho) { const int n = rho >> 4, i = rho & 15; return 8 * (i >> 2) + 4 * n + (i & 3); }
__device__ __forceinline__ unsigned cvt_pk_bf16(float lo, float hi) { unsigned r; asm volatile("v_cvt_pk_bf16_f32 %0, %1, %2" : "=v"(r) : "v"(lo), "v"(hi)); return r; }

typedef int v4i_t __attribute__((ext_vector_type(4)));
typedef int v8i_t __attribute__((ext_vector_type(8)));
struct Unit { const char* A; const char* B; int pm, pn, aux; };

struct SchedGrid {
    static constexpr bool GATHER = false;
    const char* A; const char* B; size_t tstepA, tstepB; int nM, nN, pm0, pn0, G, c;
    int xN, xPm0, xPn0, xCnt;
    int split, gap;
    int msplit, mgap;
    __device__ bool next(int i, Unit& u) const {
        const long L = (long)i * G + c; const int nwg = nM * nN;
        if (L >= nwg + xCnt) return false;
        if (L >= nwg) { const int q = (int)L - nwg; u.pm = xPm0 + q / xN; u.pn = xPn0 + q % xN; u.aux = 1; }
        else {
            int wgid = (int)L; { const int q = nwg / 8, r = nwg % 8, xcd = wgid % 8, off = wgid / 8; wgid = (xcd < r ? xcd * (q + 1) : r * (q + 1) + (xcd - r) * q) + off; }
            const int nig = 8 * nN, gid = wgid / nig, fm = gid * 8, gsz = (nM - fm) < 8 ? (nM - fm) : 8;
            { const int im = fm + ((wgid % nig) % gsz); u.pm = pm0 + im + (im >= msplit ? mgap : 0); } { const int idx = (wgid % nig) / gsz; u.pn = pn0 + idx + (idx >= split ? gap : 0); } u.aux = 0;
        }
        u.A = A + (size_t)u.pm * tstepA; u.B = B + (size_t)u.pn * tstepB; return true;
    }
};
struct SchedChain {
    static constexpr bool GATHER = false;
    SchedGrid G; size_t half;
    __device__ bool next(int i, Unit& u) const {
        if (!G.next(i >> 1, u)) return false;
        u.aux = i & 1; u.A += (size_t)(i & 1) * half; u.B += (size_t)(i & 1) * half; return true;
    }
};

struct SchedMoe {
    static constexpr bool GATHER = false;
    const char* A; const char* B; size_t tstepA, tstepB, estepA, estepB; int nM, nN, G, c;
    __device__ bool next(int i, Unit& u) const {
        const long L = (long)i * G + c; const int e8 = (int)(L % 8); const long ta = L / 8; const int per = nM * nN;
        if (ta >= 2L * per) return false;
        const int e = e8 + 8 * (int)(ta / per); const int t = (int)(ta % per);
        if (nN == 16) { const int blk = t >> 5, wi = t & 31; u.pm = 4 * (blk >> 1) + (wi >> 3); u.pn = 8 * (blk & 1) + (wi & 7); }
        else { u.pm = t / nN; u.pn = t % nN; }
        u.aux = e;
        u.A = A + (size_t)e * estepA + (size_t)u.pm * tstepA; u.B = B + (size_t)e * estepB + (size_t)u.pn * tstepB; return true;
    }
};
struct SchedMoeG {
    static constexpr bool GATHER = true;
    const char* A; const char* B; const int* sidx; size_t tstepB, estepB; int nM, nN, G, c;
    __device__ bool next(int i, Unit& u) const {
        const long L = (long)i * G + c; const int e8 = (int)(L % 8); const long ta = L / 8; const int per = nM * nN;
        if (ta >= 2L * per) return false;
        const int e = e8 + 8 * (int)(ta / per); const int t = (int)(ta % per);
        if (nN == 16) { const int blk = t >> 5, wi = t & 31; u.pm = 4 * (blk >> 1) + (wi >> 3); u.pn = 8 * (blk & 1) + (wi & 7); }
        else { u.pm = t / nN; u.pn = t % nN; }
        u.aux = e;
        u.A = A + (size_t)(u.pm >> 1) * SEQ * DM; u.B = B + (size_t)e * estepB + (size_t)u.pn * tstepB; return true;
    }
    __device__ void gather(const Unit& u, const int (&R)[2], const int (&cb)[2], unsigned (&v0)[2], unsigned (&v1)[2]) const {
        const int* sp = sidx + (((u.pm >> 1) * NE + u.aux) * CAP + (u.pm & 1) * 256);
#pragma unroll
        for (int i = 0; i < 2; ++i) { v0[i] = (unsigned)sp[R[i]] * (unsigned)DM + (unsigned)cb[i]; v1[i] = (unsigned)sp[R[i] + 128] * (unsigned)DM + (unsigned)cb[i]; }
    }
};

template <class Epi, class Sched, bool NORMAL, bool F8 = false>
__device__ __forceinline__ void gemm_phase(LAS unsigned char* lds, const int K  , const unsigned lda, const unsigned ldb, const Sched& S, const Epi& E) {
    int tid = threadIdx.x; asm volatile("" : "+v"(tid));
    const int wid = __builtin_amdgcn_readfirstlane(tid >> 6), lane = tid & 63, wr = wid >> 2, wc = wid & 3, fr = lane & 15, fq = lane >> 4;
    const int nt = K / BK;
    unsigned voffA[2], voffB[2]; int rA[2], cbA[2];
#pragma unroll
    for (int i = 0; i < 2; ++i) { int R, C; stage_rc(tid * 16 + i * 8192, R, C); rA[i] = R; cbA[i] = C * 2; const int Rb = Epi::PERM2 ? (64 * (R >> 5) + 16 * ((R & 15) >> 2) + 4 * ((R >> 4) & 1) + (R & 3)) : (Epi::PERM ? ((R & ~31) + perm32(R & 31)) : R);
        voffA[i] = (unsigned)R * lda + (unsigned)C * 2u; voffB[i] = (unsigned)Rb * ldb + (unsigned)C * 2u; }
    const size_t kstep = (size_t)(BK * 2);
    const size_t hstepA = (size_t)HALF * lda, hstepB = (size_t)(Epi::PERM2 ? 8 : HALF) * ldb;
    const unsigned ldsw = (unsigned)wid * 1024u;
    const int aoff = lds_byte(wr * 64 + fr, fq * 8), boff = lds_byte(wc * 32 + fr, fq * 8);
#define PG8_SA(b, h) (((b) * 2 + (h)) * HTB)
#define PG8_SB(b, h) ((4 + (b) * 2 + (h)) * HTB)
#define PG8_STAGE(bufoff, gbase, voff) do { _Pragma("unroll") for (int _i = 0; _i < 2; ++_i) \
        __builtin_amdgcn_global_load_lds((const unsigned*)((const char*)(gbase) + (voff)[_i]), (LAS unsigned*)(lds + (bufoff) + ldsw + _i * 8192), 16, 0, 0); } while (0)
#define PG8_LDA(dst, b, h) do { if constexpr (F8) { _Pragma("unroll") for (int m = 0; m < 4; ++m) dst##8[m] = __builtin_shufflevector(*(const LAS v4i_t*)(lds + PG8_SA(b, h) + aoff + m * 2048), *(const LAS v4i_t*)(lds + PG8_SA(b, h) + aoff + m * 2048 + 1024), 0, 1, 2, 3, 4, 5, 6, 7); } \
        else { _Pragma("unroll") for (int m = 0; m < 4; ++m) _Pragma("unroll") for (int k = 0; k < 2; ++k) dst[m][k] = *(const LAS bf16x8*)(lds + PG8_SA(b, h) + aoff + m * 2048 + k * 1024); } } while (0)
#define PG8_LDB(dst, b, h) do { if constexpr (F8) { _Pragma("unroll") for (int n = 0; n < 2; ++n) dst##8[n] = __builtin_shufflevector(*(const LAS v4i_t*)(lds + PG8_SB(b, h) + boff + n * 2048), *(const LAS v4i_t*)(lds + PG8_SB(b, h) + boff + n * 2048 + 1024), 0, 1, 2, 3, 4, 5, 6, 7); } \
        else { _Pragma("unroll") for (int n = 0; n < 2; ++n) _Pragma("unroll") for (int k = 0; k < 2; ++k) dst[n][k] = *(const LAS bf16x8*)(lds + PG8_SB(b, h) + boff + n * 2048 + k * 1024); } } while (0)
#define PG8_MMA(ai, bj, At, Bt) do { __builtin_amdgcn_s_setprio(1); \
        if constexpr (F8) { _Pragma("unroll") for (int m = 0; m < 4; ++m) _Pragma("unroll") for (int n = 0; n < 2; ++n) \
            asm volatile("v_mfma_scale_f32_16x16x128_f8f6f4 %0, %1, %2, %0, %3, %3 op_sel_hi:[0,0,0]" : "+v"(acc[ai][bj][m][n]) : "v"(Bt##8[n]), "v"(At##8[m]), "v"(sc8)); } \
        else { _Pragma("unroll") for (int m = 0; m < 4; ++m) _Pragma("unroll") for (int n = 0; n < 2; ++n) _Pragma("unroll") for (int k = 0; k < 2; ++k) \
        acc[ai][bj][m][n] = NORMAL ? __builtin_amdgcn_mfma_f32_16x16x32_bf16(At[m][k], Bt[n][k], acc[ai][bj][m][n], 0, 0, 0) \
                                   : __builtin_amdgcn_mfma_f32_16x16x32_bf16(Bt[n][k], At[m][k], acc[ai][bj][m][n], 0, 0, 0); } __builtin_amdgcn_s_setprio(0); } while (0)
#define PG8_WAIT_V(n) asm volatile("s_waitcnt vmcnt(" #n ")" ::: "memory")
#define PG8_WAIT_L(n) asm volatile("s_waitcnt lgkmcnt(" #n ")" ::: "memory")
#define PG8_BAR __builtin_amdgcn_s_barrier()
#define PG8_SCHED __builtin_amdgcn_sched_barrier(0)
    Unit cur, nxt; int ui = 0;
    if (!S.next(0, cur)) return;
    unsigned vc0[2], vc1[2], vn0[2], vn1[2];
    if constexpr (Sched::GATHER) S.gather(cur, rA, cbA, vc0, vc1); else { _Pragma("unroll") for (int i = 0; i < 2; ++i) { vc0[i] = voffA[i]; vc1[i] = voffA[i] + (unsigned)hstepA; } }
    f32x4 acc[2][2][4][2];
#pragma unroll
    for (int a = 0; a < 2; ++a)
#pragma unroll
        for (int b = 0; b < 2; ++b)
#pragma unroll
            for (int m = 0; m < 4; ++m)
#pragma unroll
                for (int n = 0; n < 2; ++n) acc[a][b][m][n] = (f32x4){0.f, 0.f, 0.f, 0.f};
    bf16x8 At[4][2], B0[2][2], B1[2][2];
    v8i_t At8[4], B08[2], B18[2]; const int sc8 = 0x7F7F7F7F;
    const char* cA = cur.A; const char* cB = cur.B;
    PG8_STAGE(PG8_SB(0, 0), cB, voffB); PG8_STAGE(PG8_SB(0, 1), cB + hstepB, voffB); PG8_STAGE(PG8_SA(0, 0), cA, vc0); PG8_STAGE(PG8_SA(0, 1), cA, vc1);
    if (wr == 1) PG8_BAR;
    PG8_WAIT_V(2); PG8_BAR;
    PG8_STAGE(PG8_SB(1, 0), cB + kstep, voffB); PG8_STAGE(PG8_SA(1, 0), cA + kstep, vc0); PG8_STAGE(PG8_SB(1, 1), cB + hstepB + kstep, voffB);
    PG8_WAIT_V(6); PG8_BAR;
    for (;;) {
        const bool has_next = S.next(ui + 1, nxt);
        const char* nA = has_next ? nxt.A : cA; const char* nB = has_next ? nxt.B : cB;
        if constexpr (Sched::GATHER) { if (has_next) S.gather(nxt, rA, cbA, vn0, vn1); else { _Pragma("unroll") for (int i = 0; i < 2; ++i) { vn0[i] = vc0[i]; vn1[i] = vc1[i]; } } }
        else { _Pragma("unroll") for (int i = 0; i < 2; ++i) { vn0[i] = vc0[i]; vn1[i] = vc1[i]; } }
#pragma unroll 1
        for (int t = 0; t < nt; t += 2) {
            const bool last = (t == nt - 2);
            const char* a1 = cA + (size_t)(t + 1) * kstep;
            const char* a2 = last ? nA : cA + (size_t)(t + 2) * kstep; const char* b2 = last ? nB : cB + (size_t)(t + 2) * kstep;
            const char* a3 = a2 + kstep; const char* b3 = b2 + kstep;
            unsigned vx0[2], vx1[2];
            _Pragma("unroll") for (int i = 0; i < 2; ++i) { vx0[i] = last ? vn0[i] : vc0[i]; vx1[i] = last ? vn1[i] : vc1[i]; }
            PG8_LDB(B0, 0, 0); PG8_LDB(B1, 0, 1); PG8_SCHED; PG8_LDA(At, 0, 0); PG8_STAGE(PG8_SA(1, 1), a1, vc1);
            PG8_WAIT_V(8); PG8_WAIT_L(0); PG8_BAR; PG8_MMA(0, 0, At, B0); PG8_MMA(0, 1, At, B1); PG8_BAR; PG8_SCHED;
            PG8_LDA(At, 0, 1); PG8_STAGE(PG8_SB(0, 0), b2, voffB); PG8_STAGE(PG8_SB(0, 1), b2 + hstepB, voffB); PG8_STAGE(PG8_SA(0, 0), a2, vx0);
            PG8_WAIT_V(8); PG8_WAIT_L(0); PG8_BAR; PG8_MMA(1, 0, At, B0); PG8_MMA(1, 1, At, B1); PG8_BAR; PG8_SCHED;
            PG8_LDB(B0, 1, 0); PG8_LDB(B1, 1, 1); PG8_SCHED; PG8_LDA(At, 1, 0); PG8_STAGE(PG8_SA(0, 1), a2, vx1);
            PG8_WAIT_V(8); PG8_WAIT_L(0); PG8_BAR; PG8_MMA(0, 0, At, B0); PG8_MMA(0, 1, At, B1); PG8_BAR; PG8_SCHED;
            PG8_LDA(At, 1, 1); PG8_STAGE(PG8_SB(1, 0), b3, voffB); PG8_STAGE(PG8_SB(1, 1), b3 + hstepB, voffB); PG8_STAGE(PG8_SA(1, 0), a3, vx0);
            PG8_WAIT_V(8); PG8_WAIT_L(0); PG8_BAR; PG8_MMA(1, 0, At, B0); PG8_MMA(1, 1, At, B1); PG8_BAR; PG8_SCHED;
        }
        if (wr == 0) PG8_BAR;
        if constexpr (F8) asm volatile("s_nop 15\n\ts_nop 15" ::: "memory");
        bool keep = false;
        if constexpr (Epi::HAS_MID) { if (cur.aux == 0) { E.mid(acc, cur, wr, wc, fr, fq); keep = true; } else E(acc, cur, wr, wc, fr, fq); }
        else E(acc, cur, wr, wc, fr, fq);
        if (!has_next) break;
        if (!keep) {
#pragma unroll
        for (int a = 0; a < 2; ++a)
#pragma unroll
            for (int b = 0; b < 2; ++b)
#pragma unroll
                for (int m = 0; m < 4; ++m)
#pragma unroll
                    for (int n = 0; n < 2; ++n) acc[a][b][m][n] = (f32x4){0.f, 0.f, 0.f, 0.f};
        }
        cur = nxt; cA = nA; cB = nB; ++ui;
        _Pragma("unroll") for (int i = 0; i < 2; ++i) { vc0[i] = vn0[i]; vc1[i] = vn1[i]; }
        if (wr == 1) PG8_BAR;
    }
    PG8_WAIT_V(0);
    PG8_BAR;
#undef PG8_SA
#undef PG8_SB
#undef PG8_STAGE
#undef PG8_LDA
#undef PG8_LDB
#undef PG8_MMA
#undef PG8_WAIT_V
#undef PG8_WAIT_L
#undef PG8_BAR
#undef PG8_SCHED
}


struct EpiCM {
    static constexpr bool PERM = false, PERM2 = false, HAS_MID = false;
    bf16_t* pcm; bf16_t* kvcm; const float* bias; bool skip;
    __device__ __forceinline__ void operator()(const f32x4 (&acc)[2][2][4][2], const Unit& u, int wr, int wc, int fr, int fq) const {
        if (skip) { _Pragma("unroll") for (int a = 0; a < 2; ++a) _Pragma("unroll") for (int b = 0; b < 2; ++b) _Pragma("unroll") for (int m = 0; m < 4; ++m) _Pragma("unroll") for (int n = 0; n < 2; ++n) asm volatile("" :: "v"(acc[a][b][m][n])); return; }
        const bool kv = u.pn >= 8;
        float bv4[2][2];
#pragma unroll
        for (int bj = 0; bj < 2; ++bj)
#pragma unroll
            for (int n = 0; n < 2; ++n) bv4[bj][n] = bias[u.pn * BM + bj * HALF + wc * 32 + n * 16 + fr];
#pragma unroll
        for (int bj = 0; bj < 2; ++bj)
#pragma unroll
            for (int n = 0; n < 2; ++n) {
                const int c = u.pn * BM + bj * HALF + wc * 32 + n * 16 + fr; const float bv = bv4[bj][n];
                bf16_t* base = kv ? (kvcm + (size_t)(c - 2048) * MT) : (pcm + (size_t)c * MX);
#pragma unroll
                for (int ai = 0; ai < 2; ++ai)
#pragma unroll
                    for (int m = 0; m < 4; ++m) {
                        const int r = u.pm * BM + ai * HALF + wr * 64 + m * 16 + 4 * fq; const f32x4 v = acc[ai][bj][m][n] + bv;
                        u32x2 w; w.x = cvt_pk_bf16(v[0], v[1]); w.y = cvt_pk_bf16(v[2], v[3]);
                        *(u32x2*)(base + r) = w; }
                asm volatile("" ::: "memory");
            }
    }
};

struct EpiCMT {
    static constexpr bool PERM = true, PERM2 = false, HAS_MID = false;
    bf16_t* pcm; bf16_t* kvcm; const float* bias; bool skip;
    __device__ __forceinline__ void operator()(const f32x4 (&acc)[2][2][4][2], const Unit& u, int wr, int wc, int fr, int fq) const {
        if (skip) { _Pragma("unroll") for (int a = 0; a < 2; ++a) _Pragma("unroll") for (int b = 0; b < 2; ++b) _Pragma("unroll") for (int m = 0; m < 4; ++m) _Pragma("unroll") for (int n = 0; n < 2; ++n) asm volatile("" :: "v"(acc[a][b][m][n])); return; }
        const bool kv = u.pm >= 8; const int c0 = u.pm * BM + wr * 64 + fr, t0 = u.pn * BM + wc * 32 + 8 * fq;
        float bv[2][4];
#pragma unroll
        for (int ai = 0; ai < 2; ++ai)
#pragma unroll
            for (int m = 0; m < 4; ++m) bv[ai][m] = bias[c0 + ai * HALF + m * 16];
#pragma unroll
        for (int ai = 0; ai < 2; ++ai)
#pragma unroll
            for (int m = 0; m < 4; ++m) { const int c = c0 + ai * HALF + m * 16; bf16_t* rowp = (kv ? (kvcm + (size_t)(c - 2048) * MT) : (pcm + (size_t)c * MX)) + t0;
#pragma unroll
                for (int bj = 0; bj < 2; ++bj) { const f32x4 v0 = acc[ai][bj][m][0] + bv[ai][m], v1 = acc[ai][bj][m][1] + bv[ai][m];
                    u32x4 w; w.x = cvt_pk_bf16(v0[0], v0[1]); w.y = cvt_pk_bf16(v0[2], v0[3]); w.z = cvt_pk_bf16(v1[0], v1[1]); w.w = cvt_pk_bf16(v1[2], v1[3]);
                    __builtin_nontemporal_store(w, (u32x4*)(rowp + bj * HALF)); }
                asm volatile("" ::: "memory"); }
    }
};

struct EpiIn2 {
    static constexpr bool PERM = true, PERM2 = false, HAS_MID = false;
    bf16_t* pml; unsigned char* pmg; const float* bias; bool skip;
    __device__ __forceinline__ void operator()(const f32x4 (&acc)[2][2][4][2], const Unit& u, int wr, int wc, int fr, int fq) const {
        if (skip) { _Pragma("unroll") for (int a = 0; a < 2; ++a) _Pragma("unroll") for (int b = 0; b < 2; ++b) _Pragma("unroll") for (int m = 0; m < 4; ++m) _Pragma("unroll") for (int n = 0; n < 2; ++n) asm volatile("" :: "v"(acc[a][b][m][n])); return; }
        const int colt = u.pn * BM; int cbase, bofs = 0; const int row0 = u.pm * BM; bool sg = false;
        if (colt < 2048) cbase = colt - 1536;
        else if (colt < GATE0) cbase = colt - 3072 + 512;
        else { cbase = colt - GATE0; bofs = 16; sg = true; }
        const int col0 = cbase + wc * 32 + 8 * fq, bcol0 = colt + bofs + wc * 32 + 8 * fq;
        f32x4 bv[2][2];
#pragma unroll
        for (int bj = 0; bj < 2; ++bj)
#pragma unroll
            for (int n = 0; n < 2; ++n) bv[bj][n] = *(const f32x4*)(bias + bcol0 + bj * HALF + 4 * n);
#pragma unroll
        for (int ai = 0; ai < 2; ++ai)
#pragma unroll
            for (int m = 0; m < 4; ++m) { const size_t row = (size_t)(row0 + wr * 64 + fr + ai * HALF + m * 16);
#pragma unroll
                for (int bj = 0; bj < 2; ++bj) { f32x4 v0 = acc[ai][bj][m][0] + bv[bj][0], v1 = acc[ai][bj][m][1] + bv[bj][1];
                    if (sg) { u32x2 w; w.x = pk4_u8(sigm(v0[0]), sigm(v0[1]), sigm(v0[2]), sigm(v0[3])); w.y = pk4_u8(sigm(v1[0]), sigm(v1[1]), sigm(v1[2]), sigm(v1[3]));
                        *(u32x2*)(pmg + row * 2048 + col0 + bj * HALF) = w; }
                    else { u32x4 w; w.x = cvt_pk_bf16(v0[0], v0[1]); w.y = cvt_pk_bf16(v0[2], v0[3]); w.z = cvt_pk_bf16(v1[0], v1[1]); w.w = cvt_pk_bf16(v1[2], v1[3]);
                        *(u32x4*)(pml + row * 1024 + col0 + bj * HALF) = w; } }
                asm volatile("" ::: "memory"); }
    }
};

struct EpiMerge {
    static constexpr bool PERM = true, PERM2 = false, HAS_MID = true;
    bf16_t* Z; const unsigned char* pmg;
    __device__ __forceinline__ void mid(f32x4 (&acc)[2][2][4][2], const Unit& u, int wr, int wc, int fr, int fq) const {
        const int row0 = u.pm * BM + wr * 64 + fr, col0 = u.pn * BM + wc * 32 + 8 * fq;
#pragma unroll
        for (int ai = 0; ai < 2; ++ai) {
            u32x2 ga[4][2], gb[4][2];
#pragma unroll
            for (int m = 0; m < 4; ++m)
#pragma unroll
                for (int bj = 0; bj < 2; ++bj) { const unsigned char* gp = pmg + (size_t)(row0 + ai * HALF + m * 16) * 2048 + col0 + bj * HALF;
                    ga[m][bj] = *(const u32x2*)gp; gb[m][bj] = *(const u32x2*)(gp + 1024); }
#pragma unroll
            for (int m = 0; m < 4; ++m)
#pragma unroll
                for (int bj = 0; bj < 2; ++bj) { const u32x2 a = ga[m][bj], b = gb[m][bj];
                    f32x4& v0 = acc[ai][bj][m][0]; f32x4& v1 = acc[ai][bj][m][1];
#pragma unroll
                    for (int j = 0; j < 4; ++j) { v0[j] *= u8f(a.x, j) * __builtin_amdgcn_rcpf(fmaxf(u8f(b.x, j), 1.f)); v1[j] *= u8f(a.y, j) * __builtin_amdgcn_rcpf(fmaxf(u8f(b.y, j), 1.f)); } }
            asm volatile("" ::: "memory"); }
    }
    __device__ __forceinline__ void operator()(const f32x4 (&acc)[2][2][4][2], const Unit& u, int wr, int wc, int fr, int fq) const {
        const int row0 = u.pm * BM + wr * 64 + fr, col0 = u.pn * BM + wc * 32 + 8 * fq;
#pragma unroll
        for (int ai = 0; ai < 2; ++ai) {
            u32x2 g[4][2];
#pragma unroll
            for (int m = 0; m < 4; ++m)
#pragma unroll
                for (int bj = 0; bj < 2; ++bj) g[m][bj] = *(const u32x2*)(pmg + (size_t)(row0 + ai * HALF + m * 16) * 2048 + 1024 + col0 + bj * HALF);
#pragma unroll
            for (int m = 0; m < 4; ++m)
#pragma unroll
                for (int bj = 0; bj < 2; ++bj) { const size_t row = (size_t)(row0 + ai * HALF + m * 16); const u32x2 gg = g[m][bj];
                    f32x4 v0 = acc[ai][bj][m][0], v1 = acc[ai][bj][m][1];
#pragma unroll
                    for (int j = 0; j < 4; ++j) { v0[j] *= fmaxf(u8f(gg.x, j), 1.f) * (1.f / 255.f); v1[j] *= fmaxf(u8f(gg.y, j), 1.f) * (1.f / 255.f); }
                    u32x4 w; w.x = cvt_pk_bf16(v0[0], v0[1]); w.y = cvt_pk_bf16(v0[2], v0[3]); w.z = cvt_pk_bf16(v1[0], v1[1]); w.w = cvt_pk_bf16(v1[2], v1[3]);
                    *(u32x4*)(Z + row * 1024 + col0 + bj * HALF) = w; }
            asm volatile("" ::: "memory"); }
    }
};

struct EpiOut {
    static constexpr bool PERM = true, PERM2 = false, HAS_MID = false;
    const float* x; bf16_t* xmid; const float* ada;
    __device__ __forceinline__ void operator()(const f32x4 (&acc)[2][2][4][2], const Unit& u, int wr, int wc, int fr, int fq) const {
        const int row0 = u.pm * BM + wr * 64 + fr, col0 = u.pn * BM + wc * 32 + 8 * fq;
        const int b = (u.pm * BM) / SEQ;
        f32x4 gv[2][2];
#pragma unroll
        for (int bj = 0; bj < 2; ++bj)
#pragma unroll
            for (int n = 0; n < 2; ++n) gv[bj][n] = *(const f32x4*)(ada + (size_t)b * 6144 + 2048 + col0 + bj * HALF + 4 * n);
        f32x4 xa[2][2], xb[2][2];
#define EO_LD(dst, g) do { const size_t _o = (size_t)(row0 + ((g) >> 2) * HALF + ((g) & 3) * 16) * DM + col0; _Pragma("unroll") for (int bj = 0; bj < 2; ++bj) _Pragma("unroll") for (int n = 0; n < 2; ++n) dst[bj][n] = __builtin_nontemporal_load((const f32x4*)(x + _o + bj * HALF + 4 * n)); } while (0)
#define EO_ST(srcv, g) do { const int ai = (g) >> 2, m = (g) & 3; const size_t _o = (size_t)(row0 + ai * HALF + m * 16) * DM + col0; _Pragma("unroll") for (int bj = 0; bj < 2; ++bj) { \
            const f32x4 v0 = srcv[bj][0] + gv[bj][0] * acc[ai][bj][m][0], v1 = srcv[bj][1] + gv[bj][1] * acc[ai][bj][m][1]; \
            u32x4 w; w.x = cvt_pk_bf16(v0[0], v0[1]); w.y = cvt_pk_bf16(v0[2], v0[3]); w.z = cvt_pk_bf16(v1[0], v1[1]); w.w = cvt_pk_bf16(v1[2], v1[3]); \
            *(u32x4*)(xmid + _o + bj * HALF) = w; } } while (0)
        EO_LD(xa, 0);
#pragma unroll
        for (int g = 0; g < 8; g += 2) {
            EO_LD(xb, g + 1); asm volatile("" ::: "memory"); EO_ST(xa, g);
            if (g + 2 < 8) EO_LD(xa, g + 2); asm volatile("" ::: "memory"); EO_ST(xb, g + 1);
        }
#undef EO_LD
#undef EO_ST
    }
};

struct EpiMoe1 {
    static constexpr bool PERM = true, PERM2 = true, HAS_MID = false;
    unsigned char* act; int skip;
    __device__ __forceinline__ void operator()(const f32x4 (&acc)[2][2][4][2], const Unit& u, int wr, int wc, int fr, int fq) const {
        if (skip == 1) { asm volatile("" :: "v"(acc[0][0][0][0]), "v"(acc[1][1][3][1])); return; }
        const int row0 = u.aux * 4096 + u.pm * BM + wr * 64 + fr, col0 = (u.pn * BM) / 2 + 32 * wc + 8 * fq;
#pragma unroll
        for (int ai = 0; ai < 2; ++ai)
#pragma unroll
            for (int m = 0; m < 4; ++m) { unsigned char* rowp = act + (size_t)(row0 + ai * HALF + m * 16) * DFF + col0;
                u32x2 pk2v;
#pragma unroll
                for (int bj = 0; bj < 2; ++bj) { const f32x4 v0 = acc[ai][bj][m][0] * W8_INV, v1 = acc[ai][bj][m][1] * W8_INV;
                    const unsigned pk = pk4_fp8(siluf(v0[0]) * v0[1], siluf(v0[2]) * v0[3], siluf(v1[0]) * v1[1], siluf(v1[2]) * v1[3]);
                    if (bj) pk2v.y = pk; else pk2v.x = pk; }
                if (skip == 2) asm volatile("" :: "v"(pk2v.x), "v"(pk2v.y)); else *(u32x2*)rowp = pk2v;
                asm volatile("" ::: "memory"); }
    }
};

struct EpiMoe2 {
    static constexpr bool PERM = true, PERM2 = true, HAS_MID = false;
    unsigned char* ye; const float* sgate; bool skip;
    __device__ __forceinline__ void operator()(const f32x4 (&acc)[2][2][4][2], const Unit& u, int wr, int wc, int fr, int fq) const {
        if (skip) { _Pragma("unroll") for (int a = 0; a < 2; ++a) _Pragma("unroll") for (int b = 0; b < 2; ++b) _Pragma("unroll") for (int m = 0; m < 4; ++m) _Pragma("unroll") for (int n = 0; n < 2; ++n) asm volatile("" :: "v"(acc[a][b][m][n])); return; }
        const int e = u.aux, col0 = u.pn * BM + wc * 64 + 16 * fq;
        float gt[2][4];
#pragma unroll
        for (int ai = 0; ai < 2; ++ai)
#pragma unroll
            for (int m = 0; m < 4; ++m) { const int rr = u.pm * BM + wr * 64 + fr + ai * HALF + m * 16; gt[ai][m] = sgate[((rr >> 9) * NE + e) * CAP + (rr & 511)] * (W8_INV * 16.f); }
#pragma unroll
        for (int ai = 0; ai < 2; ++ai)
#pragma unroll
            for (int m = 0; m < 4; ++m) { const int rr = u.pm * BM + wr * 64 + fr + ai * HALF + m * 16;
                const float g = gt[ai][m];
                unsigned char* rowp = ye + ((size_t)e * 4096 + rr) * DM + col0;
                u32x4 w;
                { const f32x4 v0 = acc[ai][0][m][0] * g, v1 = acc[ai][0][m][1] * g, v2 = acc[ai][1][m][0] * g, v3 = acc[ai][1][m][1] * g;
                  w.x = pk4_fp8(v0[0], v0[1], v0[2], v0[3]); w.y = pk4_fp8(v1[0], v1[1], v1[2], v1[3]); w.z = pk4_fp8(v2[0], v2[1], v2[2], v2[3]); w.w = pk4_fp8(v3[0], v3[1], v3[2], v3[3]); }
                *(u32x4*)rowp = w;
                asm volatile("" ::: "memory"); }
    }
};
struct EpiG8 {
    static constexpr bool PERM = true, PERM2 = true, HAS_MID = false;
    unsigned char* pmg; bf16_t* pml; const float* bias;
    __device__ __forceinline__ void operator()(const f32x4 (&acc)[2][2][4][2], const Unit& u, int wr, int wc, int fr, int fq) const {
        const bool sg = u.pn < 8;
        const int row0 = u.pm * BM + wr * 64 + fr, ct = wc * 64 + 16 * fq;
        const int col0 = (sg ? u.pn * BM : (u.pn - 8) * BM) + ct;
        const int bcol0 = (sg ? MERGE0 + u.pn * BM : (u.pn < 10 ? 1536 + (u.pn - 8) * BM : 3072 + (u.pn - 10) * BM)) + ct;
        f32x4 bv[2][2];
#pragma unroll
        for (int bj = 0; bj < 2; ++bj)
#pragma unroll
            for (int n = 0; n < 2; ++n) bv[bj][n] = *(const f32x4*)(bias + bcol0 + 8 * bj + 4 * n);
#pragma unroll
        for (int ai = 0; ai < 2; ++ai)
#pragma unroll
            for (int m = 0; m < 4; ++m) { const size_t row = (size_t)(row0 + ai * HALF + m * 16);
                const f32x4 v0 = acc[ai][0][m][0] * W8_INV + bv[0][0], v1 = acc[ai][0][m][1] * W8_INV + bv[0][1], v2 = acc[ai][1][m][0] * W8_INV + bv[1][0], v3 = acc[ai][1][m][1] * W8_INV + bv[1][1];
                if (sg) { u32x4 w;
                    w.x = pk4_u8(sigm(v0[0]), sigm(v0[1]), sigm(v0[2]), sigm(v0[3])); w.y = pk4_u8(sigm(v1[0]), sigm(v1[1]), sigm(v1[2]), sigm(v1[3]));
                    w.z = pk4_u8(sigm(v2[0]), sigm(v2[1]), sigm(v2[2]), sigm(v2[3])); w.w = pk4_u8(sigm(v3[0]), sigm(v3[1]), sigm(v3[2]), sigm(v3[3]));
                    __builtin_nontemporal_store(w, (u32x4*)(pmg + row * 2048 + col0)); }
                else { u32x4 a, b; a.x = cvt_pk_bf16(v0[0], v0[1]); a.y = cvt_pk_bf16(v0[2], v0[3]); a.z = cvt_pk_bf16(v1[0], v1[1]); a.w = cvt_pk_bf16(v1[2], v1[3]);
                    b.x = cvt_pk_bf16(v2[0], v2[1]); b.y = cvt_pk_bf16(v2[2], v2[3]); b.z = cvt_pk_bf16(v3[0], v3[1]); b.w = cvt_pk_bf16(v3[2], v3[3]);
                    *(u32x4*)(pml + row * 1024 + col0) = a; *(u32x4*)(pml + row * 1024 + col0 + 8) = b; }
                asm volatile("" ::: "memory"); }
    }
};
struct EpiKV8 {
    static constexpr bool PERM = true, PERM2 = false, HAS_MID = false;
    bf16_t* kvcm; const float* bias;
    __device__ __forceinline__ void operator()(const f32x4 (&acc)[2][2][4][2], const Unit& u, int wr, int wc, int fr, int fq) const {
        const int c0 = u.pm * BM + wr * 64 + fr, t0 = u.pn * BM + wc * 32 + 8 * fq;
#pragma unroll
        for (int ai = 0; ai < 2; ++ai)
#pragma unroll
            for (int m = 0; m < 4; ++m) { const int c = c0 + ai * HALF + m * 16; const float bvv = bias[2048 + c]; bf16_t* rowp = kvcm + (size_t)c * MT + t0;
#pragma unroll
                for (int bj = 0; bj < 2; ++bj) { const f32x4 v0 = acc[ai][bj][m][0] * W8_INV + bvv, v1 = acc[ai][bj][m][1] * W8_INV + bvv;
                    u32x4 w; w.x = cvt_pk_bf16(v0[0], v0[1]); w.y = cvt_pk_bf16(v0[2], v0[3]); w.z = cvt_pk_bf16(v1[0], v1[1]); w.w = cvt_pk_bf16(v1[2], v1[3]);
                    *(u32x4*)(rowp + bj * HALF) = w; }
                asm volatile("" ::: "memory"); }
    }
};
}

struct Ctx {
    LAS unsigned char* lds;
    int tid, lane, wave, bid, G;
};

__device__ __forceinline__ void transpose_item(const float* W, int ldw, int ldt, int ncol0, bf16_t* WT, int dst_row0, int rmul, LAS float* scr, int kb, int nb, int lane) {
    const int k0 = 64 * kb, n0 = 32 * nb;
    float t32[32];
#pragma unroll
    for (int i = 0; i < 32; ++i) { const int kk = 2 * i + (lane >> 5); t32[i] = W[(size_t)(k0 + kk) * ldw + ncol0 + n0 + (lane & 31)]; }
#pragma unroll
    for (int i = 0; i < 32; ++i) { const int kk = 2 * i + (lane >> 5); scr[kk * 33 + (lane & 31)] = t32[i]; }
    LDS_WAIT();
    const int c = lane & 7;
#pragma unroll
    for (int j = 0; j < 4; ++j) { const int n = (lane >> 3) + 8 * j; const LAS float* s = scr + (8 * c) * 33 + n;
        u32x4 o; o.x = pk2(s[0 * 33], s[1 * 33]); o.y = pk2(s[2 * 33], s[3 * 33]); o.z = pk2(s[4 * 33], s[5 * 33]); o.w = pk2(s[6 * 33], s[7 * 33]);
        *(u32x4*)(WT + (size_t)(dst_row0 + (n0 + n) * rmul) * ldt + k0 + 8 * c) = o; }
    LDS_WAIT();
}

__device__ __forceinline__ void transpose_item_f8(const float* W, int ldw, int K, unsigned char* WT, int dst_row0, int rmul, LAS float* scr, int kb, int nb, int lane) {
    const int k0 = 64 * kb, n0 = 32 * nb;
    float t32[32];
#pragma unroll
    for (int i = 0; i < 32; ++i) { const int kk = 2 * i + (lane >> 5); t32[i] = __builtin_nontemporal_load(W + (size_t)(k0 + kk) * ldw + n0 + (lane & 31)); }
#pragma unroll
    for (int i = 0; i < 32; ++i) { const int kk = 2 * i + (lane >> 5); scr[kk * 33 + (lane & 31)] = t32[i]; }
    LDS_WAIT();
    const int c = lane & 3;
#pragma unroll
    for (int j = 0; j < 2; ++j) { const int n = (lane >> 2) + 16 * j; const LAS float* s = scr + (16 * c) * 33 + n;
        u32x4 o;
        o.x = pk4_fp8(s[0 * 33] * W8_SCALE, s[1 * 33] * W8_SCALE, s[2 * 33] * W8_SCALE, s[3 * 33] * W8_SCALE);
        o.y = pk4_fp8(s[4 * 33] * W8_SCALE, s[5 * 33] * W8_SCALE, s[6 * 33] * W8_SCALE, s[7 * 33] * W8_SCALE);
        o.z = pk4_fp8(s[8 * 33] * W8_SCALE, s[9 * 33] * W8_SCALE, s[10 * 33] * W8_SCALE, s[11 * 33] * W8_SCALE);
        o.w = pk4_fp8(s[12 * 33] * W8_SCALE, s[13 * 33] * W8_SCALE, s[14 * 33] * W8_SCALE, s[15 * 33] * W8_SCALE);
        *(u32x4*)(WT + (size_t)(dst_row0 + (n0 + n) * rmul) * K + k0 + 16 * c) = o; }
    LDS_WAIT();
}
struct Cvt8 { const float* W; int ldw, K; unsigned char* WT; int dst_row0, rmul, kb, nb; };
__device__ __forceinline__ void cvt8_load(const Cvt8& d, int lane, float (&t32)[32]) {
    const int k0 = 64 * d.kb, n0 = 32 * d.nb;
#pragma unroll
    for (int i = 0; i < 32; ++i) { const int kk = 2 * i + (lane >> 5); t32[i] = __builtin_nontemporal_load(d.W + (size_t)(k0 + kk) * d.ldw + n0 + (lane & 31)); }
}
__device__ __forceinline__ void cvt8_store(const Cvt8& d, int lane, const float (&t32)[32], LAS float* scr) {
    const int k0 = 64 * d.kb, n0 = 32 * d.nb;
#pragma unroll
    for (int i = 0; i < 32; ++i) { const int kk = 2 * i + (lane >> 5); scr[kk * 33 + (lane & 31)] = t32[i]; }
    LDS_WAIT();
    const int c = lane & 3;
#pragma unroll
    for (int j = 0; j < 2; ++j) { const int n = (lane >> 2) + 16 * j; const LAS float* s = scr + (16 * c) * 33 + n;
        u32x4 o;
        o.x = pk4_fp8(s[0 * 33] * W8_SCALE, s[1 * 33] * W8_SCALE, s[2 * 33] * W8_SCALE, s[3 * 33] * W8_SCALE);
        o.y = pk4_fp8(s[4 * 33] * W8_SCALE, s[5 * 33] * W8_SCALE, s[6 * 33] * W8_SCALE, s[7 * 33] * W8_SCALE);
        o.z = pk4_fp8(s[8 * 33] * W8_SCALE, s[9 * 33] * W8_SCALE, s[10 * 33] * W8_SCALE, s[11 * 33] * W8_SCALE);
        o.w = pk4_fp8(s[12 * 33] * W8_SCALE, s[13 * 33] * W8_SCALE, s[14 * 33] * W8_SCALE, s[15 * 33] * W8_SCALE);
        __builtin_nontemporal_store(o, (u32x4*)(d.WT + (size_t)(d.dst_row0 + (n0 + n) * d.rmul) * d.K + k0 + 16 * c)); }
    LDS_WAIT();
}
template <class F> __device__ __forceinline__ void cvt8_stream(int first, int last, int stride, LAS float* scr, int lane, F decode) {
    int it = first; if (it >= last) return;
    Cvt8 da, db; float ta[32], tb[32];
    decode(it, da); cvt8_load(da, lane, ta);
    for (;;) {
        const int it2 = it + stride; const bool h2 = it2 < last;
        if (h2) { decode(it2, db); cvt8_load(db, lane, tb); }
        cvt8_store(da, lane, ta, scr);
        if (!h2) break;
        const int it3 = it2 + stride; const bool h3 = it3 < last;
        if (h3) { decode(it3, da); cvt8_load(da, lane, ta); }
        cvt8_store(db, lane, tb, scr);
        if (!h3) break;
        it = it3;
    }
}

__device__ __forceinline__ void cvt8_expert_item(const Params& P, int it, Cvt8& d) {
    const int NW13 = NE * 2048;
    if (it >= NW13) { const int q = it - NW13, e = q >> 10, r = q & 1023; d = Cvt8{P.in[25] + (size_t)e * DFF * DM, DM, DFF, P.ws + WS_W2 + (size_t)e * DM * DFF, 0, 1, r / 32, r % 32}; return; }
    const int e = it / 2048, r = it % 2048;
    if (r < 1024) d = Cvt8{P.in[23] + (size_t)e * DM * DFF, DFF, DM, P.ws + WS_W13 + (size_t)e * 4096 * DM, 0, 2, r / 64, r % 64};
    else d = Cvt8{P.in[24] + (size_t)e * DM * DFF, DFF, DM, P.ws + WS_W13 + (size_t)e * 4096 * DM, 1, 2, (r - 1024) / 64, (r - 1024) % 64};
}
constexpr int W13_T2 = 224 * 8 * 6, W13_T4 = 192 * 8 * 10, W13_EARLY = W13_T2 + W13_T4;
__device__ __forceinline__ void convert_experts(const Ctx& C, const Params& P) {
    LAS float* scr = (LAS float*)(C.lds + C.wave * 8448);
    const int NW13 = NE * 2048, NTOT = NW13 + ((C.G == 256) ? 0 : NE * 1024);
    const int nbusy = (BATCH * NE < C.G) ? BATCH * NE : C.G, nfree = C.G - nbusy;
    const int W13E = (C.G == 256) ? W13_EARLY : 0;
    const int NPRE = (nfree > 0) ? ((C.G == 256) ? NTOT : W13E + 6912) : W13E;
    if (C.bid >= nbusy && nfree > 0) cvt8_stream(W13E + (C.bid - nbusy) * 8 + C.wave, NPRE, nfree * 8, scr, C.lane, [&](int it, Cvt8& d) { cvt8_expert_item(P, it, d); });
    cvt8_stream(NPRE + C.bid * 8 + C.wave, NTOT, C.G * 8, scr, C.lane, [&](int it, Cvt8& d) { cvt8_expert_item(P, it, d); });
}

__device__ __forceinline__ void phase0(const Ctx& C, const Params& P) {
    unsigned char* ws = P.ws;
    const int WB = (C.G >= 192) ? (768 + C.G - 1) / C.G : 0;
    {
        LAS float* w1s = (LAS float*)(C.lds + 69632) + 16 * 33 + 2 * 16 * 64; LAS float* w2s = w1s + 33 * 64;
        const float* w1 = P.in[11]; const float* w2 = P.in[13];
        for (int idx = C.tid; idx < 33 * 64; idx += NTHR) w1s[idx] = w1[idx];
        for (int idx = C.tid; idx < 64 * 64; idx += NTHR) w2s[idx] = w2[idx];
    }
    if (C.wave >= WB) {
        const int gw = C.bid * (8 - WB) + (C.wave - WB), NGW = C.G * (8 - WB);
        LAS float* scr = (LAS float*)(C.lds + C.wave * 8448);
        const int I_IN1 = 16 * 112, I_IN2 = 16 * 64, I_BH = 8 * 32, I_BM = 8 * 32, I_OUT = 16 * 32, I_QO = 16 * 32, I_KV = 16 * 32;
        const int NIT = I_IN1 + I_IN2 + I_BH + I_BM + I_OUT + I_QO + I_KV;
        for (int it = gw; it < NIT; it += NGW) {
            int r = it;
            if (r < I_IN1) { transpose_item(P.in[8], DIN, DM, 0, (bf16_t*)(ws + WS_WIN), 0, 1, scr, r / 112, r % 112, C.lane); continue; } r -= I_IN1;
            if (r < I_IN2) { transpose_item_f8(P.in[8] + MERGE0, DIN, DM, ws + WS_WG8, 0, 1, scr, r / 64, r % 64, C.lane); continue; } r -= I_IN2;
            if (r < I_BH) { transpose_item(P.in[19], DM, 1024, 0, (bf16_t*)(ws + WS_WB), 0, 1, scr, r / 32, r % 32, C.lane); continue; } r -= I_BH;
            if (r < I_BM) { transpose_item(P.in[20], DM, 1024, 0, (bf16_t*)(ws + WS_WB) + 512, 0, 1, scr, r / 32, r % 32, C.lane); continue; } r -= I_BM;
            if (r < I_OUT) { transpose_item(P.in[21], DM, DM, 0, (bf16_t*)(ws + WS_WOUT), 0, 1, scr, r / 32, r % 32, C.lane); continue; } r -= I_OUT;
            if (r < I_QO) { const int kb = r / 32, nb = r % 32;
              transpose_item_f8(P.in[8] + (nb < 16 ? 1536 : 3072 - 512), DIN, DM, ws + WS_WG8, 2048, 1, scr, kb, nb, C.lane); continue; } r -= I_QO;
            transpose_item_f8(P.in[8] + 2048, DIN, DM, ws + WS_WG8, 3072, 1, scr, r / 32, r % 32, C.lane);
        }
    }
    if (WB == 0 || C.wave < WB) {
        const float* wada = P.in[4]; const float* bada = P.in[5]; float* part = (float*)(ws + WS_ADAP);
        const int it0 = WB ? C.wave * C.G + C.bid : C.bid * 8 + C.wave, its = WB ? 768 : C.G * 8;
        for (int it = it0; it < 96 * 8; it += its) {
            const int cgp = it % 96, ks = it / 96, n = cgp * 64 + C.lane;
            float a[9];
#pragma unroll
            for (int r = 0; r < 9; ++r) a[r] = 0.f;
#pragma unroll 1
            for (int k1 = 0; k1 < 4; ++k1) {
                const int k0 = ks * 128 + k1 * 32;
                float sv[9];
                { const int k = k0 + (C.lane & 31);
#pragma unroll
                  for (int r = 0; r < 8; ++r) sv[r] = siluf(P.in[1][r * DM + k]);
                  sv[8] = siluf(P.in[3][k]); }
                float wv[32];
#pragma unroll
                for (int kk = 0; kk < 32; ++kk) wv[kk] = wada[(size_t)(k0 + kk) * 6144 + n];
#pragma unroll
                for (int kk = 0; kk < 32; ++kk) {
#pragma unroll
                    for (int r = 0; r < 9; ++r) a[r] += __shfl(sv[r], kk) * wv[kk]; }
            }
            const float bb = (ks == 0) ? bada[n] : 0.f;
#pragma unroll
            for (int r = 0; r < 9; ++r) part[((size_t)ks * 9 + r) * 6144 + n] = a[r] + bb;
        }
    }
    __syncthreads();
    {
        LAS float* zs = (LAS float*)(C.lds + 69632);
        LAS float* h1 = zs + 16 * 33;
        LAS float* h2 = h1 + 16 * 64;
        LAS float* w1s = h2 + 16 * 64;
        LAS float* w2s = w1s + 33 * 64;
        bf16_t* krev = (bf16_t*)(ws + WS_KREV);
        const float* w1 = P.in[11]; const float* b1 = P.in[12]; const float* w2 = P.in[13]; const float* b2 = P.in[14]; const float* w3 = P.in[15];
        for (int it = C.bid; it < 256; it += C.G) {
            const int l0 = it * 16;
            __syncthreads();
            for (int idx = C.tid; idx < 16 * 33; idx += NTHR) { const int pos = idx / 33, m = idx % 33, l = l0 + pos; float v;
                if (m == 0) v = (float)l / 4095.0f;
                else { const int bi = (m - 1) & 15; const float band = 1e-4f + (float)bi * ((15.0f - 1e-4f) / 15.0f);
                    const float ang = ((float)(2.0 * 3.14159265358979323846 / 4096.0) * (float)l) * band; v = (m <= 16) ? cosf(ang) : sinf(ang); }
                zs[idx] = v; }
            __syncthreads();
            for (int idx = C.tid; idx < 16 * 64; idx += NTHR) { const int pos = idx >> 6, j = idx & 63; float s = b1[j];
#pragma unroll
                for (int m = 0; m < 33; ++m) s += zs[pos * 33 + m] * w1s[m * 64 + j];
                h1[idx] = sinf(s); }
            __syncthreads();
            for (int idx = C.tid; idx < 16 * 64; idx += NTHR) { const int pos = idx >> 6, j = idx & 63; float s = b2[j];
#pragma unroll 16
                for (int k = 0; k < 64; ++k) s += h1[pos * 64 + k] * w2s[k * 64 + j];
                h2[j * 16 + pos] = sinf(s); }
            __syncthreads();
#pragma unroll 1
            for (int q = 0; q < 4; ++q) {
                const int n = C.tid + NTHR * q;
                float a[16];
#pragma unroll
                for (int p = 0; p < 16; ++p) a[p] = 0.f;
                float wv[16];
#pragma unroll
                for (int k = 0; k < 16; ++k) wv[k] = w3[k * 2048 + n];
#pragma unroll 1
                for (int kb = 0; kb < 4; ++kb) {
                    float wc[16];
#pragma unroll
                    for (int k = 0; k < 16; ++k) wc[k] = wv[k];
                    const int kn = (kb < 3) ? (kb + 1) * 16 : 0;
#pragma unroll
                    for (int k = 0; k < 16; ++k) wv[k] = w3[(kn + k) * 2048 + n];
#pragma unroll
                    for (int kk = 0; kk < 16; ++kk) { const float w = wc[kk]; const LAS float* hp = h2 + (kb * 16 + kk) * 16;
#pragma unroll
                        for (int p4 = 0; p4 < 4; ++p4) { const f32x4 hv = *(const LAS f32x4*)(hp + 4 * p4);
                            a[4 * p4] += hv[0] * w; a[4 * p4 + 1] += hv[1] * w; a[4 * p4 + 2] += hv[2] * w; a[4 * p4 + 3] += hv[3] * w; }
                        if (kk & 1) asm volatile("" ::: "memory"); }
                }
                const int o = q >> 1, side = q & 1, c = n & 511;
                const float delta = fabsf(-3.0701134573253944f + (float)c * ((-15.350567286626972f + 3.0701134573253944f) / 511.0f));
                bf16_t* dst = krev + ((size_t)o * 512 + c) * 8192;
                float v[16];
#pragma unroll
                for (int p = 0; p < 16; ++p) { const int l = l0 + p; const float t = (float)l / 4095.0f; v[p] = a[p] * expf(-t * delta); }
                if (side == 0) {
                    bf16_t* dp = dst + 4081 - l0;
                    dp[0] = (bf16_t)f2bf(v[15]);
                    *(unsigned*)(dp + 1) = pk2(v[14], v[13]);
                    *(u32x2*)(dp + 3) = (u32x2){pk2(v[12], v[11]), pk2(v[10], v[9])};
                    *(u32x4*)(dp + 7) = (u32x4){pk2(v[8], v[7]), pk2(v[6], v[5]), pk2(v[4], v[3]), pk2(v[2], v[1])};
                    dp[15] = (bf16_t)f2bf(v[0]);
                } else if (l0 > 0) {
                    bf16_t* dp = dst + 4096 + l0;
                    *(u32x4*)dp = (u32x4){pk2(v[0], v[1]), pk2(v[2], v[3]), pk2(v[4], v[5]), pk2(v[6], v[7])};
                    *(u32x4*)(dp + 8) = (u32x4){pk2(v[8], v[9]), pk2(v[10], v[11]), pk2(v[12], v[13]), pk2(v[14], v[15])};
                } else {
                    dst[0] = 0;
#pragma unroll
                    for (int p = 1; p < 16; ++p) dst[4096 + p] = (bf16_t)f2bf(v[p]);
                }
            }
        }
    }
}

__device__ __forceinline__ int wl_pos(int k) { return ((k & 3) + 4 * (k >> 8)) * 64 + ((k >> 2) & 63); }
typedef float f32x2 __attribute__((ext_vector_type(2)));
__device__ __forceinline__ float pair32(float keep_lo, float keep_hi) { const auto s = __builtin_amdgcn_permlane32_swap(__builtin_bit_cast(unsigned, keep_lo), __builtin_bit_cast(unsigned, keep_hi), false, false);
    unsigned r0 = s[0], r1 = s[1]; asm volatile("" : "+v"(r0), "+v"(r1)); return __builtin_bit_cast(float, r0) + __builtin_bit_cast(float, r1); }
__device__ __forceinline__ float pair16(float keep_ev, float keep_od) { const auto s = __builtin_amdgcn_permlane16_swap(__builtin_bit_cast(unsigned, keep_ev), __builtin_bit_cast(unsigned, keep_od), false, false);
    unsigned r0 = s[0], r1 = s[1]; asm volatile("" : "+v"(r0), "+v"(r1)); return __builtin_bit_cast(float, r0) + __builtin_bit_cast(float, r1); }
__device__ __forceinline__ float rd16_reduce(const f32x2 (&r2)[8], int lane) {
    float r[16];
#pragma unroll
    for (int e = 0; e < 8; ++e) { r[2 * e] = r2[e][0]; r[2 * e + 1] = r2[e][1]; }
    const bool b3 = (lane & 8) != 0, b2 = (lane & 4) != 0;
    float t[8];
#pragma unroll
    for (int e = 0; e < 8; ++e) t[e] = pair32(r[e], r[e + 8]);
    float u[4];
#pragma unroll
    for (int e = 0; e < 4; ++e) u[e] = pair16(t[e], t[e + 4]);
    float v2[2];
#pragma unroll
    for (int e = 0; e < 2; ++e) { const float snd = b3 ? u[e] : u[e + 2], kp = b3 ? u[e + 2] : u[e]; v2[e] = kp + dppf<DPP_XOR8>(snd); }
    float s; { const float snd = b2 ? v2[0] : v2[1], kp = b2 ? v2[1] : v2[0]; s = kp + dppf<DPP_XOR7>(snd); }
    s += dppf<DPP_XOR2>(s); s += dppf<DPP_XOR1>(s);
    return s;
}
__device__ __forceinline__ float row_dot16(const f32x4 (&y)[4], const LAS float* Wl, int lane) {
    f32x2 r2[8];
#pragma unroll
    for (int e = 0; e < 8; ++e) r2[e] = (f32x2){0.f, 0.f};
    f32x4 wa[16], wb[16];
#define RD16(dst, j) do { _Pragma("unroll") for (int q = 0; q < 4; ++q) _Pragma("unroll") for (int e4 = 0; e4 < 4; ++e4) dst[q * 4 + e4] = *(const LAS f32x4*)(Wl + ((q + 4 * (j)) * 64 + lane) * 20 + e4 * 4); } while (0)
#define FM16(src, j) do { _Pragma("unroll") for (int q = 0; q < 4; ++q) { const f32x2 v2 = (f32x2){y[j][q], y[j][q]}; _Pragma("unroll") for (int e4 = 0; e4 < 4; ++e4) { const f32x4 w = src[q * 4 + e4]; \
        r2[e4 * 2] += v2 * (f32x2){w[0], w[1]}; r2[e4 * 2 + 1] += v2 * (f32x2){w[2], w[3]}; } } } while (0)
    RD16(wa, 0);
    RD16(wb, 1); asm volatile("" ::: "memory"); FM16(wa, 0);
    RD16(wa, 2); asm volatile("" ::: "memory"); FM16(wb, 1);
    RD16(wb, 3); asm volatile("" ::: "memory"); FM16(wa, 2);
    FM16(wb, 3);
#undef RD16
#undef FM16
    return rd16_reduce(r2, lane);
}
__device__ __forceinline__ void row_dot16x2(const f32x4 (&ya)[4], const f32x4 (&yb)[4], const LAS float* Wl, int lane, float& oa, float& ob) {
    f32x2 ra[8], rb[8];
#pragma unroll
    for (int e = 0; e < 8; ++e) { ra[e] = (f32x2){0.f, 0.f}; rb[e] = (f32x2){0.f, 0.f}; }
    f32x4 wa[8], wb[8];
#define RD8(dst, jb) do { _Pragma("unroll") for (int qq = 0; qq < 2; ++qq) _Pragma("unroll") for (int e4 = 0; e4 < 4; ++e4) dst[qq * 4 + e4] = *(const LAS f32x4*)(Wl + ((2 * ((jb) & 1) + qq + 4 * ((jb) >> 1)) * 64 + lane) * 20 + e4 * 4); } while (0)
#define FM8(src, jb) do { _Pragma("unroll") for (int qq = 0; qq < 2; ++qq) { const int q = 2 * ((jb) & 1) + qq, j = (jb) >> 1; const f32x2 va = (f32x2){ya[j][q], ya[j][q]}, vb = (f32x2){yb[j][q], yb[j][q]}; \
        _Pragma("unroll") for (int e4 = 0; e4 < 4; ++e4) { const f32x4 w = src[qq * 4 + e4]; \
        const f32x2 wl = (f32x2){w[0], w[1]}, wh = (f32x2){w[2], w[3]}; ra[e4 * 2] += va * wl; ra[e4 * 2 + 1] += va * wh; rb[e4 * 2] += vb * wl; rb[e4 * 2 + 1] += vb * wh; } } } while (0)
    RD8(wa, 0);
    RD8(wb, 1); asm volatile("" ::: "memory"); FM8(wa, 0);
    RD8(wa, 2); asm volatile("" ::: "memory"); FM8(wb, 1);
    RD8(wb, 3); asm volatile("" ::: "memory"); FM8(wa, 2);
    RD8(wa, 4); asm volatile("" ::: "memory"); FM8(wb, 3);
    RD8(wb, 5); asm volatile("" ::: "memory"); FM8(wa, 4);
    RD8(wa, 6); asm volatile("" ::: "memory"); FM8(wb, 5);
    RD8(wb, 7); asm volatile("" ::: "memory"); FM8(wa, 6);
    FM8(wb, 7);
#undef RD8
#undef FM8
    oa = rd16_reduce(ra, lane); ob = rd16_reduce(rb, lane);
}

__device__ __forceinline__ void phase1(const Ctx& C, const Params& P) {
    unsigned char* ws = P.ws;
    const float* part = (const float*)(ws + WS_ADAP); float* ada = (float*)(ws + WS_ADA);
    for (int o = C.bid * NTHR + C.tid; o < 9 * 6144; o += C.G * NTHR) { float s = 0.f;
#pragma unroll
        for (int ks = 0; ks < 8; ++ks) s += part[(size_t)ks * 9 * 6144 + o];
        ada[o] = s; }
    LAS float* Wg = (LAS float*)C.lds;
    LAS float* mod = Wg + 1024 * 20;
#pragma unroll 1
    for (int i0 = C.tid; i0 < 1024 * 16; i0 += 8 * NTHR) { float t8[8];
#pragma unroll
        for (int u = 0; u < 8; ++u) { const int idx = i0 + u * NTHR; t8[u] = P.in[8][(size_t)(idx >> 4) * DIN + GATE0 + (idx & 15)]; }
#pragma unroll
        for (int u = 0; u < 8; ++u) { const int idx = i0 + u * NTHR; Wg[wl_pos(idx >> 4) * 20 + (idx & 15)] = t8[u]; } }
    const float* gmix = P.in[6]; const float* bin = P.in[9];
    bf16_t* hx = (bf16_t*)(ws + WS_HX); float* gates = (float*)(ws + WS_GATES);
    for (int rg = C.bid; rg < 256; rg += C.G) {
        const int b = rg >> 5;
        auto rowsrc = [&](int rr) -> const float* { return (rr < 128) ? (P.in[0] + (size_t)(rg * 128 + rr) * DM) : (P.in[2] + (size_t)(rg * 8 + (rr - 128)) * DM); };
        f32x4 nxa[4], nxb[4];
        { const float* s0 = rowsrc(C.wave); const float* s1 = rowsrc(C.wave + 8);
#pragma unroll
          for (int j = 0; j < 4; ++j) { nxa[j] = __builtin_nontemporal_load((const f32x4*)(s0 + 4 * C.lane + 256 * j)); nxb[j] = __builtin_nontemporal_load((const f32x4*)(s1 + 4 * C.lane + 256 * j)); } }
        __syncthreads();
#pragma unroll 2
        for (int idx = C.tid; idx < 4096; idx += NTHR) { const int which = idx >> 10, k = idx & 1023; const int r = (which < 2) ? b : 8; const int col = (which & 1) * 1024 + k;
            float s = 0.f;
#pragma unroll
            for (int ks = 0; ks < 8; ++ks) s += part[((size_t)ks * 9 + r) * 6144 + col];
            mod[idx] = s; }
        __syncthreads();
        f32x4 gm[4];
#pragma unroll
        for (int j = 0; j < 4; ++j) gm[j] = *(const f32x4*)(gmix + 4 * C.lane + 256 * j);
#pragma unroll 1
        for (int kp = 0; kp < 8; ++kp) {
            const int rra = C.wave + 16 * kp, growa = rg * 128 + rra, growb = growa + 8;
            const LAS float* sh = mod; const LAS float* sc = sh + 1024;
            f32x4 va[4], vb[4]; float ssa = 0.f, ssb = 0.f;
#pragma unroll
            for (int j = 0; j < 4; ++j) { va[j] = nxa[j]; vb[j] = nxb[j]; ssa += va[j][0] * va[j][0] + va[j][1] * va[j][1] + va[j][2] * va[j][2] + va[j][3] * va[j][3];
                ssb += vb[j][0] * vb[j][0] + vb[j][1] * vb[j][1] + vb[j][2] * vb[j][2] + vb[j][3] * vb[j][3]; }
            { const float* s0 = rowsrc(kp < 7 ? rra + 16 : 128 + C.wave); const float* s1 = rowsrc(kp < 7 ? rra + 24 : 128 + C.wave);
#pragma unroll
              for (int j = 0; j < 4; ++j) { nxa[j] = __builtin_nontemporal_load((const f32x4*)(s0 + 4 * C.lane + 256 * j)); if (kp < 7) nxb[j] = __builtin_nontemporal_load((const f32x4*)(s1 + 4 * C.lane + 256 * j)); } }
            const float rstda = rsqrtf(wave_sum(ssa) * (1.f / DM) + RMS_EPS), rstdb = rsqrtf(wave_sum(ssb) * (1.f / DM) + RMS_EPS);
#pragma unroll
            for (int j = 0; j < 4; ++j) { const int k = 4 * C.lane + 256 * j;
                const f32x4 s4 = *(const LAS f32x4*)(sc + k), h4 = *(const LAS f32x4*)(sh + k);
#pragma unroll
                for (int q = 0; q < 4; ++q) { va[j][q] = (va[j][q] * rstda * gm[j][q]) * (1.f + s4[q]) + h4[q]; vb[j][q] = (vb[j][q] * rstdb * gm[j][q]) * (1.f + s4[q]) + h4[q]; }
                u32x2 wa; wa.x = pk2(va[j][0], va[j][1]); wa.y = pk2(va[j][2], va[j][3]);
                u32x2 wb; wb.x = pk2(vb[j][0], vb[j][1]); wb.y = pk2(vb[j][2], vb[j][3]);
                *(u32x2*)(hx + (size_t)growa * DM + k) = wa; *(u32x2*)(hx + (size_t)growb * DM + k) = wb;
                *(unsigned*)(ws + WS_HX8 + (size_t)growa * DM + k) = pk4_fp8(va[j][0], va[j][1], va[j][2], va[j][3]);
                *(unsigned*)(ws + WS_HX8 + (size_t)growb * DM + k) = pk4_fp8(vb[j][0], vb[j][1], vb[j][2], vb[j][3]); }
            float ga, gb; row_dot16x2(va, vb, Wg, C.lane, ga, gb);
            if ((C.lane & 3) == 0) { gates[(size_t)growa * 16 + (C.lane >> 2)] = ga + bin[GATE0 + (C.lane >> 2)]; gates[(size_t)growb * 16 + (C.lane >> 2)] = gb + bin[GATE0 + (C.lane >> 2)]; }
        }
        {
            const int grow = MX + rg * 8 + C.wave;
            const LAS float* sh = mod + 2048; const LAS float* sc = sh + 1024;
            f32x4 v[4]; float ss = 0.f;
#pragma unroll
            for (int j = 0; j < 4; ++j) { v[j] = nxa[j]; ss += v[j][0] * v[j][0] + v[j][1] * v[j][1] + v[j][2] * v[j][2] + v[j][3] * v[j][3]; }
            const float rstd = rsqrtf(wave_sum(ss) * (1.f / DM) + RMS_EPS);
#pragma unroll
            for (int j = 0; j < 4; ++j) { const int k = 4 * C.lane + 256 * j;
                const f32x4 s4 = *(const LAS f32x4*)(sc + k), h4 = *(const LAS f32x4*)(sh + k);
#pragma unroll
                for (int q = 0; q < 4; ++q) v[j][q] = (v[j][q] * rstd * gm[j][q]) * (1.f + s4[q]) + h4[q];
                u32x2 w; w.x = pk2(v[j][0], v[j][1]); w.y = pk2(v[j][2], v[j][3]);
                *(u32x2*)(hx + (size_t)grow * DM + k) = w;
                *(unsigned*)(ws + WS_HX8 + (size_t)grow * DM + k) = pk4_fp8(v[j][0], v[j][1], v[j][2], v[j][3]); }
            const float gsum = row_dot16(v, Wg, C.lane);
            if ((C.lane & 3) == 0) gates[(size_t)grow * 16 + (C.lane >> 2)] = gsum + bin[GATE0 + (C.lane >> 2)];
        }
    }
}

__device__ __forceinline__ void phase2a(const Ctx& C, const Params& P, bool skip_epi) {
    unsigned char* ws = P.ws;
    pg8::SchedGrid S{(const char*)(ws + WS_WIN), (const char*)(ws + WS_HX), (size_t)256 * 2048, (size_t)256 * 2048, 6, 128, 0, 0, C.G, C.bid, 8, 8, 128, 0, 1 << 30, 0, 1 << 30, 0};
    pg8::EpiCMT E{(bf16_t*)(ws + WS_PCM), (bf16_t*)(ws + WS_KVCM), P.in[9], skip_epi};
    pg8::gemm_phase<pg8::EpiCMT, pg8::SchedGrid, false>(C.lds, 1024, 2048, 2048, S, E);
}
__device__ __forceinline__ void phase2b(const Ctx& C, const Params& P, bool skip_epi) {
    unsigned char* ws = P.ws;
    pg8::SchedGrid S{(const char*)(ws + WS_HX), (const char*)(ws + WS_WIN), (size_t)256 * 2048, (size_t)256 * 2048, 128, 4, 0, 6, C.G, C.bid, 1, 0, 0, 0, 2, 4, 1 << 30, 0};
    pg8::EpiIn2 E{(bf16_t*)(ws + WS_PML), (unsigned char*)P.out, P.in[9], skip_epi};
    pg8::gemm_phase<pg8::EpiIn2, pg8::SchedGrid, false>(C.lds, 1024, 2048, 2048, S, E);
}
__device__ __forceinline__ void phase2g(const Ctx& C, const Params& P) {
    unsigned char* ws = P.ws;
    pg8::SchedGrid S{(const char*)(ws + WS_HX8), (const char*)(ws + WS_WG8), (size_t)256 * 1024, (size_t)256 * 1024, 128, 12, 0, 0, C.G, C.bid, 1, 0, 0, 0, 1 << 30, 0, 1 << 30, 0};
    pg8::EpiG8 E{(unsigned char*)P.out, (bf16_t*)(ws + WS_PML), P.in[9]};
    pg8::gemm_phase<pg8::EpiG8, pg8::SchedGrid, false, true>(C.lds, 512, 1024, 1024, S, E);
}
__device__ __forceinline__ void phase2kv(const Ctx& C, const Params& P) {
    unsigned char* ws = P.ws;
    pg8::SchedGrid S{(const char*)(ws + WS_WG8 + (size_t)3072 * 1024), (const char*)(ws + WS_HX8), (size_t)256 * 1024, (size_t)256 * 1024, 4, 136, 0, 0, C.G, C.bid, 1, 0, 0, 0, 1 << 30, 0, 1 << 30, 0};
    pg8::EpiKV8 E{(bf16_t*)(ws + WS_KVCM), P.in[9]};
    pg8::gemm_phase<pg8::EpiKV8, pg8::SchedGrid, false, true>(C.lds, 512, 1024, 1024, S, E);
}
__device__ __forceinline__ void phase_merge(const Ctx& C, const Params& P) {
    unsigned char* ws = P.ws;
    pg8::SchedChain S{{(const char*)(ws + WS_YAB), (const char*)(ws + WS_WB), (size_t)256 * 2048, (size_t)256 * 2048, 128, 4, 0, 0, C.G, C.bid, 1, 0, 0, 0, 1 << 30, 0, 1 << 30, 0}, 1024};
    pg8::EpiMerge E{(bf16_t*)(ws + WS_Z), (const unsigned char*)P.out};
    pg8::gemm_phase<pg8::EpiMerge, pg8::SchedChain, false>(C.lds, 512, 2048, 2048, S, E);
}
__device__ __forceinline__ void phase_outproj(const Ctx& C, const Params& P) {
    unsigned char* ws = P.ws;
    pg8::SchedGrid S{(const char*)(ws + WS_Z), (const char*)(ws + WS_WOUT), (size_t)256 * 2048, (size_t)256 * 2048, 128, 4, 0, 0, C.G, C.bid, 1, 0, 0, 0, 1 << 30, 0, 1 << 30, 0};
    pg8::EpiOut E{P.in[0], (bf16_t*)(ws + WS_XMID), (const float*)(ws + WS_ADA)};
    pg8::gemm_phase<pg8::EpiOut, pg8::SchedGrid, false>(C.lds, 1024, 2048, 2048, S, E);
}

constexpr int HY_KSTR = 16448;
constexpr int HY_UOFF = 4 * HY_KSTR;
constexpr int HY_USTR = 4616;
template <int MODE>
__device__ __forceinline__ void hyena_item(const Ctx& C, const Params& P, int o, int c) {
    unsigned char* ws = P.ws;
    LAS bf16_t* krv = (LAS bf16_t*)C.lds;
    LAS bf16_t* up = (LAS bf16_t*)(C.lds + HY_UOFF);
    const bf16_t* pcm = (const bf16_t*)(ws + WS_PCM);
    const float* hconv = P.in[10];
    int tid = C.tid; asm volatile("" : "+v"(tid));
    __syncthreads();
    {
        const u32x4* src = (const u32x4*)((const bf16_t*)(ws + WS_KREV) + ((size_t)o * 512 + c) * 8192);
        for (int i = tid; i < 1024; i += NTHR) *(LAS u32x4*)(krv + 8 * i) = src[i];
        for (int i = tid; i < 8 * 65; i += NTHR) { const int b = i / 65, q = i % 65; const int off = (q < 32) ? 8 * q : (4352 + 8 * (q - 32));
            *(LAS u32x4*)(up + b * HY_USTR + off) = (u32x4){0u, 0u, 0u, 0u}; }
        if (o == 0) {
            const bf16_t* src0 = pcm + (size_t)c * MX; const float w0 = hconv[c], w1 = hconv[1536 + c], w2 = hconv[3072 + c];
            u32x4 vv[8];
#pragma unroll
            for (int it = 0; it < 8; ++it) { const int r0 = 8 * (tid + NTHR * it); vv[it] = *(const u32x4*)(src0 + r0); }
#pragma unroll
            for (int it = 0; it < 8; ++it) { const int r0 = 8 * (tid + NTHR * it); const u32x4 v = vv[it];
                const unsigned vl = __shfl_up(v.w, 1), vr = __shfl_down(v.x, 1);
                float x[10]; x[1] = bflo(v.x); x[2] = bfhi(v.x); x[3] = bflo(v.y); x[4] = bfhi(v.y); x[5] = bflo(v.z); x[6] = bfhi(v.z); x[7] = bflo(v.w); x[8] = bfhi(v.w);
                x[0] = ((r0 & 63) != 0) ? bfhi(vl) : 0.f; x[9] = ((r0 & 63) != 56) ? bflo(vr) : 0.f;
                float y[8];
#pragma unroll
                for (int j = 0; j < 8; ++j) y[j] = w0 * x[j] + w1 * x[j + 1] + w2 * x[j + 2];
                u32x4 w; w.x = pk2(y[0], y[1]); w.y = pk2(y[2], y[3]); w.z = pk2(y[4], y[5]); w.w = pk2(y[6], y[7]);
                *(LAS u32x4*)(up + (r0 >> 12) * HY_USTR + 256 + (r0 & 4095)) = w; }
        } else {
            const u32x4* src1 = (const u32x4*)((const bf16_t*)(ws + WS_Z1) + (size_t)c * MX);
            u32x4 vv[8];
#pragma unroll
            for (int it = 0; it < 8; ++it) vv[it] = src1[tid + NTHR * it];
#pragma unroll
            for (int it = 0; it < 8; ++it) { const int r0 = 8 * (tid + NTHR * it); *(LAS u32x4*)(up + (r0 >> 12) * HY_USTR + 256 + (r0 & 4095)) = vv[it]; }
        }
    }
    __syncthreads();
    for (int idx = tid; idx < 3 * 1025; idx += NTHR) { const int rho = 1 + idx / 1025, ch = idx % 1025; unsigned short e[8];
#pragma unroll
        for (int j = 0; j < 8; ++j) { const int z = 8 * ch + j - rho; e[j] = (z >= 0 && z < 8192) ? krv[z] : (unsigned short)0; }
        u32x4 w; w.x = e[0] | ((unsigned)e[1] << 16); w.y = e[2] | ((unsigned)e[3] << 16); w.z = e[4] | ((unsigned)e[5] << 16); w.w = e[6] | ((unsigned)e[7] << 16);
        *(LAS u32x4*)(C.lds + rho * HY_KSTR + 16 * ch) = w; }
    if (tid == 0) *(LAS u32x4*)(C.lds + 16 * 1024) = (u32x4){0u, 0u, 0u, 0u};
    if (tid < 12) *(LAS u32x4*)(C.lds + (tid / 3) * HY_KSTR + 16 * (1025 + tid % 3)) = (u32x4){0u, 0u, 0u, 0u};
    __syncthreads();
    const int lane = tid & 63, w = __builtin_amdgcn_readfirstlane(tid >> 6), kh = w >> 2, wq = w & 3;
    const int i = lane & 15, kq = lane >> 4, ksg = ((kq & 1) << 1) | (kq >> 1), rho = i & 3, nb = lane & 7, np = (lane >> 3) & 1, rq = kq;
    f32x4 acc[8][4];
#pragma unroll
    for (int a = 0; a < 8; ++a)
#pragma unroll
        for (int pg = 0; pg < 4; ++pg) acc[a][pg] = (f32x4){0.f, 0.f, 0.f, 0.f};
    const int sb = -112 + 2112 * kh;
    const int abase = rho * HY_KSTR + 2 * (4096 - 1024 * wq - 896 - i + rho + sb + 8 * ksg);
    const int bbase = HY_UOFF + 2 * (nb * HY_USTR + 256 + sb + 16 * np + 8 * ksg);
    typedef const volatile LAS u32x2* vp2;
#define HY_LDA1(AF, a, m) do { const int _a = abase + 64 * (m) + 256 * (7 - (a)); const u32x2 lo = *(vp2)(C.lds + _a), hi = *(vp2)(C.lds + _a + 8); \
        AF[a] = __builtin_bit_cast(bf16x8, (u32x4){lo.x, lo.y, hi.x, hi.y}); } while (0)
#define HY_LDB(x) (*(const LAS bf16x8*)(C.lds + bbase + 64 * (x)))
#define HY_STEP(m, B0, B1, B2, B3, BN, ldA, ldB) do { \
        if (ldB) BN = HY_LDB((m) + 4); \
        _Pragma("unroll") for (int a = 0; a < 8; ++a) { \
            __builtin_amdgcn_sched_barrier(0); \
            acc[a][0] = __builtin_amdgcn_mfma_f32_16x16x32_bf16(af[a], B0, acc[a][0], 0, 0, 0); acc[a][1] = __builtin_amdgcn_mfma_f32_16x16x32_bf16(af[a], B1, acc[a][1], 0, 0, 0); \
            acc[a][2] = __builtin_amdgcn_mfma_f32_16x16x32_bf16(af[a], B2, acc[a][2], 0, 0, 0); acc[a][3] = __builtin_amdgcn_mfma_f32_16x16x32_bf16(af[a], B3, acc[a][3], 0, 0, 0); \
            __builtin_amdgcn_sched_barrier(0); \
            if (ldA) HY_LDA1(af, a, (m) + 1); } \
        __builtin_amdgcn_sched_barrier(0); } while (0)
    {
        bf16x8 af[8], bw0, bw1, bw2, bw3, bw4;
#pragma unroll
        for (int a = 0; a < 8; ++a) HY_LDA1(af, a, 0);
        bw0 = HY_LDB(0); bw1 = HY_LDB(1); bw2 = HY_LDB(2); bw3 = HY_LDB(3);
#pragma unroll 1
        for (int it = 0; it < (MODE == 1 ? 0 : 13); ++it) { const int m = 5 * it;
            HY_STEP(m,     bw0, bw1, bw2, bw3, bw4, true, true);
            HY_STEP(m + 1, bw1, bw2, bw3, bw4, bw0, true, true);
            HY_STEP(m + 2, bw2, bw3, bw4, bw0, bw1, true, true);
            HY_STEP(m + 3, bw3, bw4, bw0, bw1, bw2, true, true);
            HY_STEP(m + 4, bw4, bw0, bw1, bw2, bw3, true, true);
        }
        if (MODE != 1) HY_STEP(65, bw0, bw1, bw2, bw3, bw4, false, false);
    }
#undef HY_LDA1
#undef HY_LDB
#undef HY_STEP
    const float skip = P.in[16][o * 512 + c];
    if (kh == 0) {
#pragma unroll
        for (int a = 0; a < 8; ++a)
#pragma unroll
            for (int pg = 0; pg < 4; ++pg) { const int tl = 1024 * wq + 128 * a + 32 * pg + 16 * np + 4 * rq;
                const u32x2 uv = *(const LAS u32x2*)(up + nb * HY_USTR + 256 + tl);
                acc[a][pg][0] += skip * bflo(uv.x); acc[a][pg][1] += skip * bfhi(uv.x); acc[a][pg][2] += skip * bflo(uv.y); acc[a][pg][3] += skip * bfhi(uv.y); }
    }
    if (kh) {
#pragma unroll
        for (int al = 0; al < 4; ++al)
#pragma unroll
            for (int pg = 0; pg < 4; ++pg) { const f32x4 t = acc[al][pg]; acc[al][pg] = acc[4 + al][pg]; acc[4 + al][pg] = t; }
    }
    const int gch = (o == 0 ? 512 : 1024) + c;
    const float w0 = hconv[gch], w1 = hconv[1536 + gch], w2 = hconv[3072 + gch];
    const bf16_t* gsrc = pcm + (size_t)gch * MX + (size_t)nb * SEQ;
    const int cl = 1024 * wq + 512 * kh + 32 * (rq & 1) + 16 * np + 8 * (rq >> 1);
    u32x4 gq[4][2]; unsigned gel[4][2], ger[4][2];
#define HY_GLOAD(al) do { _Pragma("unroll") for (int j2 = 0; j2 < 2; ++j2) { const bf16_t* gp = gsrc + cl + 128 * (al) + 64 * j2; \
            gq[al][j2] = *(const u32x4*)gp; gel[al][j2] = *(const unsigned*)(gp - 2); ger[al][j2] = *(const unsigned*)(gp + 8); } } while (0)
    HY_GLOAD(0); HY_GLOAD(1);
    __builtin_amdgcn_sched_barrier(0);
    __syncthreads();
    {
        LAS f32x4* slot = (LAS f32x4*)(C.lds + w * 16384);
#pragma unroll
        for (int al = 0; al < 4; ++al)
#pragma unroll
            for (int pg = 0; pg < 4; ++pg) slot[(al * 4 + pg) * 64 + lane] = acc[4 + al][pg];
    }
    __syncthreads();
    HY_GLOAD(2); HY_GLOAD(3);
#undef HY_GLOAD
    __builtin_amdgcn_sched_barrier(0);
    bf16_t* dst = (bf16_t*)(ws + (o == 0 ? WS_Z1 : WS_Z2CM)) + (size_t)c * MX + (size_t)nb * SEQ;
    const LAS f32x4* pslot = (const LAS f32x4*)(C.lds + (w ^ 4) * 16384);
#pragma unroll
    for (int al = 0; al < 4; ++al) {
#pragma unroll
        for (int j2 = 0; j2 < 2; ++j2) {
            unsigned px[4], py[4];
            { const u32x4 q = gq[al][j2]; const unsigned el = gel[al][j2], er = ger[al][j2];
              const auto r0 = __builtin_amdgcn_permlane16_swap(el, q.y, false, false), r1 = __builtin_amdgcn_permlane16_swap(q.x, q.z, false, false);
              const auto r2 = __builtin_amdgcn_permlane16_swap(q.y, q.w, false, false), r3 = __builtin_amdgcn_permlane16_swap(q.z, er, false, false);
              px[0] = r0[0]; py[0] = r0[1]; px[1] = r1[0]; py[1] = r1[1]; px[2] = r2[0]; py[2] = r2[1]; px[3] = r3[0]; py[3] = r3[1]; }
            unsigned zx[2], zy[2];
#pragma unroll
            for (int xy = 0; xy < 2; ++xy) {
                const int pg = 2 * j2 + xy, tl = 128 * al + 32 * pg + 16 * np + 4 * rq;
                const f32x4 pv = pslot[(al * 4 + pg) * 64 + lane];
                const f32x4 av = acc[al][pg];
                const unsigned dm = xy ? py[0] : px[0], d0 = xy ? py[1] : px[1], d1 = xy ? py[2] : px[2], d2 = xy ? py[3] : px[3];
                float x[6]; x[1] = bflo(d0); x[2] = bfhi(d0); x[3] = bflo(d1); x[4] = bfhi(d1);
                x[0] = ((tl & 63) != 0) ? bfhi(dm) : 0.f; x[5] = ((tl & 63) != 60) ? bflo(d2) : 0.f;
                float z[4];
#pragma unroll
                for (int j = 0; j < 4; ++j) { const float gate = w0 * x[j] + w1 * x[j + 1] + w2 * x[j + 2]; z[j] = gate * (av[j] + pv[j]); }
                if (xy) { zy[0] = pk2_swap(z[0], z[1]); zy[1] = pk2_swap(z[2], z[3]); } else { zx[0] = pk2_swap(z[0], z[1]); zx[1] = pk2_swap(z[2], z[3]); }
            }
            const auto s0 = __builtin_amdgcn_permlane16_swap(zx[0], zy[0], false, false), s1 = __builtin_amdgcn_permlane16_swap(zx[1], zy[1], false, false);
            const u32x4 ov = (u32x4){s0[0], s1[0], s0[1], s1[1]};
            bf16_t* dp = dst + cl + 128 * al + 64 * j2;
            if (MODE == 1) { if (ov.x == 0x12345678u) *(u32x4*)dp = ov; } else *(u32x4*)dp = ov;
        }
    }
}

typedef short s16x4 __attribute__((ext_vector_type(4)));
__device__ __forceinline__ unsigned off_b(unsigned row, unsigned ch) { return 256u * row + 16u * (ch ^ (((row & 3) << 2) | ((row >> 2) & 3))); }
__device__ __forceinline__ bf16x8 tile_row_read(const LAS unsigned char* T, int lane, int rb, int s) { return *(const LAS bf16x8*)(T + off_b((lane & 15) + 16 * rb, 4 * s + (lane >> 4))); }
__device__ __forceinline__ bf16x8 tile_tr_read(const LAS unsigned char* T, int lane, int c, int ks) {
    const unsigned g = lane >> 4, q = (lane & 15) >> 2, p = lane & 3;
    const unsigned a0 = off_b(32 * ks + 8 * g + q, 2 * c + (p >> 1)) + 8 * (p & 1), a1 = off_b(32 * ks + 8 * g + 4 + q, 2 * c + (p >> 1)) + 8 * (p & 1);
    const s16x4 lo = __builtin_amdgcn_ds_read_tr16_b64_v4i16((LAS s16x4*)(T + a0)), hi = __builtin_amdgcn_ds_read_tr16_b64_v4i16((LAS s16x4*)(T + a1));
    return __builtin_shufflevector(lo, hi, 0, 1, 2, 3, 4, 5, 6, 7);
}
struct ChunkRef { int isctx, b, h, d, oc; };
__device__ __forceinline__ int chunk_row0(const ChunkRef& r) { return r.isctx ? (MX + r.b * CTXL + r.oc * 128) : (r.b * SEQ + r.oc * 128); }

__device__ __forceinline__ void mlstm_prep(const Ctx& C, const Params& P) {
    unsigned char* ws = P.ws;
    const float* cw = P.in[17];
    {
        const bf16_t* kvcm = (const bf16_t*)(ws + WS_KVCM); bf16_t* kact = (bf16_t*)(ws + WS_KACT);
        const int NCH = 512 * (MT / 8), STR = C.G * NTHR;
        for (int i0 = C.bid * NTHR + C.tid; i0 < NCH; i0 += 4 * STR) {
            u32x4 vv[4]; unsigned vl4[4], vr4[4];
#pragma unroll
            for (int u = 0; u < 4; ++u) { const int i = i0 + u * STR; vv[u] = (u32x4){0u, 0u, 0u, 0u}; if (i < NCH) { const int c = i / (MT / 8), col = 8 * (i % (MT / 8)); const bf16_t* src = kvcm + (size_t)c * MT + col;
                vv[u] = *(const u32x4*)src; } }
#pragma unroll
            for (int u = 0; u < 4; ++u) { vl4[u] = __shfl_up(vv[u].w, 1); vr4[u] = __shfl_down(vv[u].x, 1); }
#pragma unroll
            for (int u = 0; u < 4; ++u) { const int i = i0 + u * STR; if (i < NCH) { const int c = i / (MT / 8), col = 8 * (i % (MT / 8)); const u32x4 v = vv[u];
                const int t = (col < MX) ? (col & 63) : ((col - MX) & 255), rl = (col < MX) ? 64 : 256;
                float x[10]; x[1] = bflo(v.x); x[2] = bfhi(v.x); x[3] = bflo(v.y); x[4] = bfhi(v.y); x[5] = bflo(v.z); x[6] = bfhi(v.z); x[7] = bflo(v.w); x[8] = bfhi(v.w);
                x[0] = (t != 0) ? bfhi(vl4[u]) : 0.f; x[9] = (t + 8 != rl) ? bflo(vr4[u]) : 0.f;
                const float w0 = cw[512 + c], w1 = cw[1024 + 512 + c], w2 = cw[2048 + 512 + c]; float y[8];
#pragma unroll
                for (int j = 0; j < 8; ++j) y[j] = siluf(w0 * x[j] + w1 * x[j + 1] + w2 * x[j + 2]);
                u32x4 o; o.x = pk2(y[0], y[1]); o.y = pk2(y[2], y[3]); o.z = pk2(y[4], y[5]); o.w = pk2(y[6], y[7]);
                *(u32x4*)(kact + (size_t)c * MT + col) = o; } }
        }
    }
    {
        const bf16_t* pml = (const bf16_t*)(ws + WS_PML); bf16_t* qact = (bf16_t*)(ws + WS_QACT);
        const int NG = (MX / 4) * 64, STR = C.G * NTHR;
        for (int i = C.bid * NTHR + C.tid; i < NG; i += STR) {
            const int r0 = 4 * (i >> 6), c0 = 8 * (i & 63); const bf16_t* base = pml + (size_t)r0 * 1024 + c0;
            u32x4 v[6];
#pragma unroll
            for (int u = 0; u < 4; ++u) v[u + 1] = *(const u32x4*)(base + u * 1024);
            v[0] = (u32x4){0u, 0u, 0u, 0u}; v[5] = (u32x4){0u, 0u, 0u, 0u};
            if ((r0 & 63) != 0) v[0] = *(const u32x4*)(base - 1024);
            if ((r0 & 63) != 60) v[5] = *(const u32x4*)(base + 4 * 1024);
            float wl[8], wc[8], wr[8];
#pragma unroll
            for (int j = 0; j < 8; ++j) { wl[j] = cw[c0 + j]; wc[j] = cw[1024 + c0 + j]; wr[j] = cw[2048 + c0 + j]; }
#pragma unroll
            for (int u = 0; u < 4; ++u) {
                const u32x4 vl = v[u], vc = v[u + 1], vr = v[u + 2];
                const unsigned l4[4] = {vl.x, vl.y, vl.z, vl.w}, c4[4] = {vc.x, vc.y, vc.z, vc.w}, r4[4] = {vr.x, vr.y, vr.z, vr.w}; unsigned o4[4];
#pragma unroll
                for (int q = 0; q < 4; ++q) {
                    const float a0 = wl[2 * q] * bflo(l4[q]) + wc[2 * q] * bflo(c4[q]) + wr[2 * q] * bflo(r4[q]);
                    const float a1 = wl[2 * q + 1] * bfhi(l4[q]) + wc[2 * q + 1] * bfhi(c4[q]) + wr[2 * q + 1] * bfhi(r4[q]);
                    o4[q] = pk2(siluf(a0) * 0.08838834764831845f, siluf(a1) * 0.08838834764831845f); }
                *(u32x4*)(qact + (size_t)(r0 + u) * 512 + c0) = (u32x4){o4[0], o4[1], o4[2], o4[3]}; }
        }
    }

}
__device__ __forceinline__ void mlstm_gate_scans(const Ctx& C, const Params& P, int gw, int ngw) {
    unsigned char* ws = P.ws;
    for (int item = gw; item < 64 * NCHK; item += ngw) {
        const int j = item % NCHK, seq = item / NCHK, h = seq & 3, b = (seq >> 2) & 7, d = seq >> 5;
        ChunkRef r; r.isctx = j < 2; r.b = b; r.h = h; r.d = d; { const int jj = r.isctx ? j : j - 2, nch = r.isctx ? 2 : 32; r.oc = d ? (nch - 1 - jj) : jj; }
        const float* gates = (const float*)(ws + WS_GATES) + (size_t)chunk_row0(r) * 16;
        const int p0 = 2 * C.lane, t0 = d ? 127 - p0 : p0, t1 = d ? 126 - p0 : p0 + 1;
        const float li0 = gates[(size_t)t0 * 16 + (d ? 8 : 0) + h], li1 = gates[(size_t)t1 * 16 + (d ? 8 : 0) + h];
        const float lf0 = logsig(gates[(size_t)t0 * 16 + (d ? 12 : 4) + h]), lf1 = logsig(gates[(size_t)t1 * 16 + (d ? 12 : 4) + h]);
        float run = lf0 + lf1;
#pragma unroll
        for (int o = 1; o < 64; o <<= 1) { const float t = __shfl_up(run, o); if (C.lane >= o) run += t; }
        const float b1 = run, b0 = run - lf1;
        const float c0 = li0 - b0, c1 = li1 - b1;
        float gm = fmaxf(c0, c1);
#pragma unroll
        for (int o = 1; o < 64; o <<= 1) { const float t = __shfl_up(gm, o); if (C.lane >= o) gm = fmaxf(gm, t); }
        float gprev = __shfl_up(gm, 1); if (C.lane == 0) gprev = -3.0e38f;
        float* gc = (float*)(ws + WS_GC) + (size_t)item * 384;
        gc[t0] = c0; gc[t1] = c1; gc[128 + t0] = b0; gc[128 + t1] = b1; gc[256 + t0] = fmaxf(gprev, c0); gc[256 + t1] = gm;
        if (C.lane == 63) { float* bl = (float*)(ws + WS_BL) + (size_t)item * 2; bl[0] = b1; bl[1] = gm; }
    }
}

struct SeqPre { u32x4 k[4]; u32x4 v[4]; float g; float bl0, bl1; };
__device__ __forceinline__ ChunkRef seq_chunk(int jc, int b, int h, int d) {
    ChunkRef r; r.isctx = jc < 2; r.b = b; r.h = h; r.d = d; const int jj = r.isctx ? jc : jc - 2, nch = r.isctx ? 2 : 32; r.oc = d ? (nch - 1 - jj) : jj; return r; }
__device__ __forceinline__ void seq_prefetch(const Params& P, const ChunkRef& r, int item, SeqPre& pf, int tid) {
    const bf16_t* kact = (const bf16_t*)(P.ws + WS_KACT); const bf16_t* kvcm = (const bf16_t*)(P.ws + WS_KVCM); const int col0 = chunk_row0(r);
#pragma unroll
    for (int it = 0; it < 4; ++it) { const int idx = tid + NTHR * it, dd = idx >> 4, s0 = 8 * (idx & 15);
        pf.k[it] = *(const u32x4*)(kact + (size_t)(r.h * 128 + dd) * MT + col0 + s0);
        pf.v[it] = *(const u32x4*)(kvcm + (size_t)(512 + r.h * 128 + dd) * MT + col0 + s0); }
    pf.g = (tid < 384) ? ((const float*)(P.ws + WS_GC))[(size_t)item * 384 + tid] : 0.f;
    const float* bl = (const float*)(P.ws + WS_BL) + (size_t)item * 2; pf.bl0 = bl[0]; pf.bl1 = bl[1];
}
#define SEQ_BAR() do { asm volatile("s_waitcnt lgkmcnt(0)" ::: "memory"); __builtin_amdgcn_s_barrier(); asm volatile("" ::: "memory"); } while (0)
__device__ __forceinline__ void mlstm_seq(const Ctx& C, const Params& P, int seq) {
    unsigned char* ws = P.ws;
    const int h = seq & 3, b = (seq >> 2) & 7, d = seq >> 5;
    LAS unsigned char* KT = C.lds; LAS unsigned char* VT = C.lds + 32768; LAS unsigned char* CT = C.lds + 65536; LAS unsigned char* PS = C.lds + 98304;
    LAS float* colf = (LAS float*)(C.lds + 131072); LAS float* bcs = colf + 128; LAS float* gms = bcs + 128; LAS float* wls = gms + 128; LAS float* nbuf = wls + 128  ;
    const int w = C.wave;
    f32x4 Cst[8]; f32x4 nst = (f32x4){0.f, 0.f, 0.f, 0.f};
#pragma unroll
    for (int nt = 0; nt < 8; ++nt) Cst[nt] = (f32x4){0.f, 0.f, 0.f, 0.f};
    float m = 0.f;
    __syncthreads();
    if (C.tid < 256) nbuf[C.tid] = 0.f;
    SeqPre pre;
    seq_prefetch(P, seq_chunk(0, b, h, d), seq * NCHK, pre, C.tid);
    const bf16x8 ones = (bf16x8){0x3f80, 0x3f80, 0x3f80, 0x3f80, 0x3f80, 0x3f80, 0x3f80, 0x3f80};
#pragma unroll 1
    for (int jc = 0; jc < NCHK; ++jc) {
        const ChunkRef r = seq_chunk(jc, b, h, d);
        const LAS float* nsl = nbuf + 128 * (jc & 1); LAS float* nnew = nbuf + 128 * ((jc & 1) ^ 1);
        int tid = C.tid; asm volatile("" : "+v"(tid));
        const int lane = tid & 63, fr = lane & 15, fq = lane >> 4;
        bf16x8 qf[4];
        if (!r.isctx) { const bf16_t* qa = (const bf16_t*)(ws + WS_QACT) + (size_t)(b * SEQ + r.oc * 128 + 16 * w + fr) * 512 + h * 128 + 8 * fq;
#pragma unroll
            for (int ks = 0; ks < 4; ++ks) qf[ks] = *(const bf16x8*)(qa + 32 * ks); }
        else {
#pragma unroll
            for (int ks = 0; ks < 4; ++ks) qf[ks] = (bf16x8){0, 0, 0, 0, 0, 0, 0, 0}; }
        const float Bj = pre.bl0, gfin = pre.bl1, mxs = fmaxf(m, gfin), decay = __expf(m - mxs);
        SEQ_BAR();
        {
#pragma unroll
            for (int it = 0; it < 4; ++it) { const int idx = tid + NTHR * it, dd = idx >> 4, ch = idx & 15;
                *(LAS u32x4*)(KT + off_b(dd, ch)) = pre.k[it]; *(LAS u32x4*)(VT + off_b(dd, ch)) = pre.v[it]; }
            if (tid < 384) colf[tid] = pre.g;
            if (tid < 128) wls[tid] = __expf(pre.g - mxs);
        }
#pragma unroll
        for (int nt = 0; nt < 8; ++nt) { u32x2 pw; pw.x = pk2(Cst[nt][0], Cst[nt][1]); pw.y = pk2(Cst[nt][2], Cst[nt][3]);
            *(LAS u32x2*)(CT + off_b(16 * nt + fr, 2 * w + (fq >> 1)) + 8 * (fq & 1)) = pw; }
        if (fr == 0) *(LAS f32x4*)(nnew + 16 * w + 4 * fq) = nst;
        SEQ_BAR();
        if (jc + 1 < NCHK) seq_prefetch(P, seq_chunk(jc + 1, b, h, d), seq * NCHK + jc + 1, pre, tid);
        bf16x8 kfs[4];
        {   u32x4 kk[4]; f32x4 ca[4], cb[4];
#pragma unroll
            for (int ks = 0; ks < 4; ++ks) { kk[ks] = __builtin_bit_cast(u32x4, tile_row_read(KT, lane, w, ks)); const LAS float* cp = wls + 32 * ks + 8 * fq; ca[ks] = *(const LAS f32x4*)cp; cb[ks] = *(const LAS f32x4*)(cp + 4); }
#pragma unroll
            for (int ks = 0; ks < 4; ++ks) { u32x4 o; o.x = pk2(bflo(kk[ks].x) * ca[ks][0], bfhi(kk[ks].x) * ca[ks][1]); o.y = pk2(bflo(kk[ks].y) * ca[ks][2], bfhi(kk[ks].y) * ca[ks][3]);
                o.z = pk2(bflo(kk[ks].z) * cb[ks][0], bfhi(kk[ks].z) * cb[ks][1]); o.w = pk2(bflo(kk[ks].w) * cb[ks][2], bfhi(kk[ks].w) * cb[ks][3]);
                kfs[ks] = __builtin_bit_cast(bf16x8, o); }
        }
        if (!r.isctx) {
            const int t = 16 * w + fr;
            const float mx = fmaxf(m, gms[t]), rowf2 = -mx * 1.44269504f, ainter = __expf(m - mx), emneg = __expf(-(bcs[t] + mx));
            float qn = 0.f;
            {   f32x4 na[4], nb[4];
#pragma unroll
                for (int ks = 0; ks < 4; ++ks) { const LAS float* np_ = nnew + 32 * ks + 8 * fq; na[ks] = *(const LAS f32x4*)np_; nb[ks] = *(const LAS f32x4*)(np_ + 4); }
#pragma unroll
                for (int ks = 0; ks < 4; ++ks) { const u32x4 qq = __builtin_bit_cast(u32x4, qf[ks]);
                    qn += bflo(qq.x) * na[ks][0] + bfhi(qq.x) * na[ks][1] + bflo(qq.y) * na[ks][2] + bfhi(qq.y) * na[ks][3] + bflo(qq.z) * nb[ks][0] + bfhi(qq.z) * nb[ks][1] + bflo(qq.w) * nb[ks][2] + bfhi(qq.w) * nb[ks][3]; }
            }
            qn = xrow_sum(qn);
            const int sgn = d ? -1 : 1, dts = sgn * (t - 4 * fq);
            float rs = 0.f;
            bf16x8 kA[4], kB[4]; f32x4 cfA, cfB;
#define QK_LD(kb, cfb, nt_) do { _Pragma("unroll") for (int ks = 0; ks < 4; ++ks) kb[ks] = tile_tr_read(KT, lane, (nt_), ks); cfb = *(const LAS f32x4*)(colf + 16 * (nt_) + 4 * fq); } while (0)
#define QK_STEP(kb, cfb, nt_) do { f32x4 a = (f32x4){0.f, 0.f, 0.f, 0.f}; \
                _Pragma("unroll") for (int ks = 0; ks < 4; ++ks) a = __builtin_amdgcn_mfma_f32_16x16x32_bf16(kb[ks], qf[ks], a, 0, 0, 0); \
                float pv[4]; \
                _Pragma("unroll") for (int q = 0; q < 4; ++q) { const bool ok = sgn * (16 * (nt_) + q) <= dts; pv[q] = ok ? __builtin_amdgcn_exp2f(fmaf(cfb[q], 1.44269504f, rowf2)) * a[q] : 0.f; rs += pv[q]; } \
                u32x2 pw; pw.x = pk2(pv[0], pv[1]); pw.y = pk2(pv[2], pv[3]); \
                *(LAS u32x2*)(PS + off_b(t, 2 * (nt_) + (fq >> 1)) + 8 * (fq & 1)) = pw; } while (0)
            const int wu = __builtin_amdgcn_readfirstlane(w);
#define QK_LIVE(nt_) (d ? ((nt_) >= wu) : ((nt_) <= wu))
#define QK_ZERO(nt_) (*(LAS u32x2*)(PS + off_b(t, 2 * (nt_) + (fq >> 1)) + 8 * (fq & 1)) = (u32x2){0u, 0u})
            QK_LD(kA, cfA, 0);
#pragma unroll
            for (int n2 = 0; n2 < 4; ++n2) {
                QK_LD(kB, cfB, 2 * n2 + 1);
                __builtin_amdgcn_sched_barrier(0);
                if (QK_LIVE(2 * n2)) QK_STEP(kA, cfA, 2 * n2); else QK_ZERO(2 * n2);
                __builtin_amdgcn_sched_barrier(0);
                if (n2 < 3) QK_LD(kA, cfA, 2 * n2 + 2);
                __builtin_amdgcn_sched_barrier(0);
                if (QK_LIVE(2 * n2 + 1)) QK_STEP(kB, cfB, 2 * n2 + 1); else QK_ZERO(2 * n2 + 1);
                __builtin_amdgcn_sched_barrier(0);
            }
#undef QK_LIVE
#undef QK_ZERO
#undef QK_LD
#undef QK_STEP
            rs = xrow_sum(rs);
            const float inv = 1.f / fmaxf(fabsf(rs + ainter * qn), emneg);
            LDS_WAIT();
            bf16x8 pfr[4];
#pragma unroll
            for (int ks = 0; ks < 4; ++ks) pfr[ks] = tile_row_read(PS, lane, w, ks);
            bf16_t* hd = (bf16_t*)(ws + WS_HDIR) + ((size_t)d * MX + (size_t)(b * SEQ + r.oc * 128) + t) * 512 + h * 128 + 4 * fq;
            bf16x8 vA[4], cA[4], vB[4], cB[4];
#define PV_LD(vb, cb, nt_) do { _Pragma("unroll") for (int ks = 0; ks < 4; ++ks) { vb[ks] = tile_row_read(VT, lane, (nt_), ks); cb[ks] = tile_row_read(CT, lane, (nt_), ks); } } while (0)
#define PV_STEP(vb, cb, nt_) do { f32x4 a = (f32x4){0.f, 0.f, 0.f, 0.f}, c = (f32x4){0.f, 0.f, 0.f, 0.f}, u = (f32x4){0.f, 0.f, 0.f, 0.f}; \
                _Pragma("unroll") for (int ks = 0; ks < 4; ++ks) { a = __builtin_amdgcn_mfma_f32_16x16x32_bf16(vb[ks], pfr[ks], a, 0, 0, 0); \
                    c = __builtin_amdgcn_mfma_f32_16x16x32_bf16(cb[ks], qf[ks], c, 0, 0, 0); \
                    u = __builtin_amdgcn_mfma_f32_16x16x32_bf16(kfs[ks], vb[ks], u, 0, 0, 0); } \
                u32x2 ov; ov.x = pk2((a[0] + ainter * c[0]) * inv, (a[1] + ainter * c[1]) * inv); ov.y = pk2((a[2] + ainter * c[2]) * inv, (a[3] + ainter * c[3]) * inv); \
                *(u32x2*)(hd + 16 * (nt_)) = ov; \
                Cst[nt_] = Cst[nt_] * decay + u; } while (0)
            PV_LD(vA, cA, 0);
#pragma unroll
            for (int n2 = 0; n2 < 4; ++n2) {
                PV_LD(vB, cB, 2 * n2 + 1);
                __builtin_amdgcn_sched_barrier(0);
                PV_STEP(vA, cA, 2 * n2);
                __builtin_amdgcn_sched_barrier(0);
                if (n2 < 3) PV_LD(vA, cA, 2 * n2 + 2);
                __builtin_amdgcn_sched_barrier(0);
                PV_STEP(vB, cB, 2 * n2 + 1);
                __builtin_amdgcn_sched_barrier(0);
            }
#undef PV_LD
#undef PV_STEP
        } else {
#pragma unroll 2
            for (int nt = 0; nt < 8; ++nt) { f32x4 a = (f32x4){0.f, 0.f, 0.f, 0.f};
#pragma unroll
                for (int ks = 0; ks < 4; ++ks) a = __builtin_amdgcn_mfma_f32_16x16x32_bf16(kfs[ks], tile_row_read(VT, lane, nt, ks), a, 0, 0, 0);
                Cst[nt] = Cst[nt] * decay + a; }
        }
        {
            f32x4 a = (f32x4){0.f, 0.f, 0.f, 0.f};
#pragma unroll
            for (int ks = 0; ks < 4; ++ks) a = __builtin_amdgcn_mfma_f32_16x16x32_bf16(kfs[ks], ones, a, 0, 0, 0);
            nst = nst * decay + a;
            m = Bj + mxs;
        }
    }
}
#undef SEQ_BAR

__device__ __forceinline__ void mlstm_combine(const Ctx& C, const Params& P) {
    unsigned char* ws = P.ws;
    const bf16_t* hd = (const bf16_t*)(ws + WS_HDIR); const bf16_t* pml = (const bf16_t*)(ws + WS_PML); bf16_t* yab = (bf16_t*)(ws + WS_YAB); const float* ng = P.in[18];
    const f32x4 g0 = *(const f32x4*)(ng + 8 * C.lane), g1 = *(const f32x4*)(ng + 8 * C.lane + 4);
    const int RS = C.G * 8;
    u32x4 na, nb, no, pa, pb, po;
#define MC_LD(da, db, dx, r) do { if ((r) < MX) { da = *(const u32x4*)(hd + (size_t)(r) * 512 + 8 * C.lane); db = *(const u32x4*)(hd + ((size_t)MX + (r)) * 512 + 8 * C.lane); dx = *(const u32x4*)(pml + (size_t)(r) * 1024 + 512 + 8 * C.lane); } } while (0)
    MC_LD(na, nb, no, C.bid * 8 + C.wave); MC_LD(pa, pb, po, C.bid * 8 + C.wave + RS);
    for (int row = C.bid * 8 + C.wave; row < MX; row += RS) {
        const u32x4 a = na, bq = nb, og = no;
        na = pa; nb = pb; no = po;
        MC_LD(pa, pb, po, row + 2 * RS);
        float v[8] = {bflo(a.x) + bflo(bq.x), bfhi(a.x) + bfhi(bq.x), bflo(a.y) + bflo(bq.y), bfhi(a.y) + bfhi(bq.y), bflo(a.z) + bflo(bq.z), bfhi(a.z) + bfhi(bq.z), bflo(a.w) + bflo(bq.w), bfhi(a.w) + bfhi(bq.w)};
        float ss = 0.f;
#pragma unroll
        for (int j = 0; j < 8; ++j) ss += v[j] * v[j];
        ss = row16_sum(ss);
        const float rstd = rsqrtf(ss * (1.f / 128.f) + RMS_EPS);
        const float o8[8] = {bflo(og.x), bfhi(og.x), bflo(og.y), bfhi(og.y), bflo(og.z), bfhi(og.z), bflo(og.w), bfhi(og.w)};
        const float gg[8] = {g0[0], g0[1], g0[2], g0[3], g1[0], g1[1], g1[2], g1[3]};
        float y[8];
#pragma unroll
        for (int j = 0; j < 8; ++j) y[j] = v[j] * rstd * gg[j] * sigm(o8[j]);
        u32x4 wv; wv.x = pk2(y[0], y[1]); wv.y = pk2(y[2], y[3]); wv.z = pk2(y[4], y[5]); wv.w = pk2(y[6], y[7]);
        *(u32x4*)(yab + (size_t)row * 1024 + 512 + 8 * C.lane) = wv;
    }
#undef MC_LD
}

__device__ __forceinline__ void hy_post(unsigned* flag) {
    asm volatile("s_waitcnt vmcnt(0)" ::: "memory");
    __syncthreads();
    if (threadIdx.x == 0) { __builtin_amdgcn_fence(__ATOMIC_RELEASE, "agent"); asm volatile("s_waitcnt vmcnt(0)" ::: "memory"); (void)xb_add(flag, 1u); }
}
__device__ __forceinline__ void hy_wait(unsigned* flag, unsigned* bar) {
    if (threadIdx.x == 0) { XB_SPIN(xb_ld(flag) == 0u, bar); __builtin_amdgcn_fence(__ATOMIC_ACQUIRE, "agent"); asm volatile("s_waitcnt vmcnt(0)" ::: "memory"); }
    __syncthreads();
}
template <int PM>
__device__ __forceinline__ void mixer_phase(const Ctx& C, const Params& P, unsigned* bar) {
    constexpr int NM = 64;
    if (PM == 0 && C.G == 256) {
        unsigned* flags = bar + HY_FLAG0;
        const int hb0 = C.bid - NM, kind = (C.bid < NM) ? 2 : (hb0 < 128 ? 0 : 1);
        if (kind == 2) mlstm_seq(C, P, C.bid);
#pragma unroll 1
        for (int j = (kind == 2) ? 4 : 0; j < 5; ++j) {
            int o, c; bool post = false, wait = false;
            if (kind == 0) { if (j == 0) { o = 0; c = 384 + hb0; post = true; } else { o = (j - 1) & 1; c = hb0 + 192 * ((j - 1) >> 1); } }
            else if (kind == 1) { if (j == 4) { o = 1; c = 384 + hb0 - 128; wait = true; } else { o = j & 1; c = hb0 + 192 * (j >> 1); } }
            else { o = 1; c = 448 + C.bid; wait = true; }
            if (wait) hy_wait(flags + 16 * (c - 384), bar);
            else if (o) asm volatile("s_waitcnt vmcnt(0)" ::: "memory");
            hyena_item<0>(C, P, o, c);
            if (post) hy_post(flags + 16 * hb0);
        }
        if (kind != 2) {
            __syncthreads();
            LAS float* scr = (LAS float*)(C.lds + C.wave * 8448);
            cvt8_stream(NE * 2048 + hb0 * 8 + C.wave, NE * 3072, 192 * 8, scr, C.lane, [&](int it, Cvt8& d) { cvt8_expert_item(P, it, d); });
            cvt8_stream(W13_T2 + hb0 * 8 + C.wave, W13_EARLY, 192 * 8, scr, C.lane, [&](int it, Cvt8& d) { cvt8_expert_item(P, it, d); });
        }
        return;
    }
    const bool small = C.G < 2 * NM;
    const int nh = small ? C.G : C.G - NM, hb = small ? C.bid : C.bid - NM;
    if (PM != 2 && PM != 3) if (small || C.bid < NM) for (int s = C.bid; s < 64; s += (small ? C.G : NM)) mlstm_seq(C, P, s);
    if (PM != 1 && hb >= 0) {
        const int nch = (512 - hb + nh - 1) / nh;
#pragma unroll 1
        for (int j = 0; j < 2 * nch; ++j) { const int c = hb + (j >> 1) * nh, o = j & 1;
            if (o) asm volatile("s_waitcnt vmcnt(0)" ::: "memory");
            hyena_item<(PM == 3) ? 1 : 0>(C, P, o, c); }
    }
}

__device__ __forceinline__ void transpose_z2(const Ctx& C, const Params& P) {
    unsigned char* ws = P.ws;
    const bf16_t* src = (const bf16_t*)(ws + WS_Z2CM); bf16_t* dst = (bf16_t*)(ws + WS_YAB);
    LAS bf16_t* tl = (LAS bf16_t*)(C.lds + 143360 - 20480);
    u32x4 nv[2];
    auto issue = [&](int it) { const int c0 = (it & 7) * 64, r0 = (it >> 3) * 128;
#pragma unroll
        for (int u = 0; u < 2; ++u) { const int idx = C.tid + NTHR * u, cc = idx >> 4, rc = (idx & 15) * 8; nv[u] = *(const u32x4*)(src + (size_t)(c0 + cc) * MX + r0 + rc); } };
    if (C.bid < 8 * 256) issue(C.bid);
    for (int it = C.bid; it < 8 * 256; it += C.G) {
        const int c0 = (it & 7) * 64, r0 = (it >> 3) * 128;
        __syncthreads();
#pragma unroll
        for (int u = 0; u < 2; ++u) { const int idx = C.tid + NTHR * u, cc = idx >> 4, rc = (idx & 15) * 8; const u32x4 v = nv[u]; const unsigned v4[4] = {v.x, v.y, v.z, v.w};
#pragma unroll
            for (int q = 0; q < 4; ++q) { tl[(rc + 2 * q) * 72 + cc] = (bf16_t)(v4[q] & 0xffffu); tl[(rc + 2 * q + 1) * 72 + cc] = (bf16_t)(v4[q] >> 16); } }
        if (it + C.G < 8 * 256) issue(it + C.G);
        __syncthreads();
#pragma unroll
        for (int u = 0; u < 2; ++u) { const int idx = C.tid + NTHR * u, rr = idx >> 3, c8 = (idx & 7) * 8;
            *(u32x4*)(dst + (size_t)(r0 + rr) * 1024 + c0 + c8) = *(const LAS u32x4*)(tl + rr * 72 + c8); }
    }
}

template <int PMODE>
__device__ __forceinline__ void phase6(const Ctx& C, const Params& P) {
    unsigned char* ws = P.ws;
    LAS float* Wr = (LAS float*)C.lds;
    const float* ada = (const float*)(ws + WS_ADA); const float* gffn = P.in[7];
    unsigned char* hx2 = ws + WS_HX2; float* aff = (float*)(ws + WS_AFF); int* slot = (int*)(ws + WS_SLOT);
    const bf16_t* xm = (const bf16_t*)(ws + WS_XMID);
    const int RS = C.G * 8;
    u32x2 nxa[4], nxb[4];
    { const int row0 = C.bid * 8 + C.wave;
      if (row0 < MX) { const int row1 = (row0 + RS < MX) ? row0 + RS : row0;
#pragma unroll
        for (int j = 0; j < 4; ++j) { nxa[j] = *(const u32x2*)(xm + (size_t)row0 * DM + 4 * C.lane + 256 * j); nxb[j] = *(const u32x2*)(xm + (size_t)row1 * DM + 4 * C.lane + 256 * j); } } }
#pragma unroll 1
    for (int i0 = C.tid; i0 < 1024 * 16; i0 += 8 * NTHR) { float t8[8];
#pragma unroll
        for (int u = 0; u < 8; ++u) t8[u] = P.in[22][i0 + u * NTHR];
#pragma unroll
        for (int u = 0; u < 8; ++u) { const int idx = i0 + u * NTHR; Wr[wl_pos(idx >> 4) * 20 + (idx & 15)] = t8[u]; } }
    __syncthreads();
    f32x4 gg[4];
#pragma unroll
    for (int j = 0; j < 4; ++j) gg[j] = *(const f32x4*)(gffn + 4 * C.lane + 256 * j);
    for (int row = C.bid * 8 + C.wave; row < MX; row += 2 * RS) {
        const bool hasb = row + RS < MX; const int rowb = hasb ? row + RS : row;
        f32x4 va[4], vb[4]; float ssa = 0.f, ssb = 0.f;
#pragma unroll
        for (int j = 0; j < 4; ++j) { va[j] = (f32x4){bflo(nxa[j].x), bfhi(nxa[j].x), bflo(nxa[j].y), bfhi(nxa[j].y)}; ssa += va[j][0] * va[j][0] + va[j][1] * va[j][1] + va[j][2] * va[j][2] + va[j][3] * va[j][3];
            vb[j] = (f32x4){bflo(nxb[j].x), bfhi(nxb[j].x), bflo(nxb[j].y), bfhi(nxb[j].y)}; ssb += vb[j][0] * vb[j][0] + vb[j][1] * vb[j][1] + vb[j][2] * vb[j][2] + vb[j][3] * vb[j][3]; }
        if (row + 2 * RS < MX) { const int r0 = row + 2 * RS, r1 = (r0 + RS < MX) ? r0 + RS : r0;
#pragma unroll
            for (int j = 0; j < 4; ++j) { nxa[j] = *(const u32x2*)(xm + (size_t)r0 * DM + 4 * C.lane + 256 * j); nxb[j] = *(const u32x2*)(xm + (size_t)r1 * DM + 4 * C.lane + 256 * j); } }
        const float rstda = rsqrtf(wave_sum(ssa) * (1.f / DM) + RMS_EPS), rstdb = rsqrtf(wave_sum(ssb) * (1.f / DM) + RMS_EPS);
        const int ba = row >> 12, bb = rowb >> 12;
#pragma unroll
        for (int j = 0; j < 4; ++j) { const int k = 4 * C.lane + 256 * j;
            const f32x4 h4a = *(const f32x4*)(ada + (size_t)ba * 6144 + 3072 + k), s4a = *(const f32x4*)(ada + (size_t)ba * 6144 + 4096 + k);
            const f32x4 h4b = *(const f32x4*)(ada + (size_t)bb * 6144 + 3072 + k), s4b = *(const f32x4*)(ada + (size_t)bb * 6144 + 4096 + k);
#pragma unroll
            for (int q = 0; q < 4; ++q) { va[j][q] = (va[j][q] * rstda * gg[j][q]) * (1.f + s4a[q]) + h4a[q]; vb[j][q] = (vb[j][q] * rstdb * gg[j][q]) * (1.f + s4b[q]) + h4b[q]; }
            const unsigned pka = pk4_fp8(va[j][0], va[j][1], va[j][2], va[j][3]), pkb = pk4_fp8(vb[j][0], vb[j][1], vb[j][2], vb[j][3]);
            if (PMODE == 0) { *(unsigned*)(hx2 + (size_t)row * DM + k) = pka; if (hasb) *(unsigned*)(hx2 + (size_t)rowb * DM + k) = pkb; } else asm volatile("" :: "v"(pka), "v"(pkb)); }
        float lga, lgb;
        if (PMODE == 1) { lga = va[0][0]; lgb = vb[0][0]; } else row_dot16x2(va, vb, Wr, C.lane, lga, lgb);
        float mxa = lga, mxb = lgb;
        mxa = fmaxf(mxa, dppf<DPP_XOR7>(mxa)); mxb = fmaxf(mxb, dppf<DPP_XOR7>(mxb)); mxa = fmaxf(mxa, dppf<DPP_XOR8>(mxa)); mxb = fmaxf(mxb, dppf<DPP_XOR8>(mxb));
        mxa = xrow_max(mxa); mxb = xrow_max(mxb);
        const float exa = expf(lga - mxa), exb = expf(lgb - mxb);
        float suma = exa, sumb = exb;
        suma += dppf<DPP_XOR7>(suma); sumb += dppf<DPP_XOR7>(sumb); suma += dppf<DPP_XOR8>(suma); sumb += dppf<DPP_XOR8>(sumb);
        suma = xrow_sum(suma); sumb = xrow_sum(sumb);
        if (PMODE == 0) { if ((C.lane & 3) == 0) { const int e = C.lane >> 2;
                aff[((size_t)ba * NE + e) * SEQ + (row & 4095)] = exa / suma; slot[(size_t)row * 16 + e] = -1;
                if (hasb) { aff[((size_t)bb * NE + e) * SEQ + (rowb & 4095)] = exb / sumb; slot[(size_t)rowb * 16 + e] = -1; } } }
        else asm volatile("" :: "v"(exa / suma), "v"(exb / sumb));
    }
}

__device__ __forceinline__ void topk_item(const Ctx& C, const Params& P, int item) {
    unsigned char* ws = P.ws;
    const int b = item >> 4, e = item & 15;
    const float* aff = (const float*)(ws + WS_AFF) + (size_t)item * SEQ;
    LAS unsigned* red = (LAS unsigned*)C.lds;
    unsigned v[8];
    { const u32x4 a = *(const u32x4*)(aff + 8 * C.tid), c = *(const u32x4*)(aff + 8 * C.tid + 4);
      v[0] = a.x; v[1] = a.y; v[2] = a.z; v[3] = a.w; v[4] = c.x; v[5] = c.y; v[6] = c.z; v[7] = c.w; }
    unsigned prefix = 0u;
#pragma unroll 1
    for (int bit = 30; bit >= 1; bit -= 2) {
        const unsigned hi = 1u << bit, lo = 1u << (bit - 1);
        const unsigned ca = prefix | hi | lo, cb = prefix | hi, cc = prefix | lo; int na = 0, nb = 0, nc = 0;
#pragma unroll
        for (int q = 0; q < 8; ++q) { na += (v[q] >= ca) ? 1 : 0; nb += (v[q] >= cb) ? 1 : 0; nc += (v[q] >= cc) ? 1 : 0; }
        const float fa = wave_sum((float)na), fb = wave_sum((float)nb), fc = wave_sum((float)nc);
        __syncthreads();
        if (C.lane == 0) { red[C.wave] = (unsigned)fa; red[8 + C.wave] = (unsigned)fb; red[16 + C.wave] = (unsigned)fc; }
        __syncthreads();
        int ta = 0, tb = 0, tc = 0;
#pragma unroll
        for (int q = 0; q < 8; ++q) { ta += (int)red[q]; tb += (int)red[8 + q]; tc += (int)red[16 + q]; }
        prefix = (ta >= CAP) ? ca : ((tb >= CAP) ? cb : ((tc >= CAP) ? cc : prefix));
    }
    {   const unsigned cand = prefix | 1u; int cnt = 0;
#pragma unroll
        for (int q = 0; q < 8; ++q) cnt += (v[q] >= cand) ? 1 : 0;
        cnt = (int)wave_sum((float)cnt);
        __syncthreads();
        if (C.lane == 0) red[C.wave] = (unsigned)cnt;
        __syncthreads();
        int tot = 0;
#pragma unroll
        for (int q = 0; q < 8; ++q) tot += (int)red[q];
        if (tot >= CAP) prefix = cand;
    }
    int cg_ = 0, ce_ = 0;
#pragma unroll
    for (int q = 0; q < 8; ++q) { cg_ += (v[q] > prefix) ? 1 : 0; ce_ += (v[q] == prefix) ? 1 : 0; }
    int ig = cg_, ie = ce_;
#pragma unroll
    for (int o = 1; o < 64; o <<= 1) { const int tg = __shfl_up(ig, o), te = __shfl_up(ie, o); if (C.lane >= o) { ig += tg; ie += te; } }
    __syncthreads();
    if (C.lane == 63) { red[C.wave] = (unsigned)ig; red[8 + C.wave] = (unsigned)ie; }
    __syncthreads();
    int bg = 0, be = 0, totg = 0;
#pragma unroll
    for (int q = 0; q < 8; ++q) { const int xg = (int)red[q], xe = (int)red[8 + q]; if (q < C.wave) { bg += xg; be += xe; } totg += xg; }
    int pg = bg + ig - cg_, pe = be + ie - ce_;
    const int need = CAP - totg;
    float* sg = (float*)(ws + WS_SGATE) + (size_t)item * CAP; int* slot = (int*)(ws + WS_SLOT);
    int* sidx = (int*)(ws + WS_SIDX) + (size_t)item * CAP;
#pragma unroll
    for (int q = 0; q < 8; ++q) { const int n = 8 * C.tid + q; int s = -1;
        if (v[q] > prefix) s = pg++;
        else if (v[q] == prefix) { if (pe < need) s = totg + pe; ++pe; }
        if (s >= 0) { sidx[s] = n; sg[s] = __builtin_bit_cast(float, v[q]); slot[((size_t)b * SEQ + n) * 16 + e] = s; } }
    __syncthreads();
    __syncthreads();
}

__device__ __forceinline__ void moe_gemm1(const Ctx& C, const Params& P, int skip_epi) {
    unsigned char* ws = P.ws;
    pg8::SchedMoeG S{(const char*)(ws + WS_HX2), (const char*)(ws + WS_W13), (const int*)(ws + WS_SIDX), (size_t)256 * 1024, (size_t)4096 * 1024, 16, 16, C.G, C.bid};
    pg8::EpiMoe1 E{ws + WS_ACT, skip_epi};
    pg8::gemm_phase<pg8::EpiMoe1, pg8::SchedMoeG, false, true>(C.lds, 512, 1024, 1024, S, E);
}
__device__ __forceinline__ void moe_gemm2(const Ctx& C, const Params& P, bool skip_epi) {
    unsigned char* ws = P.ws;
    pg8::SchedMoe S{(const char*)(ws + WS_ACT), (const char*)(ws + WS_W2), (size_t)256 * 2048, (size_t)256 * 2048, (size_t)4096 * 2048, (size_t)1024 * 2048, 16, 4, C.G, C.bid};
    pg8::EpiMoe2 E{ws + WS_YE, (const float*)(ws + WS_SGATE), skip_epi};
    pg8::gemm_phase<pg8::EpiMoe2, pg8::SchedMoe, false, true>(C.lds, 1024, 2048, 2048, S, E);
}

__device__ __forceinline__ void phase_final(const Ctx& C, const Params& P) {
    unsigned char* ws = P.ws;
    const float* ada = (const float*)(ws + WS_ADA); const float* gfin = P.in[26];
    const int* slot = (const int*)(ws + WS_SLOT); const unsigned char* ye = ws + WS_YE;
    const bf16_t* xm = (const bf16_t*)(ws + WS_XMID);
    constexpr int T = 4;
    const int RS = C.G * 8;
    u32x2 nx[T][4]; int ns[T];
#define PF_LD(t, r) do { ns[t] = -1; if ((r) < MX) { ns[t] = (C.lane < 16) ? slot[(size_t)(r) * 16 + C.lane] : -1; \
        _Pragma("unroll") for (int j = 0; j < 4; ++j) nx[t][j] = *(const u32x2*)(xm + (size_t)(r) * DM + 4 * C.lane + 256 * j); } } while (0)
#pragma unroll
    for (int t = 0; t < T; ++t) PF_LD(t, C.bid * 8 + C.wave + t * RS);
    f32x4 gf[4];
#pragma unroll
    for (int j = 0; j < 4; ++j) gf[j] = *(const f32x4*)(gfin + 4 * C.lane + 256 * j);
    for (int row0 = C.bid * 8 + C.wave; row0 < MX; row0 += T * RS) {
        int rowt[T], bt[T], sl[T]; bool has[T]; u32x2 xp[T][4]; f32x4 m[T][4]; unsigned long long em[T];
#pragma unroll
        for (int t = 0; t < T; ++t) { has[t] = row0 + t * RS < MX; rowt[t] = has[t] ? row0 + t * RS : row0; bt[t] = rowt[t] >> 12; sl[t] = has[t] ? ns[t] : -1;
            em[t] = __ballot(sl[t] >= 0) & 0xffffull;
#pragma unroll
            for (int j = 0; j < 4; ++j) { xp[t][j] = nx[t][j]; m[t][j] = (f32x4){0.f, 0.f, 0.f, 0.f}; } }
        while (em[0] | em[1] | em[2] | em[3]) {
            int w[T][4]; bool h[T];
#pragma unroll
            for (int t = 0; t < T; ++t) { h[t] = em[t] != 0; const int e0 = h[t] ? __builtin_ctzll(em[t]) : 0; if (h[t]) em[t] &= em[t] - 1;
                const int s0 = h[t] ? __builtin_amdgcn_readlane(sl[t], e0) : 0;
                const unsigned char* y0 = ye + ((size_t)e0 * 4096 + bt[t] * CAP + s0) * DM;
#pragma unroll
                for (int j = 0; j < 4; ++j) w[t][j] = *(const int*)(y0 + 4 * C.lane + 256 * j); }
#pragma unroll
            for (int t = 0; t < T; ++t) if (h[t]) {
#pragma unroll
                for (int j = 0; j < 4; ++j) { m[t][j][0] += __builtin_amdgcn_cvt_f32_fp8(w[t][j], 0); m[t][j][1] += __builtin_amdgcn_cvt_f32_fp8(w[t][j], 1); m[t][j][2] += __builtin_amdgcn_cvt_f32_fp8(w[t][j], 2); m[t][j][3] += __builtin_amdgcn_cvt_f32_fp8(w[t][j], 3); } }
        }
#pragma unroll
        for (int t = 0; t < T; ++t) PF_LD(t, row0 + (T + t) * RS);
#pragma unroll
        for (int t = 0; t < T; ++t) {
            f32x4 v[4]; float ss = 0.f;
#pragma unroll
            for (int j = 0; j < 4; ++j) { const int k = 4 * C.lane + 256 * j; const f32x4 g5 = *(const f32x4*)(ada + (size_t)bt[t] * 6144 + 5120 + k);
                const f32x4 xv = (f32x4){bflo(xp[t][j].x), bfhi(xp[t][j].x), bflo(xp[t][j].y), bfhi(xp[t][j].y)};
                v[j] = xv + g5 * m[t][j] * (1.f / 16.f); ss += v[j][0] * v[j][0] + v[j][1] * v[j][1] + v[j][2] * v[j][2] + v[j][3] * v[j][3]; }
            const float rstd = rsqrtf(wave_sum(ss) * (1.f / DM) + RMS_EPS);
            float* xr = P.out + (size_t)rowt[t] * DM;
            if (has[t]) {
#pragma unroll
                for (int j = 0; j < 4; ++j) { const int k = 4 * C.lane + 256 * j; *(f32x4*)(xr + k) = v[j] * rstd * gf[j]; } }
        }
    }
#undef PF_LD
}

constexpr int N_PHASES = 14;
__global__ void __launch_bounds__(NTHR, 2) mega(Params P) {
    extern __shared__ __attribute__((aligned(16))) unsigned char lds_raw[];
    Ctx C; C.lds = (LAS unsigned char*)lds_raw; C.tid = threadIdx.x; C.lane = C.tid & 63; C.wave = __builtin_amdgcn_readfirstlane(C.tid >> 6); C.bid = blockIdx.x; C.G = gridDim.x;
    unsigned char* ws = P.ws;
    if (C.tid < 32) ((LAS unsigned*)(C.lds + LDS_MISC))[C.tid] = 0u;
    __syncthreads();
    XcdBarrier bar = xcd_barrier_post((unsigned*)(ws + WS_CTL), (volatile LAS unsigned*)(C.lds + LDS_MISC));
#define IN(k) (lo <= (k) && (k) < hi)
#define SEAM(k) do { if (IN(k) && IN((k) + 1)) { xcd_barrier(bar); if ((REPEAT >> 23) & 1u) xcd_barrier(bar); } } while (0)
#define RUN(id, ...) do { { constexpr bool rep = false; (void)rep; __VA_ARGS__; } if ((REPEAT >> (id)) & 1u) { xcd_barrier(bar); { constexpr bool rep = true; (void)rep; __VA_ARGS__; } } } while (0)
#define PHASE_PROGRAM(LO, HI) do { const int lo = (LO), hi = (HI); \
    if (IN(0)) RUN(0, phase0(C, P)); \
    SEAM(0); \
    if (IN(1)) RUN(1, phase1(C, P)); \
    SEAM(1); \
    if (IN(2)) { \
        RUN(2, phase2a(C, P, rep && ((REPEAT >> 25) & 1u))); \
        RUN(3, phase2g(C, P)); \
        phase2kv(C, P); \
        if (C.G != 256) mlstm_gate_scans(C, P, C.bid * 8 + C.wave, C.G * 8); else if (C.bid >= 32) { mlstm_gate_scans(C, P, (C.bid - 32) * 8 + C.wave, 224 * 8); __syncthreads(); \
            cvt8_stream((C.bid - 32) * 8 + C.wave, W13_T2, 224 * 8, (LAS float*)(C.lds + C.wave * 8448), C.lane, [&](int it, Cvt8& d) { cvt8_expert_item(P, it, d); }); } \
    } \
    SEAM(2); \
    if (IN(3)) RUN(5, mlstm_prep(C, P)); \
    SEAM(3); \
    if (IN(4)) RUN(4, mixer_phase<rep ? (int)((REPEAT >> 25) & 3u) : 0>(C, P, bar.bar)); \
    SEAM(4); \
    if (IN(5)) { \
        RUN(9, transpose_z2(C, P)); \
        RUN(8, mlstm_combine(C, P)); \
    } \
    SEAM(5); \
    if (IN(6)) RUN(10, phase_merge(C, P)); \
    SEAM(6); \
    if (IN(7)) RUN(11, phase_outproj(C, P)); \
    SEAM(7); \
    if (IN(8)) RUN(12, phase6<rep ? (int)((REPEAT >> 25) & 3u) : 0>(C, P)); \
    SEAM(8); \
    if (IN(9)) { \
        RUN(13, for (int it = C.bid; it < BATCH * NE; it += C.G) topk_item(C, P, it)); \
        __syncthreads(); \
        RUN(14, convert_experts(C, P)); \
    } \
    SEAM(9); \
    if (IN(11)) RUN(16, moe_gemm1(C, P, rep ? (int)((REPEAT >> 25) & 3u) : 0)); \
    SEAM(11); \
    if (IN(12)) RUN(17, moe_gemm2(C, P, rep && ((REPEAT >> 25) & 1u))); \
    SEAM(12); \
    if (IN(13)) phase_final(C, P); \
} while (0)
    PHASE_PROGRAM(P.ph_lo, P.ph_hi);
#undef PHASE_PROGRAM
#undef IN
#undef SEAM
#undef RUN
}

extern "C" void kernel_launch(void* const* d_in, const int* in_sizes, int n_in, void* d_out, int out_size, void* d_ws, size_t ws_size, hipStream_t stream) {
    static int grid = 0;
    if (grid == 0) {
        if (n_in != 27 || out_size != MX * DM || ws_size < WS_END) { fprintf(stderr, "kernel_launch: unexpected shapes (n_in %d, out %d, ws %zu < %zu)\n", n_in, out_size, ws_size, (size_t)WS_END); grid = -1; return; }
        int dev = 0, cus = 0, per_cu = 0;
        hipGetDevice(&dev);
        hipDeviceGetAttribute(&cus, hipDeviceAttributeMultiprocessorCount, dev);
        if (hipFuncSetAttribute((const void*)mega, hipFuncAttributeMaxDynamicSharedMemorySize, LDS_BYTES) != hipSuccess) { fprintf(stderr, "kernel_launch: hipFuncSetAttribute failed\n"); grid = -1; return; }
        if (hipOccupancyMaxActiveBlocksPerMultiprocessor(&per_cu, (const void*)mega, NTHR, LDS_BYTES) != hipSuccess || per_cu < 1) { fprintf(stderr, "kernel_launch: occupancy query says %d\n", per_cu); per_cu = 1; }
        (void)hipGetLastError();
        grid = cus * 1;
        if (grid <= 0) grid = 256;
    }
    if (grid < 0) return;
    Params p; memset(&p, 0, sizeof(p));
    for (int i = 0; i < 27; ++i) p.in[i] = (const float*)d_in[i];
    p.out = (float*)d_out; p.ws = (unsigned char*)d_ws;
    (void)hipMemsetAsync((unsigned char*)d_ws + WS_CTL, 0, CTL_WORDS * 4, stream);
#if N_LAUNCH_MODE == 1
    if (PREFIX > 0) {
        p.ph_lo = 0; p.ph_hi = PREFIX;
        void* pargs[] = {&p};
        (void)hipLaunchCooperativeKernel((const void*)mega, dim3(grid), dim3(NTHR), pargs, LDS_BYTES, stream);
        (void)hipMemsetAsync((unsigned char*)d_ws + WS_CTL, 0, CTL_WORDS * 4, stream);
    }
    p.ph_lo = 0; p.ph_hi = N_PHASES;
    void* args[] = {&p};
    hipError_t e = hipLaunchCooperativeKernel((const void*)mega, dim3(grid), dim3(NTHR), args, LDS_BYTES, stream);
    if (e != hipSuccess) fprintf(stderr, "kernel_launch: cooperative launch failed: %s (grid %d)\n", hipGetErrorString(e), grid);
#else
    for (int ph = 0; ph < N_PHASES; ++ph) {
        p.ph_lo = ph; p.ph_hi = ph + 1;
        void* args[] = {&p};
        hipError_t e = hipLaunchCooperativeKernel((const void*)mega, dim3(grid), dim3(NTHR), args, LDS_BYTES, stream);
        if (e != hipSuccess) { fprintf(stderr, "kernel_launch: launch %d failed: %s (grid %d)\n", ph, hipGetErrorString(e), grid); break; }
    }
#endif
}
```
